# Optimizing an MI355X kernel written in HIP

```python
import math
import jax, jax.numpy as jnp
from jax import lax
import numpy as np

D_MODEL = 1024
BATCH = 4
SEQ = 8192
DEPTH = 2

GRID_W = 64
CTX_LEN = 256
A_HEADS = 4
A_HEAD_DIM = 64
A_WIDTH = A_HEADS * 2 * A_HEAD_DIM
B_HEADS = 8
B_HEAD_DIM = 64
B_WIDTH = B_HEADS * B_HEAD_DIM
NA_ROWS = 8
NA_COLS = 16
C_HEADS = 8
C_NOPE = 64
C_ROPE = 32
C_VDIM = 64
C_Q_RANK = 384
C_KV_RANK = 256
C_WIDTH = C_HEADS * C_VDIM
N_BRANCH = 3
IN_SIZES = (A_WIDTH, A_WIDTH, A_WIDTH, B_WIDTH, B_WIDTH, B_WIDTH, C_Q_RANK, C_KV_RANK, C_ROPE, N_BRANCH * D_MODEL)
IN_SPLITS = tuple(sum(IN_SIZES[:i + 1]) for i in range(len(IN_SIZES) - 1))
D_IN = sum(IN_SIZES)
N_EXPERTS = 32
TOP_K = 4
D_FF = D_MODEL
SWIGLU_LIMIT = 7.0
SWIGLU_ALPHA = 1.702
N_MOD = 6
ROPE_BASE = 10000.0
EPS = 1e-6
NEG_INF = -1e30
Q_BLOCK = 128
E_BLOCK = 128

kernel_name = 'hybrid_diffusion_trunk_ctx_prefix'


def rmsnorm(x, g):
    xf = x.astype(jnp.float32)
    y = xf * lax.rsqrt(jnp.mean(xf * xf, axis=-1, keepdims=True) + EPS)
    return (y * g.astype(jnp.float32)).astype(x.dtype)


def modulate(x, g, shift, scale):
    return rmsnorm(x, g) * (1.0 + scale) + shift


def axial_tables(n, rot_dim, dtype):
    pos = jnp.arange(n, dtype=jnp.int32)
    rows = (pos // GRID_W).astype(jnp.float32)
    cols = (pos % GRID_W).astype(jnp.float32)
    n_freq = rot_dim // 4
    inv = ROPE_BASE ** (-jnp.arange(n_freq, dtype=jnp.float32) / n_freq)
    ang = jnp.concatenate([rows[:, None] * inv, cols[:, None] * inv], axis=-1)
    return jnp.cos(ang).astype(dtype), jnp.sin(ang).astype(dtype)


def rope_axial(x, cos, sin):
    d = x.shape[-1]
    qd = d // 4
    shape = (x.shape[1],) + (1,) * (x.ndim - 3) + (2 * qd,)
    cos = cos.reshape(shape)
    sin = sin.reshape(shape)

    def rot(h, cs, sn):
        a, b = h[..., :qd], h[..., qd:]
        return jnp.concatenate([a * cs - b * sn, b * cs + a * sn], axis=-1)

    return jnp.concatenate([rot(x[..., :2 * qd], cos[..., :qd], sin[..., :qd]),
                            rot(x[..., 2 * qd:], cos[..., qd:], sin[..., qd:])], axis=-1)


def blocked_attention(q, k, v, scale):
    bsz, nq, nh, dk = q.shape
    qb = min(Q_BLOCK, nq)
    q_blocks = jnp.moveaxis(q.reshape(bsz, nq // qb, qb, nh, dk), 1, 0)

    def one(qblk):
        s = jnp.einsum('bqhd,bkhd->bhqk', qblk, k).astype(jnp.float32) * scale
        p = jax.nn.softmax(s, axis=-1).astype(v.dtype)
        return jnp.einsum('bhqk,bkhe->bqhe', p, v)

    out = lax.map(one, q_blocks)
    return jnp.moveaxis(out, 0, 1).reshape(bsz, nq, nh, v.shape[-1])


def blocked_diff_attention(q, k, v, lam, scale):
    bsz, nq = q.shape[0], q.shape[1]
    qb = min(Q_BLOCK, nq)
    q_blocks = jnp.moveaxis(q.reshape((bsz, nq // qb, qb) + q.shape[2:]), 1, 0)

    def one(qblk):
        s = jnp.einsum('bqhcd,bkhcd->bhcqk', qblk, k).astype(jnp.float32) * scale
        p = jax.nn.softmax(s, axis=-1)
        a = (p[:, :, 0] - lam * p[:, :, 1]).astype(v.dtype)
        return jnp.einsum('bhqk,bkhe->bqhe', a, v)

    out = lax.map(one, q_blocks)
    return jnp.moveaxis(out, 0, 1).reshape((bsz, nq) + v.shape[2:])


def neighbourhood_attention(q, k, v, k_ctx, v_ctx, rpb):
    bsz, n, nh, d = q.shape
    rows = n // GRID_W
    win_r = min(NA_ROWS, rows)
    scale = d ** -0.5
    qg = q.reshape(bsz, rows, GRID_W, nh, d)
    kg = k.reshape(bsz, rows, GRID_W, nh, d)
    vg = v.reshape(bsz, rows, GRID_W, nh, d)
    r_idx = jnp.arange(rows, dtype=jnp.int32)
    row_start = jnp.clip(r_idx - NA_ROWS // 2, 0, rows - win_r)
    c_idx = jnp.arange(GRID_W, dtype=jnp.int32)
    col_start = jnp.clip(c_idx - NA_COLS // 2, 0, GRID_W - NA_COLS)
    col_mask = (c_idx[None, :] >= col_start[:, None]) & (c_idx[None, :] < col_start[:, None] + NA_COLS)
    col_bias_idx = jnp.clip(c_idx[None, :] - c_idx[:, None] + NA_COLS - 1, 0, 2 * NA_COLS - 2)
    rpb_c = rpb[:, :, col_bias_idx]
    n_lat = win_r * GRID_W

    def one(args):
        q_r, r, rs = args
        k_blk = lax.dynamic_slice_in_dim(kg, rs, win_r, axis=1)
        v_blk = lax.dynamic_slice_in_dim(vg, rs, win_r, axis=1)
        bias = jnp.take(rpb_c, rs + jnp.arange(win_r) - r + NA_ROWS - 1, axis=1)
        s = jnp.einsum('bqhd,bikhd->bhqik', q_r, k_blk).astype(jnp.float32) * scale
        s = s + jnp.transpose(bias, (0, 2, 1, 3))[None].astype(jnp.float32)
        s = jnp.where(col_mask[:, None, :], s, NEG_INF)
        s_ctx = jnp.einsum('bqhd,bkhd->bhqk', q_r, k_ctx).astype(jnp.float32) * scale
        s_all = jnp.concatenate([s.reshape(bsz, nh, GRID_W, n_lat), s_ctx], axis=-1)
        p = jax.nn.softmax(s_all, axis=-1).astype(v.dtype)
        p_lat = p[..., :n_lat].reshape(bsz, nh, GRID_W, win_r, GRID_W)
        return (jnp.einsum('bhqik,bikhe->bqhe', p_lat, v_blk)
                + jnp.einsum('bhqk,bkhe->bqhe', p[..., n_lat:], v_ctx))

    out = lax.map(one, (jnp.moveaxis(qg, 1, 0), r_idx, row_start))
    return jnp.moveaxis(out, 0, 1).reshape(bsz, n, nh, d)


def diff_qkv(qa, ka, va, rope):
    q = qa.reshape(qa.shape[:-1] + (A_HEADS, 2, A_HEAD_DIM))
    k = ka.reshape(ka.shape[:-1] + (A_HEADS, 2, A_HEAD_DIM))
    v = va.reshape(va.shape[:-1] + (A_HEADS, 2 * A_HEAD_DIM))
    if rope is not None:
        q = rope_axial(q, *rope)
        k = rope_axial(k, *rope)
    return q, k, v


def diff_post(o, g_subln, lam_init):
    o = rmsnorm(o, g_subln) * (1.0 - lam_init)
    return o.reshape(o.shape[:-2] + (A_WIDTH,))


def heads(t, nh):
    return t.reshape(t.shape[:-1] + (nh, t.shape[-1] // nh))


def mla_qkv(q_lat, kv_lat, k_rope, g_q_a, w_q_b, g_kv_a, w_kv_b, rope):
    q = heads(rmsnorm(q_lat, g_q_a) @ w_q_b, C_HEADS)
    kv = heads(rmsnorm(kv_lat, g_kv_a) @ w_kv_b, C_HEADS)
    q_nope, q_pe = q[..., :C_NOPE], q[..., C_NOPE:]
    k_nope, v = kv[..., :C_NOPE], kv[..., C_NOPE:]
    k_pe = k_rope[:, :, None, :]
    if rope is not None:
        q_pe = rope_axial(q_pe, *rope)
        k_pe = rope_axial(k_pe, *rope)
    k_pe = jnp.broadcast_to(k_pe, k_nope.shape[:-1] + (C_ROPE,))
    return (jnp.concatenate([q_nope, q_pe], axis=-1), jnp.concatenate([k_nope, k_pe], axis=-1), v)


def merge_branches(ya, yb, yc, gates, w_br_a, w_br_b, w_br_c, w_out):
    g = jax.nn.sigmoid(gates.astype(jnp.float32)).astype(ya.dtype)
    g = g.reshape(g.shape[:-1] + (N_BRANCH, D_MODEL))
    m = g[..., 0, :] * (ya @ w_br_a) + g[..., 1, :] * (yb @ w_br_b) + g[..., 2, :] * (yc @ w_br_c)
    return m @ w_out


def moe_ffn(h, w_router, b_router, w_gate_up, b_gate_up, w_down, b_down):
    shp = h.shape
    ht = h.reshape(-1, shp[-1])
    n_tok = ht.shape[0]
    logits = (ht @ w_router).astype(jnp.float32) + b_router.astype(jnp.float32)
    top_val, top_idx = lax.top_k(logits, TOP_K)
    gate_w = jax.nn.softmax(top_val, axis=-1)
    m = n_tok * TOP_K
    flat_e = top_idx.reshape(m)
    flat_t = jnp.repeat(jnp.arange(n_tok, dtype=jnp.int32), TOP_K)
    order = jnp.argsort(flat_e)
    e_s, t_s, w_s = flat_e[order], flat_t[order], gate_w.reshape(m)[order]
    counts = jnp.zeros((N_EXPERTS,), jnp.int32).at[flat_e].add(1)
    start = jnp.cumsum(counts) - counts
    padded = ((counts + E_BLOCK - 1) // E_BLOCK) * E_BLOCK
    pend = jnp.cumsum(padded)
    pstart = pend - padded
    dest = pstart[e_s] + jnp.arange(m, dtype=jnp.int32) - start[e_s]
    n_blk = -(-m // E_BLOCK) + N_EXPERTS
    n_rows = n_blk * E_BLOCK
    buf_t = jnp.full((n_rows,), n_tok, jnp.int32).at[dest].set(t_s)
    buf_w = jnp.zeros((n_rows,), jnp.float32).at[dest].set(w_s)
    blk_e = jnp.clip(jnp.searchsorted(pend, jnp.arange(n_blk, dtype=jnp.int32) * E_BLOCK, side='right'), 0, N_EXPERTS - 1)
    x_pad = jnp.concatenate([ht, jnp.zeros((1, ht.shape[-1]), ht.dtype)], axis=0)

    def expert_block(args):
        tok, e = args
        gu = x_pad[tok] @ w_gate_up[e] + b_gate_up[e]
        gate = jnp.minimum(gu[:, 0::2], SWIGLU_LIMIT)
        up = jnp.clip(gu[:, 1::2], -SWIGLU_LIMIT, SWIGLU_LIMIT)
        act = (up + 1.0) * (gate * jax.nn.sigmoid(SWIGLU_ALPHA * gate))
        return act @ w_down[e] + b_down[e]

    y = lax.map(expert_block, (buf_t.reshape(n_blk, E_BLOCK), blk_e)).reshape(n_rows, -1)
    out = jax.ops.segment_sum(y * buf_w[:, None].astype(y.dtype), buf_t, num_segments=n_tok + 1)[:n_tok]
    return out.reshape(shp)


def setup_inputs(seed: int = 0) -> dict:
    key = jax.random.key(seed)
    ks = jax.random.split(key, 30)
    f32 = jnp.float32

    def nrm(k, shape, scale):
        return jax.random.normal(k, shape, f32) * scale

    def gain(k, shape):
        return 1.0 + 0.05 * jax.random.normal(k, shape, f32)

    L = DEPTH
    return {
        'x': nrm(ks[0], (BATCH, SEQ, D_MODEL), 1.0),
        'c': nrm(ks[1], (BATCH, D_MODEL), 1.0),
        'ctx': nrm(ks[2], (BATCH, CTX_LEN, D_MODEL), 1.0),
        'c_ctx': nrm(ks[3], (D_MODEL,), 1.0),
        'w_mod': nrm(ks[4], (L, D_MODEL, N_MOD * D_MODEL), 0.5 * D_MODEL ** -0.5),
        'b_mod': nrm(ks[5], (L, N_MOD * D_MODEL), 0.01),
        'g_mix': gain(ks[6], (L, D_MODEL)),
        'w_in': nrm(ks[7], (L, D_MODEL, D_IN), D_MODEL ** -0.5),
        'lam_q1': nrm(ks[8], (L, A_HEAD_DIM), 0.1),
        'lam_k1': nrm(ks[9], (L, A_HEAD_DIM), 0.1),
        'lam_q2': nrm(ks[10], (L, A_HEAD_DIM), 0.1),
        'lam_k2': nrm(ks[11], (L, A_HEAD_DIM), 0.1),
        'g_subln': gain(ks[12], (L, 2 * A_HEAD_DIM)),
        'rpb': nrm(ks[13], (L, B_HEADS, 2 * NA_ROWS - 1, 2 * NA_COLS - 1), 0.1),
        'g_q_a': gain(ks[14], (L, C_Q_RANK)),
        'w_q_b': nrm(ks[15], (L, C_Q_RANK, C_HEADS * (C_NOPE + C_ROPE)), C_Q_RANK ** -0.5),
        'g_kv_a': gain(ks[16], (L, C_KV_RANK)),
        'w_kv_b': nrm(ks[17], (L, C_KV_RANK, C_HEADS * (C_NOPE + C_VDIM)), C_KV_RANK ** -0.5),
        'w_br_a': nrm(ks[18], (L, A_WIDTH, D_MODEL), A_WIDTH ** -0.5),
        'w_br_b': nrm(ks[19], (L, B_WIDTH, D_MODEL), B_WIDTH ** -0.5),
        'w_br_c': nrm(ks[20], (L, C_WIDTH, D_MODEL), C_WIDTH ** -0.5),
        'w_out': nrm(ks[21], (L, D_MODEL, D_MODEL), D_MODEL ** -0.5),
        'g_ffn': gain(ks[22], (L, D_MODEL)),
        'w_router': nrm(ks[23], (L, D_MODEL, N_EXPERTS), D_MODEL ** -0.5),
        'b_router': nrm(ks[24], (L, N_EXPERTS), 0.01),
        'w_gate_up': nrm(ks[25], (L, N_EXPERTS, D_MODEL, 2 * D_FF), D_MODEL ** -0.5),
        'b_gate_up': nrm(ks[26], (L, N_EXPERTS, 2 * D_FF), 0.01),
        'w_down': nrm(ks[27], (L, N_EXPERTS, D_FF, D_MODEL), D_FF ** -0.5),
        'b_down': nrm(ks[28], (L, N_EXPERTS, D_MODEL), 0.01),
        'g_final': gain(ks[29], (D_MODEL,)),
    }


def reference(x, c, ctx, c_ctx, w_mod, b_mod, g_mix, w_in, lam_q1, lam_k1, lam_q2, lam_k2, g_subln, rpb,
              g_q_a, w_q_b, g_kv_a, w_kv_b, w_br_a, w_br_b, w_br_c, w_out, g_ffn, w_router, b_router,
              w_gate_up, b_gate_up, w_down, b_down, g_final):
    n = x.shape[1]
    rope_a = axial_tables(n, A_HEAD_DIM, x.dtype)
    rope_c = axial_tables(n, C_ROPE, x.dtype)
    scale_a = A_HEAD_DIM ** -0.5
    scale_b = B_HEAD_DIM ** -0.5
    scale_c = (C_NOPE + C_ROPE) ** -0.5
    xc = ctx
    for l in range(DEPTH):
        last = l == DEPTH - 1
        lam_init = 0.8 - 0.6 * math.exp(-0.3 * l)
        lam = (jnp.exp(jnp.sum(lam_q1[l].astype(jnp.float32) * lam_k1[l].astype(jnp.float32)))
               - jnp.exp(jnp.sum(lam_q2[l].astype(jnp.float32) * lam_k2[l].astype(jnp.float32))) + lam_init)
        mod = (jax.nn.silu(c) @ w_mod[l] + b_mod[l])[:, None, :]
        mod_c = jax.nn.silu(c_ctx) @ w_mod[l] + b_mod[l]
        sh1, sc1, gt1, sh2, sc2, gt2 = jnp.split(mod, N_MOD, axis=-1)
        csh1, csc1, cgt1, csh2, csc2, cgt2 = jnp.split(mod_c, N_MOD, axis=-1)
        h = modulate(x, g_mix[l], sh1, sc1)
        hc = modulate(xc, g_mix[l], csh1, csc1)
        qa, ka, va, qb, kb, vb, cq, ckv, ckr, gates = jnp.split(h @ w_in[l], IN_SPLITS, axis=-1)
        qa_c, ka_c, va_c, qb_c, kb_c, vb_c, cq_c, ckv_c, ckr_c, gates_c = jnp.split(hc @ w_in[l], IN_SPLITS, axis=-1)
        qA, kA, vA = diff_qkv(qa, ka, va, rope_a)
        qAc, kAc, vAc = diff_qkv(qa_c, ka_c, va_c, None)
        oA = blocked_diff_attention(qA, jnp.concatenate([kA, kAc], axis=1), jnp.concatenate([vA, vAc], axis=1), lam, scale_a)
        qB, kB, vB = heads(qb, B_HEADS), heads(kb, B_HEADS), heads(vb, B_HEADS)
        qBc, kBc, vBc = heads(qb_c, B_HEADS), heads(kb_c, B_HEADS), heads(vb_c, B_HEADS)
        oB = neighbourhood_attention(qB, kB, vB, kBc, vBc, rpb[l])
        qC, kC, vC = mla_qkv(cq, ckv, ckr, g_q_a[l], w_q_b[l], g_kv_a[l], w_kv_b[l], rope_c)
        qCc, kCc, vCc = mla_qkv(cq_c, ckv_c, ckr_c, g_q_a[l], w_q_b[l], g_kv_a[l], w_kv_b[l], None)
        oC = blocked_attention(qC, jnp.concatenate([kC, kCc], axis=1), jnp.concatenate([vC, vCc], axis=1), scale_c)
        y = merge_branches(diff_post(oA, g_subln[l], lam_init), oB.reshape(oB.shape[:2] + (B_WIDTH,)),
                           oC.reshape(oC.shape[:2] + (C_WIDTH,)), gates, w_br_a[l], w_br_b[l], w_br_c[l], w_out[l])
        x = x + gt1 * y
        x = x + gt2 * moe_ffn(modulate(x, g_ffn[l], sh2, sc2), w_router[l], b_router[l],
                              w_gate_up[l], b_gate_up[l], w_down[l], b_down[l])
        if not last:
            oAc = blocked_diff_attention(qAc, kAc, vAc, lam, scale_a)
            oBc = blocked_attention(qBc, kBc, vBc, scale_b)
            oCc = blocked_attention(qCc, kCc, vCc, scale_c)
            yc = merge_branches(diff_post(oAc, g_subln[l], lam_init), oBc.reshape(oBc.shape[:2] + (B_WIDTH,)),
                                oCc.reshape(oCc.shape[:2] + (C_WIDTH,)), gates_c, w_br_a[l], w_br_b[l], w_br_c[l], w_out[l])
            xc = xc + cgt1 * yc
            xc = xc + cgt2 * moe_ffn(modulate(xc, g_ffn[l], csh2, csc2), w_router[l], b_router[l],
                                     w_gate_up[l], b_gate_up[l], w_down[l], b_down[l])
    return rmsnorm(x, g_final)
```

```cpp
#include <hip/hip_runtime.h>
#include <cstdio>
#include <cstdint>

#ifndef MK_ONE_LAUNCH
#define MK_ONE_LAUNCH 0
#endif
#ifndef DBG_CHECK
#define DBG_CHECK 0
#endif

#ifndef DBG_LAST_PHASE
#define DBG_LAST_PHASE 9999
#endif
namespace pg8 {
#define PG8_LAS __attribute__((address_space(3)))
typedef unsigned short bf16_t;
typedef short bf16x8 __attribute__((ext_vector_type(8)));
typedef float f32x4 __attribute__((ext_vector_type(4)));
typedef unsigned u32x4 __attribute__((ext_vector_type(4)));
constexpr int BM = 256, BK = 64, HALF = 128, HTB = HALF * BK * 2  , STAGE_BYTES = 8 * HTB, NXCD = 8, WGM = 8;

__host__ __device__ __forceinline__ int lds_byte(int r, int c) { const int st = (r >> 4) * 2 + (c >> 5), rr = r & 15, cc = c & 31, ob = rr * 64 + cc * 2; return st * 1024 + (ob ^ (((ob >> 9) & 1) << 5)); }
__host__ __device__ __forceinline__ void stage_rc(int b, int& R, int& C) { const int st = b / 1024, sb = b % 1024, swz = sb ^ (((sb >> 9) & 1) << 5); R = (st >> 1) * 16 + swz / 64; C = (st & 1) * 32 + (swz % 64) / 2; }
__host__ __device__ __forceinline__ int perm32(int rho) { const int n = rho >> 4, i = rho & 15; return 8 * (i >> 2) + 4 * n + (i & 3); }

struct Unit { int pm, pn; };
struct Gemm { const bf16_t* A; const bf16_t* Bt; int M, N, K; };

struct StaticOrder {
    int nM, nN, nwg, G, c;
    __host__ __device__ void init(int M, int N, int G_, int c_) { nM = M / BM; nN = N / BM; nwg = nM * nN; G = G_; c = c_; }
    __host__ __device__ bool next(int i, Unit& u) const {
        const long L = (long)i * G + c; if (L >= nwg) return false;
        int wgid = (int)L; { const int q = nwg / NXCD, r = nwg % NXCD, xcd = wgid % NXCD, off = wgid / NXCD; wgid = (xcd < r ? xcd * (q + 1) : r * (q + 1) + (xcd - r) * q) + off; }
        const int nig = WGM * nN, gid = wgid / nig, fm = gid * WGM, gsz = (nM - fm) < WGM ? (nM - fm) : WGM;
        u.pm = fm + ((wgid % nig) % gsz); u.pn = (wgid % nig) / gsz; return true;
    }
    __device__ __forceinline__ void a_ready(const Unit&) const {}
    __device__ __forceinline__ void done(const Unit&) const {}
};


constexpr int DM = 1024, NBATCH = 4, SEQ = 8192, NLAT = NBATCH * SEQ, CTXL = 256, NCTX = NBATCH * CTXL, MTOT = NLAT + NCTX;
constexpr int DEPTH = 2, DIN = 6816, NINP = 6912, NEXP = 32, TOPK = 4;
constexpr int PM_CTX = NLAT / 256;
constexpr float LOG2E = 1.4426950408889634f;
constexpr float QSCALE_AB = 0.125f * LOG2E;
constexpr float QSCALE_C = 0.10206207261596575f * LOG2E;
constexpr float EPS = 1e-6f;
constexpr int OFF_CQ = 3072, OFF_CKR = 3456, OFF_PADW = 3488, OFF_CKV = 3584, OFF_GATES = 3840;

typedef float f32x2 __attribute__((ext_vector_type(2)));
__device__ __forceinline__ unsigned cvt_pk_bf16(float lo, float hi) { unsigned r; asm volatile("v_cvt_pk_bf16_f32 %0, %1, %2" : "=v"(r) : "v"(lo), "v"(hi)); return r; }
__device__ __forceinline__ u32x4 pack8(const f32x4 a, const f32x4 b) { u32x4 w; w.x = cvt_pk_bf16(a[0], a[1]); w.y = cvt_pk_bf16(a[2], a[3]); w.z = cvt_pk_bf16(b[0], b[1]); w.w = cvt_pk_bf16(b[2], b[3]); return w; }
__device__ __forceinline__ float bf_lo(unsigned w) { return __uint_as_float(w << 16); }
__device__ __forceinline__ float bf_hi(unsigned w) { return __uint_as_float(w & 0xffff0000u); }
__device__ __forceinline__ void rope8(f32x4& v0, f32x4& v1, const f32x4 cs0, const f32x4 cs1) {
    const f32x4 r0 = (f32x4){v0[0] * cs0[0] - v0[1] * cs0[1], v0[1] * cs0[0] + v0[0] * cs0[1], v0[2] * cs0[2] - v0[3] * cs0[3], v0[3] * cs0[2] + v0[2] * cs0[3]};
    const f32x4 r1 = (f32x4){v1[0] * cs1[0] - v1[1] * cs1[1], v1[1] * cs1[0] + v1[0] * cs1[1], v1[2] * cs1[2] - v1[3] * cs1[3], v1[3] * cs1[2] + v1[2] * cs1[3]};
    v0 = r0; v1 = r1;
}
__device__ __forceinline__ float sigmoidf_(float x) { return __builtin_amdgcn_rcpf(1.0f + __builtin_amdgcn_exp2f(-x * LOG2E)); }

struct EpiIn {
    static constexpr bool PERM = true, AFTER_DRAIN = false;
    bf16_t *QA, *KA, *VA, *QB, *KB, *VB, *CQ, *CKR, *CKV, *GATES; float *ssq_q, *ssq_kv; const float* tabA; const float* tabC;
    __device__ __forceinline__ void operator()(const f32x4 (&acc)[2][2][4][2], const Unit& u, int wr, int wc, int fr, int fq) const {
        asm volatile("" : "+v"(fr), "+v"(fq));
        const int pn = u.pn; const bool ctx = u.pm >= PM_CTX;
        const int row0 = u.pm * BM + wr * 64 + fr;
        if (pn < 12) {
            const int seg = pn >> 1; bf16_t* base = seg == 0 ? QA : seg == 1 ? KA : seg == 2 ? VA : seg == 3 ? QB : seg == 4 ? KB : VB;
            const float sc = (seg == 0 || seg == 3) ? QSCALE_AB : 1.0f; const bool rope = (seg <= 1) && !ctx;
            const int col0 = (pn & 1) * 256 + wc * 32 + 8 * fq;
#pragma unroll
            for (int ai = 0; ai < 2; ++ai) {
                const int gr = ((u.pm * 4 + ai * 2 + wr) & 127);
#pragma unroll
                for (int m = 0; m < 4; ++m) {
                    const int row = row0 + ai * HALF + m * 16; bf16_t* rowp = base + (size_t)row * 512 + col0;
                    f32x4 cs0 = (f32x4){1.f, 0.f, 1.f, 0.f}, cs1 = cs0;
                    if (rope) { const int trow = (wc & 1) ? 128 + m * 16 + fr : gr; const f32x4* tp = (const f32x4*)(tabA + (size_t)(trow * 16 + 4 * fq) * 2); cs0 = tp[0]; cs1 = tp[1]; }
#pragma unroll
                    for (int bj = 0; bj < 2; ++bj) { f32x4 v0 = acc[ai][bj][m][0] * sc, v1 = acc[ai][bj][m][1] * sc; rope8(v0, v1, cs0, cs1); *(u32x4*)(rowp + bj * HALF) = pack8(v0, v1); }
                }
            }
        } else if (pn == 12 || pn == 14) {
            bf16_t* base = pn == 12 ? CQ : CKV; const int ld = pn == 12 ? 384 : 256; float* ssq = pn == 12 ? ssq_q : ssq_kv; const int sst = pn == 12 ? 8 : 4;
            const int col0 = wc * 32 + 8 * fq;
#pragma unroll
            for (int ai = 0; ai < 2; ++ai)
#pragma unroll
                for (int m = 0; m < 4; ++m) {
                    const int row = row0 + ai * HALF + m * 16; bf16_t* rowp = base + (size_t)row * ld + col0; float s = 0.f;
#pragma unroll
                    for (int bj = 0; bj < 2; ++bj) { const f32x4 v0 = acc[ai][bj][m][0], v1 = acc[ai][bj][m][1]; *(u32x4*)(rowp + bj * HALF) = pack8(v0, v1);
                        s += (v0[0] * v0[0] + v0[1] * v0[1]) + (v0[2] * v0[2] + v0[3] * v0[3]) + (v1[0] * v1[0] + v1[1] * v1[1]) + (v1[2] * v1[2] + v1[3] * v1[3]); }
                    s += __shfl_xor(s, 16); s += __shfl_xor(s, 32);
                    if (fq == 0) ssq[(size_t)row * sst + wc] = s;
                }
        } else if (pn == 13) {
#pragma unroll
            for (int ai = 0; ai < 2; ++ai) {
                const int gr = ((u.pm * 4 + ai * 2 + wr) & 127);
#pragma unroll
                for (int m = 0; m < 4; ++m) {
                    const int row = row0 + ai * HALF + m * 16;
                    { const f32x4 v0 = acc[ai][0][m][0], v1 = acc[ai][0][m][1]; *(u32x4*)(CQ + (size_t)row * 384 + 256 + wc * 32 + 8 * fq) = pack8(v0, v1);
                      float s = (v0[0] * v0[0] + v0[1] * v0[1]) + (v0[2] * v0[2] + v0[3] * v0[3]) + (v1[0] * v1[0] + v1[1] * v1[1]) + (v1[2] * v1[2] + v1[3] * v1[3]);
                      s += __shfl_xor(s, 16); s += __shfl_xor(s, 32); if (fq == 0) ssq_q[(size_t)row * 8 + 4 + wc] = s; }
                    if (wc == 0) {
                        f32x4 v0 = acc[ai][1][m][0], v1 = acc[ai][1][m][1];
                        if (!ctx) { const int trow = (fq >= 2) ? 128 + m * 16 + fr : gr; const f32x4* tp = (const f32x4*)(tabC + (size_t)(trow * 8 + 4 * (fq & 1)) * 2); rope8(v0, v1, tp[0], tp[1]); }
                        *(u32x4*)(CKR + (size_t)row * 32 + 8 * fq) = pack8(v0, v1);
                    }
                }
            }
        } else {
            const int col0 = (pn - 15) * 256 + wc * 32 + 8 * fq;
#pragma unroll
            for (int ai = 0; ai < 2; ++ai)
#pragma unroll
                for (int m = 0; m < 4; ++m) {
                    const int row = row0 + ai * HALF + m * 16; bf16_t* rowp = GATES + (size_t)row * 3072 + col0;
#pragma unroll
                    for (int bj = 0; bj < 2; ++bj) { f32x4 v0 = acc[ai][bj][m][0], v1 = acc[ai][bj][m][1];
#pragma unroll
                        for (int j = 0; j < 4; ++j) { v0[j] = sigmoidf_(v0[j]); v1[j] = sigmoidf_(v1[j]); }
                        *(u32x4*)(rowp + bj * HALF) = pack8(v0, v1); }
                }
        }
    }
};
struct EpiQ {
    static constexpr bool PERM = true, AFTER_DRAIN = false;
    bf16_t* QC; const float* ssq_q; const float* tabC;
    __device__ __forceinline__ void operator()(const f32x4 (&acc)[2][2][4][2], const Unit& u, int wr, int wc, int fr, int fq) const {
        asm volatile("" : "+v"(fr), "+v"(fq));
        const bool ctx = u.pm >= PM_CTX; const int row0 = u.pm * BM + wr * 64 + fr;
        const int cA = u.pn * BM + wc * 32 + 8 * fq, cB = cA + HALF, pA = cA % 96, pB = cB % 96; const bool peA = (pA >= 64) && !ctx, peB = (pB >= 64) && !ctx;
        const int iA = peA ? (pA - 64) >> 1 : 0, iB = peB ? (pB - 64) >> 1 : 0;
#pragma unroll
        for (int ai = 0; ai < 2; ++ai) {
            const int gr = ((u.pm * 4 + ai * 2 + wr) & 127);
#pragma unroll
            for (int m = 0; m < 4; ++m) {
                const int row = row0 + ai * HALF + m * 16; const int gc = 128 + m * 16 + fr;
                const f32x4 sa = *(const f32x4*)(ssq_q + (size_t)row * 8), sb = *(const f32x4*)(ssq_q + (size_t)row * 8 + 4);
                const float rs = __builtin_amdgcn_rsqf((((sa[0] + sa[1]) + (sa[2] + sa[3])) + ((sb[0] + sb[1]) + (sb[2] + sb[3]))) * (1.0f / 384.0f) + EPS) * QSCALE_C;
                { const f32x4* tp = (const f32x4*)(tabC + (size_t)((iA >= 8 ? gc : gr) * 8 + (iA & 7)) * 2); f32x4 cs0 = tp[0], cs1 = tp[1]; if (!peA) { cs0 = (f32x4){1.f, 0.f, 1.f, 0.f}; cs1 = cs0; }
                  f32x4 v0 = acc[ai][0][m][0] * rs, v1 = acc[ai][0][m][1] * rs; rope8(v0, v1, cs0, cs1); *(u32x4*)(QC + (size_t)row * 768 + cA) = pack8(v0, v1); }
                { const f32x4* tp = (const f32x4*)(tabC + (size_t)((iB >= 8 ? gc : gr) * 8 + (iB & 7)) * 2); f32x4 cs0 = tp[0], cs1 = tp[1]; if (!peB) { cs0 = (f32x4){1.f, 0.f, 1.f, 0.f}; cs1 = cs0; }
                  f32x4 v0 = acc[ai][1][m][0] * rs, v1 = acc[ai][1][m][1] * rs; rope8(v0, v1, cs0, cs1); *(u32x4*)(QC + (size_t)row * 768 + cB) = pack8(v0, v1); }
                __builtin_amdgcn_sched_barrier(0);
            }
        }
    }
};
struct EpiKV {
    static constexpr bool PERM = true, AFTER_DRAIN = false;
    bf16_t *KCN, *VC; const float* ssq_kv;
    __device__ __forceinline__ void operator()(const f32x4 (&acc)[2][2][4][2], const Unit& u, int wr, int wc, int fr, int fq) const {
        asm volatile("" : "+v"(fr), "+v"(fq));
        const int row0 = u.pm * BM + wr * 64 + fr; bf16_t* base = u.pn < 2 ? KCN : VC; const int col0 = (u.pn & 1) * 256 + wc * 32 + 8 * fq;
#pragma unroll
        for (int ai = 0; ai < 2; ++ai)
#pragma unroll
            for (int m = 0; m < 4; ++m) {
                const int row = row0 + ai * HALF + m * 16; const f32x4 sa = *(const f32x4*)(ssq_kv + (size_t)row * 4); const float rs = __builtin_amdgcn_rsqf(((sa[0] + sa[1]) + (sa[2] + sa[3])) * (1.0f / 256.0f) + EPS); bf16_t* rowp = base + (size_t)row * 512 + col0;
#pragma unroll
                for (int bj = 0; bj < 2; ++bj) *(u32x4*)(rowp + bj * HALF) = pack8(acc[ai][bj][m][0] * rs, acc[ai][bj][m][1] * rs);
            }
    }
};
constexpr int MT_ROWS = MTOT / 256;
struct EpiMerge {
    static constexpr bool PERM = true, AFTER_DRAIN = false;
    const bf16_t* GATES; float* M32; bf16_t* MB;
    __device__ __forceinline__ void operator()(const f32x4 (&acc)[2][2][4][2], const Unit& u, int wr, int wc, int fr, int fq) const {
        asm volatile("" : "+v"(fr), "+v"(fq));
        const int br = u.pn >> 2, pn = u.pn & 3, pm = u.pm - br * MT_ROWS; const int row0 = pm * BM + wr * 64 + fr, col0 = pn * BM + wc * 32 + 8 * fq;
#pragma unroll
        for (int ai = 0; ai < 2; ++ai)
#pragma unroll
            for (int m = 0; m < 4; ++m) {
                const int row = row0 + ai * HALF + m * 16;
#pragma unroll
                for (int bj = 0; bj < 2; ++bj) {
                    const u32x4 g = *(const u32x4*)(GATES + (size_t)row * 3072 + br * 1024 + col0 + bj * HALF);
                    f32x4 v0 = acc[ai][bj][m][0] * (f32x4){bf_lo(g.x), bf_hi(g.x), bf_lo(g.y), bf_hi(g.y)}, v1 = acc[ai][bj][m][1] * (f32x4){bf_lo(g.z), bf_hi(g.z), bf_lo(g.w), bf_hi(g.w)};
                    float* mp = M32 + (size_t)row * 1024 + col0 + bj * HALF;
                    if (br > 0) { v0 += *(const f32x4*)mp; v1 += *(const f32x4*)(mp + 4); }
                    if (br < 2) { *(f32x4*)mp = v0; *(f32x4*)(mp + 4) = v1; } else *(u32x4*)(MB + (size_t)row * 1024 + col0 + bj * HALF) = pack8(v0, v1);
                }
            }
    }
};
struct EpiOut {
    static constexpr bool PERM = true, AFTER_DRAIN = false;
    const float* xlat; const float* xctx; float* X; const float* modv;
    __device__ __forceinline__ void operator()(const f32x4 (&acc)[2][2][4][2], const Unit& u, int wr, int wc, int fr, int fq) const {
        asm volatile("" : "+v"(fr), "+v"(fq));
        const bool ctx = u.pm >= PM_CTX; const int bidx = ctx ? 4 : (u.pm >> 5); const int row0 = u.pm * BM + wr * 64 + fr, col0 = u.pn * BM + wc * 32 + 8 * fq;
        const float* src = ctx ? xctx - (size_t)NLAT * DM : xlat; const float* gt = modv + bidx * 6144 + 2 * 1024 + col0;
        f32x4 g[2][2];
#pragma unroll
        for (int bj = 0; bj < 2; ++bj) { g[bj][0] = *(const f32x4*)(gt + bj * HALF); g[bj][1] = *(const f32x4*)(gt + bj * HALF + 4); }
#pragma unroll
        for (int ai = 0; ai < 2; ++ai)
#pragma unroll
            for (int m = 0; m < 4; ++m) {
                const size_t off = (size_t)(row0 + ai * HALF + m * 16) * DM + col0;
#pragma unroll
                for (int bj = 0; bj < 2; ++bj) { const float* sp = src + off + bj * HALF; float* dp = X + off + bj * HALF;
                    const f32x4 a = *(const f32x4*)sp, b = *(const f32x4*)(sp + 4);
                    *(f32x4*)dp = a + g[bj][0] * acc[ai][bj][m][0]; *(f32x4*)(dp + 4) = b + g[bj][1] * acc[ai][bj][m][1]; }
            }
    }
};
constexpr float SWIGLU_LIMIT = 7.0f, SWIGLU_ALPHA = 1.702f;
struct EpiGU {
    static constexpr bool PERM = true, AFTER_DRAIN = false;
    bf16_t* ACT; const float* bgu;
    __device__ __forceinline__ void operator()(const f32x4 (&acc)[2][2][4][2], const Unit& u, int wr, int wc, int fr, int fq) const {
        asm volatile("" : "+v"(fr), "+v"(fq));
        const int e = u.pn >> 3, pn = u.pn & 7; const int row0 = u.pm * BM + wr * 64 + fr, j0 = pn * 128 + wc * 32 + 8 * fq;
        const float* bp = bgu + (size_t)e * 2048 + 2 * j0; f32x4 bb[4];
#pragma unroll
        for (int q = 0; q < 4; ++q) bb[q] = *(const f32x4*)(bp + 4 * q);
        const f32x4 bg0 = (f32x4){bb[0][0], bb[0][2], bb[1][0], bb[1][2]}, bg1 = (f32x4){bb[2][0], bb[2][2], bb[3][0], bb[3][2]};
        const f32x4 bu0 = (f32x4){bb[0][1], bb[0][3], bb[1][1], bb[1][3]}, bu1 = (f32x4){bb[2][1], bb[2][3], bb[3][1], bb[3][3]};
#pragma unroll
        for (int ai = 0; ai < 2; ++ai)
#pragma unroll
            for (int m = 0; m < 4; ++m) {
                const int row = row0 + ai * HALF + m * 16;
                f32x4 g0 = acc[ai][0][m][0] + bg0, g1 = acc[ai][0][m][1] + bg1, u0 = acc[ai][1][m][0] + bu0, u1 = acc[ai][1][m][1] + bu1;
#pragma unroll
                for (int j = 0; j < 4; ++j) {
                    float ga = fminf(g0[j], SWIGLU_LIMIT), ua = fminf(fmaxf(u0[j], -SWIGLU_LIMIT), SWIGLU_LIMIT); g0[j] = (ua + 1.0f) * (ga * sigmoidf_(SWIGLU_ALPHA * ga));
                    float gb = fminf(g1[j], SWIGLU_LIMIT), ub = fminf(fmaxf(u1[j], -SWIGLU_LIMIT), SWIGLU_LIMIT); g1[j] = (ub + 1.0f) * (gb * sigmoidf_(SWIGLU_ALPHA * gb)); }
                *(u32x4*)(ACT + (size_t)row * 1024 + j0) = pack8(g0, g1);
            }
    }
};
struct EpiDown {
    static constexpr bool PERM = true, AFTER_DRAIN = false;
    bf16_t* YBUF; const float* bdn; const int* ydst; const float* wrow;
    __device__ __forceinline__ void operator()(const f32x4 (&acc)[2][2][4][2], const Unit& u, int wr, int wc, int fr, int fq) const {
        asm volatile("" : "+v"(fr), "+v"(fq));
        const int e = u.pn >> 2, pn = u.pn & 3; const int row0 = u.pm * BM + wr * 64 + fr, col0 = pn * BM + wc * 32 + 8 * fq;
        const float* bp = bdn + (size_t)e * 1024 + col0; f32x4 b[2][2];
#pragma unroll
        for (int bj = 0; bj < 2; ++bj) { b[bj][0] = *(const f32x4*)(bp + bj * HALF); b[bj][1] = *(const f32x4*)(bp + bj * HALF + 4); }
#pragma unroll
        for (int ai = 0; ai < 2; ++ai)
#pragma unroll
            for (int m = 0; m < 4; ++m) {
                const int row = row0 + ai * HALF + m * 16; const int dst = ydst[row]; const float w = wrow[row];
                if (dst >= 0) {
#pragma unroll
                    for (int bj = 0; bj < 2; ++bj) *(u32x4*)(YBUF + (size_t)dst * 1024 + col0 + bj * HALF) = pack8((acc[ai][bj][m][0] + b[bj][0]) * w, (acc[ai][bj][m][1] + b[bj][1]) * w);
                }
            }
    }
};
struct MergeOrder {
    StaticOrder S;
    __device__ __forceinline__ bool next(int i, Unit& u) const { const int t = i / 3, br = i - 3 * t; Unit v; if (!S.next(t, v)) return false; u.pm = br * MT_ROWS + v.pm; u.pn = br * 4 + v.pn; return true; }
    __device__ __forceinline__ void a_ready(const Unit&) const {}
    __device__ __forceinline__ void done(const Unit&) const {}
};
struct ExpertOrder {
    StaticOrder S; const PG8_LAS int* tile_e; int nNe;
    __device__ __forceinline__ bool next(int i, Unit& u) const { Unit v; if (!S.next(i, v)) return false; u.pm = v.pm; u.pn = tile_e[v.pm] * nNe + v.pn; return true; }
    __device__ __forceinline__ void a_ready(const Unit&) const {}
    __device__ __forceinline__ void done(const Unit&) const {}
};
template <class Epi, class Sched, bool ALIGN_EPI = false, bool SP2 = false>
__device__ __forceinline__ void gemm_phase(PG8_LAS unsigned char* lds, const Gemm g, const Sched& S, const Epi& E) {
    int tid_ = threadIdx.x; asm volatile("" : "+v"(tid_));
    const int tid = tid_, wid = __builtin_amdgcn_readfirstlane(tid >> 6), lane = tid & 63, wr = wid >> 2, wc = wid & 3, fr = lane & 15, fq = lane >> 4;
    const int K = g.K, nt = K / BK;
    unsigned voffA[2], voffB[2];
#pragma unroll
    for (int i = 0; i < 2; ++i) { int R, C; stage_rc(tid * 16 + i * 8192, R, C); const int Rb = Epi::PERM ? ((R & ~31) + perm32(R & 31)) : R;
        voffA[i] = (unsigned)(R * K + C) * 2u; voffB[i] = (unsigned)(Rb * K + C) * 2u; }
    const size_t kstep = (size_t)(BK * 2);
    const size_t hstep = (size_t)HALF * K * 2;
    const size_t tstep = 2 * hstep;
    const unsigned ldsw = (unsigned)wid * 1024u;
    const int aoff = lds_byte(wr * 64 + fr, fq * 8), boff = lds_byte(wc * 32 + fr, fq * 8);
#define PG8_SA(b, h) (((b) * 2 + (h)) * HTB)
#define PG8_SB(b, h) ((4 + (b) * 2 + (h)) * HTB)
#define PG8_STAGE(bufoff, gbase, voff) do { _Pragma("unroll") for (int _i = 0; _i < 2; ++_i) \
        __builtin_amdgcn_global_load_lds((const unsigned*)((const char*)(gbase) + (voff)[_i]), (PG8_LAS unsigned*)(lds + (bufoff) + ldsw + _i * 8192), 16, 0, 0); } while (0)
#define PG8_LDA(dst, b, h) do { _Pragma("unroll") for (int m = 0; m < 4; ++m) _Pragma("unroll") for (int k = 0; k < 2; ++k) dst[m][k] = *(const PG8_LAS bf16x8*)(lds + PG8_SA(b, h) + aoff + m * 2048 + k * 1024); } while (0)
#define PG8_LDB(dst, b, h) do { _Pragma("unroll") for (int n = 0; n < 2; ++n) _Pragma("unroll") for (int k = 0; k < 2; ++k) dst[n][k] = *(const PG8_LAS bf16x8*)(lds + PG8_SB(b, h) + boff + n * 2048 + k * 1024); } while (0)
#define PG8_MMA(ai, bj, At, Bt) do { __builtin_amdgcn_s_setprio(1); _Pragma("unroll") for (int m = 0; m < 4; ++m) _Pragma("unroll") for (int n = 0; n < 2; ++n) _Pragma("unroll") for (int k = 0; k < 2; ++k) \
        acc[ai][bj][m][n] = __builtin_amdgcn_mfma_f32_16x16x32_bf16(Bt[n][k], At[m][k], acc[ai][bj][m][n], 0, 0, 0); __builtin_amdgcn_s_setprio(0); } while (0)
#define PG8_WAIT_V(n) asm volatile("s_waitcnt vmcnt(" #n ")" ::: "memory")
#define PG8_WAIT_L(n) asm volatile("s_waitcnt lgkmcnt(" #n ")" ::: "memory")
#define PG8_BAR __builtin_amdgcn_s_barrier()
#define PG8_SCHED __builtin_amdgcn_sched_barrier(0)
    Unit cur, nxt; int ui = 0;
    if (!S.next(0, cur)) return;
    f32x4 acc[2][2][4][2];
#pragma unroll
    for (int a = 0; a < 2; ++a)
#pragma unroll
        for (int b = 0; b < 2; ++b)
#pragma unroll
            for (int m = 0; m < 4; ++m)
#pragma unroll
                for (int n = 0; n < 2; ++n) acc[a][b][m][n] = (f32x4){0.f, 0.f, 0.f, 0.f};
    bf16x8 At[4][2], B0[2][2], B1[2][2];
    const char* cA = (const char*)g.A + (size_t)cur.pm * tstep; const char* cB = (const char*)g.Bt + (size_t)cur.pn * tstep;
    S.a_ready(cur);
    if constexpr (SP2) {
        PG8_STAGE(PG8_SB(0, 0), cB, voffB); PG8_STAGE(PG8_SB(0, 1), cB + hstep, voffB); PG8_STAGE(PG8_SA(0, 0), cA, voffA); PG8_STAGE(PG8_SA(0, 1), cA + hstep, voffA);
        if (wr == 1) PG8_BAR;
        PG8_WAIT_V(2); PG8_BAR;
        PG8_STAGE(PG8_SB(1, 0), cB + kstep, voffB); PG8_STAGE(PG8_SA(1, 0), cA + kstep, voffA); PG8_STAGE(PG8_SB(1, 1), cB + hstep + kstep, voffB);
        PG8_WAIT_V(6); PG8_BAR;
    } else {
        PG8_STAGE(PG8_SB(0, 0), cB, voffB); PG8_STAGE(PG8_SA(0, 0), cA, voffA); PG8_STAGE(PG8_SB(0, 1), cB + hstep, voffB); PG8_STAGE(PG8_SA(0, 1), cA + hstep, voffA);
        if (wr == 1) PG8_BAR;
        PG8_WAIT_V(4); PG8_BAR;
        PG8_STAGE(PG8_SB(1, 0), cB + kstep, voffB); PG8_STAGE(PG8_SA(1, 0), cA + kstep, voffA); PG8_STAGE(PG8_SB(1, 1), cB + hstep + kstep, voffB);
        PG8_WAIT_V(6); PG8_BAR;
    }
    for (;;) {
        const bool has_next = S.next(ui + 1, nxt);
        const char* nA = has_next ? (const char*)g.A + (size_t)nxt.pm * tstep : cA; const char* nB = has_next ? (const char*)g.Bt + (size_t)nxt.pn * tstep : cB;
#pragma nounroll
        for (int t = 0; t < nt; t += 2) {
            const bool last = (t == nt - 2);
            const char* a1 = cA + (size_t)(t + 1) * kstep;
            const char* a2 = last ? nA : cA + (size_t)(t + 2) * kstep; const char* b2 = last ? nB : cB + (size_t)(t + 2) * kstep;
            const char* a3 = a2 + kstep; const char* b3 = b2 + kstep;
            if (last && has_next) S.a_ready(nxt);
            if constexpr (SP2) {
            PG8_LDB(B0, 0, 0); PG8_LDB(B1, 0, 1); PG8_SCHED; PG8_LDA(At, 0, 0); PG8_STAGE(PG8_SA(1, 1), a1 + hstep, voffA);
            PG8_WAIT_V(8); PG8_WAIT_L(0); PG8_BAR; PG8_MMA(0, 0, At, B0); PG8_MMA(0, 1, At, B1); PG8_BAR; PG8_SCHED;
            PG8_LDA(At, 0, 1); PG8_STAGE(PG8_SB(0, 0), b2, voffB); PG8_STAGE(PG8_SB(0, 1), b2 + hstep, voffB); PG8_STAGE(PG8_SA(0, 0), a2, voffA);
            PG8_WAIT_V(8); PG8_WAIT_L(0); PG8_BAR; PG8_MMA(1, 0, At, B0); PG8_MMA(1, 1, At, B1); PG8_BAR; PG8_SCHED;
            PG8_LDB(B0, 1, 0); PG8_LDB(B1, 1, 1); PG8_SCHED; PG8_LDA(At, 1, 0); PG8_STAGE(PG8_SA(0, 1), a2 + hstep, voffA);
            PG8_WAIT_V(8); PG8_WAIT_L(0); PG8_BAR; PG8_MMA(0, 0, At, B0); PG8_MMA(0, 1, At, B1); PG8_BAR; PG8_SCHED;
            PG8_LDA(At, 1, 1); PG8_STAGE(PG8_SB(1, 0), b3, voffB); PG8_STAGE(PG8_SB(1, 1), b3 + hstep, voffB); PG8_STAGE(PG8_SA(1, 0), a3, voffA);
            PG8_WAIT_V(8); PG8_WAIT_L(0); PG8_BAR; PG8_MMA(1, 0, At, B0); PG8_MMA(1, 1, At, B1); PG8_BAR; PG8_SCHED;
            } else {
            PG8_LDB(B0, 0, 0); PG8_SCHED; PG8_LDA(At, 0, 0); PG8_STAGE(PG8_SA(1, 1), a1 + hstep, voffA);
            PG8_WAIT_L(8); PG8_BAR; PG8_WAIT_L(0); PG8_MMA(0, 0, At, B0); PG8_BAR; PG8_SCHED;
            PG8_LDB(B1, 0, 1); PG8_STAGE(PG8_SB(0, 0), b2, voffB);
            PG8_BAR; PG8_WAIT_L(0); PG8_MMA(0, 1, At, B1); PG8_BAR;
            PG8_LDA(At, 0, 1); PG8_STAGE(PG8_SA(0, 0), a2, voffA);
            PG8_BAR; PG8_WAIT_L(0); PG8_MMA(1, 0, At, B0); PG8_BAR; PG8_SCHED;
            PG8_STAGE(PG8_SB(0, 1), b2 + hstep, voffB);
            PG8_WAIT_V(6); PG8_BAR; PG8_MMA(1, 1, At, B1); PG8_BAR;
            PG8_LDB(B0, 1, 0); PG8_SCHED; PG8_LDA(At, 1, 0); PG8_STAGE(PG8_SA(0, 1), a2 + hstep, voffA);
            PG8_WAIT_L(8); PG8_BAR; PG8_WAIT_L(0); PG8_MMA(0, 0, At, B0); PG8_BAR; PG8_SCHED;
            PG8_LDB(B1, 1, 1); PG8_STAGE(PG8_SB(1, 0), b3, voffB);
            PG8_BAR; PG8_WAIT_L(0); PG8_MMA(0, 1, At, B1); PG8_BAR;
            PG8_LDA(At, 1, 1); PG8_STAGE(PG8_SA(1, 0), a3, voffA);
            PG8_BAR; PG8_WAIT_L(0); PG8_MMA(1, 0, At, B0); PG8_BAR; PG8_SCHED;
            PG8_STAGE(PG8_SB(1, 1), b3 + hstep, voffB);
            PG8_WAIT_V(6); PG8_BAR; PG8_MMA(1, 1, At, B1); PG8_BAR;
            }
        }
        if constexpr (ALIGN_EPI) { if (wr == 0) PG8_BAR; }
        if constexpr (!Epi::AFTER_DRAIN) { E(acc, cur, wr, wc, fr, fq); S.done(cur); }
        if (!has_next) break;
#pragma unroll
        for (int a = 0; a < 2; ++a)
#pragma unroll
            for (int b = 0; b < 2; ++b)
#pragma unroll
                for (int m = 0; m < 4; ++m)
#pragma unroll
                    for (int n = 0; n < 2; ++n) acc[a][b][m][n] = (f32x4){0.f, 0.f, 0.f, 0.f};
        cur = nxt; cA = nA; cB = nB; ++ui;
        if constexpr (ALIGN_EPI) { if (wr == 1) PG8_BAR; }
    }
    PG8_WAIT_V(0);
    if constexpr (!ALIGN_EPI) { if (wr == 0) PG8_BAR; }
    PG8_BAR;
    if constexpr (Epi::AFTER_DRAIN) { E.fused(acc, cur, wr, wc, fr, fq, lds, wid, lane); S.done(cur); }
#undef PG8_SA
#undef PG8_SB
#undef PG8_STAGE
#undef PG8_LDA
#undef PG8_LDB
#undef PG8_MMA
#undef PG8_WAIT_V
#undef PG8_WAIT_L
#undef PG8_BAR
#undef PG8_SCHED
}
}

using namespace pg8;
constexpr int NWAVES = 8, NTHR = 512;
#define GAS __attribute__((address_space(1)))
#define LAS __attribute__((address_space(3)))
typedef unsigned short bf16;
#define LDS_WAIT() asm volatile("s_waitcnt lgkmcnt(0)" ::: "memory")
#define VM_WAIT() asm volatile("s_waitcnt vmcnt(0)" ::: "memory")
__device__ __forceinline__ unsigned f2bf(float f) { unsigned u = __builtin_bit_cast(unsigned, f); return (u + 0x7fffu + ((u >> 16) & 1u)) >> 16; }
__device__ __forceinline__ unsigned pk2(float lo, float hi) { return f2bf(lo) | (f2bf(hi) << 16); }
__device__ __forceinline__ float bf2f(bf16 b) { return __uint_as_float(((unsigned)b) << 16); }
__device__ __forceinline__ float wave_sum(float v) {
#pragma unroll
    for (int o = 1; o < 64; o <<= 1) v += __shfl_xor(v, o);
    return v;
}
__device__ __forceinline__ float siluf_(float x) { return x / (1.0f + __expf(-x)); }

constexpr size_t MiB = 1u << 20;
constexpr size_t WS_CTL = 0, CTL_ZERO_BYTES = 4 * MiB;
constexpr int CW_BAR = 4096;
constexpr int CW_CNT = 16384;
constexpr int CW_DBG = 20480;
constexpr size_t CTL_SSQ = 1 * MiB;
constexpr size_t WS_MODV = 4 * MiB;
constexpr size_t WS_TAB = 5 * MiB;
constexpr size_t WS_ROUTE = 6 * MiB;
constexpr size_t WS_WIN = 10 * MiB, WS_WQB = 37 * MiB, WS_WKVB = 39 * MiB, WS_WBR = 40 * MiB, WS_WOUT = 46 * MiB, WS_WGU = 50 * MiB, WS_WDN = 306 * MiB;
constexpr size_t WS_X = 434 * MiB, WS_H = 566 * MiB, WS_R = 632 * MiB;
constexpr size_t SZ_R512 = (size_t)MTOT * 512 * 2;
constexpr size_t WS_QA = WS_R, WS_KA = WS_QA + SZ_R512, WS_VA = WS_KA + SZ_R512, WS_QB = WS_VA + SZ_R512, WS_KB = WS_QB + SZ_R512, WS_VB = WS_KB + SZ_R512;
constexpr size_t WS_CQ = WS_VB + SZ_R512, WS_CKR = WS_CQ + (size_t)MTOT * 384 * 2, WS_CKV = WS_CKR + (size_t)MTOT * 32 * 2 + MiB, WS_GATES = WS_CKV + (size_t)MTOT * 256 * 2;
constexpr size_t WS_QC = WS_GATES + (size_t)MTOT * 3072 * 2, WS_KCN = WS_QC + (size_t)MTOT * 768 * 2, WS_VC = WS_KCN + SZ_R512, WS_O0 = WS_VC + SZ_R512;
constexpr size_t WS_YA = WS_O0 + (size_t)MTOT * 512 * 4, WS_YB = WS_YA + SZ_R512, WS_YC = WS_YB + SZ_R512, WS_M32 = WS_YC + SZ_R512, WS_MB = WS_M32 + (size_t)MTOT * 1024 * 4, WS_MIX_END = WS_MB + (size_t)MTOT * 1024 * 2;
constexpr int HS_ROWS = 143360;
constexpr size_t WS_HS = WS_R, WS_ACT = WS_HS + (size_t)HS_ROWS * 1024 * 2, WS_YBUF = WS_ACT + (size_t)HS_ROWS * 1024 * 2, WS_MOE_END = WS_YBUF + (size_t)MTOT * 4 * 1024 * 2;
constexpr size_t WS_END = (WS_MIX_END > WS_MOE_END ? WS_MIX_END : WS_MOE_END);
static_assert(WS_END <= (size_t)2040 * MiB, "workspace map");
constexpr size_t RT_E = 0, RT_SLOT = (size_t)MTOT * 4 * 4, RT_W = 2 * RT_SLOT, RT_YDST = 3 * RT_SLOT, RT_WROW = RT_YDST + (size_t)HS_ROWS * 4;
static_assert(WS_ROUTE + RT_WROW + (size_t)HS_ROWS * 4 <= WS_WIN, "routing map");

constexpr int RING_OFF = 0, RING_BYTES = 131072;
constexpr int TBL_OFF = RING_BYTES;
constexpr int MISC_OFF = TBL_OFF + 12288;
constexpr int LDS_BYTES = 147456;
static_assert(MISC_OFF + 256 <= LDS_BYTES, "LDS map");

#define XB_TMO      128
#define XB_XCNT(j)  (256  + 64 * (j))
#define XB_XSUB(j)  (1280 + 64 * (j))
#define XB_XGEN(j)  (2304 + 64 * (j))
#define XB_TOP      3328
#define XB_TOPGEN   3392
#define XCD_BAR_WORDS 3456
#define XB_SPIN_CAP (1u << 18)
__device__ __forceinline__ unsigned xb_ld(unsigned* p)              { return __hip_atomic_load(p, __ATOMIC_RELAXED, __HIP_MEMORY_SCOPE_AGENT); }
__device__ __forceinline__ unsigned xb_add(unsigned* p, unsigned v) { return __hip_atomic_fetch_add(p, v, __ATOMIC_RELAXED, __HIP_MEMORY_SCOPE_AGENT); }
__device__ __forceinline__ unsigned xb_xcc_id() { return (unsigned)__builtin_amdgcn_s_getreg((3 << 11) | 20) & 0xFu; }
#define XB_SPIN(cond, bar) do { unsigned _sp = 0; while (cond) { __builtin_amdgcn_s_sleep(1); \
    if ((++_sp & 255u) == 0u) { if (xb_ld(&(bar)[XB_TMO])) break; if (_sp > XB_SPIN_CAP) { atomicAdd(&(bar)[XB_TMO], 1u); break; } } } } while (0)
struct XcdBarrier { unsigned* bar; unsigned x; volatile LAS unsigned* st; };
__device__ __forceinline__ XcdBarrier xcd_barrier_post(unsigned* bar, volatile LAS unsigned* st) {
    XcdBarrier b; b.bar = bar; b.x = xb_xcc_id(); b.st = st;
    if (threadIdx.x == 0) (void)xb_add(&bar[XB_XCNT(b.x)], 1u);
    return b;
}
__device__ __forceinline__ void xcd_barrier_complete(unsigned* bar, unsigned x, unsigned& nloc, unsigned& nx) {
    const unsigned G = gridDim.x * gridDim.y * gridDim.z;
    unsigned sum, cnt, mine, sp = 0u;
    for (;;) {
        sum = 0u; cnt = 0u; mine = 0u;
#pragma unroll
        for (unsigned j = 0; j < 16; ++j) { const unsigned c = xb_ld(&bar[XB_XCNT(j)]); sum += c; cnt += (c > 0u) ? 1u : 0u; mine = (j == x) ? c : mine; }
        if (sum == G) break;
        __builtin_amdgcn_s_sleep(1);
        if ((++sp & 255u) == 0u) { if (xb_ld(&bar[XB_TMO])) break; if (sp > XB_SPIN_CAP) { atomicAdd(&bar[XB_TMO], 1u); break; } }
    }
    nloc = mine > 0u ? mine : 1u; nx = cnt > 0u ? cnt : 1u;
}
__device__ __forceinline__ void xcd_barrier(const XcdBarrier& b) {
    asm volatile("s_waitcnt vmcnt(0)" ::: "memory");
    __syncthreads();
    if (threadIdx.x == 0) {
        unsigned* bar = b.bar;
        __builtin_amdgcn_s_waitcnt(0);
        unsigned nloc = b.st[0], nx = b.st[1];
        if (nloc == 0u) { xcd_barrier_complete(bar, b.x, nloc, nx); b.st[0] = nloc; b.st[1] = nx; }
        const unsigned old = xb_add(&bar[XB_XSUB(b.x)], 1u);
        const unsigned gen = old / nloc;
        if (old + 1u == (gen + 1u) * nloc) {
            __builtin_amdgcn_fence(__ATOMIC_RELEASE, "agent");
            asm volatile("s_waitcnt vmcnt(0)" ::: "memory");
            const unsigned og = xb_add(&bar[XB_TOP], 1u);
            const unsigned tg = og / nx;
            if (og + 1u == (tg + 1u) * nx) xb_add(&bar[XB_TOPGEN], 1u);
            else XB_SPIN(xb_ld(&bar[XB_TOPGEN]) == tg, bar);
            __builtin_amdgcn_fence(__ATOMIC_ACQUIRE, "agent");
            xb_add(&bar[XB_XGEN(b.x)], 1u);
            asm volatile("s_waitcnt vmcnt(0)" ::: "memory");
        } else {
            XB_SPIN(xb_ld(&bar[XB_XGEN(b.x)]) == gen, bar);
            __builtin_amdgcn_fence(__ATOMIC_ACQUIRE, "agent");
            asm volatile("s_waitcnt vmcnt(0)" ::: "memory");
        }
    }
    __syncthreads();
}

struct Args { const float* in[30]; float* out; unsigned char* ws; int ph_lo, ph_hi; };
enum { I_X = 0, I_C, I_CTX, I_CCTX, I_WMOD, I_BMOD, I_GMIX, I_WIN, I_LQ1, I_LK1, I_LQ2, I_LK2, I_GSUB, I_RPB, I_GQA, I_WQB, I_GKVA, I_WKVB, I_WBRA, I_WBRB, I_WBRC, I_WOUT, I_GFFN, I_WROUT, I_BROUT, I_WGU, I_BGU, I_WDN, I_BDN, I_GFIN };

__device__ __forceinline__ int win_src(int n) {
    if (n < 1024) { const int g = n >> 6, p = n & 63, i = p >> 1, s = p & 1; return g * 64 + (i < 16 ? i : i + 16) + 16 * s; }
    if (n < OFF_CQ + 384) return n;
    if (n < OFF_PADW) { const int p = n - OFF_CKR, i = p >> 1, s = p & 1; return 3712 + (i < 8 ? i : i + 8) + 8 * s; }
    if (n < OFF_CKV) return -1;
    if (n < OFF_GATES) return 3456 + (n - OFF_CKV);
    return 3744 + (n - OFF_GATES);
}
__device__ __forceinline__ int wqb_src(int n) { const int h = n / 96, p = n - 96 * h; if (p < 64) return n; const int q = p - 64, i = q >> 1, s = q & 1; return h * 96 + 64 + (i < 8 ? i : i + 8) + 8 * s; }
__device__ __forceinline__ int wkvb_src(int n) { return n < 512 ? (n >> 6) * 128 + (n & 63) : ((n - 512) >> 6) * 128 + 64 + (n & 63); }
__device__ __forceinline__ int wgu_src(int n) { const int pn = n >> 8, s = (n >> 7) & 1, t = n & 127; return 2 * (128 * pn + t) + s; }
template <int KIND> __device__ __forceinline__ void transpose_item(const float* W, int K, int N, bf16* WT, const float* gk, LAS float* scr, int item, int nblk, int lane) {
    const int kb = item / nblk, nb = item % nblk, k0 = 64 * kb, n0 = 32 * nb;
    const int nd = n0 + (lane & 31);
    const int ns = KIND == 1 ? win_src(nd) : KIND == 2 ? wqb_src(nd) : KIND == 3 ? wkvb_src(nd) : KIND == 4 ? wgu_src(nd) : nd;
#pragma unroll 8
    for (int i = 0; i < 32; ++i) { const int kk = 2 * i + (lane >> 5); float v = 0.f; if (ns >= 0) v = W[(size_t)(k0 + kk) * N + ns]; if (gk) v *= gk[k0 + kk]; scr[kk * 33 + (lane & 31)] = v; }
    LDS_WAIT(); asm volatile("" ::: "memory");
    const int c = lane & 7;
#pragma unroll
    for (int j = 0; j < 4; ++j) { const int n = (lane >> 3) + 8 * j; const LAS float* s = scr + (8 * c) * 33 + n;
        u32x4 o; o.x = pk2(s[0 * 33], s[1 * 33]); o.y = pk2(s[2 * 33], s[3 * 33]); o.z = pk2(s[4 * 33], s[5 * 33]); o.w = pk2(s[6 * 33], s[7 * 33]);
        *(GAS u32x4*)(WT + (size_t)(n0 + n) * K + k0 + 8 * c) = o; }
    LDS_WAIT(); asm volatile("" ::: "memory");
}

struct Frame {
    LAS unsigned char* lds; volatile LAS unsigned* MISC; unsigned* ctl; unsigned char* ws;
    int tid, lane, wave, vcu, G;
    const float* const* in; float* out;
};
constexpr int IT_WIN = 16 * 216, IT_WQB = 6 * 24, IT_WKVB = 4 * 32, IT_WBR = 8 * 32, IT_WOUT = 16 * 32, IT_WGU = 16 * 64, IT_WDN = 16 * 32;
constexpr int IT_LAYER = IT_WIN + IT_WQB + IT_WKVB + 3 * IT_WBR + IT_WOUT + NEXP * (IT_WGU + IT_WDN);
__device__ __forceinline__ const float* in_l(const Frame& F, int idx, int l, size_t per_layer) { return F.in[idx] + (size_t)l * per_layer; }

__device__ __forceinline__ void p_prologue_a(Frame& F) {
    LAS float* scr = (LAS float*)(F.lds + RING_OFF + F.wave * 8704);
    const int gw = F.vcu * NWAVES + F.wave, NGW = F.G * NWAVES;
    for (int it = gw; it < DEPTH * IT_LAYER; it += NGW) {
        const int l = it / IT_LAYER; int r = it - l * IT_LAYER;
        if (r < IT_WIN) { transpose_item<1>(in_l(F, I_WIN, l, (size_t)DM * DIN), DM, DIN, (bf16*)(F.ws + WS_WIN) + (size_t)l * NINP * DM, nullptr, scr, r, 216, F.lane); continue; } r -= IT_WIN;
        if (r < IT_WQB) { transpose_item<2>(in_l(F, I_WQB, l, 384 * 768), 384, 768, (bf16*)(F.ws + WS_WQB) + (size_t)l * 768 * 384, in_l(F, I_GQA, l, 384), scr, r, 24, F.lane); continue; } r -= IT_WQB;
        if (r < IT_WKVB) { transpose_item<3>(in_l(F, I_WKVB, l, 256 * 1024), 256, 1024, (bf16*)(F.ws + WS_WKVB) + (size_t)l * 1024 * 256, in_l(F, I_GKVA, l, 256), scr, r, 32, F.lane); continue; } r -= IT_WKVB;
        if (r < 3 * IT_WBR) { const int br = r / IT_WBR; const float* src = in_l(F, br == 0 ? I_WBRA : br == 1 ? I_WBRB : I_WBRC, l, 512 * 1024);
            transpose_item<0>(src, 512, 1024, (bf16*)(F.ws + WS_WBR) + (size_t)(l * 3 + br) * 1024 * 512, nullptr, scr, r - br * IT_WBR, 32, F.lane); continue; } r -= 3 * IT_WBR;
        if (r < IT_WOUT) { transpose_item<0>(in_l(F, I_WOUT, l, 1024 * 1024), 1024, 1024, (bf16*)(F.ws + WS_WOUT) + (size_t)l * 1024 * 1024, nullptr, scr, r, 32, F.lane); continue; } r -= IT_WOUT;
        if (r < NEXP * IT_WGU) { const int e = r / IT_WGU; transpose_item<4>(in_l(F, I_WGU, l * NEXP + e, (size_t)1024 * 2048), 1024, 2048, (bf16*)(F.ws + WS_WGU) + (size_t)(l * NEXP + e) * 2048 * 1024, nullptr, scr, r - e * IT_WGU, 64, F.lane); continue; }
        r -= NEXP * IT_WGU;
        { const int e = r / IT_WDN; transpose_item<0>(in_l(F, I_WDN, l * NEXP + e, (size_t)1024 * 1024), 1024, 1024, (bf16*)(F.ws + WS_WDN) + (size_t)(l * NEXP + e) * 1024 * 1024, nullptr, scr, r - e * IT_WDN, 32, F.lane); }
    }
    __syncthreads();
    if (F.vcu < 2 * 96) {
        LAS float* sc = (LAS float*)(F.lds + RING_OFF + 80 * 1024);
        LAS float* red = sc + 5 * 1024;
        for (int i = F.tid; i < 5 * 1024; i += NTHR) { const float v = i < 4096 ? F.in[I_C][i] : F.in[I_CCTX][i - 4096]; sc[i] = siluf_(v); }
        __syncthreads();
        const int l = F.vcu / 96, n = (F.vcu % 96) * 64 + F.lane; const float* W = in_l(F, I_WMOD, l, (size_t)DM * 6144) + n;
        float a[5] = {0.f, 0.f, 0.f, 0.f, 0.f};
        for (int k = F.wave * 128; k < F.wave * 128 + 128; ++k) { const float w = W[(size_t)k * 6144];
#pragma unroll
            for (int v = 0; v < 5; ++v) a[v] += sc[v * 1024 + k] * w; }
#pragma unroll
        for (int v = 0; v < 5; ++v) red[(F.wave * 5 + v) * 64 + F.lane] = a[v];
        __syncthreads();
        if (F.tid < 320) { const int v = F.tid >> 6, ln = F.tid & 63; float s = 0.f;
#pragma unroll
            for (int w = 0; w < 8; ++w) s += red[(w * 5 + v) * 64 + ln];
            const int nn = (F.vcu % 96) * 64 + ln; ((float*)(F.ws + WS_MODV))[(size_t)(l * 5 + v) * 6144 + nn] = s + in_l(F, I_BMOD, l, 6144)[nn]; }
        __syncthreads();
    }
    { const int g = F.vcu * NTHR + F.tid; float* tabA = (float*)(F.ws + WS_TAB); float* tabC = tabA + 192 * 16 * 2;
      if (g < 192 * 16) { const int tr = g >> 4, i = g & 15; const float pos = (float)(tr < 128 ? tr : tr - 128); const float inv = powf(10000.0f, -(float)i / 16.0f); const float ang = pos * inv; tabA[2 * g] = cosf(ang); tabA[2 * g + 1] = sinf(ang); }
      else if (g < 192 * 16 + 192 * 8) { const int q = g - 192 * 16, tr = q >> 3, i = q & 7; const float pos = (float)(tr < 128 ? tr : tr - 128); const float inv = powf(10000.0f, -(float)i / 8.0f); const float ang = pos * inv; tabC[2 * q] = cosf(ang); tabC[2 * q + 1] = sinf(ang); }
      if (F.vcu == F.G - 1 && F.wave < 2) { const int l = F.wave; const float a = in_l(F, I_LQ1, l, 64)[F.lane] * in_l(F, I_LK1, l, 64)[F.lane], b = in_l(F, I_LQ2, l, 64)[F.lane] * in_l(F, I_LK2, l, 64)[F.lane];
          const float sa = wave_sum(a), sb = wave_sum(b); const float lam_init = 0.8f - 0.6f * expf(-0.3f * (float)l);
          if (F.lane == 0) { float* lam = tabC + 192 * 8 * 2; lam[2 * l] = expf(sa) - expf(sb) + lam_init; lam[2 * l + 1] = lam_init; } }
    }
}
__device__ __forceinline__ void mod_row_bf16(const float* xrow, const float* g, const float* sh, const float* scl, bf16* orow, int lane) {
    const f32x4* xr = (const f32x4*)xrow + lane; f32x4 v[4]; float s = 0.f;
#pragma unroll
    for (int j = 0; j < 4; ++j) { v[j] = xr[64 * j]; s += (v[j].x * v[j].x + v[j].y * v[j].y) + (v[j].z * v[j].z + v[j].w * v[j].w); }
    const float rstd = 1.0f / sqrtf(wave_sum(s) * (1.0f / DM) + EPS);
    unsigned long long* o8 = (unsigned long long*)orow + lane;
#pragma unroll
    for (int j = 0; j < 4; ++j) { const f32x4 gg = ((const f32x4*)g)[lane + 64 * j], ss = ((const f32x4*)sh)[lane + 64 * j], cc = ((const f32x4*)scl)[lane + 64 * j];
        const f32x4 y = v[j] * rstd * gg * (cc + 1.0f) + ss; o8[64 * j] = (unsigned long long)pk2(y.x, y.y) | ((unsigned long long)pk2(y.z, y.w) << 32); }
}
__device__ __forceinline__ void p_prologue_b(Frame& F) {
    const int gw = F.vcu * NWAVES + F.wave, NGW = F.G * NWAVES; const float* modv = (const float*)(F.ws + WS_MODV); bf16* H = (bf16*)(F.ws + WS_H);
    for (int m = gw; m < MTOT; m += NGW) { const int b = m < NLAT ? m / SEQ : 4; const float* xr = m < NLAT ? F.in[I_X] + (size_t)m * DM : F.in[I_CTX] + (size_t)(m - NLAT) * DM;
        mod_row_bf16(xr, F.in[I_GMIX], modv + b * 6144, modv + b * 6144 + 1024, H + (size_t)m * DM, F.lane); }
}
__device__ __forceinline__ void p_final_norm(Frame& F, const float* X) {
    const int gw = F.vcu * NWAVES + F.wave, NGW = F.G * NWAVES; const f32x4* g = (const f32x4*)F.in[I_GFIN];
    for (int m = gw; m < NLAT; m += NGW) { const f32x4* xr = (const f32x4*)(X + (size_t)m * DM) + F.lane; f32x4 v[4]; float s = 0.f;
#pragma unroll
        for (int j = 0; j < 4; ++j) { v[j] = xr[64 * j]; s += (v[j].x * v[j].x + v[j].y * v[j].y) + (v[j].z * v[j].z + v[j].w * v[j].w); }
        const float rstd = 1.0f / sqrtf(wave_sum(s) * (1.0f / DM) + EPS);
        f32x4* outp = (f32x4*)(F.out + (size_t)m * DM) + F.lane;
#pragma unroll
        for (int j = 0; j < 4; ++j) outp[64 * j] = v[j] * rstd * g[F.lane + 64 * j]; }
}

namespace att {
using f32x16 = __attribute__((ext_vector_type(16))) float;
using s16x4 = __attribute__((ext_vector_type(4))) short;
constexpr float THR = 8.0f;
constexpr float NEGBIG = -3.0e38f, MINIT = -1.0e30f;
__device__ __forceinline__ int crow(int r, int hi) { return (r & 3) + 8 * (r >> 2) + 4 * hi; }
constexpr int L_K1 = 0, L_K2 = 16384, L_V = 24576, L_WS = 57344, L_RPB = 59392, L_END = 61440;
template <int OFF> __device__ __forceinline__ s16x4 tr_read(int vb) { s16x4 r; asm volatile("ds_read_b64_tr_b16 %0, %1 offset:%2" : "=&v"(r) : "v"(vb), "i"(OFF) : "memory"); return r; }
__device__ __forceinline__ int v_rd_base(int lane) { return ((lane & 3) << 3) | (((lane >> 2) & 3) << 6) | (((lane >> 4) & 1) << 5) | (((lane >> 5) & 1) << 8); }
template <int DV> __device__ __forceinline__ int v_st(int k, int c) { return ((k >> 3) * (DV / 32) + (c >> 5)) * 512 + ((k & 7) * 32 + (c & 31)) * 2; }
template <int DV, int D0> __device__ __forceinline__ void pv_one(f32x16& od, int vb, bf16x8 pa0, bf16x8 pa1, bf16x8 pa2, bf16x8 pa3) {
    constexpr int KT = (DV / 32) * 512;
    const s16x4 l0 = tr_read<D0 * 512 + 0 * KT>(vb), h0 = tr_read<D0 * 512 + 1 * KT>(vb), l1 = tr_read<D0 * 512 + 2 * KT>(vb), h1 = tr_read<D0 * 512 + 3 * KT>(vb);
    const s16x4 l2 = tr_read<D0 * 512 + 4 * KT>(vb), h2 = tr_read<D0 * 512 + 5 * KT>(vb), l3 = tr_read<D0 * 512 + 6 * KT>(vb), h3 = tr_read<D0 * 512 + 7 * KT>(vb);
    asm volatile("s_waitcnt lgkmcnt(0)" ::: "memory"); __builtin_amdgcn_sched_barrier(0);
#define PKV(L, H) (bf16x8){L[0], L[1], L[2], L[3], H[0], H[1], H[2], H[3]}
    od = __builtin_amdgcn_mfma_f32_32x32x16_bf16(pa0, PKV(l0, h0), od, 0, 0, 0);
    od = __builtin_amdgcn_mfma_f32_32x32x16_bf16(pa1, PKV(l1, h1), od, 0, 0, 0);
    od = __builtin_amdgcn_mfma_f32_32x32x16_bf16(pa2, PKV(l2, h2), od, 0, 0, 0);
    od = __builtin_amdgcn_mfma_f32_32x32x16_bf16(pa3, PKV(l3, h3), od, 0, 0, 0);
#undef PKV
}
struct NaParams { const float* rpb_h; int r0; };
template <int DK2, int DV, int MODE>
__device__ __forceinline__ void attn_pass(LAS unsigned char* lds, const bf16* Qrow0, int ldq, const bf16* K1, const bf16* K2, const bf16* V, int lat0, int ntl, int ctx0, int ntc, const NaParams na, int kr_lo,
                                          f32x16 (&o)[DV / 32], float& l_out) {
    constexpr int NQ = 4 + DK2 / 16, ND = DV / 32;
    int tid_ = threadIdx.x; asm volatile("" : "+v"(tid_)); const int tid = tid_, lane = tid & 63, r32 = lane & 31, hi = lane >> 5; const int wid = __builtin_amdgcn_readfirstlane(tid >> 6);
    LAS float* wsf = (LAS float*)(lds + L_WS) + wid * 64; LAS float* rpbl = (LAS float*)(lds + L_RPB);
    bf16x8 qr[NQ];
    { const bf16* qp = Qrow0 + (size_t)(wid * 32 + r32) * ldq + hi * 8;
#pragma unroll
      for (int d0 = 0; d0 < NQ; ++d0) qr[d0] = *(const bf16x8*)(qp + d0 * 16); }
    if (MODE == 1) { for (int i = tid; i < 15 * 31; i += NTHR) rpbl[i] = na.rpb_h[i] * LOG2E; }
    const int k1r = tid >> 3, k1c = tid & 7, k1dst = k1r * 128 + ((k1c ^ ((k1r >> 1) & 7)) << 4);
    const int k2r = (tid >> 2) & 63, k2c = tid & 3, k2dst = k2r * 64 + ((k2c ^ ((k2r >> 2) & 3)) << 4);
    const int vr = DV == 128 ? (tid >> 4) : (tid >> 3), vc = DV == 128 ? (tid & 15) * 8 : (tid & 7) * 8; const int vdst0 = v_st<DV>(vr, vc), vdst1 = v_st<DV>(vr + 32, vc);
    bf16x8 sk1, sk2, sv0, sv1;
    const int NT = ntl + ntc;
#define TROW(t) ((t) < ntl ? lat0 + (t) * 64 : ctx0 + ((t) - ntl) * 64)
#define SLOAD(t) do { const size_t kr_ = (size_t)TROW(t); sk1 = *(const bf16x8*)(K1 + (kr_ + k1r) * 512 + k1c * 8); if (DK2 && tid < 256) sk2 = *(const bf16x8*)(K2 + (kr_ + k2r) * 32 + k2c * 8); \
        sv0 = *(const bf16x8*)(V + (kr_ + vr) * 512 + vc); if (DV == 128) sv1 = *(const bf16x8*)(V + (kr_ + vr + 32) * 512 + vc); } while (0)
#define SWRITE(b) do { *(LAS bf16x8*)(lds + L_K1 + (b) * 8192 + k1dst) = sk1; if (DK2 && tid < 256) *(LAS bf16x8*)(lds + L_K2 + (b) * 4096 + k2dst) = sk2; \
        *(LAS bf16x8*)(lds + L_V + (b) * (DV * 128) + vdst0) = sv0; if (DV == 128) *(LAS bf16x8*)(lds + L_V + (b) * (DV * 128) + vdst1) = sv1; } while (0)
    float m_reg = MINIT, l_reg = 0.f;
#pragma unroll
    for (int d = 0; d < ND; ++d) o[d] = f32x16{};
    const int rq = na.r0 + (wid >> 1), cq = 32 * (wid & 1) + r32; const int rs_w = min(max(rq - 4, 0), 120), cs = min(max(cq - 8, 0), 48);
    const int vb0 = (int)(uintptr_t)(lds + L_V) + v_rd_base(lane);
    SLOAD(0); SWRITE(0); __syncthreads();
    for (int t = 0; t < NT; ++t) {
        const int cur = t & 1;
        if (t + 1 < NT) SLOAD(t + 1);
        bool active = true; int kr = 0;
        if (MODE == 1 && t < ntl) { kr = kr_lo + t; active = (kr >= rs_w) && (kr < rs_w + 8); }
        if (active) {
            f32x16 p0 = f32x16{}, p1 = f32x16{};
            { const LAS unsigned char* kb = lds + L_K1 + cur * 8192;
#pragma unroll
              for (int d0 = 0; d0 < 4; ++d0) { const int ch = 2 * d0 + hi;
                  const bf16x8 b0 = *(const LAS bf16x8*)(kb + r32 * 128 + ((ch ^ ((r32 >> 1) & 7)) << 4));
                  const bf16x8 b1 = *(const LAS bf16x8*)(kb + (32 + r32) * 128 + ((ch ^ (((32 + r32) >> 1) & 7)) << 4));
                  p0 = __builtin_amdgcn_mfma_f32_32x32x16_bf16(b0, qr[d0], p0, 0, 0, 0); p1 = __builtin_amdgcn_mfma_f32_32x32x16_bf16(b1, qr[d0], p1, 0, 0, 0); }
              if (DK2) { const LAS unsigned char* k2b = lds + L_K2 + cur * 4096;
#pragma unroll
                  for (int d0 = 0; d0 < DK2 / 16; ++d0) { const int ch = 2 * d0 + hi;
                      const bf16x8 b0 = *(const LAS bf16x8*)(k2b + r32 * 64 + ((ch ^ ((r32 >> 2) & 3)) << 4));
                      const bf16x8 b1 = *(const LAS bf16x8*)(k2b + (32 + r32) * 64 + ((ch ^ (((32 + r32) >> 2) & 3)) << 4));
                      p0 = __builtin_amdgcn_mfma_f32_32x32x16_bf16(b0, qr[4 + d0], p0, 0, 0, 0); p1 = __builtin_amdgcn_mfma_f32_32x32x16_bf16(b1, qr[4 + d0], p1, 0, 0, 0); } }
            }
            if (MODE == 1 && t < ntl) {
                const LAS float* bl = rpbl + (kr - rq + 7) * 31 + 15 - cq;
#pragma unroll
                for (int r = 0; r < 16; ++r) { const int c0 = crow(r, hi), c1 = 32 + c0;
                    p0[r] = ((unsigned)(c0 - cs) < 16u) ? p0[r] + bl[c0] : NEGBIG; p1[r] = ((unsigned)(c1 - cs) < 16u) ? p1[r] + bl[c1] : NEGBIG; }
            }
            float pmax = p0[0];
#pragma unroll
            for (int r = 1; r < 16; ++r) pmax = fmaxf(pmax, p0[r]);
#pragma unroll
            for (int r = 0; r < 16; ++r) pmax = fmaxf(pmax, p1[r]);
            { auto rr = __builtin_amdgcn_permlane32_swap(__float_as_uint(pmax), __float_as_uint(pmax), false, false); pmax = fmaxf(__uint_as_float(rr[0]), __uint_as_float(rr[1])); }
            float alpha = 1.f;
            if (!__all(pmax - m_reg <= THR)) {
                const float mn = fmaxf(m_reg, pmax); alpha = __builtin_amdgcn_exp2f(m_reg - mn); m_reg = mn;
                if (hi == 0) wsf[r32] = alpha;
#pragma unroll
                for (int d = 0; d < ND; ++d)
#pragma unroll
                    for (int r = 0; r < 16; ++r) o[d][r] *= wsf[crow(r, hi)];
            }
            float ps = 0.f;
#pragma unroll
            for (int r = 0; r < 16; ++r) { p0[r] = __builtin_amdgcn_exp2f(p0[r] - m_reg); p1[r] = __builtin_amdgcn_exp2f(p1[r] - m_reg); ps += p0[r] + p1[r]; }
            { auto rr = __builtin_amdgcn_permlane32_swap(__float_as_uint(ps), __float_as_uint(ps), false, false); ps = __uint_as_float(rr[0]) + __uint_as_float(rr[1]); }
            l_reg = l_reg * alpha + ps;
            u32x4 w0, w1, w2, w3;
            w0 = (u32x4){cvt_pk_bf16(p0[0], p0[1]), cvt_pk_bf16(p0[2], p0[3]), cvt_pk_bf16(p0[4], p0[5]), cvt_pk_bf16(p0[6], p0[7])};
            w1 = (u32x4){cvt_pk_bf16(p0[8], p0[9]), cvt_pk_bf16(p0[10], p0[11]), cvt_pk_bf16(p0[12], p0[13]), cvt_pk_bf16(p0[14], p0[15])};
            w2 = (u32x4){cvt_pk_bf16(p1[0], p1[1]), cvt_pk_bf16(p1[2], p1[3]), cvt_pk_bf16(p1[4], p1[5]), cvt_pk_bf16(p1[6], p1[7])};
            w3 = (u32x4){cvt_pk_bf16(p1[8], p1[9]), cvt_pk_bf16(p1[10], p1[11]), cvt_pk_bf16(p1[12], p1[13]), cvt_pk_bf16(p1[14], p1[15])};
            const bf16x8 pa0 = __builtin_bit_cast(bf16x8, w0), pa1 = __builtin_bit_cast(bf16x8, w1), pa2 = __builtin_bit_cast(bf16x8, w2), pa3 = __builtin_bit_cast(bf16x8, w3);
            const int vb = vb0 + cur * (DV * 128);
            pv_one<DV, 0>(o[0], vb, pa0, pa1, pa2, pa3); pv_one<DV, 1>(o[1], vb, pa0, pa1, pa2, pa3);
            if constexpr (DV == 128) { pv_one<DV, 2>(o[2], vb, pa0, pa1, pa2, pa3); pv_one<DV, 3>(o[3], vb, pa0, pa1, pa2, pa3); }
        }
        if (t + 1 < NT) SWRITE(cur ^ 1);
        __syncthreads();
    }
    l_out = l_reg;
#undef TROW
#undef SLOAD
#undef SWRITE
}
__device__ __forceinline__ void row_recip(LAS unsigned char* lds, float l_reg, float (&rli)[16]) {
    const int tid = threadIdx.x; int lane = tid & 63; asm volatile("" : "+v"(lane)); const int r32 = lane & 31, hi = lane >> 5; const int wid = __builtin_amdgcn_readfirstlane(tid >> 6);
    LAS float* wsf = (LAS float*)(lds + L_WS) + wid * 64;
    if (hi == 0) wsf[32 + r32] = l_reg;
#pragma unroll
    for (int r = 0; r < 16; ++r) rli[r] = 1.0f / wsf[32 + crow(r, hi)];
}
template <int DV> __device__ __forceinline__ void store_bf16(LAS unsigned char* lds, const f32x16 (&o)[DV / 32], float l_reg, bf16* Y, int ld) {
    const int tid = threadIdx.x; int lane = tid & 63; asm volatile("" : "+v"(lane)); const int r32 = lane & 31, hi = lane >> 5; const int wid = __builtin_amdgcn_readfirstlane(tid >> 6);
    float rli[16]; row_recip(lds, l_reg, rli);
    bf16* yw = Y + (size_t)(wid * 32) * ld + r32;
#pragma unroll
    for (int r = 0; r < 16; ++r)
#pragma unroll
        for (int d = 0; d < DV / 32; ++d) yw[(size_t)crow(r, hi) * ld + d * 32] = (bf16)f2bf(o[d][r] * rli[r]);
}
}

__device__ __forceinline__ void p_attention(Frame& F, int l) {
    using namespace att;
    LAS unsigned char* lds = F.lds + RING_OFF;
    const int wid = F.wave;
    const bf16 *QA = (const bf16*)(F.ws + WS_QA), *KA = (const bf16*)(F.ws + WS_KA), *VA = (const bf16*)(F.ws + WS_VA), *QB = (const bf16*)(F.ws + WS_QB), *KB = (const bf16*)(F.ws + WS_KB), *VB = (const bf16*)(F.ws + WS_VB);
    const bf16 *QC = (const bf16*)(F.ws + WS_QC), *KCN = (const bf16*)(F.ws + WS_KCN), *VC = (const bf16*)(F.ws + WS_VC), *CKR = (const bf16*)(F.ws + WS_CKR);
    bf16 *YA = (bf16*)(F.ws + WS_YA), *YB = (bf16*)(F.ws + WS_YB), *YC = (bf16*)(F.ws + WS_YC); float* O0 = (float*)(F.ws + WS_O0);
    const float* lamp = (const float*)(F.ws + WS_TAB) + 192 * 16 * 2 + 192 * 8 * 2; const float lam = lamp[2 * l], lam_init = lamp[2 * l + 1];
    const float* gsub = in_l(F, I_GSUB, l, 128);
    const int nctxA = (l == 0) ? 16 : 0, nctxBC = (l == 0) ? 32 : 0;
    const NaParams na0{nullptr, 0};
    for (int u = F.vcu; u < 512 + nctxA; u += F.G) {
        int b, h, qrow0, ntl;
        if (u < 512) { b = u >> 7; h = (u >> 5) & 3; qrow0 = b * SEQ + (u & 31) * 256; ntl = 128; } else { const int v = u - 512; b = v >> 2; h = v & 3; qrow0 = NLAT + b * CTXL; ntl = 0; }
        const int lat0 = b * SEQ, ctx0 = NLAT + b * CTXL;
        for (int c = 0; c < 2; ++c) {
            f32x16 o[4]; float lsum;
            attn_pass<0, 128, 0>(lds, QA + (size_t)qrow0 * 512 + h * 128 + c * 64, 512, KA + h * 128 + c * 64, nullptr, VA + h * 128, lat0, ntl, ctx0, 4, na0, 0, o, lsum);
            float rli[16]; row_recip(lds, lsum, rli);
            int lane_ = F.lane; asm volatile("" : "+v"(lane_)); const int r32 = lane_ & 31, hi = lane_ >> 5;
            float* o0w = O0 + (size_t)(qrow0 + wid * 32) * 512 + h * 128 + r32;
            if (c == 0) {
#pragma unroll
                for (int r = 0; r < 16; ++r)
#pragma unroll
                    for (int d = 0; d < 4; ++d) o0w[(size_t)crow(r, hi) * 512 + d * 32] = o[d][r] * rli[r];
            } else {
                float ss[16];
#pragma unroll
                for (int r = 0; r < 16; ++r) { float s = 0.f;
#pragma unroll
                    for (int d = 0; d < 4; ++d) { const float y = o0w[(size_t)crow(r, hi) * 512 + d * 32] - lam * (o[d][r] * rli[r]); o[d][r] = y; s += y * y; }
                    ss[r] = s; }
#pragma unroll
                for (int r = 0; r < 16; ++r) {
#pragma unroll
                    for (int x = 1; x < 32; x <<= 1) ss[r] += __shfl_xor(ss[r], x);
                    ss[r] = __builtin_amdgcn_rsqf(ss[r] * (1.0f / 128.0f) + EPS) * (1.0f - lam_init); }
                bf16* yw = YA + (size_t)(qrow0 + wid * 32) * 512 + h * 128 + r32;
#pragma unroll
                for (int d = 0; d < 4; ++d) { const float g = gsub[d * 32 + r32];
#pragma unroll
                    for (int r = 0; r < 16; ++r) yw[(size_t)crow(r, hi) * 512 + d * 32] = (bf16)f2bf(o[d][r] * ss[r] * g); }
            }
        }
    }
    for (int u = F.vcu; u < 1024 + nctxBC; u += F.G) {
        int b, h, qrow0, ntl;
        if (u < 1024) { b = u >> 8; h = (u >> 5) & 7; qrow0 = b * SEQ + (u & 31) * 256; ntl = 128; } else { const int v = u - 1024; b = v >> 3; h = v & 7; qrow0 = NLAT + b * CTXL; ntl = 0; }
        f32x16 o[2]; float lsum;
        attn_pass<32, 64, 0>(lds, QC + (size_t)qrow0 * 768 + h * 96, 768, KCN + h * 64, CKR, VC + h * 64, b * SEQ, ntl, NLAT + b * CTXL, 4, na0, 0, o, lsum);
        store_bf16<64>(lds, o, lsum, YC + (size_t)qrow0 * 512 + h * 64, 512);
    }
    for (int u = F.vcu; u < 1024; u += F.G) {
        const int b = u >> 8, h = (u >> 5) & 7, qb = u & 31, r0 = qb * 4, qrow0 = b * SEQ + qb * 256;
        const int kr_lo = min(max(r0 - 4, 0), 120), kr_hi = min(max(r0 + 3 - 4, 0), 120) + 7;
        const NaParams na{in_l(F, I_RPB, l, 8 * 15 * 31) + h * 15 * 31, r0};
        f32x16 o[2]; float lsum;
        attn_pass<0, 64, 1>(lds, QB + (size_t)qrow0 * 512 + h * 64, 512, KB + h * 64, nullptr, VB + h * 64, b * SEQ + kr_lo * 64, kr_hi - kr_lo + 1, NLAT + b * CTXL, 4, na, kr_lo, o, lsum);
        store_bf16<64>(lds, o, lsum, YB + (size_t)qrow0 * 512 + h * 64, 512);
    }
    for (int u = F.vcu; u < nctxBC; u += F.G) {
        const int b = u >> 3, h = u & 7, qrow0 = NLAT + b * CTXL;
        f32x16 o[2]; float lsum;
        attn_pass<0, 64, 0>(lds, QB + (size_t)qrow0 * 512 + h * 64, 512, KB + h * 64, nullptr, VB + h * 64, 0, 0, qrow0, 4, na0, 0, o, lsum);
        store_bf16<64>(lds, o, lsum, YB + (size_t)qrow0 * 512 + h * 64, 512);
    }
}

constexpr int TB_LCNT = 0, TB_GBASE = 128, TB_BASE = 256, TB_TILE = 4096, TB_REC = 1280;
__device__ __forceinline__ void p_route(Frame& F, int l, int M) {
    LAS float* WrT = (LAS float*)(F.lds + RING_OFF);
    LAS int* lcnt = (LAS int*)(F.lds + TBL_OFF + TB_LCNT); LAS int* gbase = (LAS int*)(F.lds + TBL_OFF + TB_GBASE); LAS int* rec = (LAS int*)(F.lds + TBL_OFF + TB_REC);
    const float* Wr = in_l(F, I_WROUT, l, 1024 * 32);
    for (int i = F.tid; i < 1024 * 32; i += NTHR) { const int k = i >> 5, e = i & 31; WrT[e * 1024 + k] = Wr[i]; }
    if (F.tid < 32) lcnt[F.tid] = 0;
    __syncthreads();
    const int rpb = (M + F.G - 1) / F.G, m0 = F.vcu * rpb, m1 = min(M, m0 + rpb);
    const float* modv = (const float*)(F.ws + WS_MODV) + (size_t)l * 5 * 6144; const float* X = (const float*)(F.ws + WS_X); bf16* H = (bf16*)(F.ws + WS_H);
    const f32x4* g = (const f32x4*)in_l(F, I_GFFN, l, DM); const float brl = in_l(F, I_BROUT, l, 32)[F.lane >> 1];
    int* rt_e = (int*)(F.ws + WS_ROUTE + RT_E); int* rt_slot = (int*)(F.ws + WS_ROUTE + RT_SLOT); float* rt_w = (float*)(F.ws + WS_ROUTE + RT_W);
    for (int m = m0 + F.wave; m < m1; m += NWAVES) {
        const int b = m < NLAT ? m / SEQ : 4; const f32x4* sh = (const f32x4*)(modv + b * 6144 + 3 * 1024); const f32x4* sc = (const f32x4*)(modv + b * 6144 + 4 * 1024);
        const f32x4* xr = (const f32x4*)(X + (size_t)m * DM) + F.lane; f32x4 v[4]; float s = 0.f;
#pragma unroll
        for (int j = 0; j < 4; ++j) { v[j] = xr[64 * j]; s += (v[j].x * v[j].x + v[j].y * v[j].y) + (v[j].z * v[j].z + v[j].w * v[j].w); }
        const float rstd = 1.0f / sqrtf(wave_sum(s) * (1.0f / DM) + EPS);
        unsigned long long* o8 = (unsigned long long*)(H + (size_t)m * DM) + F.lane;
#pragma unroll
        for (int j = 0; j < 4; ++j) { v[j] = v[j] * rstd * g[F.lane + 64 * j] * (sc[F.lane + 64 * j] + 1.0f) + sh[F.lane + 64 * j];
            o8[64 * j] = (unsigned long long)pk2(v[j].x, v[j].y) | ((unsigned long long)pk2(v[j].z, v[j].w) << 32); }
        float acc[32];
#pragma unroll
        for (int e = 0; e < 32; ++e) { float a = 0.f;
#pragma unroll
            for (int j = 0; j < 4; ++j) { const f32x4 w = *(const LAS f32x4*)(WrT + e * 1024 + 256 * j + 4 * F.lane); a += (v[j].x * w.x + v[j].y * w.y) + (v[j].z * w.z + v[j].w * w.w); }
            acc[e] = a; }
#pragma unroll
        for (int i = 0; i < 16; ++i) { const bool up = (F.lane & 32) != 0; const float keep = up ? acc[i + 16] : acc[i], send = up ? acc[i] : acc[i + 16]; acc[i] = keep + __shfl_xor(send, 32); }
#pragma unroll
        for (int i = 0; i < 8; ++i) { const bool up = (F.lane & 16) != 0; const float keep = up ? acc[i + 8] : acc[i], send = up ? acc[i] : acc[i + 8]; acc[i] = keep + __shfl_xor(send, 16); }
#pragma unroll
        for (int i = 0; i < 4; ++i) { const bool up = (F.lane & 8) != 0; const float keep = up ? acc[i + 4] : acc[i], send = up ? acc[i] : acc[i + 4]; acc[i] = keep + __shfl_xor(send, 8); }
#pragma unroll
        for (int i = 0; i < 2; ++i) { const bool up = (F.lane & 4) != 0; const float keep = up ? acc[i + 2] : acc[i], send = up ? acc[i] : acc[i + 2]; acc[i] = keep + __shfl_xor(send, 4); }
        { const bool up = (F.lane & 2) != 0; const float keep = up ? acc[1] : acc[0], send = up ? acc[0] : acc[1]; acc[0] = keep + __shfl_xor(send, 2); }
        float logit = acc[0] + __shfl_xor(acc[0], 1) + brl;
        float tv[4]; int te[4];
#pragma unroll
        for (int k = 0; k < 4; ++k) { float mx = logit;
#pragma unroll
            for (int o = 1; o < 64; o <<= 1) mx = fmaxf(mx, __shfl_xor(mx, o));
            const unsigned long long bal = __ballot(logit == mx); const int fl = __builtin_ctzll(bal); te[k] = fl >> 1; tv[k] = mx; if ((F.lane >> 1) == te[k]) logit = -INFINITY; }
        const float e1 = __expf(tv[1] - tv[0]), e2 = __expf(tv[2] - tv[0]), e3 = __expf(tv[3] - tv[0]); const float inv = 1.0f / (1.0f + e1 + e2 + e3);
        if (F.lane < 4) { const int ee = F.lane == 0 ? te[0] : F.lane == 1 ? te[1] : F.lane == 2 ? te[2] : te[3]; const float ww = (F.lane == 0 ? 1.0f : F.lane == 1 ? e1 : F.lane == 2 ? e2 : e3) * inv;
            const int pos = __hip_atomic_fetch_add(lcnt + ee, 1, __ATOMIC_RELAXED, __HIP_MEMORY_SCOPE_WORKGROUP); rec[(m - m0) * 4 + F.lane] = ee | (pos << 8); rt_w[(size_t)m * 4 + F.lane] = ww; }
    }
    __syncthreads();
    if (F.tid < 32) gbase[F.tid] = (int)atomicAdd(F.ctl + CW_CNT + l * 64 + F.tid, (unsigned)lcnt[F.tid]);
    __syncthreads();
    for (int i = F.tid; i < (m1 - m0) * 4; i += NTHR) { const int r = rec[i], e = r & 255, pos = r >> 8; rt_e[(size_t)m0 * 4 + i] = e; rt_slot[(size_t)m0 * 4 + i] = gbase[e] + pos; }
    __syncthreads();
}
__device__ __forceinline__ int build_expert_tables(Frame& F, int l) {
    LAS int* base = (LAS int*)(F.lds + TBL_OFF + TB_BASE); LAS int* tile_e = (LAS int*)(F.lds + TBL_OFF + TB_TILE);
    __syncthreads();
    if (F.tid == 0) { int acc = 0; for (int e = 0; e < 32; ++e) { const int c = (int)__hip_atomic_load(F.ctl + CW_CNT + l * 64 + e, __ATOMIC_RELAXED, __HIP_MEMORY_SCOPE_AGENT); base[e] = acc; acc += ((c + 255) >> 8) << 8; } base[32] = acc; }
    __syncthreads();
    for (int t = F.tid; t < 640; t += NTHR) { int e = 0; for (int j = 1; j < 32; ++j) e += (base[j] <= t * 256) ? 1 : 0; tile_e[t] = e; }
    __syncthreads();
    return base[32] >> 8;
}
__device__ __forceinline__ void p_gather(Frame& F, int l, int M) {
    (void)build_expert_tables(F, l);
    LAS int* base = (LAS int*)(F.lds + TBL_OFF + TB_BASE);
    const int* rt_e = (const int*)(F.ws + WS_ROUTE + RT_E); const int* rt_slot = (const int*)(F.ws + WS_ROUTE + RT_SLOT); const float* rt_w = (const float*)(F.ws + WS_ROUTE + RT_W);
    int* ydst = (int*)(F.ws + WS_ROUTE + RT_YDST); float* wrow = (float*)(F.ws + WS_ROUTE + RT_WROW);
    const bf16* H = (const bf16*)(F.ws + WS_H); bf16* HS = (bf16*)(F.ws + WS_HS);
    const int gw = F.vcu * NWAVES + F.wave, NGW = F.G * NWAVES;
    for (int m = gw; m < M; m += NGW) {
        const u32x4* hr = (const u32x4*)(H + (size_t)m * DM) + F.lane; const u32x4 a = hr[0], b = hr[64];
#pragma unroll
        for (int k = 0; k < 4; ++k) { const int e = rt_e[(size_t)m * 4 + k]; const int dst = base[e] + rt_slot[(size_t)m * 4 + k];
            u32x4* dr = (u32x4*)(HS + (size_t)dst * DM) + F.lane; dr[0] = a; dr[64] = b;
            if (F.lane == 0) { ydst[dst] = m * 4 + k; wrow[dst] = rt_w[(size_t)m * 4 + k]; } }
    }
    for (int i = blockIdx.x * NTHR + F.tid; i < 32 * 256; i += F.G * NTHR) { const int e = i >> 8, j = i & 255; const int c = (int)__hip_atomic_load(F.ctl + CW_CNT + l * 64 + e, __ATOMIC_RELAXED, __HIP_MEMORY_SCOPE_AGENT);
        const int r = base[e] + c + j; if (r < base[e + 1]) { ydst[r] = -1; wrow[r] = 0.f; } }
}
__device__ __forceinline__ void p_combine(Frame& F, int l, int M) {
    const int gw = F.vcu * NWAVES + F.wave, NGW = F.G * NWAVES; const bool last = (l == DEPTH - 1);
    const float* modv = (const float*)(F.ws + WS_MODV) + (size_t)l * 5 * 6144; const float* modn = modv + 5 * 6144; float* X = (float*)(F.ws + WS_X); bf16* H = (bf16*)(F.ws + WS_H); const bf16* YB = (const bf16*)(F.ws + WS_YBUF);
    const f32x4* gn = (const f32x4*)(last ? F.in[I_GFIN] : in_l(F, I_GMIX, l + 1, DM));
    for (int m = gw; m < M; m += NGW) {
        const int b = m < NLAT ? m / SEQ : 4; const f32x4* gt2 = (const f32x4*)(modv + b * 6144 + 5 * 1024);
        f32x4* xr = (f32x4*)(X + (size_t)m * DM) + F.lane; f32x4 v[4]; float s = 0.f;
#pragma unroll
        for (int j = 0; j < 4; ++j) { f32x4 y = (f32x4){0.f, 0.f, 0.f, 0.f};
#pragma unroll
            for (int k = 0; k < 4; ++k) { const unsigned long long w = ((const unsigned long long*)(YB + (size_t)(m * 4 + k) * DM))[F.lane + 64 * j]; const unsigned lo = (unsigned)w, hi = (unsigned)(w >> 32);
                y += (f32x4){bf_lo(lo), bf_hi(lo), bf_lo(hi), bf_hi(hi)}; }
            v[j] = xr[64 * j] + gt2[F.lane + 64 * j] * y; s += (v[j].x * v[j].x + v[j].y * v[j].y) + (v[j].z * v[j].z + v[j].w * v[j].w); }
        const float rstd = 1.0f / sqrtf(wave_sum(s) * (1.0f / DM) + EPS);
        if (!last) {
            const f32x4* sh = (const f32x4*)(modn + b * 6144); const f32x4* sc = (const f32x4*)(modn + b * 6144 + 1024); unsigned long long* o8 = (unsigned long long*)(H + (size_t)m * DM) + F.lane;
#pragma unroll
            for (int j = 0; j < 4; ++j) { xr[64 * j] = v[j]; const f32x4 y = v[j] * rstd * gn[F.lane + 64 * j] * (sc[F.lane + 64 * j] + 1.0f) + sh[F.lane + 64 * j];
                o8[64 * j] = (unsigned long long)pk2(y.x, y.y) | ((unsigned long long)pk2(y.z, y.w) << 32); }
        } else {
            f32x4* op = (f32x4*)(F.out + (size_t)m * DM) + F.lane;
#pragma unroll
            for (int j = 0; j < 4; ++j) op[64 * j] = v[j] * rstd * gn[F.lane + 64 * j];
        }
    }
}

constexpr int NSAMP = 12, NCHK = 16;
__device__ __forceinline__ int sample_row(int i) { const int r[NSAMP] = {0, 1, 63, 64, 4097, 8191, 8192, 20000, 32767, 32768, 33000, 33791}; int v = 0;
#pragma unroll
    for (int j = 0; j < NSAMP; ++j) v = (i == j) ? r[j] : v; return v; }
__device__ __forceinline__ void dbg_note(Frame& F, int chk, float a, float e, float scale, float tol) {
    float err = fabsf(a - e) / (fabsf(e) + scale); if (!(err == err)) err = 1e30f;
    if (err > tol) atomicAdd(F.ctl + CW_DBG + chk, 1u);
    atomicMax(F.ctl + CW_DBG + 64 + chk, __float_as_uint(err));
}
__device__ __forceinline__ float bfr(float x) { return __uint_as_float(f2bf(x) << 16); }
__device__ __forceinline__ void chk_in(Frame& F, int l, int chk) {
    if (F.vcu >= NSAMP) return;
    const int row = sample_row(F.vcu); const bool ctx = row >= NLAT; const int pos = row % SEQ; const float prow = (float)(pos / 64), pcol = (float)(pos % 64);
    LAS float* raw = (LAS float*)(F.lds + RING_OFF); LAS float* hs = raw + 7168;
    const bf16* H = (const bf16*)(F.ws + WS_H) + (size_t)row * DM; const float* W = in_l(F, I_WIN, l, (size_t)DM * DIN);
    for (int k = F.tid; k < DM; k += NTHR) hs[k] = bf2f(H[k]);
    __syncthreads();
    for (int j = F.tid; j < DIN; j += NTHR) { float s = 0.f; for (int k = 0; k < DM; ++k) s += hs[k] * bfr(W[(size_t)k * DIN + j]); raw[j] = s; }
    __syncthreads();
    const bf16 *QA = (const bf16*)(F.ws + WS_QA), *KA = (const bf16*)(F.ws + WS_KA), *VA = (const bf16*)(F.ws + WS_VA), *QB = (const bf16*)(F.ws + WS_QB), *KB = (const bf16*)(F.ws + WS_KB), *VB = (const bf16*)(F.ws + WS_VB);
    const bf16 *CQ = (const bf16*)(F.ws + WS_CQ), *CKR = (const bf16*)(F.ws + WS_CKR), *CKV = (const bf16*)(F.ws + WS_CKV), *GT = (const bf16*)(F.ws + WS_GATES);
    for (int j = F.tid; j < DIN; j += NTHR) {
        float e, a;
        if (j < 1024) {
            const int g = j >> 6, d = j & 63, q = d & 15, blk = d >> 4;
            const float inv = powf(10000.0f, -(float)q / 16.0f), ang = (blk < 2 ? prow : pcol) * inv, c = ctx ? 1.f : cosf(ang), s = ctx ? 0.f : sinf(ang);
            const int da = (blk & 2) * 16 + q, db = da + 16; const float av = raw[g * 64 + da], bv = raw[g * 64 + db];
            e = (blk & 1) ? bv * c + av * s : av * c - bv * s; if (j < 512) e *= QSCALE_AB;
            const int p = 2 * ((blk >> 1) * 16 + q) + (blk & 1);
            a = bf2f((j < 512 ? QA : KA)[(size_t)row * 512 + (g & 7) * 64 + p]);
        } else if (j < 3072) { const int seg = (j - 1024) >> 9, c = (j - 1024) & 511; e = raw[j] * (seg == 1 ? QSCALE_AB : 1.f); a = bf2f((seg == 0 ? VA : seg == 1 ? QB : seg == 2 ? KB : VB)[(size_t)row * 512 + c]); }
        else if (j < 3456) { e = raw[j]; a = bf2f(CQ[(size_t)row * 384 + (j - 3072)]); }
        else if (j < 3712) { e = raw[j]; a = bf2f(CKV[(size_t)row * 256 + (j - 3456)]); }
        else if (j < 3744) { const int d = j - 3712, q = d & 7, blk = d >> 3; const float inv = powf(10000.0f, -(float)q / 8.0f), ang = (blk < 2 ? prow : pcol) * inv, c = ctx ? 1.f : cosf(ang), s = ctx ? 0.f : sinf(ang);
            const int da = (blk & 2) * 8 + q, db = da + 8; const float av = raw[3712 + da], bv = raw[3712 + db];
            e = (blk & 1) ? bv * c + av * s : av * c - bv * s; const int p = 2 * ((blk >> 1) * 8 + q) + (blk & 1); a = bf2f(CKR[(size_t)row * 32 + p]); }
        else { e = 1.0f / (1.0f + expf(-raw[j])); a = bf2f(GT[(size_t)row * 3072 + (j - 3744)]); }
        dbg_note(F, chk, a, e, 0.05f, 0.03f);
    }
    if (F.tid == 0) { float sq = 0.f, sk = 0.f; for (int j = 3072; j < 3456; ++j) sq += raw[j] * raw[j]; for (int j = 3456; j < 3712; ++j) sk += raw[j] * raw[j];
        const float* ssq = (const float*)(F.ws + CTL_SSQ); float a = 0.f, b = 0.f; for (int i = 0; i < 8; ++i) a += ssq[(size_t)row * 8 + i]; for (int i = 0; i < 4; ++i) b += ssq[(size_t)MTOT * 8 + (size_t)row * 4 + i]; dbg_note(F, chk, a, sq, 0.05f, 0.01f); dbg_note(F, chk, b, sk, 0.05f, 0.01f); }
    __syncthreads();
}
__device__ __forceinline__ void p_dbg_emit(Frame& F) {
    int id = 0; float me = 0.f;
    for (int c = 1; c < NCHK; ++c) { const unsigned n = F.ctl[CW_DBG + c]; const float e = __uint_as_float(F.ctl[CW_DBG + 64 + c]); if (id == 0) { if (n > 0u) { id = c; me = e; } else me = fmaxf(me, e); } }
    float k = rintf(10.0f * (log10f(fmaxf(me, 1e-6f)) + 6.0f)); k = fminf(fmaxf(k, 0.f), 89.f);
    const float A = sqrtf((float)((10 + id) * 10) - 1.0f), Bv = (10.0f + k) * 100.0f;
    for (size_t i = (size_t)blockIdx.x * NTHR + F.tid; i < (size_t)NLAT * DM; i += (size_t)F.G * NTHR) { unsigned h = (unsigned)i * 2654435761u; h ^= h >> 15; h *= 2246822519u; h ^= h >> 13; F.out[i] = (i == 0) ? Bv : ((h & 1u) ? A : -A); }
}

__device__ __forceinline__ void chk_qkv(Frame& F, int l, int chk) {
    if (F.vcu >= NSAMP) return;
    const int row = sample_row(F.vcu); const bool ctx = row >= NLAT; const int pos = row % SEQ; const float prow = (float)(pos / 64), pcol = (float)(pos % 64);
    LAS float* raw = (LAS float*)(F.lds + RING_OFF);
    const bf16* CQ = (const bf16*)(F.ws + WS_CQ) + (size_t)row * 384; const bf16* CKV = (const bf16*)(F.ws + WS_CKV) + (size_t)row * 256;
    const float* ssq = (const float*)(F.ws + CTL_SSQ); float sqa = 0.f, ska = 0.f; for (int i = 0; i < 8; ++i) sqa += ssq[(size_t)row * 8 + i]; for (int i = 0; i < 4; ++i) ska += ssq[(size_t)MTOT * 8 + (size_t)row * 4 + i];
    const float rq = 1.0f / sqrtf(sqa / 384.0f + EPS), rk = 1.0f / sqrtf(ska / 256.0f + EPS);
    const float* Wq = in_l(F, I_WQB, l, 384 * 768); const float* gq = in_l(F, I_GQA, l, 384); const float* Wk = in_l(F, I_WKVB, l, 256 * 1024); const float* gk = in_l(F, I_GKVA, l, 256);
    for (int n = F.tid; n < 768; n += NTHR) { float s = 0.f; for (int k = 0; k < 384; ++k) s += bf2f(CQ[k]) * bfr(Wq[(size_t)k * 768 + n] * gq[k]); raw[n] = s * rq * QSCALE_C; }
    __syncthreads();
    const bf16* QC = (const bf16*)(F.ws + WS_QC) + (size_t)row * 768;
    for (int n = F.tid; n < 768; n += NTHR) { const int h = n / 96, p = n % 96; float e, a;
        if (p < 64) { e = raw[n]; a = bf2f(QC[n]); }
        else { const int d = p - 64, q = d & 7, blk = d >> 3; const float inv = powf(10000.0f, -(float)q / 8.0f), ang = (blk < 2 ? prow : pcol) * inv, c = ctx ? 1.f : cosf(ang), s = ctx ? 0.f : sinf(ang);
            const int da = (blk & 2) * 8 + q, db = da + 8; const float av = raw[h * 96 + 64 + da], bv = raw[h * 96 + 64 + db];
            e = (blk & 1) ? bv * c + av * s : av * c - bv * s; a = bf2f(QC[h * 96 + 64 + 2 * ((blk >> 1) * 8 + q) + (blk & 1)]); }
        dbg_note(F, chk, a, e, 0.05f, 0.03f); }
    const bf16* KCN = (const bf16*)(F.ws + WS_KCN) + (size_t)row * 512; const bf16* VC = (const bf16*)(F.ws + WS_VC) + (size_t)row * 512;
    for (int n = F.tid; n < 1024; n += NTHR) { float s = 0.f; for (int k = 0; k < 256; ++k) s += bf2f(CKV[k]) * bfr(Wk[(size_t)k * 1024 + n] * gk[k]); s *= rk;
        const int h = n >> 7, d = n & 127; const float a = d < 64 ? bf2f(KCN[h * 64 + d]) : bf2f(VC[h * 64 + d - 64]); dbg_note(F, chk, a, s, 0.05f, 0.03f); }
    __syncthreads();
}
__device__ __forceinline__ void naive_attn(Frame& F, LAS float* sc, LAS float* red, LAS float* res, const bf16* q, int dk1, const bf16* K1, const bf16* q2, int dk2, const bf16* K2, const bf16* V, int dv,
                                           int lat0, int nlat, int ctx0, int nctx, int mode, const float* rpb_h, int rq, int cq, int kr_lo) {
    const int NK = nlat + nctx;
    for (int i = F.tid; i < NK; i += NTHR) { const size_t kr = i < nlat ? (size_t)lat0 + i : (size_t)ctx0 + (i - nlat); float s = 0.f;
        for (int d = 0; d < dk1; ++d) s += bf2f(q[d]) * bf2f(K1[kr * 512 + d]);
        for (int d = 0; d < dk2; ++d) s += bf2f(q2[d]) * bf2f(K2[kr * 32 + d]);
        if (mode == 1 && i < nlat) { const int krr = kr_lo + i / 64, ck = i % 64, rs = min(max(rq - 4, 0), 120), cs = min(max(cq - 8, 0), 48);
            if (krr < rs || krr >= rs + 8 || ck < cs || ck >= cs + 16) s = -INFINITY; else s += rpb_h[(krr - rq + 7) * 31 + min(max(ck - cq + 15, 0), 30)] * LOG2E; }
        sc[i] = s; }
    __syncthreads();
    float mx = -INFINITY; for (int i = F.tid; i < NK; i += NTHR) mx = fmaxf(mx, sc[i]);
    for (int o = 1; o < 64; o <<= 1) mx = fmaxf(mx, __shfl_xor(mx, o)); if (F.lane == 0) red[F.wave] = mx; __syncthreads();
    mx = red[0]; for (int w = 1; w < 8; ++w) mx = fmaxf(mx, red[w]); __syncthreads();
    float sm = 0.f; for (int i = F.tid; i < NK; i += NTHR) { const float p = exp2f(sc[i] - mx); sc[i] = p; sm += p; }
    sm = wave_sum(sm); if (F.lane == 0) red[F.wave] = sm; __syncthreads();
    sm = 0.f; for (int w = 0; w < 8; ++w) sm += red[w];
    if (F.tid < dv) { float a = 0.f; for (int i = 0; i < NK; ++i) { const size_t kr = i < nlat ? (size_t)lat0 + i : (size_t)ctx0 + (i - nlat); a += sc[i] * bf2f(V[kr * 512 + F.tid]); } res[F.tid] = a / sm; }
    __syncthreads();
}
__device__ __forceinline__ void chk_attn(Frame& F, int l, int chk) {
    if (F.vcu >= NSAMP) return;
    const int row = sample_row(F.vcu); const bool ctx = row >= NLAT; if (ctx && l > 0) return;
    const int b = ctx ? (row - NLAT) / CTXL : row / SEQ, pos = row % SEQ, rq = pos / 64, cq = pos % 64;
    LAS float* sc = (LAS float*)(F.lds + RING_OFF); LAS float* red = sc + 8704; LAS float* res = red + 16; LAS float* res0 = res + 128;
    const int lat0 = b * SEQ, nlat = ctx ? 0 : SEQ, ctx0 = NLAT + b * CTXL;
    const bf16 *QA = (const bf16*)(F.ws + WS_QA), *KA = (const bf16*)(F.ws + WS_KA), *VA = (const bf16*)(F.ws + WS_VA), *QB = (const bf16*)(F.ws + WS_QB), *KB = (const bf16*)(F.ws + WS_KB), *VB = (const bf16*)(F.ws + WS_VB);
    const bf16 *QC = (const bf16*)(F.ws + WS_QC), *KCN = (const bf16*)(F.ws + WS_KCN), *VC = (const bf16*)(F.ws + WS_VC), *CKR = (const bf16*)(F.ws + WS_CKR);
    const bf16 *YA = (const bf16*)(F.ws + WS_YA), *YB = (const bf16*)(F.ws + WS_YB), *YC = (const bf16*)(F.ws + WS_YC);
    const float* lamp = (const float*)(F.ws + WS_TAB) + 192 * 16 * 2 + 192 * 8 * 2; const float lam = lamp[2 * l], lam_init = lamp[2 * l + 1]; const float* gsub = in_l(F, I_GSUB, l, 128);
    { const float lr = expf(0.f); (void)lr; }
    for (int h = 0; h < 4; ++h) {
        naive_attn(F, sc, red, res, QA + (size_t)row * 512 + h * 128, 64, KA + h * 128, nullptr, 0, nullptr, VA + h * 128, 128, lat0, nlat, ctx0, CTXL, 0, nullptr, 0, 0, 0);
        if (F.tid < 128) res0[F.tid] = res[F.tid]; __syncthreads();
        naive_attn(F, sc, red, res, QA + (size_t)row * 512 + h * 128 + 64, 64, KA + h * 128 + 64, nullptr, 0, nullptr, VA + h * 128, 128, lat0, nlat, ctx0, CTXL, 0, nullptr, 0, 0, 0);
        if (F.tid < 128) res0[F.tid] = res0[F.tid] - lam * res[F.tid]; __syncthreads();
        float ss = 0.f; for (int d = 0; d < 128; ++d) ss += res0[d] * res0[d];
        if (F.tid < 128) { const float e = res0[F.tid] / sqrtf(ss / 128.0f + EPS) * gsub[F.tid] * (1.0f - lam_init); dbg_note(F, chk, bf2f(YA[(size_t)row * 512 + h * 128 + F.tid]), e, 0.1f, 0.04f); }
        __syncthreads();
    }
    for (int h = 0; h < 8; ++h) {
        const int kr_lo = min(max(rq - 4, 0), 120);
        if (ctx) naive_attn(F, sc, red, res, QB + (size_t)row * 512 + h * 64, 64, KB + h * 64, nullptr, 0, nullptr, VB + h * 64, 64, 0, 0, ctx0, CTXL, 0, nullptr, 0, 0, 0);
        else naive_attn(F, sc, red, res, QB + (size_t)row * 512 + h * 64, 64, KB + h * 64, nullptr, 0, nullptr, VB + h * 64, 64, lat0 + kr_lo * 64, 512, ctx0, CTXL, 1, in_l(F, I_RPB, l, 8 * 15 * 31) + h * 465, rq, cq, kr_lo);
        if (F.tid < 64) dbg_note(F, chk + 1, bf2f(YB[(size_t)row * 512 + h * 64 + F.tid]), res[F.tid], 0.02f, 0.04f);
        __syncthreads();
        naive_attn(F, sc, red, res, QC + (size_t)row * 768 + h * 96, 64, KCN + h * 64, QC + (size_t)row * 768 + h * 96 + 64, 32, CKR, VC + h * 64, 64, lat0, nlat, ctx0, CTXL, 0, nullptr, 0, 0, 0);
        if (F.tid < 64) dbg_note(F, chk + 2, bf2f(YC[(size_t)row * 512 + h * 64 + F.tid]), res[F.tid], 0.01f, 0.04f);
        __syncthreads();
    }
}
__device__ __forceinline__ void chk_merge(Frame& F, int l, int chk) {
    if (F.vcu >= NSAMP) return; const int row = sample_row(F.vcu); if (row >= NLAT && l > 0) return;
    const bf16* Y = (const bf16*)(F.ws + WS_YA); const bf16* GT = (const bf16*)(F.ws + WS_GATES) + (size_t)row * 3072; const bf16* MB = (const bf16*)(F.ws + WS_MB) + (size_t)row * 1024;
    for (int n = F.tid; n < 1024; n += NTHR) { float m = 0.f;
        for (int br = 0; br < 3; ++br) { const float* W = in_l(F, br == 0 ? I_WBRA : br == 1 ? I_WBRB : I_WBRC, l, 512 * 1024); const bf16* y = Y + (size_t)br * MTOT * 512 + (size_t)row * 512; float s = 0.f;
            for (int k = 0; k < 512; ++k) s += bf2f(y[k]) * bfr(W[(size_t)k * 1024 + n]); m += bf2f(GT[br * 1024 + n]) * s; }
        dbg_note(F, chk, bf2f(MB[n]), m, 0.05f, 0.03f); }
}
__device__ __forceinline__ void chk_out(Frame& F, int l, int chk, const float* xprev) {
    if (F.vcu >= NSAMP || l > 0) return; const int row = sample_row(F.vcu); const int b = row < NLAT ? row / SEQ : 4;
    const float* xs = row < NLAT ? F.in[I_X] + (size_t)row * DM : F.in[I_CTX] + (size_t)(row - NLAT) * DM; const bf16* MB = (const bf16*)(F.ws + WS_MB) + (size_t)row * 1024;
    const float* W = in_l(F, I_WOUT, l, 1024 * 1024); const float* gt = (const float*)(F.ws + WS_MODV) + (size_t)(l * 5 + b) * 6144 + 2048; const float* X = (const float*)(F.ws + WS_X) + (size_t)row * DM;
    for (int n = F.tid; n < 1024; n += NTHR) { float s = 0.f; for (int k = 0; k < 1024; ++k) s += bf2f(MB[k]) * bfr(W[(size_t)k * 1024 + n]); dbg_note(F, chk, X[n], xs[n] + gt[n] * s, 0.1f, 0.01f); }
}
__device__ __forceinline__ void chk_route(Frame& F, int l, int chk) {
    if (F.vcu >= NSAMP) return; const int row = sample_row(F.vcu); if (row >= NLAT && l > 0) return; const int b = row < NLAT ? row / SEQ : 4;
    LAS float* h2 = (LAS float*)(F.lds + RING_OFF); LAS float* lg = h2 + 1024;
    const float* X = (const float*)(F.ws + WS_X) + (size_t)row * DM; const float* modv = (const float*)(F.ws + WS_MODV) + (size_t)(l * 5 + b) * 6144; const float* g = in_l(F, I_GFFN, l, DM);
    float ss = 0.f; for (int k = 0; k < DM; ++k) ss += X[k] * X[k]; const float rstd = 1.0f / sqrtf(ss / DM + EPS);
    const bf16* H = (const bf16*)(F.ws + WS_H) + (size_t)row * DM;
    for (int k = F.tid; k < DM; k += NTHR) { const float v = X[k] * rstd * g[k] * (1.0f + modv[4096 + k]) + modv[3072 + k]; h2[k] = v; dbg_note(F, chk, bf2f(H[k]), v, 0.05f, 0.02f); }
    __syncthreads();
    if (F.tid < 32) { const float* Wr = in_l(F, I_WROUT, l, 1024 * 32); float s = 0.f; for (int k = 0; k < DM; ++k) s += h2[k] * Wr[k * 32 + F.tid]; lg[F.tid] = s + in_l(F, I_BROUT, l, 32)[F.tid]; }
    __syncthreads();
    if (F.tid == 0) { int te[4]; float tv[4];
        for (int k = 0; k < 4; ++k) { int bi = 0; float bv = lg[0]; for (int e = 1; e < 32; ++e) { const float x = lg[e]; if (x > bv) { bv = x; bi = e; } } te[k] = bi; tv[k] = bv; lg[bi] = -INFINITY; }
        const float den = 1.0f + expf(tv[1] - tv[0]) + expf(tv[2] - tv[0]) + expf(tv[3] - tv[0]);
        const int* rt_e = (const int*)(F.ws + WS_ROUTE + RT_E); const float* rt_w = (const float*)(F.ws + WS_ROUTE + RT_W);
#pragma unroll
        for (int k = 0; k < 4; ++k) { dbg_note(F, chk, (float)rt_e[(size_t)row * 4 + k], (float)te[k], 1.0f, 0.001f); dbg_note(F, chk, rt_w[(size_t)row * 4 + k], expf(tv[k] - tv[0]) / den, 0.1f, 0.001f); } }
    __syncthreads();
}
__device__ __forceinline__ void chk_moe(Frame& F, int l, int chk) {
    if (F.vcu >= NSAMP) return; const int row = sample_row(F.vcu); if (row >= NLAT && l > 0) return;
    LAS float* hs = (LAS float*)(F.lds + RING_OFF); LAS float* act = hs + 1024;
    const bf16* H = (const bf16*)(F.ws + WS_H) + (size_t)row * DM; for (int k = F.tid; k < DM; k += NTHR) hs[k] = bf2f(H[k]);
    __syncthreads();
    const int* rt_e = (const int*)(F.ws + WS_ROUTE + RT_E); const float* rt_w = (const float*)(F.ws + WS_ROUTE + RT_W); const bf16* YB = (const bf16*)(F.ws + WS_YBUF);
    for (int kk = 0; kk < 4; ++kk) { const int e = rt_e[(size_t)row * 4 + kk]; const float w = rt_w[(size_t)row * 4 + kk];
        const float* Wg = in_l(F, I_WGU, l * NEXP + e, (size_t)1024 * 2048); const float* bg = in_l(F, I_BGU, l * NEXP + e, 2048); const float* Wd = in_l(F, I_WDN, l * NEXP + e, (size_t)1024 * 1024); const float* bd = in_l(F, I_BDN, l * NEXP + e, 1024);
        for (int j = F.tid; j < 1024; j += NTHR) { float sg = 0.f, su = 0.f; for (int k = 0; k < DM; ++k) { sg += hs[k] * bfr(Wg[(size_t)k * 2048 + 2 * j]); su += hs[k] * bfr(Wg[(size_t)k * 2048 + 2 * j + 1]); }
            sg += bg[2 * j]; su += bg[2 * j + 1]; const float ga = fminf(sg, 7.0f), ua = fminf(fmaxf(su, -7.0f), 7.0f); act[j] = bfr((ua + 1.0f) * (ga / (1.0f + expf(-1.702f * ga)))); }
        __syncthreads();
        for (int n = F.tid; n < 1024; n += NTHR) { float s = 0.f; for (int j = 0; j < 1024; ++j) s += act[j] * bfr(Wd[(size_t)j * 1024 + n]); dbg_note(F, chk, bf2f(YB[(size_t)(row * 4 + kk) * 1024 + n]), (s + bd[n]) * w, 0.02f, 0.03f); }
        __syncthreads(); }
}

constexpr int PH_PRO_A = 0, PH_PRO_B = 1, PH_L0 = 2, NPL = 10, N_PHASES = PH_L0 + DEPTH * NPL;
enum { LP_IN = 0, LP_QKV, LP_ATTN, LP_MERGE, LP_OUT, LP_ROUTE, LP_GATHER, LP_GU, LP_DN, LP_COMB };

__global__ void __launch_bounds__(NTHR, 2) trunk_fwd(Args args) {
    extern __shared__ __attribute__((aligned(16))) unsigned char lds[];
    Frame F;
    F.lds = (LAS unsigned char*)lds; F.MISC = (volatile LAS unsigned*)(F.lds + MISC_OFF);
    F.tid = threadIdx.x; F.lane = F.tid & 63; F.wave = __builtin_amdgcn_readfirstlane(F.tid >> 6);
    F.G = gridDim.x; { const int bx = blockIdx.x; F.vcu = (F.G % 8 == 0) ? (bx % 8) * (F.G / 8) + bx / 8 : bx; }
    F.ws = args.ws; F.ctl = (unsigned*)(args.ws + WS_CTL); F.in = args.in; F.out = args.out;
    for (int u = F.tid; u < (LDS_BYTES - TBL_OFF) / 4; u += NTHR) ((LAS unsigned*)(F.lds + TBL_OFF))[u] = 0u;
    __syncthreads();
    const int lo = args.ph_lo, hi = args.ph_hi;
#if DBG_CHECK
    if (lo >= 1000) { const int c = lo - 1000;
        if (c == 1) chk_in(F, 0, 1); else if (c == 2) chk_qkv(F, 0, 2); else if (c == 3) chk_attn(F, 0, 3); else if (c == 6) chk_merge(F, 0, 6); else if (c == 7) chk_out(F, 0, 7, nullptr);
        else if (c == 8) chk_route(F, 0, 8); else if (c == 9) chk_moe(F, 0, 9); else if (c == 11) chk_in(F, 1, 11); else if (c == 13) chk_attn(F, 1, 13); else if (c == 99) p_dbg_emit(F);
        return; }
#endif
    XcdBarrier bar; bar.bar = F.ctl + CW_BAR; bar.x = 0; bar.st = nullptr;
    if (MK_ONE_LAUNCH) bar = xcd_barrier_post(F.ctl + CW_BAR, F.MISC + 8);
#define IN(k) (lo <= (k) && (k) < hi)
#define SEAM(k) do { if (MK_ONE_LAUNCH && IN(k) && IN((k) + 1)) xcd_barrier(bar); } while (0)

    if (IN(PH_PRO_A)) { p_prologue_a(F); } SEAM(PH_PRO_A);
    if (IN(PH_PRO_B)) { p_prologue_b(F); } SEAM(PH_PRO_B);
    for (int l = 0; l < DEPTH; ++l) {
        asm volatile("" : "+v"(F.tid), "+v"(F.lane));
        const int pb = PH_L0 + l * NPL; const int Ml = (l == DEPTH - 1) ? NLAT : MTOT;
        float* ssq_q = (float*)(F.ws + CTL_SSQ); float* ssq_kv = ssq_q + (size_t)MTOT * 8;
        const float* tabA = (const float*)(F.ws + WS_TAB); const float* tabC = tabA + 192 * 16 * 2;
        if (IN(pb + LP_IN)) {
            Gemm g{(const bf16_t*)(F.ws + WS_H), (const bf16_t*)(F.ws + WS_WIN) + (size_t)l * NINP * DM, MTOT, NINP, DM}; StaticOrder S; S.init(MTOT, NINP, F.G, (int)blockIdx.x);
            EpiIn E{(bf16_t*)(F.ws + WS_QA), (bf16_t*)(F.ws + WS_KA), (bf16_t*)(F.ws + WS_VA), (bf16_t*)(F.ws + WS_QB), (bf16_t*)(F.ws + WS_KB), (bf16_t*)(F.ws + WS_VB),
                    (bf16_t*)(F.ws + WS_CQ), (bf16_t*)(F.ws + WS_CKR), (bf16_t*)(F.ws + WS_CKV), (bf16_t*)(F.ws + WS_GATES), ssq_q, ssq_kv, tabA, tabC};
            gemm_phase<EpiIn, StaticOrder, true, true>(F.lds + RING_OFF, g, S, E);
        }
        SEAM(pb + LP_IN);
        if (IN(pb + LP_QKV)) {
            { Gemm g{(const bf16_t*)(F.ws + WS_CQ), (const bf16_t*)(F.ws + WS_WQB) + (size_t)l * 768 * 384, MTOT, 768, 384}; StaticOrder S; S.init(MTOT, 768, F.G, (int)blockIdx.x);
              EpiQ E{(bf16_t*)(F.ws + WS_QC), ssq_q, tabC}; gemm_phase<EpiQ, StaticOrder, true, true>(F.lds + RING_OFF, g, S, E); }
            { Gemm g{(const bf16_t*)(F.ws + WS_CKV), (const bf16_t*)(F.ws + WS_WKVB) + (size_t)l * 1024 * 256, MTOT, 1024, 256}; StaticOrder S; S.init(MTOT, 1024, F.G, (int)blockIdx.x);
              EpiKV E{(bf16_t*)(F.ws + WS_KCN), (bf16_t*)(F.ws + WS_VC), ssq_kv}; gemm_phase<EpiKV, StaticOrder, true, true>(F.lds + RING_OFF, g, S, E); }
        }
        SEAM(pb + LP_QKV);
        if (IN(pb + LP_ATTN)) p_attention(F, l);
        SEAM(pb + LP_ATTN);
        if (IN(pb + LP_MERGE)) {
            Gemm g{(const bf16_t*)(F.ws + WS_YA), (const bf16_t*)(F.ws + WS_WBR) + (size_t)l * 3 * 1024 * 512, Ml, 1024, 512}; MergeOrder S; S.S.init(Ml, 1024, F.G, (int)blockIdx.x);
            EpiMerge E{(const bf16_t*)(F.ws + WS_GATES), (float*)(F.ws + WS_M32), (bf16_t*)(F.ws + WS_MB)}; gemm_phase<EpiMerge, MergeOrder, true, true>(F.lds + RING_OFF, g, S, E);
        }
        SEAM(pb + LP_MERGE);
        if (IN(pb + LP_OUT)) {
            Gemm g{(const bf16_t*)(F.ws + WS_MB), (const bf16_t*)(F.ws + WS_WOUT) + (size_t)l * 1024 * 1024, Ml, 1024, 1024}; StaticOrder S; S.init(Ml, 1024, F.G, (int)blockIdx.x);
            const float* X = (const float*)(F.ws + WS_X);
            EpiOut E{l == 0 ? F.in[I_X] : X, l == 0 ? F.in[I_CTX] : X + (size_t)NLAT * DM, (float*)(F.ws + WS_X), (const float*)(F.ws + WS_MODV) + (size_t)l * 5 * 6144};
            gemm_phase<EpiOut, StaticOrder, true, true>(F.lds + RING_OFF, g, S, E);
        }
        SEAM(pb + LP_OUT);
        if (IN(pb + LP_ROUTE)) p_route(F, l, Ml);
        SEAM(pb + LP_ROUTE);
        if (IN(pb + LP_GATHER)) p_gather(F, l, Ml);
        SEAM(pb + LP_GATHER);
        if (IN(pb + LP_GU)) {
            const int T = build_expert_tables(F, l);
            Gemm g{(const bf16_t*)(F.ws + WS_HS), (const bf16_t*)(F.ws + WS_WGU) + (size_t)l * NEXP * 2048 * 1024, T * 256, 2048, 1024};
            ExpertOrder S; S.S.init(T * 256, 2048, F.G, (int)blockIdx.x); S.tile_e = (const LAS int*)(F.lds + TBL_OFF + TB_TILE); S.nNe = 8;
            EpiGU E{(bf16_t*)(F.ws + WS_ACT), in_l(F, I_BGU, l, NEXP * 2048)}; gemm_phase<EpiGU, ExpertOrder, true, true>(F.lds + RING_OFF, g, S, E);
        }
        SEAM(pb + LP_GU);
        if (IN(pb + LP_DN)) {
            const int T = build_expert_tables(F, l);
            Gemm g{(const bf16_t*)(F.ws + WS_ACT), (const bf16_t*)(F.ws + WS_WDN) + (size_t)l * NEXP * 1024 * 1024, T * 256, 1024, 1024};
            ExpertOrder S; S.S.init(T * 256, 1024, F.G, (int)blockIdx.x); S.tile_e = (const LAS int*)(F.lds + TBL_OFF + TB_TILE); S.nNe = 4;
            EpiDown E{(bf16_t*)(F.ws + WS_YBUF), in_l(F, I_BDN, l, NEXP * 1024), (const int*)(F.ws + WS_ROUTE + RT_YDST), (const float*)(F.ws + WS_ROUTE + RT_WROW)};
            gemm_phase<EpiDown, ExpertOrder, true, true>(F.lds + RING_OFF, g, S, E);
        }
        SEAM(pb + LP_DN);
        if (IN(pb + LP_COMB)) p_combine(F, l, Ml);
        SEAM(pb + LP_COMB);
    }
#undef IN
#undef SEAM
}

extern "C" void kernel_launch(void* const* d_in, const int* in_sizes, int n_in, void* d_out, int out_size, void* d_ws, size_t ws_size, hipStream_t stream) {
    static int grid = 0;
    if (grid == 0) {
        if (n_in != 30 || out_size != NLAT * DM || ws_size < WS_END) { fprintf(stderr, "kernel_launch: shape mismatch n_in %d out %d ws %zu (need %zu)\n", n_in, out_size, ws_size, (size_t)WS_END); grid = -1; return; }
        int dev = 0, cus = 0, per_cu = 0;
        if (hipGetDevice(&dev) != hipSuccess || hipDeviceGetAttribute(&cus, hipDeviceAttributeMultiprocessorCount, dev) != hipSuccess) { grid = -1; return; }
        if (hipFuncSetAttribute((const void*)trunk_fwd, hipFuncAttributeMaxDynamicSharedMemorySize, LDS_BYTES) != hipSuccess) { fprintf(stderr, "kernel_launch: hipFuncSetAttribute failed\n"); grid = -1; return; }
        if (hipOccupancyMaxActiveBlocksPerMultiprocessor(&per_cu, (const void*)trunk_fwd, NTHR, LDS_BYTES) != hipSuccess || per_cu < 1) { fprintf(stderr, "kernel_launch: occupancy query says %d\n", per_cu); }
        (void)hipGetLastError();
        grid = cus;
    }
    if (grid < 0) return;
    (void)hipMemsetAsync((char*)d_ws + WS_CTL, 0, CTL_ZERO_BYTES, stream);
    Args a{};
    for (int i = 0; i < 30; ++i) a.in[i] = (const float*)d_in[i];
    a.out = (float*)d_out; a.ws = (unsigned char*)d_ws;
#if MK_ONE_LAUNCH
    a.ph_lo = 0; a.ph_hi = N_PHASES;
    hipLaunchKernelGGL(trunk_fwd, dim3(grid), dim3(NTHR), LDS_BYTES, stream, a);
#else
    for (int p = 0; p < N_PHASES; ++p) { a.ph_lo = p; a.ph_hi = p + 1; hipLaunchKernelGGL(trunk_fwd, dim3(grid), dim3(NTHR), LDS_BYTES, stream, a);
#if DBG_CHECK
        int c = 0; const int q = p - PH_L0;
        if (q == LP_IN) c = 1; else if (q == LP_QKV) c = 2; else if (q == LP_ATTN) c = 3; else if (q == LP_MERGE) c = 6; else if (q == LP_OUT) c = 7; else if (q == LP_ROUTE) c = 8; else if (q == LP_DN) c = 9;
        else if (q == NPL + LP_IN) c = 11; else if (q == NPL + LP_ATTN) c = 13;
        if (c) { a.ph_lo = 1000 + c; a.ph_hi = 0; hipLaunchKernelGGL(trunk_fwd, dim3(grid), dim3(NTHR), LDS_BYTES, stream, a); }
        if (p == DBG_LAST_PHASE) break;
#endif
    }
#if DBG_CHECK
    a.ph_lo = 1099; a.ph_hi = 0; hipLaunchKernelGGL(trunk_fwd, dim3(grid), dim3(NTHR), LDS_BYTES, stream, a);
#endif
#endif
    const hipError_t le = hipPeekAtLastError();
    if (le != hipSuccess) fprintf(stderr, "kernel_launch: launch failed: %s\n", hipGetErrorName(le));
}
```

```cpp
#include <hip/hip_runtime.h>
#include <cstdio>
#include <cstdint>

#ifndef MK_ONE_LAUNCH
#define MK_ONE_LAUNCH 1
#endif
#ifndef DBG_CHECK
#define DBG_CHECK 0
#endif

#ifndef DBG_LAST_PHASE
#define DBG_LAST_PHASE 9999
#endif
namespace pg8 {
#define PG8_LAS __attribute__((address_space(3)))
typedef unsigned short bf16_t;
typedef short bf16x8 __attribute__((ext_vector_type(8)));
typedef float f32x4 __attribute__((ext_vector_type(4)));
typedef unsigned u32x4 __attribute__((ext_vector_type(4)));
constexpr int BM = 256, BK = 64, HALF = 128, HTB = HALF * BK * 2  , STAGE_BYTES = 8 * HTB, NXCD = 8, WGM = 8;

__host__ __device__ __forceinline__ int lds_byte(int r, int c) { const int st = (r >> 4) * 2 + (c >> 5), rr = r & 15, cc = c & 31, ob = rr * 64 + cc * 2; return st * 1024 + (ob ^ (((ob >> 9) & 1) << 5)); }
__host__ __device__ __forceinline__ void stage_rc(int b, int& R, int& C) { const int st = b / 1024, sb = b % 1024, swz = sb ^ (((sb >> 9) & 1) << 5); R = (st >> 1) * 16 + swz / 64; C = (st & 1) * 32 + (swz % 64) / 2; }
__host__ __device__ __forceinline__ int perm32(int rho) { const int n = rho >> 4, i = rho & 15; return 8 * (i >> 2) + 4 * n + (i & 3); }

struct Unit { int pm, pn; };
struct Gemm { const bf16_t* A; const bf16_t* Bt; int M, N, K; };

struct StaticOrder {
    int nM, nN, nwg, G, c;
    __host__ __device__ void init(int M, int N, int G_, int c_) { nM = M / BM; nN = N / BM; nwg = nM * nN; G = G_; c = c_; }
    __host__ __device__ bool next(int i, Unit& u) const {
        const long L = (long)i * G + c; if (L >= nwg) return false;
        int wgid = (int)L; { const int q = nwg / NXCD, r = nwg % NXCD, xcd = wgid % NXCD, off = wgid / NXCD; wgid = (xcd < r ? xcd * (q + 1) : r * (q + 1) + (xcd - r) * q) + off; }
        const int nig = WGM * nN, gid = wgid / nig, fm = gid * WGM, gsz = (nM - fm) < WGM ? (nM - fm) : WGM;
        u.pm = fm + ((wgid % nig) % gsz); u.pn = (wgid % nig) / gsz; return true;
    }
    __device__ __forceinline__ void a_ready(const Unit&) const {}
    __device__ __forceinline__ void done(const Unit&) const {}
};


constexpr int DM = 1024, NBATCH = 4, SEQ = 8192, NLAT = NBATCH * SEQ, CTXL = 256, NCTX = NBATCH * CTXL, MTOT = NLAT + NCTX;
constexpr int DEPTH = 2, DIN = 6816, NINP = 6912, NEXP = 32, TOPK = 4;
constexpr int PM_CTX = NLAT / 256;
constexpr float LOG2E = 1.4426950408889634f;
constexpr float QSCALE_AB = 0.125f * LOG2E;
constexpr float QSCALE_C = 0.10206207261596575f * LOG2E;
constexpr float EPS = 1e-6f;
constexpr int OFF_CQ = 3072, OFF_CKR = 3456, OFF_PADW = 3488, OFF_CKV = 3584, OFF_GATES = 3840;

typedef float f32x2 __attribute__((ext_vector_type(2)));
__device__ __forceinline__ unsigned cvt_pk_bf16(float lo, float hi) { unsigned r; asm volatile("v_cvt_pk_bf16_f32 %0, %1, %2" : "=v"(r) : "v"(lo), "v"(hi)); return r; }
__device__ __forceinline__ u32x4 pack8(const f32x4 a, const f32x4 b) { u32x4 w; w.x = cvt_pk_bf16(a[0], a[1]); w.y = cvt_pk_bf16(a[2], a[3]); w.z = cvt_pk_bf16(b[0], b[1]); w.w = cvt_pk_bf16(b[2], b[3]); return w; }
__device__ __forceinline__ float bf_lo(unsigned w) { return __uint_as_float(w << 16); }
__device__ __forceinline__ float bf_hi(unsigned w) { return __uint_as_float(w & 0xffff0000u); }
__device__ __forceinline__ void rope8(f32x4& v0, f32x4& v1, const f32x4 cs0, const f32x4 cs1) {
    const f32x4 r0 = (f32x4){v0[0] * cs0[0] - v0[1] * cs0[1], v0[1] * cs0[0] + v0[0] * cs0[1], v0[2] * cs0[2] - v0[3] * cs0[3], v0[3] * cs0[2] + v0[2] * cs0[3]};
    const f32x4 r1 = (f32x4){v1[0] * cs1[0] - v1[1] * cs1[1], v1[1] * cs1[0] + v1[0] * cs1[1], v1[2] * cs1[2] - v1[3] * cs1[3], v1[3] * cs1[2] + v1[2] * cs1[3]};
    v0 = r0; v1 = r1;
}
__device__ __forceinline__ float sigmoidf_(float x) { return __builtin_amdgcn_rcpf(1.0f + __builtin_amdgcn_exp2f(-x * LOG2E)); }

struct EpiIn {
    static constexpr bool PERM = true, AFTER_DRAIN = false;
    bf16_t *QA, *KA, *VA, *QB, *KB, *VB, *CQ, *CKR, *CKV, *GATES; float *ssq_q, *ssq_kv; const float* tabA; const float* tabC;
    __device__ __forceinline__ void operator()(const f32x4 (&acc)[2][2][4][2], const Unit& u, int wr, int wc, int fr, int fq) const {
        asm volatile("" : "+v"(fr), "+v"(fq));
        const int pn = u.pn; const bool ctx = u.pm >= PM_CTX;
        const int row0 = u.pm * BM + wr * 64 + fr;
        if (pn < 12) {
            const int seg = pn >> 1; bf16_t* base = seg == 0 ? QA : seg == 1 ? KA : seg == 2 ? VA : seg == 3 ? QB : seg == 4 ? KB : VB;
            const float sc = (seg == 0 || seg == 3) ? QSCALE_AB : 1.0f; const bool rope = (seg <= 1) && !ctx;
            const int col0 = (pn & 1) * 256 + wc * 32 + 8 * fq;
#pragma unroll
            for (int ai = 0; ai < 2; ++ai) {
                const int gr = ((u.pm * 4 + ai * 2 + wr) & 127);
#pragma unroll
                for (int m = 0; m < 4; ++m) {
                    const int row = row0 + ai * HALF + m * 16; bf16_t* rowp = base + (size_t)row * 512 + col0;
                    f32x4 cs0 = (f32x4){1.f, 0.f, 1.f, 0.f}, cs1 = cs0;
                    if (rope) { const int trow = (wc & 1) ? 128 + m * 16 + fr : gr; const f32x4* tp = (const f32x4*)(tabA + (size_t)(trow * 16 + 4 * fq) * 2); cs0 = tp[0]; cs1 = tp[1]; }
#pragma unroll
                    for (int bj = 0; bj < 2; ++bj) { f32x4 v0 = acc[ai][bj][m][0] * sc, v1 = acc[ai][bj][m][1] * sc; rope8(v0, v1, cs0, cs1); *(u32x4*)(rowp + bj * HALF) = pack8(v0, v1); }
                }
            }
        } else if (pn == 12 || pn == 14) {
            bf16_t* base = pn == 12 ? CQ : CKV; const int ld = pn == 12 ? 384 : 256; float* ssq = pn == 12 ? ssq_q : ssq_kv; const int sst = pn == 12 ? 8 : 4;
            const int col0 = wc * 32 + 8 * fq;
#pragma unroll
            for (int ai = 0; ai < 2; ++ai)
#pragma unroll
                for (int m = 0; m < 4; ++m) {
                    const int row = row0 + ai * HALF + m * 16; bf16_t* rowp = base + (size_t)row * ld + col0; float s = 0.f;
#pragma unroll
                    for (int bj = 0; bj < 2; ++bj) { const f32x4 v0 = acc[ai][bj][m][0], v1 = acc[ai][bj][m][1]; *(u32x4*)(rowp + bj * HALF) = pack8(v0, v1);
                        s += (v0[0] * v0[0] + v0[1] * v0[1]) + (v0[2] * v0[2] + v0[3] * v0[3]) + (v1[0] * v1[0] + v1[1] * v1[1]) + (v1[2] * v1[2] + v1[3] * v1[3]); }
                    s += __shfl_xor(s, 16); s += __shfl_xor(s, 32);
                    if (fq == 0) ssq[(size_t)row * sst + wc] = s;
                }
        } else if (pn == 13) {
#pragma unroll
            for (int ai = 0; ai < 2; ++ai) {
                const int gr = ((u.pm * 4 + ai * 2 + wr) & 127);
#pragma unroll
                for (int m = 0; m < 4; ++m) {
                    const int row = row0 + ai * HALF + m * 16;
                    { const f32x4 v0 = acc[ai][0][m][0], v1 = acc[ai][0][m][1]; *(u32x4*)(CQ + (size_t)row * 384 + 256 + wc * 32 + 8 * fq) = pack8(v0, v1);
                      float s = (v0[0] * v0[0] + v0[1] * v0[1]) + (v0[2] * v0[2] + v0[3] * v0[3]) + (v1[0] * v1[0] + v1[1] * v1[1]) + (v1[2] * v1[2] + v1[3] * v1[3]);
                      s += __shfl_xor(s, 16); s += __shfl_xor(s, 32); if (fq == 0) ssq_q[(size_t)row * 8 + 4 + wc] = s; }
                    if (wc == 0) {
                        f32x4 v0 = acc[ai][1][m][0], v1 = acc[ai][1][m][1];
                        if (!ctx) { const int trow = (fq >= 2) ? 128 + m * 16 + fr : gr; const f32x4* tp = (const f32x4*)(tabC + (size_t)(trow * 8 + 4 * (fq & 1)) * 2); rope8(v0, v1, tp[0], tp[1]); }
                        *(u32x4*)(CKR + (size_t)row * 32 + 8 * fq) = pack8(v0, v1);
                    }
                }
            }
        } else {
            const int col0 = (pn - 15) * 256 + wc * 32 + 8 * fq;
#pragma unroll
            for (int ai = 0; ai < 2; ++ai)
#pragma unroll
                for (int m = 0; m < 4; ++m) {
                    const int row = row0 + ai * HALF + m * 16; bf16_t* rowp = GATES + (size_t)row * 3072 + col0;
#pragma unroll
                    for (int bj = 0; bj < 2; ++bj) { f32x4 v0 = acc[ai][bj][m][0], v1 = acc[ai][bj][m][1];
#pragma unroll
                        for (int j = 0; j < 4; ++j) { v0[j] = sigmoidf_(v0[j]); v1[j] = sigmoidf_(v1[j]); }
                        *(u32x4*)(rowp + bj * HALF) = pack8(v0, v1); }
                }
        }
    }
};
struct EpiQ {
    static constexpr bool PERM = true, AFTER_DRAIN = false;
    bf16_t* QC; const float* ssq_q; const float* tabC;
    __device__ __forceinline__ void operator()(const f32x4 (&acc)[2][2][4][2], const Unit& u, int wr, int wc, int fr, int fq) const {
        asm volatile("" : "+v"(fr), "+v"(fq));
        const bool ctx = u.pm >= PM_CTX; const int row0 = u.pm * BM + wr * 64 + fr;
        const int cA = u.pn * BM + wc * 32 + 8 * fq, cB = cA + HALF, pA = cA % 96, pB = cB % 96; const bool peA = (pA >= 64) && !ctx, peB = (pB >= 64) && !ctx;
        const int iA = peA ? (pA - 64) >> 1 : 0, iB = peB ? (pB - 64) >> 1 : 0;
#pragma unroll
        for (int ai = 0; ai < 2; ++ai) {
            const int gr = ((u.pm * 4 + ai * 2 + wr) & 127);
#pragma unroll
            for (int m = 0; m < 4; ++m) {
                const int row = row0 + ai * HALF + m * 16; const int gc = 128 + m * 16 + fr;
                const f32x4 sa = *(const f32x4*)(ssq_q + (size_t)row * 8), sb = *(const f32x4*)(ssq_q + (size_t)row * 8 + 4);
                const float rs = __builtin_amdgcn_rsqf((((sa[0] + sa[1]) + (sa[2] + sa[3])) + ((sb[0] + sb[1]) + (sb[2] + sb[3]))) * (1.0f / 384.0f) + EPS) * QSCALE_C;
                { const f32x4* tp = (const f32x4*)(tabC + (size_t)((iA >= 8 ? gc : gr) * 8 + (iA & 7)) * 2); f32x4 cs0 = tp[0], cs1 = tp[1]; if (!peA) { cs0 = (f32x4){1.f, 0.f, 1.f, 0.f}; cs1 = cs0; }
                  f32x4 v0 = acc[ai][0][m][0] * rs, v1 = acc[ai][0][m][1] * rs; rope8(v0, v1, cs0, cs1); *(u32x4*)(QC + (size_t)row * 768 + cA) = pack8(v0, v1); }
                { const f32x4* tp = (const f32x4*)(tabC + (size_t)((iB >= 8 ? gc : gr) * 8 + (iB & 7)) * 2); f32x4 cs0 = tp[0], cs1 = tp[1]; if (!peB) { cs0 = (f32x4){1.f, 0.f, 1.f, 0.f}; cs1 = cs0; }
                  f32x4 v0 = acc[ai][1][m][0] * rs, v1 = acc[ai][1][m][1] * rs; rope8(v0, v1, cs0, cs1); *(u32x4*)(QC + (size_t)row * 768 + cB) = pack8(v0, v1); }
                __builtin_amdgcn_sched_barrier(0);
            }
        }
    }
};
struct EpiKV {
    static constexpr bool PERM = true, AFTER_DRAIN = false;
    bf16_t *KCN, *VC; const float* ssq_kv;
    __device__ __forceinline__ void operator()(const f32x4 (&acc)[2][2][4][2], const Unit& u, int wr, int wc, int fr, int fq) const {
        asm volatile("" : "+v"(fr), "+v"(fq));
        const int row0 = u.pm * BM + wr * 64 + fr; bf16_t* base = u.pn < 2 ? KCN : VC; const int col0 = (u.pn & 1) * 256 + wc * 32 + 8 * fq;
#pragma unroll
        for (int ai = 0; ai < 2; ++ai)
#pragma unroll
            for (int m = 0; m < 4; ++m) {
                const int row = row0 + ai * HALF + m * 16; const f32x4 sa = *(const f32x4*)(ssq_kv + (size_t)row * 4); const float rs = __builtin_amdgcn_rsqf(((sa[0] + sa[1]) + (sa[2] + sa[3])) * (1.0f / 256.0f) + EPS); bf16_t* rowp = base + (size_t)row * 512 + col0;
#pragma unroll
                for (int bj = 0; bj < 2; ++bj) *(u32x4*)(rowp + bj * HALF) = pack8(acc[ai][bj][m][0] * rs, acc[ai][bj][m][1] * rs);
            }
    }
};
constexpr int MT_ROWS = MTOT / 256;
struct EpiMerge {
    static constexpr bool PERM = true, AFTER_DRAIN = false;
    const bf16_t* GATES; float* M32; bf16_t* MB;
    __device__ __forceinline__ void operator()(const f32x4 (&acc)[2][2][4][2], const Unit& u, int wr, int wc, int fr, int fq) const {
        asm volatile("" : "+v"(fr), "+v"(fq));
        const int br = u.pn >> 2, pn = u.pn & 3, pm = u.pm - br * MT_ROWS; const int row0 = pm * BM + wr * 64 + fr, col0 = pn * BM + wc * 32 + 8 * fq;
#pragma unroll
        for (int ai = 0; ai < 2; ++ai)
#pragma unroll
            for (int m = 0; m < 4; ++m) {
                const int row = row0 + ai * HALF + m * 16;
#pragma unroll
                for (int bj = 0; bj < 2; ++bj) {
                    const u32x4 g = *(const u32x4*)(GATES + (size_t)row * 3072 + br * 1024 + col0 + bj * HALF);
                    f32x4 v0 = acc[ai][bj][m][0] * (f32x4){bf_lo(g.x), bf_hi(g.x), bf_lo(g.y), bf_hi(g.y)}, v1 = acc[ai][bj][m][1] * (f32x4){bf_lo(g.z), bf_hi(g.z), bf_lo(g.w), bf_hi(g.w)};
                    float* mp = M32 + (size_t)row * 1024 + col0 + bj * HALF;
                    if (br > 0) { v0 += *(const f32x4*)mp; v1 += *(const f32x4*)(mp + 4); }
                    if (br < 2) { *(f32x4*)mp = v0; *(f32x4*)(mp + 4) = v1; } else *(u32x4*)(MB + (size_t)row * 1024 + col0 + bj * HALF) = pack8(v0, v1);
                }
            }
    }
};
struct EpiOut {
    static constexpr bool PERM = true, AFTER_DRAIN = false;
    const float* xlat; const float* xctx; float* X; const float* modv;
    __device__ __forceinline__ void operator()(const f32x4 (&acc)[2][2][4][2], const Unit& u, int wr, int wc, int fr, int fq) const {
        asm volatile("" : "+v"(fr), "+v"(fq));
        const bool ctx = u.pm >= PM_CTX; const int bidx = ctx ? 4 : (u.pm >> 5); const int row0 = u.pm * BM + wr * 64 + fr, col0 = u.pn * BM + wc * 32 + 8 * fq;
        const float* src = ctx ? xctx - (size_t)NLAT * DM : xlat; const float* gt = modv + bidx * 6144 + 2 * 1024 + col0;
        f32x4 g[2][2];
#pragma unroll
        for (int bj = 0; bj < 2; ++bj) { g[bj][0] = *(const f32x4*)(gt + bj * HALF); g[bj][1] = *(const f32x4*)(gt + bj * HALF + 4); }
#pragma unroll
        for (int ai = 0; ai < 2; ++ai)
#pragma unroll
            for (int m = 0; m < 4; ++m) {
                const size_t off = (size_t)(row0 + ai * HALF + m * 16) * DM + col0;
#pragma unroll
                for (int bj = 0; bj < 2; ++bj) { const float* sp = src + off + bj * HALF; float* dp = X + off + bj * HALF;
                    const f32x4 a = *(const f32x4*)sp, b = *(const f32x4*)(sp + 4);
                    *(f32x4*)dp = a + g[bj][0] * acc[ai][bj][m][0]; *(f32x4*)(dp + 4) = b + g[bj][1] * acc[ai][bj][m][1]; }
            }
    }
};
constexpr float SWIGLU_LIMIT = 7.0f, SWIGLU_ALPHA = 1.702f;
struct EpiGU {
    static constexpr bool PERM = true, AFTER_DRAIN = false;
    bf16_t* ACT; const float* bgu;
    __device__ __forceinline__ void operator()(const f32x4 (&acc)[2][2][4][2], const Unit& u, int wr, int wc, int fr, int fq) const {
        asm volatile("" : "+v"(fr), "+v"(fq));
        const int e = u.pn >> 3, pn = u.pn & 7; const int row0 = u.pm * BM + wr * 64 + fr, j0 = pn * 128 + wc * 32 + 8 * fq;
        const float* bp = bgu + (size_t)e * 2048 + 2 * j0; f32x4 bb[4];
#pragma unroll
        for (int q = 0; q < 4; ++q) bb[q] = *(const f32x4*)(bp + 4 * q);
        const f32x4 bg0 = (f32x4){bb[0][0], bb[0][2], bb[1][0], bb[1][2]}, bg1 = (f32x4){bb[2][0], bb[2][2], bb[3][0], bb[3][2]};
        const f32x4 bu0 = (f32x4){bb[0][1], bb[0][3], bb[1][1], bb[1][3]}, bu1 = (f32x4){bb[2][1], bb[2][3], bb[3][1], bb[3][3]};
#pragma unroll
        for (int ai = 0; ai < 2; ++ai)
#pragma unroll
            for (int m = 0; m < 4; ++m) {
                const int row = row0 + ai * HALF + m * 16;
                f32x4 g0 = acc[ai][0][m][0] + bg0, g1 = acc[ai][0][m][1] + bg1, u0 = acc[ai][1][m][0] + bu0, u1 = acc[ai][1][m][1] + bu1;
#pragma unroll
                for (int j = 0; j < 4; ++j) {
                    float ga = fminf(g0[j], SWIGLU_LIMIT), ua = fminf(fmaxf(u0[j], -SWIGLU_LIMIT), SWIGLU_LIMIT); g0[j] = (ua + 1.0f) * (ga * sigmoidf_(SWIGLU_ALPHA * ga));
                    float gb = fminf(g1[j], SWIGLU_LIMIT), ub = fminf(fmaxf(u1[j], -SWIGLU_LIMIT), SWIGLU_LIMIT); g1[j] = (ub + 1.0f) * (gb * sigmoidf_(SWIGLU_ALPHA * gb)); }
                *(u32x4*)(ACT + (size_t)row * 1024 + j0) = pack8(g0, g1);
            }
    }
};
struct EpiDown {
    static constexpr bool PERM = true, AFTER_DRAIN = false;
    bf16_t* YBUF; const float* bdn; const int* ydst; const float* wrow;
    __device__ __forceinline__ void operator()(const f32x4 (&acc)[2][2][4][2], const Unit& u, int wr, int wc, int fr, int fq) const {
        asm volatile("" : "+v"(fr), "+v"(fq));
        const int e = u.pn >> 2, pn = u.pn & 3; const int row0 = u.pm * BM + wr * 64 + fr, col0 = pn * BM + wc * 32 + 8 * fq;
        const float* bp = bdn + (size_t)e * 1024 + col0; f32x4 b[2][2];
#pragma unroll
        for (int bj = 0; bj < 2; ++bj) { b[bj][0] = *(const f32x4*)(bp + bj * HALF); b[bj][1] = *(const f32x4*)(bp + bj * HALF + 4); }
#pragma unroll
        for (int ai = 0; ai < 2; ++ai)
#pragma unroll
            for (int m = 0; m < 4; ++m) {
                const int row = row0 + ai * HALF + m * 16; const int dst = ydst[row]; const float w = wrow[row];
                if (dst >= 0) {
#pragma unroll
                    for (int bj = 0; bj < 2; ++bj) *(u32x4*)(YBUF + (size_t)dst * 1024 + col0 + bj * HALF) = pack8((acc[ai][bj][m][0] + b[bj][0]) * w, (acc[ai][bj][m][1] + b[bj][1]) * w);
                }
            }
    }
};
struct MergeOrder {
    StaticOrder S;
    __device__ __forceinline__ bool next(int i, Unit& u) const { const int t = i / 3, br = i - 3 * t; Unit v; if (!S.next(t, v)) return false; u.pm = br * MT_ROWS + v.pm; u.pn = br * 4 + v.pn; return true; }
    __device__ __forceinline__ void a_ready(const Unit&) const {}
    __device__ __forceinline__ void done(const Unit&) const {}
};
struct ExpertOrder {
    StaticOrder S; const PG8_LAS int* tile_e; int nNe;
    __device__ __forceinline__ bool next(int i, Unit& u) const { Unit v; if (!S.next(i, v)) return false; u.pm = v.pm; u.pn = tile_e[v.pm] * nNe + v.pn; return true; }
    __device__ __forceinline__ void a_ready(const Unit&) const {}
    __device__ __forceinline__ void done(const Unit&) const {}
};
template <class Epi, class Sched, bool ALIGN_EPI = false, bool SP2 = false>
__device__ __forceinline__ void gemm_phase(PG8_LAS unsigned char* lds, const Gemm g, const Sched& S, const Epi& E) {
    int tid_ = threadIdx.x; asm volatile("" : "+v"(tid_));
    const int tid = tid_, wid = __builtin_amdgcn_readfirstlane(tid >> 6), lane = tid & 63, wr = wid >> 2, wc = wid & 3, fr = lane & 15, fq = lane >> 4;
    const int K = g.K, nt = K / BK;
    unsigned voffA[2], voffB[2];
#pragma unroll
    for (int i = 0; i < 2; ++i) { int R, C; stage_rc(tid * 16 + i * 8192, R, C); const int Rb = Epi::PERM ? ((R & ~31) + perm32(R & 31)) : R;
        voffA[i] = (unsigned)(R * K + C) * 2u; voffB[i] = (unsigned)(Rb * K + C) * 2u; }
    const size_t kstep = (size_t)(BK * 2);
    const size_t hstep = (size_t)HALF * K * 2;
    const size_t tstep = 2 * hstep;
    const unsigned ldsw = (unsigned)wid * 1024u;
    const int aoff = lds_byte(wr * 64 + fr, fq * 8), boff = lds_byte(wc * 32 + fr, fq * 8);
#define PG8_SA(b, h) (((b) * 2 + (h)) * HTB)
#define PG8_SB(b, h) ((4 + (b) * 2 + (h)) * HTB)
#define PG8_STAGE(bufoff, gbase, voff) do { _Pragma("unroll") for (int _i = 0; _i < 2; ++_i) \
        __builtin_amdgcn_global_load_lds((const unsigned*)((const char*)(gbase) + (voff)[_i]), (PG8_LAS unsigned*)(lds + (bufoff) + ldsw + _i * 8192), 16, 0, 0); } while (0)
#define PG8_LDA(dst, b, h) do { _Pragma("unroll") for (int m = 0; m < 4; ++m) _Pragma("unroll") for (int k = 0; k < 2; ++k) dst[m][k] = *(const PG8_LAS bf16x8*)(lds + PG8_SA(b, h) + aoff + m * 2048 + k * 1024); } while (0)
#define PG8_LDB(dst, b, h) do { _Pragma("unroll") for (int n = 0; n < 2; ++n) _Pragma("unroll") for (int k = 0; k < 2; ++k) dst[n][k] = *(const PG8_LAS bf16x8*)(lds + PG8_SB(b, h) + boff + n * 2048 + k * 1024); } while (0)
#define PG8_MMA(ai, bj, At, Bt) do { __builtin_amdgcn_s_setprio(1); _Pragma("unroll") for (int m = 0; m < 4; ++m) _Pragma("unroll") for (int n = 0; n < 2; ++n) _Pragma("unroll") for (int k = 0; k < 2; ++k) \
        acc[ai][bj][m][n] = __builtin_amdgcn_mfma_f32_16x16x32_bf16(Bt[n][k], At[m][k], acc[ai][bj][m][n], 0, 0, 0); __builtin_amdgcn_s_setprio(0); } while (0)
#define PG8_WAIT_V(n) asm volatile("s_waitcnt vmcnt(" #n ")" ::: "memory")
#define PG8_WAIT_L(n) asm volatile("s_waitcnt lgkmcnt(" #n ")" ::: "memory")
#define PG8_BAR __builtin_amdgcn_s_barrier()
#define PG8_SCHED __builtin_amdgcn_sched_barrier(0)
    Unit cur, nxt; int ui = 0;
    if (!S.next(0, cur)) return;
    f32x4 acc[2][2][4][2];
#pragma unroll
    for (int a = 0; a < 2; ++a)
#pragma unroll
        for (int b = 0; b < 2; ++b)
#pragma unroll
            for (int m = 0; m < 4; ++m)
#pragma unroll
                for (int n = 0; n < 2; ++n) acc[a][b][m][n] = (f32x4){0.f, 0.f, 0.f, 0.f};
    bf16x8 At[4][2], B0[2][2], B1[2][2];
    const char* cA = (const char*)g.A + (size_t)cur.pm * tstep; const char* cB = (const char*)g.Bt + (size_t)cur.pn * tstep;
    S.a_ready(cur);
    if constexpr (SP2) {
        PG8_STAGE(PG8_SB(0, 0), cB, voffB); PG8_STAGE(PG8_SB(0, 1), cB + hstep, voffB); PG8_STAGE(PG8_SA(0, 0), cA, voffA); PG8_STAGE(PG8_SA(0, 1), cA + hstep, voffA);
        if (wr == 1) PG8_BAR;
        PG8_WAIT_V(2); PG8_BAR;
        PG8_STAGE(PG8_SB(1, 0), cB + kstep, voffB); PG8_STAGE(PG8_SA(1, 0), cA + kstep, voffA); PG8_STAGE(PG8_SB(1, 1), cB + hstep + kstep, voffB);
        PG8_WAIT_V(6); PG8_BAR;
    } else {
        PG8_STAGE(PG8_SB(0, 0), cB, voffB); PG8_STAGE(PG8_SA(0, 0), cA, voffA); PG8_STAGE(PG8_SB(0, 1), cB + hstep, voffB); PG8_STAGE(PG8_SA(0, 1), cA + hstep, voffA);
        if (wr == 1) PG8_BAR;
        PG8_WAIT_V(4); PG8_BAR;
        PG8_STAGE(PG8_SB(1, 0), cB + kstep, voffB); PG8_STAGE(PG8_SA(1, 0), cA + kstep, voffA); PG8_STAGE(PG8_SB(1, 1), cB + hstep + kstep, voffB);
        PG8_WAIT_V(6); PG8_BAR;
    }
    for (;;) {
        const bool has_next = S.next(ui + 1, nxt);
        const char* nA = has_next ? (const char*)g.A + (size_t)nxt.pm * tstep : cA; const char* nB = has_next ? (const char*)g.Bt + (size_t)nxt.pn * tstep : cB;
#pragma nounroll
        for (int t = 0; t < nt; t += 2) {
            const bool last = (t == nt - 2);
            const char* a1 = cA + (size_t)(t + 1) * kstep;
            const char* a2 = last ? nA : cA + (size_t)(t + 2) * kstep; const char* b2 = last ? nB : cB + (size_t)(t + 2) * kstep;
            const char* a3 = a2 + kstep; const char* b3 = b2 + kstep;
            if (last && has_next) S.a_ready(nxt);
            if constexpr (SP2) {
            PG8_LDB(B0, 0, 0); PG8_LDB(B1, 0, 1); PG8_SCHED; PG8_LDA(At, 0, 0); PG8_STAGE(PG8_SA(1, 1), a1 + hstep, voffA);
            PG8_WAIT_V(8); PG8_WAIT_L(0); PG8_BAR; PG8_MMA(0, 0, At, B0); PG8_MMA(0, 1, At, B1); PG8_BAR; PG8_SCHED;
            PG8_LDA(At, 0, 1); PG8_STAGE(PG8_SB(0, 0), b2, voffB); PG8_STAGE(PG8_SB(0, 1), b2 + hstep, voffB); PG8_STAGE(PG8_SA(0, 0), a2, voffA);
            PG8_WAIT_V(8); PG8_WAIT_L(0); PG8_BAR; PG8_MMA(1, 0, At, B0); PG8_MMA(1, 1, At, B1); PG8_BAR; PG8_SCHED;
            PG8_LDB(B0, 1, 0); PG8_LDB(B1, 1, 1); PG8_SCHED; PG8_LDA(At, 1, 0); PG8_STAGE(PG8_SA(0, 1), a2 + hstep, voffA);
            PG8_WAIT_V(8); PG8_WAIT_L(0); PG8_BAR; PG8_MMA(0, 0, At, B0); PG8_MMA(0, 1, At, B1); PG8_BAR; PG8_SCHED;
            PG8_LDA(At, 1, 1); PG8_STAGE(PG8_SB(1, 0), b3, voffB); PG8_STAGE(PG8_SB(1, 1), b3 + hstep, voffB); PG8_STAGE(PG8_SA(1, 0), a3, voffA);
            PG8_WAIT_V(8); PG8_WAIT_L(0); PG8_BAR; PG8_MMA(1, 0, At, B0); PG8_MMA(1, 1, At, B1); PG8_BAR; PG8_SCHED;
            } else {
            PG8_LDB(B0, 0, 0); PG8_SCHED; PG8_LDA(At, 0, 0); PG8_STAGE(PG8_SA(1, 1), a1 + hstep, voffA);
            PG8_WAIT_L(8); PG8_BAR; PG8_WAIT_L(0); PG8_MMA(0, 0, At, B0); PG8_BAR; PG8_SCHED;
            PG8_LDB(B1, 0, 1); PG8_STAGE(PG8_SB(0, 0), b2, voffB);
            PG8_BAR; PG8_WAIT_L(0); PG8_MMA(0, 1, At, B1); PG8_BAR;
            PG8_LDA(At, 0, 1); PG8_STAGE(PG8_SA(0, 0), a2, voffA);
            PG8_BAR; PG8_WAIT_L(0); PG8_MMA(1, 0, At, B0); PG8_BAR; PG8_SCHED;
            PG8_STAGE(PG8_SB(0, 1), b2 + hstep, voffB);
            PG8_WAIT_V(6); PG8_BAR; PG8_MMA(1, 1, At, B1); PG8_BAR;
            PG8_LDB(B0, 1, 0); PG8_SCHED; PG8_LDA(At, 1, 0); PG8_STAGE(PG8_SA(0, 1), a2 + hstep, voffA);
            PG8_WAIT_L(8); PG8_BAR; PG8_WAIT_L(0); PG8_MMA(0, 0, At, B0); PG8_BAR; PG8_SCHED;
            PG8_LDB(B1, 1, 1); PG8_STAGE(PG8_SB(1, 0), b3, voffB);
            PG8_BAR; PG8_WAIT_L(0); PG8_MMA(0, 1, At, B1); PG8_BAR;
            PG8_LDA(At, 1, 1); PG8_STAGE(PG8_SA(1, 0), a3, voffA);
            PG8_BAR; PG8_WAIT_L(0); PG8_MMA(1, 0, At, B0); PG8_BAR; PG8_SCHED;
            PG8_STAGE(PG8_SB(1, 1), b3 + hstep, voffB);
            PG8_WAIT_V(6); PG8_BAR; PG8_MMA(1, 1, At, B1); PG8_BAR;
            }
        }
        if constexpr (ALIGN_EPI) { if (wr == 0) PG8_BAR; }
        if constexpr (!Epi::AFTER_DRAIN) { E(acc, cur, wr, wc, fr, fq); S.done(cur); }
        if (!has_next) break;
#pragma unroll
        for (int a = 0; a < 2; ++a)
#pragma unroll
            for (int b = 0; b < 2; ++b)
#pragma unroll
                for (int m = 0; m < 4; ++m)
#pragma unroll
                    for (int n = 0; n < 2; ++n) acc[a][b][m][n] = (f32x4){0.f, 0.f, 0.f, 0.f};
        cur = nxt; cA = nA; cB = nB; ++ui;
        if constexpr (ALIGN_EPI) { if (wr == 1) PG8_BAR; }
    }
    PG8_WAIT_V(0);
    if constexpr (!ALIGN_EPI) { if (wr == 0) PG8_BAR; }
    PG8_BAR;
    if constexpr (Epi::AFTER_DRAIN) { E.fused(acc, cur, wr, wc, fr, fq, lds, wid, lane); S.done(cur); }
#undef PG8_SA
#undef PG8_SB
#undef PG8_STAGE
#undef PG8_LDA
#undef PG8_LDB
#undef PG8_MMA
#undef PG8_WAIT_V
#undef PG8_WAIT_L
#undef PG8_BAR
#undef PG8_SCHED
}
}

using namespace pg8;
constexpr int NWAVES = 8, NTHR = 512;
#define GAS __attribute__((address_space(1)))
#define LAS __attribute__((address_space(3)))
typedef unsigned short bf16;
#define LDS_WAIT() asm volatile("s_waitcnt lgkmcnt(0)" ::: "memory")
#define VM_WAIT() asm volatile("s_waitcnt vmcnt(0)" ::: "memory")
__device__ __forceinline__ unsigned f2bf(float f) { unsigned u = __builtin_bit_cast(unsigned, f); return (u + 0x7fffu + ((u >> 16) & 1u)) >> 16; }
__device__ __forceinline__ unsigned pk2(float lo, float hi) { return f2bf(lo) | (f2bf(hi) << 16); }
__device__ __forceinline__ float bf2f(bf16 b) { return __uint_as_float(((unsigned)b) << 16); }
__device__ __forceinline__ float wave_sum(float v) {
#pragma unroll
    for (int o = 1; o < 64; o <<= 1) v += __shfl_xor(v, o);
    return v;
}
__device__ __forceinline__ float siluf_(float x) { return x / (1.0f + __expf(-x)); }

constexpr size_t MiB = 1u << 20;
constexpr size_t WS_CTL = 0, CTL_ZERO_BYTES = 4 * MiB;
constexpr int CW_BAR = 4096;
constexpr int CW_CNT = 16384;
constexpr int CW_DBG = 20480;
constexpr size_t CTL_SSQ = 1 * MiB;
constexpr size_t WS_MODV = 4 * MiB;
constexpr size_t WS_TAB = 5 * MiB;
constexpr size_t WS_ROUTE = 6 * MiB;
constexpr size_t WS_WIN = 10 * MiB, WS_WQB = 37 * MiB, WS_WKVB = 39 * MiB, WS_WBR = 40 * MiB, WS_WOUT = 46 * MiB, WS_WGU = 50 * MiB, WS_WDN = 306 * MiB;
constexpr size_t WS_X = 434 * MiB, WS_H = 566 * MiB, WS_R = 632 * MiB;
constexpr size_t SZ_R512 = (size_t)MTOT * 512 * 2;
constexpr size_t WS_QA = WS_R, WS_KA = WS_QA + SZ_R512, WS_VA = WS_KA + SZ_R512, WS_QB = WS_VA + SZ_R512, WS_KB = WS_QB + SZ_R512, WS_VB = WS_KB + SZ_R512;
constexpr size_t WS_CQ = WS_VB + SZ_R512, WS_CKR = WS_CQ + (size_t)MTOT * 384 * 2, WS_CKV = WS_CKR + (size_t)MTOT * 32 * 2 + MiB, WS_GATES = WS_CKV + (size_t)MTOT * 256 * 2;
constexpr size_t WS_QC = WS_GATES + (size_t)MTOT * 3072 * 2, WS_KCN = WS_QC + (size_t)MTOT * 768 * 2, WS_VC = WS_KCN + SZ_R512, WS_O0 = WS_VC + SZ_R512;
constexpr size_t WS_YA = WS_O0 + (size_t)MTOT * 512 * 4, WS_YB = WS_YA + SZ_R512, WS_YC = WS_YB + SZ_R512, WS_M32 = WS_YC + SZ_R512, WS_MB = WS_M32 + (size_t)MTOT * 1024 * 4, WS_MIX_END = WS_MB + (size_t)MTOT * 1024 * 2;
constexpr int HS_ROWS = 143360;
constexpr size_t WS_HS = WS_R, WS_ACT = WS_HS + (size_t)HS_ROWS * 1024 * 2, WS_YBUF = WS_ACT + (size_t)HS_ROWS * 1024 * 2, WS_MOE_END = WS_YBUF + (size_t)MTOT * 4 * 1024 * 2;
constexpr size_t WS_END = (WS_MIX_END > WS_MOE_END ? WS_MIX_END : WS_MOE_END);
static_assert(WS_END <= (size_t)2040 * MiB, "workspace map");
constexpr size_t RT_E = 0, RT_SLOT = (size_t)MTOT * 4 * 4, RT_W = 2 * RT_SLOT, RT_YDST = 3 * RT_SLOT, RT_WROW = RT_YDST + (size_t)HS_ROWS * 4;
static_assert(WS_ROUTE + RT_WROW + (size_t)HS_ROWS * 4 <= WS_WIN, "routing map");

constexpr int RING_OFF = 0, RING_BYTES = 131072;
constexpr int TBL_OFF = RING_BYTES;
constexpr int MISC_OFF = TBL_OFF + 12288;
constexpr int LDS_BYTES = 147456;
static_assert(MISC_OFF + 256 <= LDS_BYTES, "LDS map");

#define XB_TMO      128
#define XB_XCNT(j)  (256  + 64 * (j))
#define XB_XSUB(j)  (1280 + 64 * (j))
#define XB_XGEN(j)  (2304 + 64 * (j))
#define XB_TOP      3328
#define XB_TOPGEN   3392
#define XCD_BAR_WORDS 3456
#define XB_SPIN_CAP (1u << 18)
__device__ __forceinline__ unsigned xb_ld(unsigned* p)              { return __hip_atomic_load(p, __ATOMIC_RELAXED, __HIP_MEMORY_SCOPE_AGENT); }
__device__ __forceinline__ unsigned xb_add(unsigned* p, unsigned v) { return __hip_atomic_fetch_add(p, v, __ATOMIC_RELAXED, __HIP_MEMORY_SCOPE_AGENT); }
__device__ __forceinline__ unsigned xb_xcc_id() { return (unsigned)__builtin_amdgcn_s_getreg((3 << 11) | 20) & 0xFu; }
#define XB_SPIN(cond, bar) do { unsigned _sp = 0; while (cond) { __builtin_amdgcn_s_sleep(1); \
    if ((++_sp & 255u) == 0u) { if (xb_ld(&(bar)[XB_TMO])) break; if (_sp > XB_SPIN_CAP) { atomicAdd(&(bar)[XB_TMO], 1u); break; } } } } while (0)
struct XcdBarrier { unsigned* bar; unsigned x; volatile LAS unsigned* st; };
__device__ __forceinline__ XcdBarrier xcd_barrier_post(unsigned* bar, volatile LAS unsigned* st) {
    XcdBarrier b; b.bar = bar; b.x = xb_xcc_id(); b.st = st;
    if (threadIdx.x == 0) (void)xb_add(&bar[XB_XCNT(b.x)], 1u);
    return b;
}
__device__ __forceinline__ void xcd_barrier_complete(unsigned* bar, unsigned x, unsigned& nloc, unsigned& nx) {
    const unsigned G = gridDim.x * gridDim.y * gridDim.z;
    unsigned sum, cnt, mine, sp = 0u;
    for (;;) {
        sum = 0u; cnt = 0u; mine = 0u;
#pragma unroll
        for (unsigned j = 0; j < 16; ++j) { const unsigned c = xb_ld(&bar[XB_XCNT(j)]); sum += c; cnt += (c > 0u) ? 1u : 0u; mine = (j == x) ? c : mine; }
        if (sum == G) break;
        __builtin_amdgcn_s_sleep(1);
        if ((++sp & 255u) == 0u) { if (xb_ld(&bar[XB_TMO])) break; if (sp > XB_SPIN_CAP) { atomicAdd(&bar[XB_TMO], 1u); break; } }
    }
    nloc = mine > 0u ? mine : 1u; nx = cnt > 0u ? cnt : 1u;
}
__device__ __forceinline__ void xcd_barrier(const XcdBarrier& b) {
    asm volatile("s_waitcnt vmcnt(0)" ::: "memory");
    __syncthreads();
    if (threadIdx.x == 0) {
        unsigned* bar = b.bar;
        __builtin_amdgcn_s_waitcnt(0);
        unsigned nloc = b.st[0], nx = b.st[1];
        if (nloc == 0u) { xcd_barrier_complete(bar, b.x, nloc, nx); b.st[0] = nloc; b.st[1] = nx; }
        const unsigned old = xb_add(&bar[XB_XSUB(b.x)], 1u);
        const unsigned gen = old / nloc;
        if (old + 1u == (gen + 1u) * nloc) {
            __builtin_amdgcn_fence(__ATOMIC_RELEASE, "agent");
            asm volatile("s_waitcnt vmcnt(0)" ::: "memory");
            const unsigned og = xb_add(&bar[XB_TOP], 1u);
            const unsigned tg = og / nx;
            if (og + 1u == (tg + 1u) * nx) xb_add(&bar[XB_TOPGEN], 1u);
            else XB_SPIN(xb_ld(&bar[XB_TOPGEN]) == tg, bar);
            __builtin_amdgcn_fence(__ATOMIC_ACQUIRE, "agent");
            xb_add(&bar[XB_XGEN(b.x)], 1u);
            asm volatile("s_waitcnt vmcnt(0)" ::: "memory");
        } else {
            XB_SPIN(xb_ld(&bar[XB_XGEN(b.x)]) == gen, bar);
            __builtin_amdgcn_fence(__ATOMIC_ACQUIRE, "agent");
            asm volatile("s_waitcnt vmcnt(0)" ::: "memory");
        }
    }
    __syncthreads();
}

struct Args { const float* in[30]; float* out; unsigned char* ws; int ph_lo, ph_hi; };
enum { I_X = 0, I_C, I_CTX, I_CCTX, I_WMOD, I_BMOD, I_GMIX, I_WIN, I_LQ1, I_LK1, I_LQ2, I_LK2, I_GSUB, I_RPB, I_GQA, I_WQB, I_GKVA, I_WKVB, I_WBRA, I_WBRB, I_WBRC, I_WOUT, I_GFFN, I_WROUT, I_BROUT, I_WGU, I_BGU, I_WDN, I_BDN, I_GFIN };

__device__ __forceinline__ int win_src(int n) {
    if (n < 1024) { const int g = n >> 6, p = n & 63, i = p >> 1, s = p & 1; return g * 64 + (i < 16 ? i : i + 16) + 16 * s; }
    if (n < OFF_CQ + 384) return n;
    if (n < OFF_PADW) { const int p = n - OFF_CKR, i = p >> 1, s = p & 1; return 3712 + (i < 8 ? i : i + 8) + 8 * s; }
    if (n < OFF_CKV) return -1;
    if (n < OFF_GATES) return 3456 + (n - OFF_CKV);
    return 3744 + (n - OFF_GATES);
}
__device__ __forceinline__ int wqb_src(int n) { const int h = n / 96, p = n - 96 * h; if (p < 64) return n; const int q = p - 64, i = q >> 1, s = q & 1; return h * 96 + 64 + (i < 8 ? i : i + 8) + 8 * s; }
__device__ __forceinline__ int wkvb_src(int n) { return n < 512 ? (n >> 6) * 128 + (n & 63) : ((n - 512) >> 6) * 128 + 64 + (n & 63); }
__device__ __forceinline__ int wgu_src(int n) { const int pn = n >> 8, s = (n >> 7) & 1, t = n & 127; return 2 * (128 * pn + t) + s; }
template <int KIND> __device__ __forceinline__ void transpose_item(const float* W, int K, int N, bf16* WT, const float* gk, LAS float* scr, int item, int nblk, int lane) {
    const int kb = item / nblk, nb = item % nblk, k0 = 64 * kb, n0 = 32 * nb;
    const int nd = n0 + (lane & 31);
    const int ns = KIND == 1 ? win_src(nd) : KIND == 2 ? wqb_src(nd) : KIND == 3 ? wkvb_src(nd) : KIND == 4 ? wgu_src(nd) : nd;
#pragma unroll 8
    for (int i = 0; i < 32; ++i) { const int kk = 2 * i + (lane >> 5); float v = 0.f; if (ns >= 0) v = W[(size_t)(k0 + kk) * N + ns]; if (gk) v *= gk[k0 + kk]; scr[kk * 33 + (lane & 31)] = v; }
    LDS_WAIT(); asm volatile("" ::: "memory");
    const int c = lane & 7;
#pragma unroll
    for (int j = 0; j < 4; ++j) { const int n = (lane >> 3) + 8 * j; const LAS float* s = scr + (8 * c) * 33 + n;
        u32x4 o; o.x = pk2(s[0 * 33], s[1 * 33]); o.y = pk2(s[2 * 33], s[3 * 33]); o.z = pk2(s[4 * 33], s[5 * 33]); o.w = pk2(s[6 * 33], s[7 * 33]);
        *(GAS u32x4*)(WT + (size_t)(n0 + n) * K + k0 + 8 * c) = o; }
    LDS_WAIT(); asm volatile("" ::: "memory");
}

struct Frame {
    LAS unsigned char* lds; volatile LAS unsigned* MISC; unsigned* ctl; unsigned char* ws;
    int tid, lane, wave, vcu, G;
    const float* const* in; float* out;
};
constexpr int IT_WIN = 16 * 216, IT_WQB = 6 * 24, IT_WKVB = 4 * 32, IT_WBR = 8 * 32, IT_WOUT = 16 * 32, IT_WGU = 16 * 64, IT_WDN = 16 * 32;
constexpr int IT_LAYER = IT_WIN + IT_WQB + IT_WKVB + 3 * IT_WBR + IT_WOUT + NEXP * (IT_WGU + IT_WDN);
__device__ __forceinline__ const float* in_l(const Frame& F, int idx, int l, size_t per_layer) { return F.in[idx] + (size_t)l * per_layer; }

__device__ __forceinline__ void p_prologue_a(Frame& F) {
    LAS float* scr = (LAS float*)(F.lds + RING_OFF + F.wave * 8704);
    const int gw = F.vcu * NWAVES + F.wave, NGW = F.G * NWAVES;
    for (int it = gw; it < DEPTH * IT_LAYER; it += NGW) {
        const int l = it / IT_LAYER; int r = it - l * IT_LAYER;
        if (r < IT_WIN) { transpose_item<1>(in_l(F, I_WIN, l, (size_t)DM * DIN), DM, DIN, (bf16*)(F.ws + WS_WIN) + (size_t)l * NINP * DM, nullptr, scr, r, 216, F.lane); continue; } r -= IT_WIN;
        if (r < IT_WQB) { transpose_item<2>(in_l(F, I_WQB, l, 384 * 768), 384, 768, (bf16*)(F.ws + WS_WQB) + (size_t)l * 768 * 384, in_l(F, I_GQA, l, 384), scr, r, 24, F.lane); continue; } r -= IT_WQB;
        if (r < IT_WKVB) { transpose_item<3>(in_l(F, I_WKVB, l, 256 * 1024), 256, 1024, (bf16*)(F.ws + WS_WKVB) + (size_t)l * 1024 * 256, in_l(F, I_GKVA, l, 256), scr, r, 32, F.lane); continue; } r -= IT_WKVB;
        if (r < 3 * IT_WBR) { const int br = r / IT_WBR; const float* src = in_l(F, br == 0 ? I_WBRA : br == 1 ? I_WBRB : I_WBRC, l, 512 * 1024);
            transpose_item<0>(src, 512, 1024, (bf16*)(F.ws + WS_WBR) + (size_t)(l * 3 + br) * 1024 * 512, nullptr, scr, r - br * IT_WBR, 32, F.lane); continue; } r -= 3 * IT_WBR;
        if (r < IT_WOUT) { transpose_item<0>(in_l(F, I_WOUT, l, 1024 * 1024), 1024, 1024, (bf16*)(F.ws + WS_WOUT) + (size_t)l * 1024 * 1024, nullptr, scr, r, 32, F.lane); continue; } r -= IT_WOUT;
        if (r < NEXP * IT_WGU) { const int e = r / IT_WGU; transpose_item<4>(in_l(F, I_WGU, l * NEXP + e, (size_t)1024 * 2048), 1024, 2048, (bf16*)(F.ws + WS_WGU) + (size_t)(l * NEXP + e) * 2048 * 1024, nullptr, scr, r - e * IT_WGU, 64, F.lane); continue; }
        r -= NEXP * IT_WGU;
        { const int e = r / IT_WDN; transpose_item<0>(in_l(F, I_WDN, l * NEXP + e, (size_t)1024 * 1024), 1024, 1024, (bf16*)(F.ws + WS_WDN) + (size_t)(l * NEXP + e) * 1024 * 1024, nullptr, scr, r - e * IT_WDN, 32, F.lane); }
    }
    __syncthreads();
    if (F.vcu < 2 * 96) {
        LAS float* sc = (LAS float*)(F.lds + RING_OFF + 80 * 1024);
        LAS float* red = sc + 5 * 1024;
        for (int i = F.tid; i < 5 * 1024; i += NTHR) { const float v = i < 4096 ? F.in[I_C][i] : F.in[I_CCTX][i - 4096]; sc[i] = siluf_(v); }
        __syncthreads();
        const int l = F.vcu / 96, n = (F.vcu % 96) * 64 + F.lane; const float* W = in_l(F, I_WMOD, l, (size_t)DM * 6144) + n;
        float a[5] = {0.f, 0.f, 0.f, 0.f, 0.f};
        for (int k = F.wave * 128; k < F.wave * 128 + 128; ++k) { const float w = W[(size_t)k * 6144];
#pragma unroll
            for (int v = 0; v < 5; ++v) a[v] += sc[v * 1024 + k] * w; }
#pragma unroll
        for (int v = 0; v < 5; ++v) red[(F.wave * 5 + v) * 64 + F.lane] = a[v];
        __syncthreads();
        if (F.tid < 320) { const int v = F.tid >> 6, ln = F.tid & 63; float s = 0.f;
#pragma unroll
            for (int w = 0; w < 8; ++w) s += red[(w * 5 + v) * 64 + ln];
            const int nn = (F.vcu % 96) * 64 + ln; ((float*)(F.ws + WS_MODV))[(size_t)(l * 5 + v) * 6144 + nn] = s + in_l(F, I_BMOD, l, 6144)[nn]; }
        __syncthreads();
    }
    { const int g = F.vcu * NTHR + F.tid; float* tabA = (float*)(F.ws + WS_TAB); float* tabC = tabA + 192 * 16 * 2;
      if (g < 192 * 16) { const int tr = g >> 4, i = g & 15; const float pos = (float)(tr < 128 ? tr : tr - 128); const float inv = powf(10000.0f, -(float)i / 16.0f); const float ang = pos * inv; tabA[2 * g] = cosf(ang); tabA[2 * g + 1] = sinf(ang); }
      else if (g < 192 * 16 + 192 * 8) { const int q = g - 192 * 16, tr = q >> 3, i = q & 7; const float pos = (float)(tr < 128 ? tr : tr - 128); const float inv = powf(10000.0f, -(float)i / 8.0f); const float ang = pos * inv; tabC[2 * q] = cosf(ang); tabC[2 * q + 1] = sinf(ang); }
      if (F.vcu == F.G - 1 && F.wave < 2) { const int l = F.wave; const float a = in_l(F, I_LQ1, l, 64)[F.lane] * in_l(F, I_LK1, l, 64)[F.lane], b = in_l(F, I_LQ2, l, 64)[F.lane] * in_l(F, I_LK2, l, 64)[F.lane];
          const float sa = wave_sum(a), sb = wave_sum(b); const float lam_init = 0.8f - 0.6f * expf(-0.3f * (float)l);
          if (F.lane == 0) { float* lam = tabC + 192 * 8 * 2; lam[2 * l] = expf(sa) - expf(sb) + lam_init; lam[2 * l + 1] = lam_init; } }
    }
}
__device__ __forceinline__ void mod_row_bf16(const float* xrow, const float* g, const float* sh, const float* scl, bf16* orow, int lane) {
    const f32x4* xr = (const f32x4*)xrow + lane; f32x4 v[4]; float s = 0.f;
#pragma unroll
    for (int j = 0; j < 4; ++j) { v[j] = xr[64 * j]; s += (v[j].x * v[j].x + v[j].y * v[j].y) + (v[j].z * v[j].z + v[j].w * v[j].w); }
    const float rstd = 1.0f / sqrtf(wave_sum(s) * (1.0f / DM) + EPS);
    unsigned long long* o8 = (unsigned long long*)orow + lane;
#pragma unroll
    for (int j = 0; j < 4; ++j) { const f32x4 gg = ((const f32x4*)g)[lane + 64 * j], ss = ((const f32x4*)sh)[lane + 64 * j], cc = ((const f32x4*)scl)[lane + 64 * j];
        const f32x4 y = v[j] * rstd * gg * (cc + 1.0f) + ss; o8[64 * j] = (unsigned long long)pk2(y.x, y.y) | ((unsigned long long)pk2(y.z, y.w) << 32); }
}
__device__ __forceinline__ void p_prologue_b(Frame& F) {
    const int gw = F.vcu * NWAVES + F.wave, NGW = F.G * NWAVES; const float* modv = (const float*)(F.ws + WS_MODV); bf16* H = (bf16*)(F.ws + WS_H);
    for (int m = gw; m < MTOT; m += NGW) { const int b = m < NLAT ? m / SEQ : 4; const float* xr = m < NLAT ? F.in[I_X] + (size_t)m * DM : F.in[I_CTX] + (size_t)(m - NLAT) * DM;
        mod_row_bf16(xr, F.in[I_GMIX], modv + b * 6144, modv + b * 6144 + 1024, H + (size_t)m * DM, F.lane); }
}
__device__ __forceinline__ void p_final_norm(Frame& F, const float* X) {
    const int gw = F.vcu * NWAVES + F.wave, NGW = F.G * NWAVES; const f32x4* g = (const f32x4*)F.in[I_GFIN];
    for (int m = gw; m < NLAT; m += NGW) { const f32x4* xr = (const f32x4*)(X + (size_t)m * DM) + F.lane; f32x4 v[4]; float s = 0.f;
#pragma unroll
        for (int j = 0; j < 4; ++j) { v[j] = xr[64 * j]; s += (v[j].x * v[j].x + v[j].y * v[j].y) + (v[j].z * v[j].z + v[j].w * v[j].w); }
        const float rstd = 1.0f / sqrtf(wave_sum(s) * (1.0f / DM) + EPS);
        f32x4* outp = (f32x4*)(F.out + (size_t)m * DM) + F.lane;
#pragma unroll
        for (int j = 0; j < 4; ++j) outp[64 * j] = v[j] * rstd * g[F.lane + 64 * j]; }
}

namespace att {
using f32x16 = __attribute__((ext_vector_type(16))) float;
using s16x4 = __attribute__((ext_vector_type(4))) short;
constexpr float THR = 8.0f;
constexpr float NEGBIG = -3.0e38f, MINIT = -1.0e30f;
__device__ __forceinline__ int crow(int r, int hi) { return (r & 3) + 8 * (r >> 2) + 4 * hi; }
constexpr int L_K1 = 0, L_K2 = 16384, L_V = 24576, L_WS = 57344, L_RPB = 59392, L_END = 61440;
template <int OFF> __device__ __forceinline__ s16x4 tr_read(int vb) { s16x4 r; asm volatile("ds_read_b64_tr_b16 %0, %1 offset:%2" : "=&v"(r) : "v"(vb), "i"(OFF) : "memory"); return r; }
__device__ __forceinline__ int v_rd_base(int lane) { return ((lane & 3) << 3) | (((lane >> 2) & 3) << 6) | (((lane >> 4) & 1) << 5) | (((lane >> 5) & 1) << 8); }
template <int DV> __device__ __forceinline__ int v_st(int k, int c) { return ((k >> 3) * (DV / 32) + (c >> 5)) * 512 + ((k & 7) * 32 + (c & 31)) * 2; }
template <int DV, int D0> __device__ __forceinline__ void pv_one(f32x16& od, int vb, bf16x8 pa0, bf16x8 pa1, bf16x8 pa2, bf16x8 pa3) {
    constexpr int KT = (DV / 32) * 512;
    const s16x4 l0 = tr_read<D0 * 512 + 0 * KT>(vb), h0 = tr_read<D0 * 512 + 1 * KT>(vb), l1 = tr_read<D0 * 512 + 2 * KT>(vb), h1 = tr_read<D0 * 512 + 3 * KT>(vb);
    const s16x4 l2 = tr_read<D0 * 512 + 4 * KT>(vb), h2 = tr_read<D0 * 512 + 5 * KT>(vb), l3 = tr_read<D0 * 512 + 6 * KT>(vb), h3 = tr_read<D0 * 512 + 7 * KT>(vb);
    asm volatile("s_waitcnt lgkmcnt(0)" ::: "memory"); __builtin_amdgcn_sched_barrier(0);
#define PKV(L, H) (bf16x8){L[0], L[1], L[2], L[3], H[0], H[1], H[2], H[3]}
    od = __builtin_amdgcn_mfma_f32_32x32x16_bf16(pa0, PKV(l0, h0), od, 0, 0, 0);
    od = __builtin_amdgcn_mfma_f32_32x32x16_bf16(pa1, PKV(l1, h1), od, 0, 0, 0);
    od = __builtin_amdgcn_mfma_f32_32x32x16_bf16(pa2, PKV(l2, h2), od, 0, 0, 0);
    od = __builtin_amdgcn_mfma_f32_32x32x16_bf16(pa3, PKV(l3, h3), od, 0, 0, 0);
#undef PKV
}
struct NaParams { const float* rpb_h; int r0; };
template <int DK2, int DV, int MODE>
__device__ __forceinline__ void attn_pass(LAS unsigned char* lds, const bf16* Qrow0, int ldq, const bf16* K1, const bf16* K2, const bf16* V, int lat0, int ntl, int ctx0, int ntc, const NaParams na, int kr_lo,
                                          f32x16 (&o)[DV / 32], float& l_out) {
    constexpr int NQ = 4 + DK2 / 16, ND = DV / 32;
    int tid_ = threadIdx.x; asm volatile("" : "+v"(tid_)); const int tid = tid_, lane = tid & 63, r32 = lane & 31, hi = lane >> 5; const int wid = __builtin_amdgcn_readfirstlane(tid >> 6);
    LAS float* wsf = (LAS float*)(lds + L_WS) + wid * 64; LAS float* rpbl = (LAS float*)(lds + L_RPB);
    bf16x8 qr[NQ];
    { const bf16* qp = Qrow0 + (size_t)(wid * 32 + r32) * ldq + hi * 8;
#pragma unroll
      for (int d0 = 0; d0 < NQ; ++d0) qr[d0] = *(const bf16x8*)(qp + d0 * 16); }
    if (MODE == 1) { for (int i = tid; i < 15 * 31; i += NTHR) rpbl[i] = na.rpb_h[i] * LOG2E; }
    const int k1r = tid >> 3, k1c = tid & 7, k1dst = k1r * 128 + ((k1c ^ ((k1r >> 1) & 7)) << 4);
    const int k2r = (tid >> 2) & 63, k2c = tid & 3, k2dst = k2r * 64 + ((k2c ^ ((k2r >> 2) & 3)) << 4);
    const int vr = DV == 128 ? (tid >> 4) : (tid >> 3), vc = DV == 128 ? (tid & 15) * 8 : (tid & 7) * 8; const int vdst0 = v_st<DV>(vr, vc), vdst1 = v_st<DV>(vr + 32, vc);
    bf16x8 sk1, sk2, sv0, sv1;
    const int NT = ntl + ntc;
#define TROW(t) ((t) < ntl ? lat0 + (t) * 64 : ctx0 + ((t) - ntl) * 64)
#define SLOAD(t) do { const size_t kr_ = (size_t)TROW(t); sk1 = *(const bf16x8*)(K1 + (kr_ + k1r) * 512 + k1c * 8); if (DK2 && tid < 256) sk2 = *(const bf16x8*)(K2 + (kr_ + k2r) * 32 + k2c * 8); \
        sv0 = *(const bf16x8*)(V + (kr_ + vr) * 512 + vc); if (DV == 128) sv1 = *(const bf16x8*)(V + (kr_ + vr + 32) * 512 + vc); } while (0)
#define SWRITE(b) do { *(LAS bf16x8*)(lds + L_K1 + (b) * 8192 + k1dst) = sk1; if (DK2 && tid < 256) *(LAS bf16x8*)(lds + L_K2 + (b) * 4096 + k2dst) = sk2; \
        *(LAS bf16x8*)(lds + L_V + (b) * (DV * 128) + vdst0) = sv0; if (DV == 128) *(LAS bf16x8*)(lds + L_V + (b) * (DV * 128) + vdst1) = sv1; } while (0)
    float m_reg = MINIT, l_reg = 0.f;
#pragma unroll
    for (int d = 0; d < ND; ++d) o[d] = f32x16{};
    const int rq = na.r0 + (wid >> 1), cq = 32 * (wid & 1) + r32; const int rs_w = min(max(rq - 4, 0), 120), cs = min(max(cq - 8, 0), 48);
    const int vb0 = (int)(uintptr_t)(lds + L_V) + v_rd_base(lane);
    SLOAD(0); SWRITE(0); __syncthreads();
    for (int t = 0; t < NT; ++t) {
        const int cur = t & 1;
        if (t + 1 < NT) SLOAD(t + 1);
        bool active = true; int kr = 0;
        if (MODE == 1 && t < ntl) { kr = kr_lo + t; active = (kr >= rs_w) && (kr < rs_w + 8); }
        if (active) {
            f32x16 p0 = f32x16{}, p1 = f32x16{};
            { const LAS unsigned char* kb = lds + L_K1 + cur * 8192;
#pragma unroll
              for (int d0 = 0; d0 < 4; ++d0) { const int ch = 2 * d0 + hi;
                  const bf16x8 b0 = *(const LAS bf16x8*)(kb + r32 * 128 + ((ch ^ ((r32 >> 1) & 7)) << 4));
                  const bf16x8 b1 = *(const LAS bf16x8*)(kb + (32 + r32) * 128 + ((ch ^ (((32 + r32) >> 1) & 7)) << 4));
                  p0 = __builtin_amdgcn_mfma_f32_32x32x16_bf16(b0, qr[d0], p0, 0, 0, 0); p1 = __builtin_amdgcn_mfma_f32_32x32x16_bf16(b1, qr[d0], p1, 0, 0, 0); }
              if (DK2) { const LAS unsigned char* k2b = lds + L_K2 + cur * 4096;
#pragma unroll
                  for (int d0 = 0; d0 < DK2 / 16; ++d0) { const int ch = 2 * d0 + hi;
                      const bf16x8 b0 = *(const LAS bf16x8*)(k2b + r32 * 64 + ((ch ^ ((r32 >> 2) & 3)) << 4));
                      const bf16x8 b1 = *(const LAS bf16x8*)(k2b + (32 + r32) * 64 + ((ch ^ (((32 + r32) >> 2) & 3)) << 4));
                      p0 = __builtin_amdgcn_mfma_f32_32x32x16_bf16(b0, qr[4 + d0], p0, 0, 0, 0); p1 = __builtin_amdgcn_mfma_f32_32x32x16_bf16(b1, qr[4 + d0], p1, 0, 0, 0); } }
            }
            if (MODE == 1 && t < ntl) {
                const LAS float* bl = rpbl + (kr - rq + 7) * 31 + 15 - cq;
#pragma unroll
                for (int r = 0; r < 16; ++r) { const int c0 = crow(r, hi), c1 = 32 + c0;
                    p0[r] = ((unsigned)(c0 - cs) < 16u) ? p0[r] + bl[c0] : NEGBIG; p1[r] = ((unsigned)(c1 - cs) < 16u) ? p1[r] + bl[c1] : NEGBIG; }
            }
            float pmax = p0[0];
#pragma unroll
            for (int r = 1; r < 16; ++r) pmax = fmaxf(pmax, p0[r]);
#pragma unroll
            for (int r = 0; r < 16; ++r) pmax = fmaxf(pmax, p1[r]);
            { auto rr = __builtin_amdgcn_permlane32_swap(__float_as_uint(pmax), __float_as_uint(pmax), false, false); pmax = fmaxf(__uint_as_float(rr[0]), __uint_as_float(rr[1])); }
            float alpha = 1.f;
            if (!__all(pmax - m_reg <= THR)) {
                const float mn = fmaxf(m_reg, pmax); alpha = __builtin_amdgcn_exp2f(m_reg - mn); m_reg = mn;
                if (hi == 0) wsf[r32] = alpha;
#pragma unroll
                for (int d = 0; d < ND; ++d)
#pragma unroll
                    for (int r = 0; r < 16; ++r) o[d][r] *= wsf[crow(r, hi)];
            }
            float ps = 0.f;
#pragma unroll
            for (int r = 0; r < 16; ++r) { p0[r] = __builtin_amdgcn_exp2f(p0[r] - m_reg); p1[r] = __builtin_amdgcn_exp2f(p1[r] - m_reg); ps += p0[r] + p1[r]; }
            { auto rr = __builtin_amdgcn_permlane32_swap(__float_as_uint(ps), __float_as_uint(ps), false, false); ps = __uint_as_float(rr[0]) + __uint_as_float(rr[1]); }
            l_reg = l_reg * alpha + ps;
            u32x4 w0, w1, w2, w3;
            w0 = (u32x4){cvt_pk_bf16(p0[0], p0[1]), cvt_pk_bf16(p0[2], p0[3]), cvt_pk_bf16(p0[4], p0[5]), cvt_pk_bf16(p0[6], p0[7])};
            w1 = (u32x4){cvt_pk_bf16(p0[8], p0[9]), cvt_pk_bf16(p0[10], p0[11]), cvt_pk_bf16(p0[12], p0[13]), cvt_pk_bf16(p0[14], p0[15])};
            w2 = (u32x4){cvt_pk_bf16(p1[0], p1[1]), cvt_pk_bf16(p1[2], p1[3]), cvt_pk_bf16(p1[4], p1[5]), cvt_pk_bf16(p1[6], p1[7])};
            w3 = (u32x4){cvt_pk_bf16(p1[8], p1[9]), cvt_pk_bf16(p1[10], p1[11]), cvt_pk_bf16(p1[12], p1[13]), cvt_pk_bf16(p1[14], p1[15])};
            const bf16x8 pa0 = __builtin_bit_cast(bf16x8, w0), pa1 = __builtin_bit_cast(bf16x8, w1), pa2 = __builtin_bit_cast(bf16x8, w2), pa3 = __builtin_bit_cast(bf16x8, w3);
            const int vb = vb0 + cur * (DV * 128);
            pv_one<DV, 0>(o[0], vb, pa0, pa1, pa2, pa3); pv_one<DV, 1>(o[1], vb, pa0, pa1, pa2, pa3);
            if constexpr (DV == 128) { pv_one<DV, 2>(o[2], vb, pa0, pa1, pa2, pa3); pv_one<DV, 3>(o[3], vb, pa0, pa1, pa2, pa3); }
        }
        if (t + 1 < NT) SWRITE(cur ^ 1);
        __syncthreads();
    }
    l_out = l_reg;
#undef TROW
#undef SLOAD
#undef SWRITE
}
__device__ __forceinline__ void row_recip(LAS unsigned char* lds, float l_reg, float (&rli)[16]) {
    const int tid = threadIdx.x; int lane = tid & 63; asm volatile("" : "+v"(lane)); const int r32 = lane & 31, hi = lane >> 5; const int wid = __builtin_amdgcn_readfirstlane(tid >> 6);
    LAS float* wsf = (LAS float*)(lds + L_WS) + wid * 64;
    if (hi == 0) wsf[32 + r32] = l_reg;
#pragma unroll
    for (int r = 0; r < 16; ++r) rli[r] = 1.0f / wsf[32 + crow(r, hi)];
}
template <int DV> __device__ __forceinline__ void store_bf16(LAS unsigned char* lds, const f32x16 (&o)[DV / 32], float l_reg, bf16* Y, int ld) {
    const int tid = threadIdx.x; int lane = tid & 63; asm volatile("" : "+v"(lane)); const int r32 = lane & 31, hi = lane >> 5; const int wid = __builtin_amdgcn_readfirstlane(tid >> 6);
    float rli[16]; row_recip(lds, l_reg, rli);
    bf16* yw = Y + (size_t)(wid * 32) * ld + r32;
#pragma unroll
    for (int r = 0; r < 16; ++r)
#pragma unroll
        for (int d = 0; d < DV / 32; ++d) yw[(size_t)crow(r, hi) * ld + d * 32] = (bf16)f2bf(o[d][r] * rli[r]);
}
}

__device__ __forceinline__ void p_attention(Frame& F, int l) {
    using namespace att;
    LAS unsigned char* lds = F.lds + RING_OFF;
    const int wid = F.wave;
    const bf16 *QA = (const bf16*)(F.ws + WS_QA), *KA = (const bf16*)(F.ws + WS_KA), *VA = (const bf16*)(F.ws + WS_VA), *QB = (const bf16*)(F.ws + WS_QB), *KB = (const bf16*)(F.ws + WS_KB), *VB = (const bf16*)(F.ws + WS_VB);
    const bf16 *QC = (const bf16*)(F.ws + WS_QC), *KCN = (const bf16*)(F.ws + WS_KCN), *VC = (const bf16*)(F.ws + WS_VC), *CKR = (const bf16*)(F.ws + WS_CKR);
    bf16 *YA = (bf16*)(F.ws + WS_YA), *YB = (bf16*)(F.ws + WS_YB), *YC = (bf16*)(F.ws + WS_YC); float* O0 = (float*)(F.ws + WS_O0);
    const float* lamp = (const float*)(F.ws + WS_TAB) + 192 * 16 * 2 + 192 * 8 * 2; const float lam = lamp[2 * l], lam_init = lamp[2 * l + 1];
    const float* gsub = in_l(F, I_GSUB, l, 128);
    const int nctxA = (l == 0) ? 16 : 0, nctxBC = (l == 0) ? 32 : 0;
    const NaParams na0{nullptr, 0};
    for (int u = F.vcu; u < 512 + nctxA; u += F.G) {
        int b, h, qrow0, ntl;
        if (u < 512) { b = u >> 7; h = (u >> 5) & 3; qrow0 = b * SEQ + (u & 31) * 256; ntl = 128; } else { const int v = u - 512; b = v >> 2; h = v & 3; qrow0 = NLAT + b * CTXL; ntl = 0; }
        const int lat0 = b * SEQ, ctx0 = NLAT + b * CTXL;
        for (int c = 0; c < 2; ++c) {
            f32x16 o[4]; float lsum;
            attn_pass<0, 128, 0>(lds, QA + (size_t)qrow0 * 512 + h * 128 + c * 64, 512, KA + h * 128 + c * 64, nullptr, VA + h * 128, lat0, ntl, ctx0, 4, na0, 0, o, lsum);
            float rli[16]; row_recip(lds, lsum, rli);
            int lane_ = F.lane; asm volatile("" : "+v"(lane_)); const int r32 = lane_ & 31, hi = lane_ >> 5;
            float* o0w = O0 + (size_t)(qrow0 + wid * 32) * 512 + h * 128 + r32;
            if (c == 0) {
#pragma unroll
                for (int r = 0; r < 16; ++r)
#pragma unroll
                    for (int d = 0; d < 4; ++d) o0w[(size_t)crow(r, hi) * 512 + d * 32] = o[d][r] * rli[r];
            } else {
                float ss[16];
#pragma unroll
                for (int r = 0; r < 16; ++r) { float s = 0.f;
#pragma unroll
                    for (int d = 0; d < 4; ++d) { const float y = o0w[(size_t)crow(r, hi) * 512 + d * 32] - lam * (o[d][r] * rli[r]); o[d][r] = y; s += y * y; }
                    ss[r] = s; }
#pragma unroll
                for (int r = 0; r < 16; ++r) {
#pragma unroll
                    for (int x = 1; x < 32; x <<= 1) ss[r] += __shfl_xor(ss[r], x);
                    ss[r] = __builtin_amdgcn_rsqf(ss[r] * (1.0f / 128.0f) + EPS) * (1.0f - lam_init); }
                bf16* yw = YA + (size_t)(qrow0 + wid * 32) * 512 + h * 128 + r32;
#pragma unroll
                for (int d = 0; d < 4; ++d) { const float g = gsub[d * 32 + r32];
#pragma unroll
                    for (int r = 0; r < 16; ++r) yw[(size_t)crow(r, hi) * 512 + d * 32] = (bf16)f2bf(o[d][r] * ss[r] * g); }
            }
        }
    }
    for (int u = F.vcu; u < 1024 + nctxBC; u += F.G) {
        int b, h, qrow0, ntl;
        if (u < 1024) { b = u >> 8; h = (u >> 5) & 7; qrow0 = b * SEQ + (u & 31) * 256; ntl = 128; } else { const int v = u - 1024; b = v >> 3; h = v & 7; qrow0 = NLAT + b * CTXL; ntl = 0; }
        f32x16 o[2]; float lsum;
        attn_pass<32, 64, 0>(lds, QC + (size_t)qrow0 * 768 + h * 96, 768, KCN + h * 64, CKR, VC + h * 64, b * SEQ, ntl, NLAT + b * CTXL, 4, na0, 0, o, lsum);
        store_bf16<64>(lds, o, lsum, YC + (size_t)qrow0 * 512 + h * 64, 512);
    }
    for (int u = F.vcu; u < 1024; u += F.G) {
        const int b = u >> 8, h = (u >> 5) & 7, qb = u & 31, r0 = qb * 4, qrow0 = b * SEQ + qb * 256;
        const int kr_lo = min(max(r0 - 4, 0), 120), kr_hi = min(max(r0 + 3 - 4, 0), 120) + 7;
        const NaParams na{in_l(F, I_RPB, l, 8 * 15 * 31) + h * 15 * 31, r0};
        f32x16 o[2]; float lsum;
        attn_pass<0, 64, 1>(lds, QB + (size_t)qrow0 * 512 + h * 64, 512, KB + h * 64, nullptr, VB + h * 64, b * SEQ + kr_lo * 64, kr_hi - kr_lo + 1, NLAT + b * CTXL, 4, na, kr_lo, o, lsum);
        store_bf16<64>(lds, o, lsum, YB + (size_t)qrow0 * 512 + h * 64, 512);
    }
    for (int u = F.vcu; u < nctxBC; u += F.G) {
        const int b = u >> 3, h = u & 7, qrow0 = NLAT + b * CTXL;
        f32x16 o[2]; float lsum;
        attn_pass<0, 64, 0>(lds, QB + (size_t)qrow0 * 512 + h * 64, 512, KB + h * 64, nullptr, VB + h * 64, 0, 0, qrow0, 4, na0, 0, o, lsum);
        store_bf16<64>(lds, o, lsum, YB + (size_t)qrow0 * 512 + h * 64, 512);
    }
}

constexpr int TB_LCNT = 0, TB_GBASE = 128, TB_BASE = 256, TB_TILE = 4096, TB_REC = 1280;
__device__ __forceinline__ void p_route(Frame& F, int l, int M) {
    LAS float* WrT = (LAS float*)(F.lds + RING_OFF);
    LAS int* lcnt = (LAS int*)(F.lds + TBL_OFF + TB_LCNT); LAS int* gbase = (LAS int*)(F.lds + TBL_OFF + TB_GBASE); LAS int* rec = (LAS int*)(F.lds + TBL_OFF + TB_REC);
    const float* Wr = in_l(F, I_WROUT, l, 1024 * 32);
    for (int i = F.tid; i < 1024 * 32; i += NTHR) { const int k = i >> 5, e = i & 31; WrT[e * 1024 + k] = Wr[i]; }
    if (F.tid < 32) lcnt[F.tid] = 0;
    __syncthreads();
    const int rpb = (M + F.G - 1) / F.G, m0 = F.vcu * rpb, m1 = min(M, m0 + rpb);
    const float* modv = (const float*)(F.ws + WS_MODV) + (size_t)l * 5 * 6144; const float* X = (const float*)(F.ws + WS_X); bf16* H = (bf16*)(F.ws + WS_H);
    const f32x4* g = (const f32x4*)in_l(F, I_GFFN, l, DM); const float brl = in_l(F, I_BROUT, l, 32)[F.lane >> 1];
    int* rt_e = (int*)(F.ws + WS_ROUTE + RT_E); int* rt_slot = (int*)(F.ws + WS_ROUTE + RT_SLOT); float* rt_w = (float*)(F.ws + WS_ROUTE + RT_W);
    for (int m = m0 + F.wave; m < m1; m += NWAVES) {
        const int b = m < NLAT ? m / SEQ : 4; const f32x4* sh = (const f32x4*)(modv + b * 6144 + 3 * 1024); const f32x4* sc = (const f32x4*)(modv + b * 6144 + 4 * 1024);
        const f32x4* xr = (const f32x4*)(X + (size_t)m * DM) + F.lane; f32x4 v[4]; float s = 0.f;
#pragma unroll
        for (int j = 0; j < 4; ++j) { v[j] = xr[64 * j]; s += (v[j].x * v[j].x + v[j].y * v[j].y) + (v[j].z * v[j].z + v[j].w * v[j].w); }
        const float rstd = 1.0f / sqrtf(wave_sum(s) * (1.0f / DM) + EPS);
        unsigned long long* o8 = (unsigned long long*)(H + (size_t)m * DM) + F.lane;
#pragma unroll
        for (int j = 0; j < 4; ++j) { v[j] = v[j] * rstd * g[F.lane + 64 * j] * (sc[F.lane + 64 * j] + 1.0f) + sh[F.lane + 64 * j];
            o8[64 * j] = (unsigned long long)pk2(v[j].x, v[j].y) | ((unsigned long long)pk2(v[j].z, v[j].w) << 32); }
        float acc[32];
#pragma unroll
        for (int e = 0; e < 32; ++e) { float a = 0.f;
#pragma unroll
            for (int j = 0; j < 4; ++j) { const f32x4 w = *(const LAS f32x4*)(WrT + e * 1024 + 256 * j + 4 * F.lane); a += (v[j].x * w.x + v[j].y * w.y) + (v[j].z * w.z + v[j].w * w.w); }
            acc[e] = a; }
#pragma unroll
        for (int i = 0; i < 16; ++i) { const bool up = (F.lane & 32) != 0; const float keep = up ? acc[i + 16] : acc[i], send = up ? acc[i] : acc[i + 16]; acc[i] = keep + __shfl_xor(send, 32); }
#pragma unroll
        for (int i = 0; i < 8; ++i) { const bool up = (F.lane & 16) != 0; const float keep = up ? acc[i + 8] : acc[i], send = up ? acc[i] : acc[i + 8]; acc[i] = keep + __shfl_xor(send, 16); }
#pragma unroll
        for (int i = 0; i < 4; ++i) { const bool up = (F.lane & 8) != 0; const float keep = up ? acc[i + 4] : acc[i], send = up ? acc[i] : acc[i + 4]; acc[i] = keep + __shfl_xor(send, 8); }
#pragma unroll
        for (int i = 0; i < 2; ++i) { const bool up = (F.lane & 4) != 0; const float keep = up ? acc[i + 2] : acc[i], send = up ? acc[i] : acc[i + 2]; acc[i] = keep + __shfl_xor(send, 4); }
        { const bool up = (F.lane & 2) != 0; const float keep = up ? acc[1] : acc[0], send = up ? acc[0] : acc[1]; acc[0] = keep + __shfl_xor(send, 2); }
        float logit = acc[0] + __shfl_xor(acc[0], 1) + brl;
        float tv[4]; int te[4];
#pragma unroll
        for (int k = 0; k < 4; ++k) { float mx = logit;
#pragma unroll
            for (int o = 1; o < 64; o <<= 1) mx = fmaxf(mx, __shfl_xor(mx, o));
            const unsigned long long bal = __ballot(logit == mx); const int fl = __builtin_ctzll(bal); te[k] = fl >> 1; tv[k] = mx; if ((F.lane >> 1) == te[k]) logit = -INFINITY; }
        const float e1 = __expf(tv[1] - tv[0]), e2 = __expf(tv[2] - tv[0]), e3 = __expf(tv[3] - tv[0]); const float inv = 1.0f / (1.0f + e1 + e2 + e3);
        if (F.lane < 4) { const int ee = F.lane == 0 ? te[0] : F.lane == 1 ? te[1] : F.lane == 2 ? te[2] : te[3]; const float ww = (F.lane == 0 ? 1.0f : F.lane == 1 ? e1 : F.lane == 2 ? e2 : e3) * inv;
            const int pos = __hip_atomic_fetch_add(lcnt + ee, 1, __ATOMIC_RELAXED, __HIP_MEMORY_SCOPE_WORKGROUP); rec[(m - m0) * 4 + F.lane] = ee | (pos << 8); rt_w[(size_t)m * 4 + F.lane] = ww; }
    }
    __syncthreads();
    if (F.tid < 32) gbase[F.tid] = (int)atomicAdd(F.ctl + CW_CNT + l * 64 + F.tid, (unsigned)lcnt[F.tid]);
    __syncthreads();
    for (int i = F.tid; i < (m1 - m0) * 4; i += NTHR) { const int r = rec[i], e = r & 255, pos = r >> 8; rt_e[(size_t)m0 * 4 + i] = e; rt_slot[(size_t)m0 * 4 + i] = gbase[e] + pos; }
    __syncthreads();
}
__device__ __forceinline__ int build_expert_tables(Frame& F, int l) {
    LAS int* base = (LAS int*)(F.lds + TBL_OFF + TB_BASE); LAS int* tile_e = (LAS int*)(F.lds + TBL_OFF + TB_TILE);
    __syncthreads();
    if (F.tid == 0) { int acc = 0; for (int e = 0; e < 32; ++e) { const int c = (int)__hip_atomic_load(F.ctl + CW_CNT + l * 64 + e, __ATOMIC_RELAXED, __HIP_MEMORY_SCOPE_AGENT); base[e] = acc; acc += ((c + 255) >> 8) << 8; } base[32] = acc; }
    __syncthreads();
    for (int t = F.tid; t < 640; t += NTHR) { int e = 0; for (int j = 1; j < 32; ++j) e += (base[j] <= t * 256) ? 1 : 0; tile_e[t] = e; }
    __syncthreads();
    return base[32] >> 8;
}
__device__ __forceinline__ void p_gather(Frame& F, int l, int M) {
    (void)build_expert_tables(F, l);
    LAS int* base = (LAS int*)(F.lds + TBL_OFF + TB_BASE);
    const int* rt_e = (const int*)(F.ws + WS_ROUTE + RT_E); const int* rt_slot = (const int*)(F.ws + WS_ROUTE + RT_SLOT); const float* rt_w = (const float*)(F.ws + WS_ROUTE + RT_W);
    int* ydst = (int*)(F.ws + WS_ROUTE + RT_YDST); float* wrow = (float*)(F.ws + WS_ROUTE + RT_WROW);
    const bf16* H = (const bf16*)(F.ws + WS_H); bf16* HS = (bf16*)(F.ws + WS_HS);
    const int gw = F.vcu * NWAVES + F.wave, NGW = F.G * NWAVES;
    for (int m = gw; m < M; m += NGW) {
        const u32x4* hr = (const u32x4*)(H + (size_t)m * DM) + F.lane; const u32x4 a = hr[0], b = hr[64];
#pragma unroll
        for (int k = 0; k < 4; ++k) { const int e = rt_e[(size_t)m * 4 + k]; const int dst = base[e] + rt_slot[(size_t)m * 4 + k];
            u32x4* dr = (u32x4*)(HS + (size_t)dst * DM) + F.lane; dr[0] = a; dr[64] = b;
            if (F.lane == 0) { ydst[dst] = m * 4 + k; wrow[dst] = rt_w[(size_t)m * 4 + k]; } }
    }
    for (int i = blockIdx.x * NTHR + F.tid; i < 32 * 256; i += F.G * NTHR) { const int e = i >> 8, j = i & 255; const int c = (int)__hip_atomic_load(F.ctl + CW_CNT + l * 64 + e, __ATOMIC_RELAXED, __HIP_MEMORY_SCOPE_AGENT);
        const int r = base[e] + c + j; if (r < base[e + 1]) { ydst[r] = -1; wrow[r] = 0.f; } }
}
__device__ __forceinline__ void p_combine(Frame& F, int l, int M) {
    const int gw = F.vcu * NWAVES + F.wave, NGW = F.G * NWAVES; const bool last = (l == DEPTH - 1);
    const float* modv = (const float*)(F.ws + WS_MODV) + (size_t)l * 5 * 6144; const float* modn = modv + 5 * 6144; float* X = (float*)(F.ws + WS_X); bf16* H = (bf16*)(F.ws + WS_H); const bf16* YB = (const bf16*)(F.ws + WS_YBUF);
    const f32x4* gn = (const f32x4*)(last ? F.in[I_GFIN] : in_l(F, I_GMIX, l + 1, DM));
    for (int m = gw; m < M; m += NGW) {
        const int b = m < NLAT ? m / SEQ : 4; const f32x4* gt2 = (const f32x4*)(modv + b * 6144 + 5 * 1024);
        f32x4* xr = (f32x4*)(X + (size_t)m * DM) + F.lane; f32x4 v[4]; float s = 0.f;
#pragma unroll
        for (int j = 0; j < 4; ++j) { f32x4 y = (f32x4){0.f, 0.f, 0.f, 0.f};
#pragma unroll
            for (int k = 0; k < 4; ++k) { const unsigned long long w = ((const unsigned long long*)(YB + (size_t)(m * 4 + k) * DM))[F.lane + 64 * j]; const unsigned lo = (unsigned)w, hi = (unsigned)(w >> 32);
                y += (f32x4){bf_lo(lo), bf_hi(lo), bf_lo(hi), bf_hi(hi)}; }
            v[j] = xr[64 * j] + gt2[F.lane + 64 * j] * y; s += (v[j].x * v[j].x + v[j].y * v[j].y) + (v[j].z * v[j].z + v[j].w * v[j].w); }
        const float rstd = 1.0f / sqrtf(wave_sum(s) * (1.0f / DM) + EPS);
        if (!last) {
            const f32x4* sh = (const f32x4*)(modn + b * 6144); const f32x4* sc = (const f32x4*)(modn + b * 6144 + 1024); unsigned long long* o8 = (unsigned long long*)(H + (size_t)m * DM) + F.lane;
#pragma unroll
            for (int j = 0; j < 4; ++j) { xr[64 * j] = v[j]; const f32x4 y = v[j] * rstd * gn[F.lane + 64 * j] * (sc[F.lane + 64 * j] + 1.0f) + sh[F.lane + 64 * j];
                o8[64 * j] = (unsigned long long)pk2(y.x, y.y) | ((unsigned long long)pk2(y.z, y.w) << 32); }
        } else {
            f32x4* op = (f32x4*)(F.out + (size_t)m * DM) + F.lane;
#pragma unroll
            for (int j = 0; j < 4; ++j) op[64 * j] = v[j] * rstd * gn[F.lane + 64 * j];
        }
    }
}

constexpr int NSAMP = 12, NCHK = 16;
__device__ __forceinline__ int sample_row(int i) { const int r[NSAMP] = {0, 1, 63, 64, 4097, 8191, 8192, 20000, 32767, 32768, 33000, 33791}; int v = 0;
#pragma unroll
    for (int j = 0; j < NSAMP; ++j) v = (i == j) ? r[j] : v; return v; }
__device__ __forceinline__ void dbg_note(Frame& F, int chk, float a, float e, float scale, float tol) {
    float err = fabsf(a - e) / (fabsf(e) + scale); if (!(err == err)) err = 1e30f;
    if (err > tol) atomicAdd(F.ctl + CW_DBG + chk, 1u);
    atomicMax(F.ctl + CW_DBG + 64 + chk, __float_as_uint(err));
}
__device__ __forceinline__ float bfr(float x) { return __uint_as_float(f2bf(x) << 16); }
__device__ __forceinline__ void chk_in(Frame& F, int l, int chk) {
    if (F.vcu >= NSAMP) return;
    const int row = sample_row(F.vcu); const bool ctx = row >= NLAT; const int pos = row % SEQ; const float prow = (float)(pos / 64), pcol = (float)(pos % 64);
    LAS float* raw = (LAS float*)(F.lds + RING_OFF); LAS float* hs = raw + 7168;
    const bf16* H = (const bf16*)(F.ws + WS_H) + (size_t)row * DM; const float* W = in_l(F, I_WIN, l, (size_t)DM * DIN);
    for (int k = F.tid; k < DM; k += NTHR) hs[k] = bf2f(H[k]);
    __syncthreads();
    for (int j = F.tid; j < DIN; j += NTHR) { float s = 0.f; for (int k = 0; k < DM; ++k) s += hs[k] * bfr(W[(size_t)k * DIN + j]); raw[j] = s; }
    __syncthreads();
    const bf16 *QA = (const bf16*)(F.ws + WS_QA), *KA = (const bf16*)(F.ws + WS_KA), *VA = (const bf16*)(F.ws + WS_VA), *QB = (const bf16*)(F.ws + WS_QB), *KB = (const bf16*)(F.ws + WS_KB), *VB = (const bf16*)(F.ws + WS_VB);
    const bf16 *CQ = (const bf16*)(F.ws + WS_CQ), *CKR = (const bf16*)(F.ws + WS_CKR), *CKV = (const bf16*)(F.ws + WS_CKV), *GT = (const bf16*)(F.ws + WS_GATES);
    for (int j = F.tid; j < DIN; j += NTHR) {
        float e, a;
        if (j < 1024) {
            const int g = j >> 6, d = j & 63, q = d & 15, blk = d >> 4;
            const float inv = powf(10000.0f, -(float)q / 16.0f), ang = (blk < 2 ? prow : pcol) * inv, c = ctx ? 1.f : cosf(ang), s = ctx ? 0.f : sinf(ang);
            const int da = (blk & 2) * 16 + q, db = da + 16; const float av = raw[g * 64 + da], bv = raw[g * 64 + db];
            e = (blk & 1) ? bv * c + av * s : av * c - bv * s; if (j < 512) e *= QSCALE_AB;
            const int p = 2 * ((blk >> 1) * 16 + q) + (blk & 1);
            a = bf2f((j < 512 ? QA : KA)[(size_t)row * 512 + (g & 7) * 64 + p]);
        } else if (j < 3072) { const int seg = (j - 1024) >> 9, c = (j - 1024) & 511; e = raw[j] * (seg == 1 ? QSCALE_AB : 1.f); a = bf2f((seg == 0 ? VA : seg == 1 ? QB : seg == 2 ? KB : VB)[(size_t)row * 512 + c]); }
        else if (j < 3456) { e = raw[j]; a = bf2f(CQ[(size_t)row * 384 + (j - 3072)]); }
        else if (j < 3712) { e = raw[j]; a = bf2f(CKV[(size_t)row * 256 + (j - 3456)]); }
        else if (j < 3744) { const int d = j - 3712, q = d & 7, blk = d >> 3; const float inv = powf(10000.0f, -(float)q / 8.0f), ang = (blk < 2 ? prow : pcol) * inv, c = ctx ? 1.f : cosf(ang), s = ctx ? 0.f : sinf(ang);
            const int da = (blk & 2) * 8 + q, db = da + 8; const float av = raw[3712 + da], bv = raw[3712 + db];
            e = (blk & 1) ? bv * c + av * s : av * c - bv * s; const int p = 2 * ((blk >> 1) * 8 + q) + (blk & 1); a = bf2f(CKR[(size_t)row * 32 + p]); }
        else { e = 1.0f / (1.0f + expf(-raw[j])); a = bf2f(GT[(size_t)row * 3072 + (j - 3744)]); }
        dbg_note(F, chk, a, e, 0.05f, 0.03f);
    }
    if (F.tid == 0) { float sq = 0.f, sk = 0.f; for (int j = 3072; j < 3456; ++j) sq += raw[j] * raw[j]; for (int j = 3456; j < 3712; ++j) sk += raw[j] * raw[j];
        const float* ssq = (const float*)(F.ws + CTL_SSQ); float a = 0.f, b = 0.f; for (int i = 0; i < 8; ++i) a += ssq[(size_t)row * 8 + i]; for (int i = 0; i < 4; ++i) b += ssq[(size_t)MTOT * 8 + (size_t)row * 4 + i]; dbg_note(F, chk, a, sq, 0.05f, 0.01f); dbg_note(F, chk, b, sk, 0.05f, 0.01f); }
    __syncthreads();
}
__device__ __forceinline__ void p_dbg_emit(Frame& F) {
    int id = 0; float me = 0.f;
    for (int c = 1; c < NCHK; ++c) { const unsigned n = F.ctl[CW_DBG + c]; const float e = __uint_as_float(F.ctl[CW_DBG + 64 + c]); if (id == 0) { if (n > 0u) { id = c; me = e; } else me = fmaxf(me, e); } }
    float k = rintf(10.0f * (log10f(fmaxf(me, 1e-6f)) + 6.0f)); k = fminf(fmaxf(k, 0.f), 89.f);
    const float A = sqrtf((float)((10 + id) * 10) - 1.0f), Bv = (10.0f + k) * 100.0f;
    for (size_t i = (size_t)blockIdx.x * NTHR + F.tid; i < (size_t)NLAT * DM; i += (size_t)F.G * NTHR) { unsigned h = (unsigned)i * 2654435761u; h ^= h >> 15; h *= 2246822519u; h ^= h >> 13; F.out[i] = (i == 0) ? Bv : ((h & 1u) ? A : -A); }
}

__device__ __forceinline__ void chk_qkv(Frame& F, int l, int chk) {
    if (F.vcu >= NSAMP) return;
    const int row = sample_row(F.vcu); const bool ctx = row >= NLAT; const int pos = row % SEQ; const float prow = (float)(pos / 64), pcol = (float)(pos % 64);
    LAS float* raw = (LAS float*)(F.lds + RING_OFF);
    const bf16* CQ = (const bf16*)(F.ws + WS_CQ) + (size_t)row * 384; const bf16* CKV = (const bf16*)(F.ws + WS_CKV) + (size_t)row * 256;
    const float* ssq = (const float*)(F.ws + CTL_SSQ); float sqa = 0.f, ska = 0.f; for (int i = 0; i < 8; ++i) sqa += ssq[(size_t)row * 8 + i]; for (int i = 0; i < 4; ++i) ska += ssq[(size_t)MTOT * 8 + (size_t)row * 4 + i];
    const float rq = 1.0f / sqrtf(sqa / 384.0f + EPS), rk = 1.0f / sqrtf(ska / 256.0f + EPS);
    const float* Wq = in_l(F, I_WQB, l, 384 * 768); const float* gq = in_l(F, I_GQA, l, 384); const float* Wk = in_l(F, I_WKVB, l, 256 * 1024); const float* gk = in_l(F, I_GKVA, l, 256);
    for (int n = F.tid; n < 768; n += NTHR) { float s = 0.f; for (int k = 0; k < 384; ++k) s += bf2f(CQ[k]) * bfr(Wq[(size_t)k * 768 + n] * gq[k]); raw[n] = s * rq * QSCALE_C; }
    __syncthreads();
    const bf16* QC = (const bf16*)(F.ws + WS_QC) + (size_t)row * 768;
    for (int n = F.tid; n < 768; n += NTHR) { const int h = n / 96, p = n % 96; float e, a;
        if (p < 64) { e = raw[n]; a = bf2f(QC[n]); }
        else { const int d = p - 64, q = d & 7, blk = d >> 3; const float inv = powf(10000.0f, -(float)q / 8.0f), ang = (blk < 2 ? prow : pcol) * inv, c = ctx ? 1.f : cosf(ang), s = ctx ? 0.f : sinf(ang);
            const int da = (blk & 2) * 8 + q, db = da + 8; const float av = raw[h * 96 + 64 + da], bv = raw[h * 96 + 64 + db];
            e = (blk & 1) ? bv * c + av * s : av * c - bv * s; a = bf2f(QC[h * 96 + 64 + 2 * ((blk >> 1) * 8 + q) + (blk & 1)]); }
        dbg_note(F, chk, a, e, 0.05f, 0.03f); }
    const bf16* KCN = (const bf16*)(F.ws + WS_KCN) + (size_t)row * 512; const bf16* VC = (const bf16*)(F.ws + WS_VC) + (size_t)row * 512;
    for (int n = F.tid; n < 1024; n += NTHR) { float s = 0.f; for (int k = 0; k < 256; ++k) s += bf2f(CKV[k]) * bfr(Wk[(size_t)k * 1024 + n] * gk[k]); s *= rk;
        const int h = n >> 7, d = n & 127; const float a = d < 64 ? bf2f(KCN[h * 64 + d]) : bf2f(VC[h * 64 + d - 64]); dbg_note(F, chk, a, s, 0.05f, 0.03f); }
    __syncthreads();
}
__device__ __forceinline__ void naive_attn(Frame& F, LAS float* sc, LAS float* red, LAS float* res, const bf16* q, int dk1, const bf16* K1, const bf16* q2, int dk2, const bf16* K2, const bf16* V, int dv,
                                           int lat0, int nlat, int ctx0, int nctx, int mode, const float* rpb_h, int rq, int cq, int kr_lo) {
    const int NK = nlat + nctx;
    for (int i = F.tid; i < NK; i += NTHR) { const size_t kr = i < nlat ? (size_t)lat0 + i : (size_t)ctx0 + (i - nlat); float s = 0.f;
        for (int d = 0; d < dk1; ++d) s += bf2f(q[d]) * bf2f(K1[kr * 512 + d]);
        for (int d = 0; d < dk2; ++d) s += bf2f(q2[d]) * bf2f(K2[kr * 32 + d]);
        if (mode == 1 && i < nlat) { const int krr = kr_lo + i / 64, ck = i % 64, rs = min(max(rq - 4, 0), 120), cs = min(max(cq - 8, 0), 48);
            if (krr < rs || krr >= rs + 8 || ck < cs || ck >= cs + 16) s = -INFINITY; else s += rpb_h[(krr - rq + 7) * 31 + min(max(ck - cq + 15, 0), 30)] * LOG2E; }
        sc[i] = s; }
    __syncthreads();
    float mx = -INFINITY; for (int i = F.tid; i < NK; i += NTHR) mx = fmaxf(mx, sc[i]);
    for (int o = 1; o < 64; o <<= 1) mx = fmaxf(mx, __shfl_xor(mx, o)); if (F.lane == 0) red[F.wave] = mx; __syncthreads();
    mx = red[0]; for (int w = 1; w < 8; ++w) mx = fmaxf(mx, red[w]); __syncthreads();
    float sm = 0.f; for (int i = F.tid; i < NK; i += NTHR) { const float p = exp2f(sc[i] - mx); sc[i] = p; sm += p; }
    sm = wave_sum(sm); if (F.lane == 0) red[F.wave] = sm; __syncthreads();
    sm = 0.f; for (int w = 0; w < 8; ++w) sm += red[w];
    if (F.tid < dv) { float a = 0.f; for (int i = 0; i < NK; ++i) { const size_t kr = i < nlat ? (size_t)lat0 + i : (size_t)ctx0 + (i - nlat); a += sc[i] * bf2f(V[kr * 512 + F.tid]); } res[F.tid] = a / sm; }
    __syncthreads();
}
__device__ __forceinline__ void chk_attn(Frame& F, int l, int chk) {
    if (F.vcu >= NSAMP) return;
    const int row = sample_row(F.vcu); const bool ctx = row >= NLAT; if (ctx && l > 0) return;
    const int b = ctx ? (row - NLAT) / CTXL : row / SEQ, pos = row % SEQ, rq = pos / 64, cq = pos % 64;
    LAS float* sc = (LAS float*)(F.lds + RING_OFF); LAS float* red = sc + 8704; LAS float* res = red + 16; LAS float* res0 = res + 128;
    const int lat0 = b * SEQ, nlat = ctx ? 0 : SEQ, ctx0 = NLAT + b * CTXL;
    const bf16 *QA = (const bf16*)(F.ws + WS_QA), *KA = (const bf16*)(F.ws + WS_KA), *VA = (const bf16*)(F.ws + WS_VA), *QB = (const bf16*)(F.ws + WS_QB), *KB = (const bf16*)(F.ws + WS_KB), *VB = (const bf16*)(F.ws + WS_VB);
    const bf16 *QC = (const bf16*)(F.ws + WS_QC), *KCN = (const bf16*)(F.ws + WS_KCN), *VC = (const bf16*)(F.ws + WS_VC), *CKR = (const bf16*)(F.ws + WS_CKR);
    const bf16 *YA = (const bf16*)(F.ws + WS_YA), *YB = (const bf16*)(F.ws + WS_YB), *YC = (const bf16*)(F.ws + WS_YC);
    const float* lamp = (const float*)(F.ws + WS_TAB) + 192 * 16 * 2 + 192 * 8 * 2; const float lam = lamp[2 * l], lam_init = lamp[2 * l + 1]; const float* gsub = in_l(F, I_GSUB, l, 128);
    { const float lr = expf(0.f); (void)lr; }
    for (int h = 0; h < 4; ++h) {
        naive_attn(F, sc, red, res, QA + (size_t)row * 512 + h * 128, 64, KA + h * 128, nullptr, 0, nullptr, VA + h * 128, 128, lat0, nlat, ctx0, CTXL, 0, nullptr, 0, 0, 0);
        if (F.tid < 128) res0[F.tid] = res[F.tid]; __syncthreads();
        naive_attn(F, sc, red, res, QA + (size_t)row * 512 + h * 128 + 64, 64, KA + h * 128 + 64, nullptr, 0, nullptr, VA + h * 128, 128, lat0, nlat, ctx0, CTXL, 0, nullptr, 0, 0, 0);
        if (F.tid < 128) res0[F.tid] = res0[F.tid] - lam * res[F.tid]; __syncthreads();
        float ss = 0.f; for (int d = 0; d < 128; ++d) ss += res0[d] * res0[d];
        if (F.tid < 128) { const float e = res0[F.tid] / sqrtf(ss / 128.0f + EPS) * gsub[F.tid] * (1.0f - lam_init); dbg_note(F, chk, bf2f(YA[(size_t)row * 512 + h * 128 + F.tid]), e, 0.1f, 0.04f); }
        __syncthreads();
    }
    for (int h = 0; h < 8; ++h) {
        const int kr_lo = min(max(rq - 4, 0), 120);
        if (ctx) naive_attn(F, sc, red, res, QB + (size_t)row * 512 + h * 64, 64, KB + h * 64, nullptr, 0, nullptr, VB + h * 64, 64, 0, 0, ctx0, CTXL, 0, nullptr, 0, 0, 0);
        else naive_attn(F, sc, red, res, QB + (size_t)row * 512 + h * 64, 64, KB + h * 64, nullptr, 0, nullptr, VB + h * 64, 64, lat0 + kr_lo * 64, 512, ctx0, CTXL, 1, in_l(F, I_RPB, l, 8 * 15 * 31) + h * 465, rq, cq, kr_lo);
        if (F.tid < 64) dbg_note(F, chk + 1, bf2f(YB[(size_t)row * 512 + h * 64 + F.tid]), res[F.tid], 0.02f, 0.04f);
        __syncthreads();
        naive_attn(F, sc, red, res, QC + (size_t)row * 768 + h * 96, 64, KCN + h * 64, QC + (size_t)row * 768 + h * 96 + 64, 32, CKR, VC + h * 64, 64, lat0, nlat, ctx0, CTXL, 0, nullptr, 0, 0, 0);
        if (F.tid < 64) dbg_note(F, chk + 2, bf2f(YC[(size_t)row * 512 + h * 64 + F.tid]), res[F.tid], 0.01f, 0.04f);
        __syncthreads();
    }
}
__device__ __forceinline__ void chk_merge(Frame& F, int l, int chk) {
    if (F.vcu >= NSAMP) return; const int row = sample_row(F.vcu); if (row >= NLAT && l > 0) return;
    const bf16* Y = (const bf16*)(F.ws + WS_YA); const bf16* GT = (const bf16*)(F.ws + WS_GATES) + (size_t)row * 3072; const bf16* MB = (const bf16*)(F.ws + WS_MB) + (size_t)row * 1024;
    for (int n = F.tid; n < 1024; n += NTHR) { float m = 0.f;
        for (int br = 0; br < 3; ++br) { const float* W = in_l(F, br == 0 ? I_WBRA : br == 1 ? I_WBRB : I_WBRC, l, 512 * 1024); const bf16* y = Y + (size_t)br * MTOT * 512 + (size_t)row * 512; float s = 0.f;
            for (int k = 0; k < 512; ++k) s += bf2f(y[k]) * bfr(W[(size_t)k * 1024 + n]); m += bf2f(GT[br * 1024 + n]) * s; }
        dbg_note(F, chk, bf2f(MB[n]), m, 0.05f, 0.03f); }
}
__device__ __forceinline__ void chk_out(Frame& F, int l, int chk, const float* xprev) {
    if (F.vcu >= NSAMP || l > 0) return; const int row = sample_row(F.vcu); const int b = row < NLAT ? row / SEQ : 4;
    const float* xs = row < NLAT ? F.in[I_X] + (size_t)row * DM : F.in[I_CTX] + (size_t)(row - NLAT) * DM; const bf16* MB = (const bf16*)(F.ws + WS_MB) + (size_t)row * 1024;
    const float* W = in_l(F, I_WOUT, l, 1024 * 1024); const float* gt = (const float*)(F.ws + WS_MODV) + (size_t)(l * 5 + b) * 6144 + 2048; const float* X = (const float*)(F.ws + WS_X) + (size_t)row * DM;
    for (int n = F.tid; n < 1024; n += NTHR) { float s = 0.f; for (int k = 0; k < 1024; ++k) s += bf2f(MB[k]) * bfr(W[(size_t)k * 1024 + n]); dbg_note(F, chk, X[n], xs[n] + gt[n] * s, 0.1f, 0.01f); }
}
__device__ __forceinline__ void chk_route(Frame& F, int l, int chk) {
    if (F.vcu >= NSAMP) return; const int row = sample_row(F.vcu); if (row >= NLAT && l > 0) return; const int b = row < NLAT ? row / SEQ : 4;
    LAS float* h2 = (LAS float*)(F.lds + RING_OFF); LAS float* lg = h2 + 1024;
    const float* X = (const float*)(F.ws + WS_X) + (size_t)row * DM; const float* modv = (const float*)(F.ws + WS_MODV) + (size_t)(l * 5 + b) * 6144; const float* g = in_l(F, I_GFFN, l, DM);
    float ss = 0.f; for (int k = 0; k < DM; ++k) ss += X[k] * X[k]; const float rstd = 1.0f / sqrtf(ss / DM + EPS);
    const bf16* H = (const bf16*)(F.ws + WS_H) + (size_t)row * DM;
    for (int k = F.tid; k < DM; k += NTHR) { const float v = X[k] * rstd * g[k] * (1.0f + modv[4096 + k]) + modv[3072 + k]; h2[k] = v; dbg_note(F, chk, bf2f(H[k]), v, 0.05f, 0.02f); }
    __syncthreads();
    if (F.tid < 32) { const float* Wr = in_l(F, I_WROUT, l, 1024 * 32); float s = 0.f; for (int k = 0; k < DM; ++k) s += h2[k] * Wr[k * 32 + F.tid]; lg[F.tid] = s + in_l(F, I_BROUT, l, 32)[F.tid]; }
    __syncthreads();
    if (F.tid == 0) { int te[4]; float tv[4];
        for (int k = 0; k < 4; ++k) { int bi = 0; float bv = lg[0]; for (int e = 1; e < 32; ++e) { const float x = lg[e]; if (x > bv) { bv = x; bi = e; } } te[k] = bi; tv[k] = bv; lg[bi] = -INFINITY; }
        const float den = 1.0f + expf(tv[1] - tv[0]) + expf(tv[2] - tv[0]) + expf(tv[3] - tv[0]);
        const int* rt_e = (const int*)(F.ws + WS_ROUTE + RT_E); const float* rt_w = (const float*)(F.ws + WS_ROUTE + RT_W);
#pragma unroll
        for (int k = 0; k < 4; ++k) { dbg_note(F, chk, (float)rt_e[(size_t)row * 4 + k], (float)te[k], 1.0f, 0.001f); dbg_note(F, chk, rt_w[(size_t)row * 4 + k], expf(tv[k] - tv[0]) / den, 0.1f, 0.001f); } }
    __syncthreads();
}
__device__ __forceinline__ void chk_moe(Frame& F, int l, int chk) {
    if (F.vcu >= NSAMP) return; const int row = sample_row(F.vcu); if (row >= NLAT && l > 0) return;
    LAS float* hs = (LAS float*)(F.lds + RING_OFF); LAS float* act = hs + 1024;
    const bf16* H = (const bf16*)(F.ws + WS_H) + (size_t)row * DM; for (int k = F.tid; k < DM; k += NTHR) hs[k] = bf2f(H[k]);
    __syncthreads();
    const int* rt_e = (const int*)(F.ws + WS_ROUTE + RT_E); const float* rt_w = (const float*)(F.ws + WS_ROUTE + RT_W); const bf16* YB = (const bf16*)(F.ws + WS_YBUF);
    for (int kk = 0; kk < 4; ++kk) { const int e = rt_e[(size_t)row * 4 + kk]; const float w = rt_w[(size_t)row * 4 + kk];
        const float* Wg = in_l(F, I_WGU, l * NEXP + e, (size_t)1024 * 2048); const float* bg = in_l(F, I_BGU, l * NEXP + e, 2048); const float* Wd = in_l(F, I_WDN, l * NEXP + e, (size_t)1024 * 1024); const float* bd = in_l(F, I_BDN, l * NEXP + e, 1024);
        for (int j = F.tid; j < 1024; j += NTHR) { float sg = 0.f, su = 0.f; for (int k = 0; k < DM; ++k) { sg += hs[k] * bfr(Wg[(size_t)k * 2048 + 2 * j]); su += hs[k] * bfr(Wg[(size_t)k * 2048 + 2 * j + 1]); }
            sg += bg[2 * j]; su += bg[2 * j + 1]; const float ga = fminf(sg, 7.0f), ua = fminf(fmaxf(su, -7.0f), 7.0f); act[j] = bfr((ua + 1.0f) * (ga / (1.0f + expf(-1.702f * ga)))); }
        __syncthreads();
        for (int n = F.tid; n < 1024; n += NTHR) { float s = 0.f; for (int j = 0; j < 1024; ++j) s += act[j] * bfr(Wd[(size_t)j * 1024 + n]); dbg_note(F, chk, bf2f(YB[(size_t)(row * 4 + kk) * 1024 + n]), (s + bd[n]) * w, 0.02f, 0.03f); }
        __syncthreads(); }
}

constexpr int PH_PRO_A = 0, PH_PRO_B = 1, PH_L0 = 2, NPL = 10, N_PHASES = PH_L0 + DEPTH * NPL;
enum { LP_IN = 0, LP_QKV, LP_ATTN, LP_MERGE, LP_OUT, LP_ROUTE, LP_GATHER, LP_GU, LP_DN, LP_COMB };

__global__ void __launch_bounds__(NTHR, 2) trunk_fwd(Args args) {
    extern __shared__ __attribute__((aligned(16))) unsigned char lds[];
    Frame F;
    F.lds = (LAS unsigned char*)lds; F.MISC = (volatile LAS unsigned*)(F.lds + MISC_OFF);
    F.tid = threadIdx.x; F.lane = F.tid & 63; F.wave = __builtin_amdgcn_readfirstlane(F.tid >> 6);
    F.G = gridDim.x; { const int bx = blockIdx.x; F.vcu = (F.G % 8 == 0) ? (bx % 8) * (F.G / 8) + bx / 8 : bx; }
    F.ws = args.ws; F.ctl = (unsigned*)(args.ws + WS_CTL); F.in = args.in; F.out = args.out;
    for (int u = F.tid; u < (LDS_BYTES - TBL_OFF) / 4; u += NTHR) ((LAS unsigned*)(F.lds + TBL_OFF))[u] = 0u;
    __syncthreads();
    const int lo = args.ph_lo, hi = args.ph_hi;
#if DBG_CHECK
    if (lo >= 1000) { const int c = lo - 1000;
        if (c == 1) chk_in(F, 0, 1); else if (c == 2) chk_qkv(F, 0, 2); else if (c == 3) chk_attn(F, 0, 3); else if (c == 6) chk_merge(F, 0, 6); else if (c == 7) chk_out(F, 0, 7, nullptr);
        else if (c == 8) chk_route(F, 0, 8); else if (c == 9) chk_moe(F, 0, 9); else if (c == 11) chk_in(F, 1, 11); else if (c == 13) chk_attn(F, 1, 13); else if (c == 99) p_dbg_emit(F);
        return; }
#endif
    XcdBarrier bar; bar.bar = F.ctl + CW_BAR; bar.x = 0; bar.st = nullptr;
    if (MK_ONE_LAUNCH) bar = xcd_barrier_post(F.ctl + CW_BAR, F.MISC + 8);
#define IN(k) (lo <= (k) && (k) < hi)
#define SEAM(k) do { if (MK_ONE_LAUNCH && IN(k) && IN((k) + 1)) xcd_barrier(bar); } while (0)

    if (IN(PH_PRO_A)) { p_prologue_a(F); } SEAM(PH_PRO_A);
    if (IN(PH_PRO_B)) { p_prologue_b(F); } SEAM(PH_PRO_B);
    for (int l = 0; l < DEPTH; ++l) {
        asm volatile("" : "+v"(F.tid), "+v"(F.lane));
        const int pb = PH_L0 + l * NPL; const int Ml = (l == DEPTH - 1) ? NLAT : MTOT;
        float* ssq_q = (float*)(F.ws + CTL_SSQ); float* ssq_kv = ssq_q + (size_t)MTOT * 8;
        const float* tabA = (const float*)(F.ws + WS_TAB); const float* tabC = tabA + 192 * 16 * 2;
        if (IN(pb + LP_IN)) {
            Gemm g{(const bf16_t*)(F.ws + WS_H), (const bf16_t*)(F.ws + WS_WIN) + (size_t)l * NINP * DM, MTOT, NINP, DM}; StaticOrder S; S.init(MTOT, NINP, F.G, (int)blockIdx.x);
            EpiIn E{(bf16_t*)(F.ws + WS_QA), (bf16_t*)(F.ws + WS_KA), (bf16_t*)(F.ws + WS_VA), (bf16_t*)(F.ws + WS_QB), (bf16_t*)(F.ws + WS_KB), (bf16_t*)(F.ws + WS_VB),
                    (bf16_t*)(F.ws + WS_CQ), (bf16_t*)(F.ws + WS_CKR), (bf16_t*)(F.ws + WS_CKV), (bf16_t*)(F.ws + WS_GATES), ssq_q, ssq_kv, tabA, tabC};
            gemm_phase<EpiIn, StaticOrder, true, true>(F.lds + RING_OFF, g, S, E);
        }
        SEAM(pb + LP_IN);
        if (IN(pb + LP_QKV)) {
            { Gemm g{(const bf16_t*)(F.ws + WS_CQ), (const bf16_t*)(F.ws + WS_WQB) + (size_t)l * 768 * 384, MTOT, 768, 384}; StaticOrder S; S.init(MTOT, 768, F.G, (int)blockIdx.x);
              EpiQ E{(bf16_t*)(F.ws + WS_QC), ssq_q, tabC}; gemm_phase<EpiQ, StaticOrder, true, true>(F.lds + RING_OFF, g, S, E); }
            { Gemm g{(const bf16_t*)(F.ws + WS_CKV), (const bf16_t*)(F.ws + WS_WKVB) + (size_t)l * 1024 * 256, MTOT, 1024, 256}; StaticOrder S; S.init(MTOT, 1024, F.G, (int)blockIdx.x);
              EpiKV E{(bf16_t*)(F.ws + WS_KCN), (bf16_t*)(F.ws + WS_VC), ssq_kv}; gemm_phase<EpiKV, StaticOrder, true, true>(F.lds + RING_OFF, g, S, E); }
        }
        SEAM(pb + LP_QKV);
        if (IN(pb + LP_ATTN)) p_attention(F, l);
        SEAM(pb + LP_ATTN);
        if (IN(pb + LP_MERGE)) {
            Gemm g{(const bf16_t*)(F.ws + WS_YA), (const bf16_t*)(F.ws + WS_WBR) + (size_t)l * 3 * 1024 * 512, Ml, 1024, 512}; MergeOrder S; S.S.init(Ml, 1024, F.G, (int)blockIdx.x);
            EpiMerge E{(const bf16_t*)(F.ws + WS_GATES), (float*)(F.ws + WS_M32), (bf16_t*)(F.ws + WS_MB)}; gemm_phase<EpiMerge, MergeOrder, true, true>(F.lds + RING_OFF, g, S, E);
        }
        SEAM(pb + LP_MERGE);
        if (IN(pb + LP_OUT)) {
            Gemm g{(const bf16_t*)(F.ws + WS_MB), (const bf16_t*)(F.ws + WS_WOUT) + (size_t)l * 1024 * 1024, Ml, 1024, 1024}; StaticOrder S; S.init(Ml, 1024, F.G, (int)blockIdx.x);
            const float* X = (const float*)(F.ws + WS_X);
            EpiOut E{l == 0 ? F.in[I_X] : X, l == 0 ? F.in[I_CTX] : X + (size_t)NLAT * DM, (float*)(F.ws + WS_X), (const float*)(F.ws + WS_MODV) + (size_t)l * 5 * 6144};
            gemm_phase<EpiOut, StaticOrder, true, true>(F.lds + RING_OFF, g, S, E);
        }
        SEAM(pb + LP_OUT);
        if (IN(pb + LP_ROUTE)) p_route(F, l, Ml);
        SEAM(pb + LP_ROUTE);
        if (IN(pb + LP_GATHER)) p_gather(F, l, Ml);
        SEAM(pb + LP_GATHER);
        if (IN(pb + LP_GU)) {
            const int T = build_expert_tables(F, l);
            Gemm g{(const bf16_t*)(F.ws + WS_HS), (const bf16_t*)(F.ws + WS_WGU) + (size_t)l * NEXP * 2048 * 1024, T * 256, 2048, 1024};
            ExpertOrder S; S.S.init(T * 256, 2048, F.G, (int)blockIdx.x); S.tile_e = (const LAS int*)(F.lds + TBL_OFF + TB_TILE); S.nNe = 8;
            EpiGU E{(bf16_t*)(F.ws + WS_ACT), in_l(F, I_BGU, l, NEXP * 2048)}; gemm_phase<EpiGU, ExpertOrder, true, true>(F.lds + RING_OFF, g, S, E);
        }
        SEAM(pb + LP_GU);
        if (IN(pb + LP_DN)) {
            const int T = build_expert_tables(F, l);
            Gemm g{(const bf16_t*)(F.ws + WS_ACT), (const bf16_t*)(F.ws + WS_WDN) + (size_t)l * NEXP * 1024 * 1024, T * 256, 1024, 1024};
            ExpertOrder S; S.S.init(T * 256, 1024, F.G, (int)blockIdx.x); S.tile_e = (const LAS int*)(F.lds + TBL_OFF + TB_TILE); S.nNe = 4;
            EpiDown E{(bf16_t*)(F.ws + WS_YBUF), in_l(F, I_BDN, l, NEXP * 1024), (const int*)(F.ws + WS_ROUTE + RT_YDST), (const float*)(F.ws + WS_ROUTE + RT_WROW)};
            gemm_phase<EpiDown, ExpertOrder, true, true>(F.lds + RING_OFF, g, S, E);
        }
        SEAM(pb + LP_DN);
        if (IN(pb + LP_COMB)) p_combine(F, l, Ml);
        SEAM(pb + LP_COMB);
    }
#undef IN
#undef SEAM
}

extern "C" void kernel_launch(void* const* d_in, const int* in_sizes, int n_in, void* d_out, int out_size, void* d_ws, size_t ws_size, hipStream_t stream) {
    static int grid = 0;
    if (grid == 0) {
        if (n_in != 30 || out_size != NLAT * DM || ws_size < WS_END) { fprintf(stderr, "kernel_launch: shape mismatch n_in %d out %d ws %zu (need %zu)\n", n_in, out_size, ws_size, (size_t)WS_END); grid = -1; return; }
        int dev = 0, cus = 0, per_cu = 0;
        if (hipGetDevice(&dev) != hipSuccess || hipDeviceGetAttribute(&cus, hipDeviceAttributeMultiprocessorCount, dev) != hipSuccess) { grid = -1; return; }
        if (hipFuncSetAttribute((const void*)trunk_fwd, hipFuncAttributeMaxDynamicSharedMemorySize, LDS_BYTES) != hipSuccess) { fprintf(stderr, "kernel_launch: hipFuncSetAttribute failed\n"); grid = -1; return; }
        if (hipOccupancyMaxActiveBlocksPerMultiprocessor(&per_cu, (const void*)trunk_fwd, NTHR, LDS_BYTES) != hipSuccess || per_cu < 1) { fprintf(stderr, "kernel_launch: occupancy query says %d\n", per_cu); }
        (void)hipGetLastError();
        grid = cus;
    }
    if (grid < 0) return;
    (void)hipMemsetAsync((char*)d_ws + WS_CTL, 0, CTL_ZERO_BYTES, stream);
    Args a{};
    for (int i = 0; i < 30; ++i) a.in[i] = (const float*)d_in[i];
    a.out = (float*)d_out; a.ws = (unsigned char*)d_ws;
#if MK_ONE_LAUNCH
    a.ph_lo = 0; a.ph_hi = N_PHASES;
    hipLaunchKernelGGL(trunk_fwd, dim3(grid), dim3(NTHR), LDS_BYTES, stream, a);
#else
    for (int p = 0; p < N_PHASES; ++p) { a.ph_lo = p; a.ph_hi = p + 1; hipLaunchKernelGGL(trunk_fwd, dim3(grid), dim3(NTHR), LDS_BYTES, stream, a);
#if DBG_CHECK
        int c = 0; const int q = p - PH_L0;
        if (q == LP_IN) c = 1; else if (q == LP_QKV) c = 2; else if (q == LP_ATTN) c = 3; else if (q == LP_MERGE) c = 6; else if (q == LP_OUT) c = 7; else if (q == LP_ROUTE) c = 8; else if (q == LP_DN) c = 9;
        else if (q == NPL + LP_IN) c = 11; else if (q == NPL + LP_ATTN) c = 13;
        if (c) { a.ph_lo = 1000 + c; a.ph_hi = 0; hipLaunchKernelGGL(trunk_fwd, dim3(grid), dim3(NTHR), LDS_BYTES, stream, a); }
        if (p == DBG_LAST_PHASE) break;
#endif
    }
#if DBG_CHECK
    a.ph_lo = 1099; a.ph_hi = 0; hipLaunchKernelGGL(trunk_fwd, dim3(grid), dim3(NTHR), LDS_BYTES, stream, a);
#endif
#endif
    const hipError_t le = hipPeekAtLastError();
    if (le != hipSuccess) fprintf(stderr, "kernel_launch: launch failed: %s\n", hipGetErrorName(le));
}
```

```cpp
#include <hip/hip_runtime.h>
#include <cstdio>
#include <cstdint>

#ifndef MK_ONE_LAUNCH
#define MK_ONE_LAUNCH 1
#endif
#ifndef DBG_CHECK
#define DBG_CHECK 0
#endif

#ifndef DBG_LAST_PHASE
#define DBG_LAST_PHASE 9999
#endif
#ifndef DUP_MASK
#define DUP_MASK 0
#endif
#ifndef F8_IN0
#define F8_IN0 1
#endif
#ifndef F8_IN1
#define F8_IN1 1
#endif
#define F8_INL(l) ((l) == 0 ? (F8_IN0 != 0) : (F8_IN1 != 0))
#ifndef F8_MOE
#define F8_MOE 1
#endif
namespace pg8 {
#define PG8_LAS __attribute__((address_space(3)))
typedef unsigned short bf16_t;
typedef short bf16x8 __attribute__((ext_vector_type(8)));
typedef float f32x4 __attribute__((ext_vector_type(4)));
typedef unsigned u32x4 __attribute__((ext_vector_type(4)));
constexpr int BM = 256, BK = 64, HALF = 128, HTB = HALF * BK * 2  , STAGE_BYTES = 8 * HTB, NXCD = 8, WGM = 8;

__host__ __device__ __forceinline__ int lds_byte(int r, int c) { const int st = (r >> 4) * 2 + (c >> 5), rr = r & 15, cc = c & 31, ob = rr * 64 + cc * 2; return st * 1024 + (ob ^ (((ob >> 9) & 1) << 5)); }
__host__ __device__ __forceinline__ void stage_rc(int b, int& R, int& C) { const int st = b / 1024, sb = b % 1024, swz = sb ^ (((sb >> 9) & 1) << 5); R = (st >> 1) * 16 + swz / 64; C = (st & 1) * 32 + (swz % 64) / 2; }
__host__ __device__ __forceinline__ int perm32(int rho) { const int n = rho >> 4, i = rho & 15; return 8 * (i >> 2) + 4 * n + (i & 3); }

struct Unit { int pm, pn; };
struct Gemm { const bf16_t* A; const bf16_t* Bt; int M, N, K; const int* rowsrc = nullptr; };

struct StaticOrder {
    int nM, nN, nwg, G, c;
    __host__ __device__ void init(int M, int N, int G_, int c_) { nM = M / BM; nN = N / BM; nwg = nM * nN; G = G_; c = c_; }
    __host__ __device__ bool next(int i, Unit& u) const {
        const long L = (long)i * G + c; if (L >= nwg) return false;
        int wgid = (int)L; { const int q = nwg / NXCD, r = nwg % NXCD, xcd = wgid % NXCD, off = wgid / NXCD; wgid = (xcd < r ? xcd * (q + 1) : r * (q + 1) + (xcd - r) * q) + off; }
        const int nig = WGM * nN, gid = wgid / nig, fm = gid * WGM, gsz = (nM - fm) < WGM ? (nM - fm) : WGM;
        u.pm = fm + ((wgid % nig) % gsz); u.pn = (wgid % nig) / gsz; return true;
    }
    __device__ __forceinline__ void a_ready(const Unit&) const {}
    __device__ __forceinline__ void done(const Unit&) const {}
};


constexpr int DM = 1024, NBATCH = 4, SEQ = 8192, NLAT = NBATCH * SEQ, CTXL = 256, NCTX = NBATCH * CTXL, MTOT = NLAT + NCTX;
constexpr int DEPTH = 2, DIN = 6816, NINP = 6912, NEXP = 32, TOPK = 4;
constexpr int PM_CTX = NLAT / 256;
constexpr float LOG2E = 1.4426950408889634f;
constexpr float QSCALE_AB = 0.125f * LOG2E;
constexpr float QSCALE_C = 0.10206207261596575f * LOG2E;
constexpr float EPS = 1e-6f;
constexpr float YS_A = 16.0f, YS_BC = 64.0f, MS8 = 32.0f;
constexpr float WSCALE = 64.0f, WINV = 1.0f / 64.0f;
constexpr int OFF_CQ = 3072, OFF_CKR = 3456, OFF_PADW = 3488, OFF_CKV = 3584, OFF_GATES = 3840;

typedef float f32x2 __attribute__((ext_vector_type(2)));
typedef __bf16 bf16x2c_t __attribute__((ext_vector_type(2)));
__device__ __forceinline__ unsigned cvt_pk_bf16(float lo, float hi) { const f32x2 v = {lo, hi}; const bf16x2c_t b = __builtin_convertvector(v, bf16x2c_t); return __builtin_bit_cast(unsigned, b); }
__device__ __forceinline__ u32x4 pack8(const f32x4 a, const f32x4 b) { u32x4 w; w.x = cvt_pk_bf16(a[0], a[1]); w.y = cvt_pk_bf16(a[2], a[3]); w.z = cvt_pk_bf16(b[0], b[1]); w.w = cvt_pk_bf16(b[2], b[3]); return w; }
__device__ __forceinline__ float bf_lo(unsigned w) { return __uint_as_float(w << 16); }
__device__ __forceinline__ float bf_hi(unsigned w) { return __uint_as_float(w & 0xffff0000u); }
typedef unsigned u32x2x_t __attribute__((ext_vector_type(2)));
__device__ __forceinline__ float4 xb_ld4_(const unsigned short* p) { const u32x2x_t w = *(const u32x2x_t*)p; return make_float4(bf_lo(w.x), bf_hi(w.x), bf_lo(w.y), bf_hi(w.y)); }
__device__ __forceinline__ void rope8(f32x4& v0, f32x4& v1, const f32x4 cs0, const f32x4 cs1) {
    const f32x4 r0 = (f32x4){v0[0] * cs0[0] - v0[1] * cs0[1], v0[1] * cs0[0] + v0[0] * cs0[1], v0[2] * cs0[2] - v0[3] * cs0[3], v0[3] * cs0[2] + v0[2] * cs0[3]};
    const f32x4 r1 = (f32x4){v1[0] * cs1[0] - v1[1] * cs1[1], v1[1] * cs1[0] + v1[0] * cs1[1], v1[2] * cs1[2] - v1[3] * cs1[3], v1[3] * cs1[2] + v1[2] * cs1[3]};
    v0 = r0; v1 = r1;
}
__device__ __forceinline__ unsigned pk4_fp8(float a, float b, float c, float d) {
    a = __builtin_amdgcn_fmed3f(a, -448.f, 448.f); b = __builtin_amdgcn_fmed3f(b, -448.f, 448.f); c = __builtin_amdgcn_fmed3f(c, -448.f, 448.f); d = __builtin_amdgcn_fmed3f(d, -448.f, 448.f);
    int w = 0; w = __builtin_amdgcn_cvt_pk_fp8_f32(a, b, w, false); w = __builtin_amdgcn_cvt_pk_fp8_f32(c, d, w, true); return (unsigned)w; }
__device__ __forceinline__ unsigned char f8_one(float a) { a = fminf(fmaxf(a, -448.0f), 448.0f); return (unsigned char)(__builtin_amdgcn_cvt_pk_fp8_f32(a, 0.0f, 0, false) & 0xff); }
__device__ __forceinline__ float sigmoidf_(float x) { return __builtin_amdgcn_rcpf(1.0f + __builtin_amdgcn_exp2f(-x * LOG2E)); }

constexpr float WINV_MOE = F8_MOE ? WINV : 1.0f;
__device__ __forceinline__ int vt_slot8(int k) { const int half = k >> 5, kk = k & 31, hi = (kk >> 2) & 1, r = (kk & 3) + 4 * (kk >> 3); return 32 * hi + r + 16 * half; }
__device__ __forceinline__ void vt_put8(unsigned char* dp, const f32x4 v0, const f32x4 v1) {
    const unsigned w0 = pk4_fp8(v0[0], v0[1], v0[2], v0[3]), w1 = pk4_fp8(v1[0], v1[1], v1[2], v1[3]);
#pragma unroll
    for (int i = 0; i < 4; ++i) { dp[i * 64] = (unsigned char)(w0 >> (8 * i)); dp[(4 + i) * 64] = (unsigned char)(w1 >> (8 * i)); }
}
struct EpiIn {
    static constexpr bool PERM = true, AFTER_DRAIN = false;
    bf16_t *QA, *KA, *VA, *QB, *KB, *VB, *CQ, *CKR, *CKV, *GATES; float *ssq_q, *ssq_kv; const float* tabA; const float* tabC; float WINV_IN; unsigned char* VTA;
    __device__ __forceinline__ void operator()(const f32x4 (&acc)[2][2][4][2], const Unit& u, int wr, int wc, int fr, int fq) const {
        asm volatile("" : "+v"(fr), "+v"(fq));
        const int pn = u.pn; const bool ctx = u.pm >= PM_CTX;
        const int row0 = u.pm * BM + wr * 64 + fr;
        if (pn < 12) {
            const int seg = pn >> 1; bf16_t* base = seg == 0 ? QA : seg == 1 ? KA : seg == 2 ? VA : seg == 3 ? QB : seg == 4 ? KB : VB;
            const float sc = ((seg == 0 || seg == 3) ? QSCALE_AB : seg == 1 ? 8.0f : 1.0f) * WINV_IN; const bool rope = (seg <= 1) && !ctx;
            const int col0 = (pn & 1) * 256 + wc * 32 + 8 * fq;
#pragma unroll
            for (int ai = 0; ai < 2; ++ai) {
                const int gr = ((u.pm * 4 + ai * 2 + wr) & 127);
#pragma unroll
                for (int m = 0; m < 4; ++m) {
                    const int row = row0 + ai * HALF + m * 16; bf16_t* rowp = base + (size_t)row * 512 + col0;
                    f32x4 cs0 = (f32x4){1.f, 0.f, 1.f, 0.f}, cs1 = cs0;
                    if (rope) { const int trow = (wc & 1) ? 128 + m * 16 + fr : gr; const f32x4* tp = (const f32x4*)(tabA + (size_t)(trow * 16 + 4 * fq) * 2); cs0 = tp[0]; cs1 = tp[1]; }
#pragma unroll
                    for (int bj = 0; bj < 2; ++bj) { f32x4 v0 = acc[ai][bj][m][0] * sc, v1 = acc[ai][bj][m][1] * sc; rope8(v0, v1, cs0, cs1);
                        if (seg == 1) { typedef unsigned u32x2_ __attribute__((ext_vector_type(2))); *(u32x2_*)((unsigned char*)KA + (size_t)row * 512 + col0 + bj * HALF) = (u32x2_){pk4_fp8(v0[0], v0[1], v0[2], v0[3]), pk4_fp8(v1[0], v1[1], v1[2], v1[3])}; }
                        else if (seg == 2) vt_put8(VTA + ((size_t)((row >> 6) * 4 + (pn & 1) * 2 + bj) * 128 + wc * 32 + 8 * fq) * 64 + vt_slot8(row & 63), v0, v1);
                        else *(u32x4*)(rowp + bj * HALF) = pack8(v0, v1); }
                }
            }
        } else if (pn == 12 || pn == 14) {
            bf16_t* base = pn == 12 ? CQ : CKV; const int ld = pn == 12 ? 384 : 256; float* ssq = pn == 12 ? ssq_q : ssq_kv; const int sst = pn == 12 ? 8 : 4;
            const int col0 = wc * 32 + 8 * fq;
#pragma unroll
            for (int ai = 0; ai < 2; ++ai)
#pragma unroll
                for (int m = 0; m < 4; ++m) {
                    const int row = row0 + ai * HALF + m * 16; bf16_t* rowp = base + (size_t)row * ld + col0; float s = 0.f;
#pragma unroll
                    for (int bj = 0; bj < 2; ++bj) { const f32x4 v0 = acc[ai][bj][m][0] * WINV_IN, v1 = acc[ai][bj][m][1] * WINV_IN; *(u32x4*)(rowp + bj * HALF) = pack8(v0, v1);
                        s += (v0[0] * v0[0] + v0[1] * v0[1]) + (v0[2] * v0[2] + v0[3] * v0[3]) + (v1[0] * v1[0] + v1[1] * v1[1]) + (v1[2] * v1[2] + v1[3] * v1[3]); }
                    s += __shfl_xor(s, 16); s += __shfl_xor(s, 32);
                    if (fq == 0) ssq[(size_t)row * sst + wc] = s;
                }
        } else if (pn == 13) {
#pragma unroll
            for (int ai = 0; ai < 2; ++ai) {
                const int gr = ((u.pm * 4 + ai * 2 + wr) & 127);
#pragma unroll
                for (int m = 0; m < 4; ++m) {
                    const int row = row0 + ai * HALF + m * 16;
                    { const f32x4 v0 = acc[ai][0][m][0] * WINV_IN, v1 = acc[ai][0][m][1] * WINV_IN; *(u32x4*)(CQ + (size_t)row * 384 + 256 + wc * 32 + 8 * fq) = pack8(v0, v1);
                      float s = (v0[0] * v0[0] + v0[1] * v0[1]) + (v0[2] * v0[2] + v0[3] * v0[3]) + (v1[0] * v1[0] + v1[1] * v1[1]) + (v1[2] * v1[2] + v1[3] * v1[3]);
                      s += __shfl_xor(s, 16); s += __shfl_xor(s, 32); if (fq == 0) ssq_q[(size_t)row * 8 + 4 + wc] = s; }
                    if (wc == 0) {
                        f32x4 v0 = acc[ai][1][m][0] * WINV_IN, v1 = acc[ai][1][m][1] * WINV_IN;
                        if (!ctx) { const int trow = (fq >= 2) ? 128 + m * 16 + fr : gr; const f32x4* tp = (const f32x4*)(tabC + (size_t)(trow * 8 + 4 * (fq & 1)) * 2); rope8(v0, v1, tp[0], tp[1]); }
                        *(u32x4*)(CKR + (size_t)row * 32 + 8 * fq) = pack8(v0, v1);
                    }
                }
            }
        } else {
            const int col0 = (pn - 15) * 256 + wc * 32 + 8 * fq;
#pragma unroll
            for (int ai = 0; ai < 2; ++ai)
#pragma unroll
                for (int m = 0; m < 4; ++m) {
                    const int row = row0 + ai * HALF + m * 16; unsigned char* rowp = (unsigned char*)GATES + (size_t)row * 3072 + col0;
#pragma unroll
                    for (int bj = 0; bj < 2; ++bj) { f32x4 v0 = acc[ai][bj][m][0] * WINV_IN, v1 = acc[ai][bj][m][1] * WINV_IN;
#pragma unroll
                        for (int j = 0; j < 4; ++j) { v0[j] = sigmoidf_(v0[j]) * 256.0f; v1[j] = sigmoidf_(v1[j]) * 256.0f; }
                        typedef unsigned u32x2_ __attribute__((ext_vector_type(2))); *(u32x2_*)(rowp + bj * HALF) = (u32x2_){pk4_fp8(v0[0], v0[1], v0[2], v0[3]), pk4_fp8(v1[0], v1[1], v1[2], v1[3])}; }
                }
        }
    }
};
struct EpiQ {
    static constexpr bool PERM = true, AFTER_DRAIN = false;
    bf16_t* QC; const float* ssq_q; const float* tabC;
    __device__ __forceinline__ void operator()(const f32x4 (&acc)[2][2][4][2], const Unit& u, int wr, int wc, int fr, int fq) const {
        asm volatile("" : "+v"(fr), "+v"(fq));
        const bool ctx = u.pm >= PM_CTX; const int row0 = u.pm * BM + wr * 64 + fr;
        const int cA = u.pn * BM + wc * 32 + 8 * fq, cB = cA + HALF, pA = cA % 96, pB = cB % 96; const bool peA = (pA >= 64) && !ctx, peB = (pB >= 64) && !ctx;
        const int iA = peA ? (pA - 64) >> 1 : 0, iB = peB ? (pB - 64) >> 1 : 0;
#pragma unroll
        for (int ai = 0; ai < 2; ++ai) {
            const int gr = ((u.pm * 4 + ai * 2 + wr) & 127);
#pragma unroll
            for (int m = 0; m < 4; ++m) {
                const int row = row0 + ai * HALF + m * 16; const int gc = 128 + m * 16 + fr;
                const f32x4 sa = *(const f32x4*)(ssq_q + (size_t)row * 8), sb = *(const f32x4*)(ssq_q + (size_t)row * 8 + 4);
                const float rs = __builtin_amdgcn_rsqf((((sa[0] + sa[1]) + (sa[2] + sa[3])) + ((sb[0] + sb[1]) + (sb[2] + sb[3]))) * (1.0f / 384.0f) + EPS) * QSCALE_C;
                { const f32x4* tp = (const f32x4*)(tabC + (size_t)((iA >= 8 ? gc : gr) * 8 + (iA & 7)) * 2); f32x4 cs0 = tp[0], cs1 = tp[1]; if (!peA) { cs0 = (f32x4){1.f, 0.f, 1.f, 0.f}; cs1 = cs0; }
                  f32x4 v0 = acc[ai][0][m][0] * rs, v1 = acc[ai][0][m][1] * rs; rope8(v0, v1, cs0, cs1); *(u32x4*)(QC + (size_t)row * 768 + cA) = pack8(v0, v1); }
                { const f32x4* tp = (const f32x4*)(tabC + (size_t)((iB >= 8 ? gc : gr) * 8 + (iB & 7)) * 2); f32x4 cs0 = tp[0], cs1 = tp[1]; if (!peB) { cs0 = (f32x4){1.f, 0.f, 1.f, 0.f}; cs1 = cs0; }
                  f32x4 v0 = acc[ai][1][m][0] * rs, v1 = acc[ai][1][m][1] * rs; rope8(v0, v1, cs0, cs1); *(u32x4*)(QC + (size_t)row * 768 + cB) = pack8(v0, v1); }
                __builtin_amdgcn_sched_barrier(0);
            }
        }
    }
};
struct EpiKV {
    static constexpr bool PERM = true, AFTER_DRAIN = false;
    bf16_t *KCN, *VC; const float* ssq_kv; unsigned char* VTC;
    __device__ __forceinline__ void operator()(const f32x4 (&acc)[2][2][4][2], const Unit& u, int wr, int wc, int fr, int fq) const {
        asm volatile("" : "+v"(fr), "+v"(fq));
        const int row0 = u.pm * BM + wr * 64 + fr; bf16_t* base = u.pn < 2 ? KCN : VC; const int col0 = (u.pn & 1) * 256 + wc * 32 + 8 * fq;
#pragma unroll
        for (int ai = 0; ai < 2; ++ai)
#pragma unroll
            for (int m = 0; m < 4; ++m) {
                const int row = row0 + ai * HALF + m * 16; const f32x4 sa = *(const f32x4*)(ssq_kv + (size_t)row * 4); const float rs = __builtin_amdgcn_rsqf(((sa[0] + sa[1]) + (sa[2] + sa[3])) * (1.0f / 256.0f) + EPS); bf16_t* rowp = base + (size_t)row * 512 + col0;
#pragma unroll
                for (int bj = 0; bj < 2; ++bj) {
                    if (u.pn < 2) { typedef unsigned u32x2_ __attribute__((ext_vector_type(2))); const f32x4 v0 = acc[ai][bj][m][0] * (rs * 8.0f), v1 = acc[ai][bj][m][1] * (rs * 8.0f);
                        *(u32x2_*)((unsigned char*)KCN + (size_t)row * 512 + col0 + bj * HALF) = (u32x2_){pk4_fp8(v0[0], v0[1], v0[2], v0[3]), pk4_fp8(v1[0], v1[1], v1[2], v1[3])}; }
                    else vt_put8(VTC + ((size_t)((row >> 6) * 8 + (u.pn & 1) * 4 + bj * 2 + (wc >> 1)) * 64 + (wc & 1) * 32 + 8 * fq) * 64 + vt_slot8(row & 63), acc[ai][bj][m][0] * rs, acc[ai][bj][m][1] * rs); }
            }
    }
};
constexpr int MT_ROWS = MTOT / 256;
struct EpiMerge {
    static constexpr bool PERM = true, AFTER_DRAIN = false;
    const bf16_t* GATES; unsigned char* M8; bf16_t* MB;
    __device__ __forceinline__ void operator()(const f32x4 (&acc)[2][2][4][2], const Unit& u, int wr, int wc, int fr, int fq) const {
        asm volatile("" : "+v"(fr), "+v"(fq));
        const int br = u.pn >> 2, pn = u.pn & 3, pm = u.pm - br * MT_ROWS; const int row0 = pm * BM + wr * 64 + fr, col0 = pn * BM + wc * 32 + 8 * fq;
        const float us = WINV / (br == 0 ? YS_A : YS_BC);
        typedef unsigned u32x2g_ __attribute__((ext_vector_type(2)));
        u32x2g_ g8[2][4][2];
#pragma unroll
        for (int ai = 0; ai < 2; ++ai)
#pragma unroll
            for (int m = 0; m < 4; ++m)
#pragma unroll
                for (int bj = 0; bj < 2; ++bj) g8[ai][m][bj] = *(const u32x2g_*)((const unsigned char*)GATES + (size_t)(row0 + ai * HALF + m * 16) * 3072 + br * 1024 + col0 + bj * HALF);
#pragma unroll
        for (int am = 0; am < 4; ++am) { const int ai = am >> 1, mh = (am & 1) * 2;
            u32x4 gq[2][2], mq[2][2];
#pragma unroll
            for (int m2 = 0; m2 < 2; ++m2)
#pragma unroll
                for (int bj = 0; bj < 2; ++bj) { const int row = row0 + ai * HALF + (mh + m2) * 16;
                    gq[m2][bj] = (u32x4){g8[ai][mh + m2][bj].x, g8[ai][mh + m2][bj].y, 0u, 0u};
                    if (br > 0) mq[m2][bj] = *(const u32x4*)(MB + (size_t)row * 1024 + col0 + bj * HALF); else mq[m2][bj] = (u32x4){0u, 0u, 0u, 0u}; }
#pragma unroll
            for (int m2 = 0; m2 < 2; ++m2) { const int m = mh + m2;
                const int row = row0 + ai * HALF + m * 16;
#pragma unroll
                for (int bj = 0; bj < 2; ++bj) {
                    const u32x4 g = gq[m2][bj], q = mq[m2][bj];
                    const float ug = us * (1.0f / 256.0f);
                    f32x4 v0 = acc[ai][bj][m][0] * ug * (f32x4){__builtin_amdgcn_cvt_f32_fp8((int)g.x, 0), __builtin_amdgcn_cvt_f32_fp8((int)g.x, 1), __builtin_amdgcn_cvt_f32_fp8((int)g.x, 2), __builtin_amdgcn_cvt_f32_fp8((int)g.x, 3)},
                          v1 = acc[ai][bj][m][1] * ug * (f32x4){__builtin_amdgcn_cvt_f32_fp8((int)g.y, 0), __builtin_amdgcn_cvt_f32_fp8((int)g.y, 1), __builtin_amdgcn_cvt_f32_fp8((int)g.y, 2), __builtin_amdgcn_cvt_f32_fp8((int)g.y, 3)};
                    bf16_t* mp = MB + (size_t)row * 1024 + col0 + bj * HALF;
                    if (br > 0) { v0 += (f32x4){bf_lo(q.x), bf_hi(q.x), bf_lo(q.y), bf_hi(q.y)}; v1 += (f32x4){bf_lo(q.z), bf_hi(q.z), bf_lo(q.w), bf_hi(q.w)}; }
                    if (br < 2) *(u32x4*)mp = pack8(v0, v1);
                    else { typedef unsigned u32x2_ __attribute__((ext_vector_type(2))); v0 = v0 * MS8; v1 = v1 * MS8;
                        *(u32x2_*)(M8 + (size_t)row * 1024 + col0 + bj * HALF) = (u32x2_){pk4_fp8(v0[0], v0[1], v0[2], v0[3]), pk4_fp8(v1[0], v1[1], v1[2], v1[3])}; }
                }
            }
        }
    }
};
struct EpiOut {
    static constexpr bool PERM = true, AFTER_DRAIN = false;
    const float* xlat; const float* xctx; bf16_t* X; const float* modv; bool xin;
    __device__ __forceinline__ void operator()(const f32x4 (&acc)[2][2][4][2], const Unit& u, int wr, int wc, int fr, int fq) const {
        asm volatile("" : "+v"(fr), "+v"(fq));
        const bool ctx = u.pm >= PM_CTX; const int bidx = ctx ? 4 : (u.pm >> 5); const int row0 = u.pm * BM + wr * 64 + fr, col0 = u.pn * BM + wc * 32 + 8 * fq;
        const float* src = ctx ? xctx - (size_t)NLAT * DM : xlat; const float* gt = modv + bidx * 6144 + 2 * 1024 + col0;
        f32x4 g[2][2];
#pragma unroll
        for (int bj = 0; bj < 2; ++bj) { g[bj][0] = *(const f32x4*)(gt + bj * HALF) * (WINV / MS8); g[bj][1] = *(const f32x4*)(gt + bj * HALF + 4) * (WINV / MS8); }
#pragma unroll
        for (int am = 0; am < 4; ++am) { const int ai = am >> 1, mh = (am & 1) * 2;
            f32x4 xa[2][2], xb[2][2];
#pragma unroll
            for (int m2 = 0; m2 < 2; ++m2)
#pragma unroll
                for (int bj = 0; bj < 2; ++bj) { const size_t o_ = (size_t)(row0 + ai * HALF + (mh + m2) * 16) * DM + col0 + bj * HALF;
                    if (xin) { const float* sp = src + o_; xa[m2][bj] = *(const f32x4*)sp; xb[m2][bj] = *(const f32x4*)(sp + 4); }
                    else { const u32x4 q = *(const u32x4*)(X + o_); xa[m2][bj] = (f32x4){bf_lo(q.x), bf_hi(q.x), bf_lo(q.y), bf_hi(q.y)}; xb[m2][bj] = (f32x4){bf_lo(q.z), bf_hi(q.z), bf_lo(q.w), bf_hi(q.w)}; } }
#pragma unroll
            for (int m2 = 0; m2 < 2; ++m2) { const int m = mh + m2;
                const size_t off = (size_t)(row0 + ai * HALF + m * 16) * DM + col0;
#pragma unroll
                for (int bj = 0; bj < 2; ++bj) *(u32x4*)(X + off + bj * HALF) = pack8(xa[m2][bj] + g[bj][0] * acc[ai][bj][m][0], xb[m2][bj] + g[bj][1] * acc[ai][bj][m][1]);
            }
        }
    }
};
constexpr float SWIGLU_LIMIT = 7.0f, SWIGLU_ALPHA = 1.702f;
struct EpiGU {
    static constexpr bool PERM = true, AFTER_DRAIN = false;
    bf16_t* ACT; const float* bgu;
    __device__ __forceinline__ void operator()(const f32x4 (&acc)[2][2][4][2], const Unit& u, int wr, int wc, int fr, int fq) const {
        asm volatile("" : "+v"(fr), "+v"(fq));
        const int e = u.pn >> 3, pn = u.pn & 7; const int row0 = u.pm * BM + wr * 64 + fr, j0 = pn * 128 + wc * 32 + 8 * fq;
        const float* bp = bgu + (size_t)e * 2048 + 2 * j0; f32x4 bb[4];
#pragma unroll
        for (int q = 0; q < 4; ++q) bb[q] = *(const f32x4*)(bp + 4 * q);
        const f32x4 bg0 = (f32x4){bb[0][0], bb[0][2], bb[1][0], bb[1][2]}, bg1 = (f32x4){bb[2][0], bb[2][2], bb[3][0], bb[3][2]};
        const f32x4 bu0 = (f32x4){bb[0][1], bb[0][3], bb[1][1], bb[1][3]}, bu1 = (f32x4){bb[2][1], bb[2][3], bb[3][1], bb[3][3]};
#pragma unroll
        for (int ai = 0; ai < 2; ++ai)
#pragma unroll
            for (int m = 0; m < 4; ++m) {
                const int row = row0 + ai * HALF + m * 16;
                f32x4 g0 = acc[ai][0][m][0] * WINV_MOE + bg0, g1 = acc[ai][0][m][1] * WINV_MOE + bg1, u0 = acc[ai][1][m][0] * WINV_MOE + bu0, u1 = acc[ai][1][m][1] * WINV_MOE + bu1;
#pragma unroll
                for (int j = 0; j < 4; ++j) {
                    float ga = fminf(g0[j], SWIGLU_LIMIT), ua = fminf(fmaxf(u0[j], -SWIGLU_LIMIT), SWIGLU_LIMIT); g0[j] = (ua + 1.0f) * (ga * sigmoidf_(SWIGLU_ALPHA * ga));
                    float gb = fminf(g1[j], SWIGLU_LIMIT), ub = fminf(fmaxf(u1[j], -SWIGLU_LIMIT), SWIGLU_LIMIT); g1[j] = (ub + 1.0f) * (gb * sigmoidf_(SWIGLU_ALPHA * gb)); }
                if constexpr (F8_MOE) { typedef unsigned u32x2_ __attribute__((ext_vector_type(2))); *(u32x2_*)((unsigned char*)ACT + (size_t)row * 1024 + j0) = (u32x2_){pk4_fp8(g0[0], g0[1], g0[2], g0[3]), pk4_fp8(g1[0], g1[1], g1[2], g1[3])}; }
                else *(u32x4*)(ACT + (size_t)row * 1024 + j0) = pack8(g0, g1);
            }
    }
};
struct EpiDown {
    static constexpr bool PERM = true, AFTER_DRAIN = false;
    bf16_t* YBUF; const float* bdn; const int* xs; const float* xw; const PG8_LAS int* base; const PG8_LAS int* cnt;
    __device__ __forceinline__ void operator()(const f32x4 (&acc)[2][2][4][2], const Unit& u, int wr, int wc, int fr, int fq) const {
        asm volatile("" : "+v"(fr), "+v"(fq));
        const int e = u.pn >> 2, pn = u.pn & 3; const int row0 = u.pm * BM + wr * 64 + fr, col0 = pn * BM + wc * 32 + 8 * fq;
        const float* bp = bdn + (size_t)e * 1024 + col0; f32x4 b[2][2];
#pragma unroll
        for (int bj = 0; bj < 2; ++bj) { b[bj][0] = *(const f32x4*)(bp + bj * HALF); b[bj][1] = *(const f32x4*)(bp + bj * HALF + 4); }
        int dsts[2][4]; float ws_[2][4];
#pragma unroll
        for (int ai = 0; ai < 2; ++ai)
#pragma unroll
            for (int m = 0; m < 4; ++m) { const int slot = row0 + ai * HALF + m * 16 - base[e]; const bool ok = slot < cnt[e]; const size_t xi = (size_t)e * MTOT + (ok ? slot : 0);
                const int d_ = xs[xi]; const float w_ = xw[xi]; dsts[ai][m] = ok ? d_ : -1; ws_[ai][m] = ok ? w_ : 0.f; }
#pragma unroll
        for (int ai = 0; ai < 2; ++ai)
#pragma unroll
            for (int m = 0; m < 4; ++m) {
                const int dst = dsts[ai][m]; const float w = ws_[ai][m];
                if (dst >= 0) {
#pragma unroll
                    for (int bj = 0; bj < 2; ++bj) *(u32x4*)(YBUF + (size_t)dst * 1024 + col0 + bj * HALF) = pack8((acc[ai][bj][m][0] * WINV_MOE + b[bj][0]) * w, (acc[ai][bj][m][1] * WINV_MOE + b[bj][1]) * w);
                }
            }
    }
};
struct MergeOrder {
    StaticOrder S;
    __device__ __forceinline__ bool next(int i, Unit& u) const { const int t = i / 3, br = i - 3 * t; Unit v; if (!S.next(t, v)) return false; u.pm = br * MT_ROWS + v.pm; u.pn = br * 4 + v.pn; return true; }
    __device__ __forceinline__ void a_ready(const Unit&) const {}
    __device__ __forceinline__ void done(const Unit&) const {}
};
struct ExpertOrder {
    StaticOrder S; const PG8_LAS int* tile_e; int nNe;
    const int* xs = nullptr; const PG8_LAS int* base = nullptr; const PG8_LAS int* cnt = nullptr;
    __device__ __forceinline__ int src_row(int pm, int rr) const { const int e = tile_e[pm]; const int slot = pm * BM + rr - base[e]; return slot < cnt[e] ? (xs[(size_t)e * MTOT + slot] >> 2) : 0; }
    __device__ __forceinline__ bool next(int i, Unit& u) const { Unit v; if (!S.next(i, v)) return false; u.pm = v.pm; u.pn = tile_e[v.pm] * nNe + v.pn; return true; }
    __device__ __forceinline__ void a_ready(const Unit&) const {}
    __device__ __forceinline__ void done(const Unit&) const {}
};
template <class Epi, class Sched, bool ALIGN_EPI = false, bool SP2 = false, bool FP8 = false, bool GATHER = false>
__device__ __forceinline__ void gemm_phase(PG8_LAS unsigned char* lds, const Gemm g, const Sched& S, const Epi& E) {
    int tid_ = threadIdx.x; asm volatile("" : "+v"(tid_));
    const int tid = tid_, wid = __builtin_amdgcn_readfirstlane(tid >> 6), lane = tid & 63, wr = wid >> 2, wc = wid & 3, fr = lane & 15, fq = lane >> 4;
    const int K = g.K, nt = K / BK;
    unsigned voffA[2], voffB[2];
#pragma unroll
    for (int i = 0; i < 2; ++i) { int R, C; stage_rc(tid * 16 + i * 8192, R, C); const int Rb = Epi::PERM ? ((R & ~31) + perm32(R & 31)) : R;
        voffA[i] = (unsigned)(R * K + C) * 2u; voffB[i] = (unsigned)(Rb * K + C) * 2u; }
    unsigned cvo[2][2] = {{0u, 0u}, {0u, 0u}}, nvo[2][2] = {{0u, 0u}, {0u, 0u}};
#define PG8_LDVO(u_, vo_) do { _Pragma("unroll") for (int h_ = 0; h_ < 2; ++h_) _Pragma("unroll") for (int i_ = 0; i_ < 2; ++i_) { int R_, C_; stage_rc(tid * 16 + i_ * 8192, R_, C_); \
        vo_[h_][i_] = (unsigned)S.src_row((u_).pm, h_ * HALF + R_) * (unsigned)(K * 2) + (unsigned)(C_ * 2); } } while (0)
    const size_t kstep = (size_t)(BK * 2);
    const size_t hstep = (size_t)HALF * K * 2;
    const size_t tstep = 2 * hstep;
    const unsigned ldsw = (unsigned)wid * 1024u;
    const int aoff = lds_byte(wr * 64 + fr, fq * 8), boff = lds_byte(wc * 32 + fr, fq * 8);
#define PG8_SA(b, h) (((b) * 2 + (h)) * HTB)
#define PG8_SB(b, h) ((4 + (b) * 2 + (h)) * HTB)
#define PG8_STAGE(bufoff, gbase, voff) do { _Pragma("unroll") for (int _i = 0; _i < 2; ++_i) \
        __builtin_amdgcn_global_load_lds((const unsigned*)((const char*)(gbase) + (voff)[_i]), (PG8_LAS unsigned*)(lds + (bufoff) + ldsw + _i * 8192), 16, 0, 0); } while (0)
#define PG8_LDA(dst, b, h) do { _Pragma("unroll") for (int m = 0; m < 4; ++m) _Pragma("unroll") for (int k = 0; k < 2; ++k) dst[m][k] = *(const PG8_LAS bf16x8*)(lds + PG8_SA(b, h) + aoff + m * 2048 + k * 1024); } while (0)
#define PG8_LDB(dst, b, h) do { _Pragma("unroll") for (int n = 0; n < 2; ++n) _Pragma("unroll") for (int k = 0; k < 2; ++k) dst[n][k] = *(const PG8_LAS bf16x8*)(lds + PG8_SB(b, h) + boff + n * 2048 + k * 1024); } while (0)
#define PG8_MMA(ai, bj, At, Bt) do { __builtin_amdgcn_s_setprio(1); _Pragma("unroll") for (int m = 0; m < 4; ++m) _Pragma("unroll") for (int n = 0; n < 2; ++n) { \
        if constexpr (FP8) { typedef int i32x4_ __attribute__((ext_vector_type(4))); typedef int i32x8_ __attribute__((ext_vector_type(8))); \
            const i32x8_ bb_ = __builtin_shufflevector(__builtin_bit_cast(i32x4_, Bt[n][0]), __builtin_bit_cast(i32x4_, Bt[n][1]), 0, 1, 2, 3, 4, 5, 6, 7); \
            const i32x8_ aa_ = __builtin_shufflevector(__builtin_bit_cast(i32x4_, At[m][0]), __builtin_bit_cast(i32x4_, At[m][1]), 0, 1, 2, 3, 4, 5, 6, 7); \
            asm volatile("v_mfma_scale_f32_16x16x128_f8f6f4 %0, %1, %2, %0, %3, %3 op_sel_hi:[0,0,0]" : "+v"(acc[ai][bj][m][n]) : "v"(bb_), "v"(aa_), "v"(f8scale)); }   \
        else { _Pragma("unroll") for (int k = 0; k < 2; ++k) acc[ai][bj][m][n] = __builtin_amdgcn_mfma_f32_16x16x32_bf16(Bt[n][k], At[m][k], acc[ai][bj][m][n], 0, 0, 0); } } \
        __builtin_amdgcn_s_setprio(0); } while (0)
#define PG8_WAIT_V(n) asm volatile("s_waitcnt vmcnt(" #n ")" ::: "memory")
#define PG8_WAIT_L(n) asm volatile("s_waitcnt lgkmcnt(" #n ")" ::: "memory")
#define PG8_BAR __builtin_amdgcn_s_barrier()
#define PG8_SCHED __builtin_amdgcn_sched_barrier(0)
    Unit cur, nxt; int ui = 0;
    if (!S.next(0, cur)) return;
    int f8scale = 0x7f7f7f7f; asm volatile("" : "+v"(f8scale));
    f32x4 acc[2][2][4][2];
#pragma unroll
    for (int a = 0; a < 2; ++a)
#pragma unroll
        for (int b = 0; b < 2; ++b)
#pragma unroll
            for (int m = 0; m < 4; ++m)
#pragma unroll
                for (int n = 0; n < 2; ++n) acc[a][b][m][n] = (f32x4){0.f, 0.f, 0.f, 0.f};
    bf16x8 At[4][2], B0[2][2], B1[2][2];
    const char* cA = (const char*)g.A + (size_t)cur.pm * tstep; const char* cB = (const char*)g.Bt + (size_t)cur.pn * tstep; const char* const gA0 = (const char*)g.A;
    S.a_ready(cur);
    if constexpr (SP2) {
        if constexpr (GATHER) { PG8_LDVO(cur, cvo); }
        PG8_STAGE(PG8_SB(0, 0), cB, voffB); PG8_STAGE(PG8_SB(0, 1), cB + hstep, voffB);
        if constexpr (GATHER) { PG8_STAGE(PG8_SA(0, 0), gA0, cvo[0]); PG8_STAGE(PG8_SA(0, 1), gA0, cvo[1]); } else { PG8_STAGE(PG8_SA(0, 0), cA, voffA); PG8_STAGE(PG8_SA(0, 1), cA + hstep, voffA); }
        if (wr == 1) PG8_BAR;
        PG8_WAIT_V(2); PG8_BAR;
        PG8_STAGE(PG8_SB(1, 0), cB + kstep, voffB); if constexpr (GATHER) PG8_STAGE(PG8_SA(1, 0), gA0 + kstep, cvo[0]); else PG8_STAGE(PG8_SA(1, 0), cA + kstep, voffA); PG8_STAGE(PG8_SB(1, 1), cB + hstep + kstep, voffB);
        PG8_WAIT_V(6); PG8_BAR;
    } else {
        PG8_STAGE(PG8_SB(0, 0), cB, voffB); PG8_STAGE(PG8_SA(0, 0), cA, voffA); PG8_STAGE(PG8_SB(0, 1), cB + hstep, voffB); PG8_STAGE(PG8_SA(0, 1), cA + hstep, voffA);
        if (wr == 1) PG8_BAR;
        PG8_WAIT_V(4); PG8_BAR;
        PG8_STAGE(PG8_SB(1, 0), cB + kstep, voffB); PG8_STAGE(PG8_SA(1, 0), cA + kstep, voffA); PG8_STAGE(PG8_SB(1, 1), cB + hstep + kstep, voffB);
        PG8_WAIT_V(6); PG8_BAR;
    }
    for (;;) {
        const bool has_next = S.next(ui + 1, nxt);
        const char* nA = has_next ? (const char*)g.A + (size_t)nxt.pm * tstep : cA; const char* nB = has_next ? (const char*)g.Bt + (size_t)nxt.pn * tstep : cB;
        if constexpr (GATHER) { if (has_next) { PG8_LDVO(nxt, nvo); } else { _Pragma("unroll") for (int h_ = 0; h_ < 2; ++h_) _Pragma("unroll") for (int i_ = 0; i_ < 2; ++i_) nvo[h_][i_] = cvo[h_][i_]; } }
#pragma nounroll
        for (int t = 0; t < nt; t += 2) {
            const bool last = (t == nt - 2);
            const char* a1 = cA + (size_t)(t + 1) * kstep;
            const char* a2 = last ? nA : cA + (size_t)(t + 2) * kstep; const char* b2 = last ? nB : cB + (size_t)(t + 2) * kstep;
            const char* a3 = a2 + kstep; const char* b3 = b2 + kstep;
            if (last && has_next) S.a_ready(nxt);
            if constexpr (SP2) {
            unsigned s0_[2], s1_[2]; const char* gk2 = gA0;
            if constexpr (GATHER) { s0_[0] = last ? nvo[0][0] : cvo[0][0]; s0_[1] = last ? nvo[0][1] : cvo[0][1]; s1_[0] = last ? nvo[1][0] : cvo[1][0]; s1_[1] = last ? nvo[1][1] : cvo[1][1]; gk2 = last ? gA0 : gA0 + (size_t)(t + 2) * kstep; }
            PG8_LDB(B0, 0, 0); PG8_LDB(B1, 0, 1); PG8_SCHED; PG8_LDA(At, 0, 0); if constexpr (GATHER) PG8_STAGE(PG8_SA(1, 1), gA0 + (size_t)(t + 1) * kstep, cvo[1]); else PG8_STAGE(PG8_SA(1, 1), a1 + hstep, voffA);
            PG8_WAIT_V(8); PG8_WAIT_L(0); PG8_BAR; PG8_MMA(0, 0, At, B0); PG8_MMA(0, 1, At, B1); PG8_BAR; PG8_SCHED;
            PG8_LDA(At, 0, 1); PG8_STAGE(PG8_SB(0, 0), b2, voffB); PG8_STAGE(PG8_SB(0, 1), b2 + hstep, voffB); if constexpr (GATHER) PG8_STAGE(PG8_SA(0, 0), gk2, s0_); else PG8_STAGE(PG8_SA(0, 0), a2, voffA);
            PG8_WAIT_V(8); PG8_WAIT_L(0); PG8_BAR; PG8_MMA(1, 0, At, B0); PG8_MMA(1, 1, At, B1); PG8_BAR; PG8_SCHED;
            PG8_LDB(B0, 1, 0); PG8_LDB(B1, 1, 1); PG8_SCHED; PG8_LDA(At, 1, 0); if constexpr (GATHER) PG8_STAGE(PG8_SA(0, 1), gk2, s1_); else PG8_STAGE(PG8_SA(0, 1), a2 + hstep, voffA);
            PG8_WAIT_V(8); PG8_WAIT_L(0); PG8_BAR; PG8_MMA(0, 0, At, B0); PG8_MMA(0, 1, At, B1); PG8_BAR; PG8_SCHED;
            PG8_LDA(At, 1, 1); PG8_STAGE(PG8_SB(1, 0), b3, voffB); PG8_STAGE(PG8_SB(1, 1), b3 + hstep, voffB); if constexpr (GATHER) PG8_STAGE(PG8_SA(1, 0), gk2 + kstep, s0_); else PG8_STAGE(PG8_SA(1, 0), a3, voffA);
            PG8_WAIT_V(8); PG8_WAIT_L(0); PG8_BAR; PG8_MMA(1, 0, At, B0); PG8_MMA(1, 1, At, B1); PG8_BAR; PG8_SCHED;
            } else {
            PG8_LDB(B0, 0, 0); PG8_SCHED; PG8_LDA(At, 0, 0); PG8_STAGE(PG8_SA(1, 1), a1 + hstep, voffA);
            PG8_WAIT_L(8); PG8_BAR; PG8_WAIT_L(0); PG8_MMA(0, 0, At, B0); PG8_BAR; PG8_SCHED;
            PG8_LDB(B1, 0, 1); PG8_STAGE(PG8_SB(0, 0), b2, voffB);
            PG8_BAR; PG8_WAIT_L(0); PG8_MMA(0, 1, At, B1); PG8_BAR;
            PG8_LDA(At, 0, 1); PG8_STAGE(PG8_SA(0, 0), a2, voffA);
            PG8_BAR; PG8_WAIT_L(0); PG8_MMA(1, 0, At, B0); PG8_BAR; PG8_SCHED;
            PG8_STAGE(PG8_SB(0, 1), b2 + hstep, voffB);
            PG8_WAIT_V(6); PG8_BAR; PG8_MMA(1, 1, At, B1); PG8_BAR;
            PG8_LDB(B0, 1, 0); PG8_SCHED; PG8_LDA(At, 1, 0); PG8_STAGE(PG8_SA(0, 1), a2 + hstep, voffA);
            PG8_WAIT_L(8); PG8_BAR; PG8_WAIT_L(0); PG8_MMA(0, 0, At, B0); PG8_BAR; PG8_SCHED;
            PG8_LDB(B1, 1, 1); PG8_STAGE(PG8_SB(1, 0), b3, voffB);
            PG8_BAR; PG8_WAIT_L(0); PG8_MMA(0, 1, At, B1); PG8_BAR;
            PG8_LDA(At, 1, 1); PG8_STAGE(PG8_SA(1, 0), a3, voffA);
            PG8_BAR; PG8_WAIT_L(0); PG8_MMA(1, 0, At, B0); PG8_BAR; PG8_SCHED;
            PG8_STAGE(PG8_SB(1, 1), b3 + hstep, voffB);
            PG8_WAIT_V(6); PG8_BAR; PG8_MMA(1, 1, At, B1); PG8_BAR;
            }
        }
        if constexpr (ALIGN_EPI) { if (wr == 0) PG8_BAR; }
        if constexpr (FP8) {
#define PG8_TIE8(a, b, TXT) asm volatile(TXT : "+v"(acc[a][b][0][0]), "+v"(acc[a][b][0][1]), "+v"(acc[a][b][1][0]), "+v"(acc[a][b][1][1]), "+v"(acc[a][b][2][0]), "+v"(acc[a][b][2][1]), "+v"(acc[a][b][3][0]), "+v"(acc[a][b][3][1]))
            PG8_TIE8(0, 0, "s_nop 15\n\ts_nop 15\n\ts_nop 15"); PG8_TIE8(0, 1, ""); PG8_TIE8(1, 0, ""); PG8_TIE8(1, 1, "");
#undef PG8_TIE8
        }
        if constexpr (!Epi::AFTER_DRAIN) { E(acc, cur, wr, wc, fr, fq); S.done(cur); }
        if (!has_next) break;
#pragma unroll
        for (int a = 0; a < 2; ++a)
#pragma unroll
            for (int b = 0; b < 2; ++b)
#pragma unroll
                for (int m = 0; m < 4; ++m)
#pragma unroll
                    for (int n = 0; n < 2; ++n) acc[a][b][m][n] = (f32x4){0.f, 0.f, 0.f, 0.f};
        cur = nxt; cA = nA; cB = nB; ++ui;
        if constexpr (GATHER) { _Pragma("unroll") for (int h_ = 0; h_ < 2; ++h_) _Pragma("unroll") for (int i_ = 0; i_ < 2; ++i_) cvo[h_][i_] = nvo[h_][i_]; }
        if constexpr (ALIGN_EPI) { if (wr == 1) PG8_BAR; }
    }
    PG8_WAIT_V(0);
    if constexpr (!ALIGN_EPI) { if (wr == 0) PG8_BAR; }
    PG8_BAR;
    if constexpr (Epi::AFTER_DRAIN) { E.fused(acc, cur, wr, wc, fr, fq, lds, wid, lane); S.done(cur); }
#undef PG8_SA
#undef PG8_SB
#undef PG8_STAGE
#undef PG8_LDA
#undef PG8_LDB
#undef PG8_MMA
#undef PG8_WAIT_V
#undef PG8_WAIT_L
#undef PG8_BAR
#undef PG8_SCHED
#undef PG8_LDVO
}
}

using namespace pg8;
constexpr int NWAVES = 8, NTHR = 512;
#define GAS __attribute__((address_space(1)))
#define LAS __attribute__((address_space(3)))
typedef unsigned short bf16;
#define LDS_WAIT() asm volatile("s_waitcnt lgkmcnt(0)" ::: "memory")
#define VM_WAIT() asm volatile("s_waitcnt vmcnt(0)" ::: "memory")
__device__ __forceinline__ unsigned f2bf(float f) { unsigned u = __builtin_bit_cast(unsigned, f); return (u + 0x7fffu + ((u >> 16) & 1u)) >> 16; }
__device__ __forceinline__ unsigned pk2(float lo, float hi) { return f2bf(lo) | (f2bf(hi) << 16); }
__device__ __forceinline__ float bf2f(bf16 b) { return __uint_as_float(((unsigned)b) << 16); }
__device__ __forceinline__ float wave_sum(float v) {
#pragma unroll
    for (int o = 1; o < 64; o <<= 1) v += __shfl_xor(v, o);
    return v;
}
__device__ __forceinline__ float siluf_(float x) { return x / (1.0f + __expf(-x)); }

constexpr size_t MiB = 1u << 20;
constexpr size_t WS_CTL = 0, CTL_ZERO_BYTES = 128 * 1024;
constexpr int CW_BAR = 4096;
constexpr int CW_CNT = 16384;
constexpr int CW_DBG = 20480;
constexpr size_t CTL_SSQ = 1 * MiB;
constexpr size_t WS_MODV = 4 * MiB;
constexpr size_t WS_WRT = 5 * MiB + 512 * 1024;
constexpr size_t WS_TAB = 5 * MiB;
constexpr size_t WS_ROUTE = 6 * MiB;
constexpr size_t WS_WIN = 10 * MiB, WS_WQB = 37 * MiB, WS_WKVB = 39 * MiB, WS_WBR = 40 * MiB, WS_WOUT = 46 * MiB, WS_WGU = 50 * MiB, WS_WDN = 306 * MiB;
constexpr size_t WS_X = 434 * MiB, WS_H = 566 * MiB, WS_R = 632 * MiB;
constexpr size_t SZ_R512 = (size_t)MTOT * 512 * 2;
constexpr size_t WS_QA = WS_R, WS_KA = WS_QA + SZ_R512, WS_VA = WS_KA + SZ_R512, WS_QB = WS_VA + SZ_R512, WS_KB = WS_QB + SZ_R512, WS_VB = WS_KB + SZ_R512;
constexpr size_t WS_CQ = WS_VB + SZ_R512, WS_CKR = WS_CQ + (size_t)MTOT * 384 * 2, WS_CKV = WS_CKR + (size_t)MTOT * 32 * 2 + MiB, WS_GATES = WS_CKV + (size_t)MTOT * 256 * 2;
constexpr size_t WS_QC = WS_GATES + (size_t)MTOT * 3072 * 2, WS_KCN = WS_QC + (size_t)MTOT * 768 * 2, WS_VC = WS_KCN + SZ_R512, WS_O0 = WS_VC + SZ_R512;
constexpr size_t WS_YA = WS_O0 + (size_t)MTOT * 512 * 4, WS_YB = WS_YA + SZ_R512, WS_YC = WS_YB + SZ_R512, WS_M32 = WS_YC + SZ_R512, WS_MB = WS_M32 + (size_t)MTOT * 1024 * 4, WS_MIX_END = WS_MB + (size_t)MTOT * 1024 * 2;
constexpr size_t WS_VTA = WS_MIX_END, WS_VTC = WS_VTA + (size_t)(MTOT / 64) * 4 * 8192, WS_VT_END = WS_VTC + (size_t)(MTOT / 64) * 8 * 4096;
constexpr int HS_ROWS = 143360;
constexpr size_t WS_XS = WS_R, WS_XW = WS_XS + (size_t)NEXP * MTOT * 4;
constexpr size_t WS_HS = WS_R, WS_ACT = WS_HS + (size_t)HS_ROWS * 1024 * 2, WS_YBUF = WS_ACT + (size_t)HS_ROWS * 1024 * 2, WS_MOE_END = WS_YBUF + (size_t)MTOT * 4 * 1024 * 2;
constexpr size_t WS_END = (WS_VT_END > WS_MOE_END ? WS_VT_END : WS_MOE_END);
static_assert(WS_END <= (size_t)2040 * MiB, "workspace map");
constexpr size_t RT_E = 0, RT_SLOT = (size_t)MTOT * 4 * 4, RT_W = 2 * RT_SLOT, RT_YDST = 3 * RT_SLOT, RT_WROW = RT_YDST + (size_t)HS_ROWS * 4, RT_YSRC = RT_WROW + (size_t)HS_ROWS * 4;
static_assert(WS_ROUTE + RT_WROW + (size_t)HS_ROWS * 4 <= WS_WIN, "routing map");

constexpr int RING_OFF = 0, RING_BYTES = 131072;
constexpr int TBL_OFF = RING_BYTES;
constexpr int MISC_OFF = TBL_OFF + 12288;
constexpr int LDS_BYTES = 147456;
static_assert(MISC_OFF + 256 <= LDS_BYTES, "LDS map");

#define XB_TMO      128
#define XB_XCNT(j)  (256  + 64 * (j))
#define XB_XSUB(j)  (1280 + 64 * (j))
#define XB_XGEN(j)  (2304 + 64 * (j))
#define XB_TOP      3328
#define XB_TOPGEN   3392
#define XCD_BAR_WORDS 3456
#define XB_SPIN_CAP (1u << 18)
__device__ __forceinline__ unsigned xb_ld(unsigned* p)              { return __hip_atomic_load(p, __ATOMIC_RELAXED, __HIP_MEMORY_SCOPE_AGENT); }
__device__ __forceinline__ unsigned xb_add(unsigned* p, unsigned v) { return __hip_atomic_fetch_add(p, v, __ATOMIC_RELAXED, __HIP_MEMORY_SCOPE_AGENT); }
__device__ __forceinline__ unsigned xb_xcc_id() { return (unsigned)__builtin_amdgcn_s_getreg((3 << 11) | 20) & 0xFu; }
#define XB_SPIN(cond, bar) do { unsigned _sp = 0; while (cond) { __builtin_amdgcn_s_sleep(1); \
    if ((++_sp & 255u) == 0u) { if (xb_ld(&(bar)[XB_TMO])) break; if (_sp > XB_SPIN_CAP) { atomicAdd(&(bar)[XB_TMO], 1u); break; } } } } while (0)
struct XcdBarrier { unsigned* bar; unsigned x; volatile LAS unsigned* st; };
__device__ __forceinline__ XcdBarrier xcd_barrier_post(unsigned* bar, volatile LAS unsigned* st) {
    XcdBarrier b; b.bar = bar; b.x = xb_xcc_id(); b.st = st;
    if (threadIdx.x == 0) (void)xb_add(&bar[XB_XCNT(b.x)], 1u);
    return b;
}
__device__ __forceinline__ void xcd_barrier_complete(unsigned* bar, unsigned x, unsigned& nloc, unsigned& nx) {
    const unsigned G = gridDim.x * gridDim.y * gridDim.z;
    unsigned sum, cnt, mine, sp = 0u;
    for (;;) {
        sum = 0u; cnt = 0u; mine = 0u;
#pragma nounroll
        for (unsigned j = 0; j < 16; ++j) { const unsigned c = xb_ld(&bar[XB_XCNT(j)]); sum += c; cnt += (c > 0u) ? 1u : 0u; mine = (j == x) ? c : mine; }
        if (sum == G) break;
        __builtin_amdgcn_s_sleep(1);
        if ((++sp & 255u) == 0u) { if (xb_ld(&bar[XB_TMO])) break; if (sp > XB_SPIN_CAP) { atomicAdd(&bar[XB_TMO], 1u); break; } }
    }
    nloc = mine > 0u ? mine : 1u; nx = cnt > 0u ? cnt : 1u;
}
__device__ __forceinline__ void xcd_barrier(const XcdBarrier& b) {
    asm volatile("s_waitcnt vmcnt(0)" ::: "memory");
    __syncthreads();
    if (threadIdx.x == 0) {
        unsigned* bar = b.bar;
        __builtin_amdgcn_s_waitcnt(0);
        unsigned nloc = b.st[0], nx = b.st[1];
        if (nloc == 0u) { xcd_barrier_complete(bar, b.x, nloc, nx); b.st[0] = nloc; b.st[1] = nx; }
        const unsigned old = xb_add(&bar[XB_XSUB(b.x)], 1u);
        const unsigned gen = old / nloc;
        if (old + 1u == (gen + 1u) * nloc) {
            __builtin_amdgcn_fence(__ATOMIC_RELEASE, "agent");
            asm volatile("s_waitcnt vmcnt(0)" ::: "memory");
            const unsigned og = xb_add(&bar[XB_TOP], 1u);
            const unsigned tg = og / nx;
            if (og + 1u == (tg + 1u) * nx) xb_add(&bar[XB_TOPGEN], 1u);
            else XB_SPIN(xb_ld(&bar[XB_TOPGEN]) == tg, bar);
            __builtin_amdgcn_fence(__ATOMIC_ACQUIRE, "agent");
            xb_add(&bar[XB_XGEN(b.x)], 1u);
            asm volatile("s_waitcnt vmcnt(0)" ::: "memory");
        } else {
            XB_SPIN(xb_ld(&bar[XB_XGEN(b.x)]) == gen, bar);
            __builtin_amdgcn_fence(__ATOMIC_ACQUIRE, "agent");
            asm volatile("s_waitcnt vmcnt(0)" ::: "memory");
        }
    }
    __syncthreads();
}

struct Args { const float* in[30]; float* out; unsigned char* ws; int ph_lo, ph_hi; };
enum { I_X = 0, I_C, I_CTX, I_CCTX, I_WMOD, I_BMOD, I_GMIX, I_WIN, I_LQ1, I_LK1, I_LQ2, I_LK2, I_GSUB, I_RPB, I_GQA, I_WQB, I_GKVA, I_WKVB, I_WBRA, I_WBRB, I_WBRC, I_WOUT, I_GFFN, I_WROUT, I_BROUT, I_WGU, I_BGU, I_WDN, I_BDN, I_GFIN };

__device__ __forceinline__ int win_src(int n) {
    if (n < 1024) { const int g = n >> 6, p = n & 63, i = p >> 1, s = p & 1; return g * 64 + (i < 16 ? i : i + 16) + 16 * s; }
    if (n < OFF_CQ + 384) return n;
    if (n < OFF_PADW) { const int p = n - OFF_CKR, i = p >> 1, s = p & 1; return 3712 + (i < 8 ? i : i + 8) + 8 * s; }
    if (n < OFF_CKV) return -1;
    if (n < OFF_GATES) return 3456 + (n - OFF_CKV);
    return 3744 + (n - OFF_GATES);
}
__device__ __forceinline__ int wqb_src(int n) { const int h = n / 96, p = n - 96 * h; if (p < 64) return n; const int q = p - 64, i = q >> 1, s = q & 1; return h * 96 + 64 + (i < 8 ? i : i + 8) + 8 * s; }
__device__ __forceinline__ int wkvb_src(int n) { return n < 512 ? (n >> 6) * 128 + (n & 63) : ((n - 512) >> 6) * 128 + 64 + (n & 63); }
__device__ __forceinline__ int wgu_src(int n) { const int pn = n >> 8, s = (n >> 7) & 1, t = n & 127; return 2 * (128 * pn + t) + s; }
template <int KIND, bool F8 = false> __device__ __forceinline__ void transpose_item(const float* W, int K, int N, bf16* WT, const float* gk, LAS float* scr, int item, int nblk, int lane) {
    asm volatile("" : "+v"(lane));
    const int pr = item >> 1, kb = 2 * (pr / nblk) + (item & 1), nb = pr % nblk, k0 = 64 * kb, n0 = 32 * nb;
    const int nd = n0 + (lane & 31);
    const int ns = KIND == 1 ? win_src(nd) : KIND == 2 ? wqb_src(nd) : KIND == 3 ? wkvb_src(nd) : KIND == 4 ? wgu_src(nd) : nd;
    float tv_[32];
#pragma unroll
    for (int i = 0; i < 32; ++i) { const int kk = 2 * i + (lane >> 5); float v = 0.f; if (ns >= 0) v = W[(size_t)(k0 + kk) * N + ns]; tv_[i] = v; }
#pragma unroll
    for (int i = 0; i < 32; ++i) { const int kk = 2 * i + (lane >> 5); float v = tv_[i]; if (gk) v *= gk[k0 + kk]; scr[kk * 33 + (lane & 31)] = v; }
    LDS_WAIT(); asm volatile("" ::: "memory");
    const int c = lane & 7;
#pragma unroll
    for (int j = 0; j < 4; ++j) { const int n = (lane >> 3) + 8 * j; const LAS float* s = scr + (8 * c) * 33 + n;
        if constexpr (F8) { typedef unsigned u32x2_ __attribute__((ext_vector_type(2)));
            *(GAS u32x2_*)((unsigned char*)WT + (size_t)(n0 + n) * K + k0 + 8 * c) = (u32x2_){pk4_fp8(s[0 * 33] * WSCALE, s[1 * 33] * WSCALE, s[2 * 33] * WSCALE, s[3 * 33] * WSCALE), pk4_fp8(s[4 * 33] * WSCALE, s[5 * 33] * WSCALE, s[6 * 33] * WSCALE, s[7 * 33] * WSCALE)}; }
        else { u32x4 o; o.x = pk2(s[0 * 33], s[1 * 33]); o.y = pk2(s[2 * 33], s[3 * 33]); o.z = pk2(s[4 * 33], s[5 * 33]); o.w = pk2(s[6 * 33], s[7 * 33]);
            *(GAS u32x4*)(WT + (size_t)(n0 + n) * K + k0 + 8 * c) = o; } }
    LDS_WAIT(); asm volatile("" ::: "memory");
}

struct Frame {
    LAS unsigned char* lds; volatile LAS unsigned* MISC; unsigned* ctl; unsigned char* ws;
    int tid, lane, wave, vcu, G;
    const float* const* in; float* out;
};
constexpr int IT_WIN = 16 * 216, IT_WQB = 6 * 24, IT_WKVB = 4 * 32, IT_WBR = 8 * 32, IT_WOUT = 16 * 32, IT_WGU = 16 * 64, IT_WDN = 16 * 32;
constexpr int IT_LAYER = IT_WIN + IT_WQB + IT_WKVB + 3 * IT_WBR + IT_WOUT + NEXP * (IT_WGU + IT_WDN);
__device__ __forceinline__ const float* in_l(const Frame& F, int idx, int l, size_t per_layer) { return F.in[idx] + (size_t)l * per_layer; }

constexpr int NE_ITEMS = IT_WIN + IT_WQB + IT_WKVB + 3 * IT_WBR + IT_WOUT, NE_PAIRS = NE_ITEMS / 2, PAIRS_LAYER = IT_LAYER / 2;
__device__ __forceinline__ void convert_item(Frame& F, int it, LAS float* scr) {
    const int l = it / IT_LAYER; int r = it - l * IT_LAYER;
    if (r < IT_WIN) { bf16* wd = (bf16*)(F.ws + WS_WIN + (size_t)l * NINP * DM * 2);
        if (F8_INL(l)) transpose_item<1, true>(in_l(F, I_WIN, l, (size_t)DM * DIN), DM, DIN, wd, nullptr, scr, r, 216, F.lane); else transpose_item<1, false>(in_l(F, I_WIN, l, (size_t)DM * DIN), DM, DIN, wd, nullptr, scr, r, 216, F.lane); return; } r -= IT_WIN;
    if (r < IT_WQB) { transpose_item<2>(in_l(F, I_WQB, l, 384 * 768), 384, 768, (bf16*)(F.ws + WS_WQB) + (size_t)l * 768 * 384, in_l(F, I_GQA, l, 384), scr, r, 24, F.lane); return; } r -= IT_WQB;
    if (r < IT_WKVB) { transpose_item<3>(in_l(F, I_WKVB, l, 256 * 1024), 256, 1024, (bf16*)(F.ws + WS_WKVB) + (size_t)l * 1024 * 256, in_l(F, I_GKVA, l, 256), scr, r, 32, F.lane); return; } r -= IT_WKVB;
    if (r < 3 * IT_WBR) { const int br = r / IT_WBR; const float* src = in_l(F, br == 0 ? I_WBRA : br == 1 ? I_WBRB : I_WBRC, l, 512 * 1024);
        transpose_item<0, true>(src, 512, 1024, (bf16*)(F.ws + WS_WBR + (size_t)(l * 3 + br) * 1024 * 512), nullptr, scr, r - br * IT_WBR, 32, F.lane); return; } r -= 3 * IT_WBR;
    if (r < IT_WOUT) { transpose_item<0, true>(in_l(F, I_WOUT, l, 1024 * 1024), 1024, 1024, (bf16*)(F.ws + WS_WOUT + (size_t)l * 1024 * 1024), nullptr, scr, r, 32, F.lane); return; } r -= IT_WOUT;
    if (r < NEXP * IT_WGU) { const int e = r / IT_WGU; transpose_item<4, F8_MOE != 0>(in_l(F, I_WGU, l * NEXP + e, (size_t)1024 * 2048), 1024, 2048, (bf16*)(F.ws + WS_WGU + (size_t)(l * NEXP + e) * 2048 * 1024 * (F8_MOE ? 1 : 2)), nullptr, scr, r - e * IT_WGU, 64, F.lane); return; }
    r -= NEXP * IT_WGU;
    { const int e = r / IT_WDN; transpose_item<0, F8_MOE != 0>(in_l(F, I_WDN, l * NEXP + e, (size_t)1024 * 1024), 1024, 1024, (bf16*)(F.ws + WS_WDN + (size_t)(l * NEXP + e) * 1024 * 1024 * (F8_MOE ? 1 : 2)), nullptr, scr, r - e * IT_WDN, 32, F.lane); }
}
__device__ __forceinline__ void p_prologue_a(Frame& F) {
    LAS float* scr = (LAS float*)(F.lds + RING_OFF + F.wave * 8704);
    const int gw = F.vcu * NWAVES + F.wave, NGW = F.G * NWAVES;
    for (int pr = gw; pr < NE_PAIRS; pr += NGW) { convert_item(F, 2 * pr, scr); convert_item(F, 2 * pr + 1, scr); }
    __syncthreads();
    if (F.vcu < 2 * 96) {
        LAS float* sc = (LAS float*)(F.lds + RING_OFF + 80 * 1024);
        LAS float* red = sc + 5 * 1024;
        for (int i = F.tid; i < 5 * 1024; i += NTHR) { const float v = i < 4096 ? F.in[I_C][i] : F.in[I_CCTX][i - 4096]; sc[i] = siluf_(v); }
        __syncthreads();
        const int l = F.vcu / 96, n = (F.vcu % 96) * 64 + F.lane; const float* W = in_l(F, I_WMOD, l, (size_t)DM * 6144) + n;
        float a[5] = {0.f, 0.f, 0.f, 0.f, 0.f};
        for (int k0 = F.wave * 128; k0 < F.wave * 128 + 128; k0 += 16) { float w[16];
#pragma unroll
            for (int i = 0; i < 16; ++i) w[i] = W[(size_t)(k0 + i) * 6144];
#pragma unroll
            for (int i = 0; i < 16; ++i) {
#pragma unroll
                for (int v = 0; v < 5; ++v) a[v] += sc[v * 1024 + k0 + i] * w[i]; } }
#pragma unroll
        for (int v = 0; v < 5; ++v) red[(F.wave * 5 + v) * 64 + F.lane] = a[v];
        __syncthreads();
        if (F.tid < 320) { const int v = F.tid >> 6, ln = F.tid & 63; float s = 0.f;
#pragma unroll
            for (int w = 0; w < 8; ++w) s += red[(w * 5 + v) * 64 + ln];
            const int nn = (F.vcu % 96) * 64 + ln; ((float*)(F.ws + WS_MODV))[(size_t)(l * 5 + v) * 6144 + nn] = s + in_l(F, I_BMOD, l, 6144)[nn]; }
        __syncthreads();
    }
    { const int g = F.vcu * NTHR + F.tid; float* tabA = (float*)(F.ws + WS_TAB); float* tabC = tabA + 192 * 16 * 2;
      if (g < 192 * 16) { const int tr = g >> 4, i = g & 15; const float pos = (float)(tr < 128 ? tr : tr - 128); const float inv = powf(10000.0f, -(float)i / 16.0f); const float ang = pos * inv; tabA[2 * g] = cosf(ang); tabA[2 * g + 1] = sinf(ang); }
      else if (g < 192 * 16 + 192 * 8) { const int q = g - 192 * 16, tr = q >> 3, i = q & 7; const float pos = (float)(tr < 128 ? tr : tr - 128); const float inv = powf(10000.0f, -(float)i / 8.0f); const float ang = pos * inv; tabC[2 * q] = cosf(ang); tabC[2 * q + 1] = sinf(ang); }
      if (F.vcu == F.G - 1 && F.wave < 2) { const int l = F.wave; const float a = in_l(F, I_LQ1, l, 64)[F.lane] * in_l(F, I_LK1, l, 64)[F.lane], b = in_l(F, I_LQ2, l, 64)[F.lane] * in_l(F, I_LK2, l, 64)[F.lane];
          const float sa = wave_sum(a), sb = wave_sum(b); const float lam_init = 0.8f - 0.6f * expf(-0.3f * (float)l);
          if (F.lane == 0) { float* lam = tabC + 192 * 8 * 2; lam[2 * l] = expf(sa) - expf(sb) + lam_init; lam[2 * l + 1] = lam_init; } }
    }
}
template <bool F8> __device__ __forceinline__ void put_h4(unsigned char* orow, int lane, int j, const f32x4 y) {
    if constexpr (F8) ((unsigned*)orow)[lane + 64 * j] = pk4_fp8(y.x, y.y, y.z, y.w);
    else ((unsigned long long*)orow)[lane + 64 * j] = (unsigned long long)pk2(y.x, y.y) | ((unsigned long long)pk2(y.z, y.w) << 32);
}
constexpr int HROW_MOE = F8_MOE ? 1024 : 2048;
#define HROW_INL(l) (F8_INL(l) ? 1024 : 2048)
__device__ __forceinline__ void mod_row_f8(const float* xrow, const float* g, const float* sh, const float* scl, unsigned char* orow, int lane) {
    const f32x4* xr = (const f32x4*)xrow + lane; f32x4 v[4]; float s = 0.f;
#pragma unroll
    for (int j = 0; j < 4; ++j) { v[j] = xr[64 * j]; s += (v[j].x * v[j].x + v[j].y * v[j].y) + (v[j].z * v[j].z + v[j].w * v[j].w); }
    const float rstd = 1.0f / sqrtf(wave_sum(s) * (1.0f / DM) + EPS);
#pragma unroll
    for (int j = 0; j < 4; ++j) { const f32x4 gg = ((const f32x4*)g)[lane + 64 * j], ss = ((const f32x4*)sh)[lane + 64 * j], cc = ((const f32x4*)scl)[lane + 64 * j];
        put_h4<F8_IN0 != 0>(orow, lane, j, v[j] * rstd * gg * (cc + 1.0f) + ss); }
}
__device__ __forceinline__ void p_prologue_b(Frame& F) {
    const int gw = F.vcu * NWAVES + F.wave, NGW = F.G * NWAVES; const float* modv = (const float*)(F.ws + WS_MODV); unsigned char* H = F.ws + WS_H;
    f32x4 nx[4];
#define XROW(m) ((m) < NLAT ? F.in[I_X] + (size_t)(m) * DM : F.in[I_CTX] + (size_t)((m) - NLAT) * DM)
    if (gw < MTOT) { const f32x4* xr = (const f32x4*)XROW(gw) + F.lane;
#pragma unroll
        for (int j = 0; j < 4; ++j) nx[j] = xr[64 * j]; }
    f32x4 gg[4];
#pragma unroll
    for (int j = 0; j < 4; ++j) gg[j] = ((const f32x4*)F.in[I_GMIX])[F.lane + 64 * j];
    for (int m = gw; m < MTOT; m += NGW) { const int b = m < NLAT ? m / SEQ : 4; f32x4 v[4]; float s = 0.f;
#pragma unroll
        for (int j = 0; j < 4; ++j) { v[j] = nx[j]; s += (v[j].x * v[j].x + v[j].y * v[j].y) + (v[j].z * v[j].z + v[j].w * v[j].w); }
        { const int mn = min(m + NGW, MTOT - 1); const f32x4* xr = (const f32x4*)XROW(mn) + F.lane;
#pragma unroll
          for (int j = 0; j < 4; ++j) nx[j] = xr[64 * j]; }
        const float* sh = modv + b * 6144; const float* scl = modv + b * 6144 + 1024; f32x4 ss[4], cc[4];
#pragma unroll
        for (int j = 0; j < 4; ++j) { ss[j] = ((const f32x4*)sh)[F.lane + 64 * j]; cc[j] = ((const f32x4*)scl)[F.lane + 64 * j]; }
        const float rstd = 1.0f / sqrtf(wave_sum(s) * (1.0f / DM) + EPS);
#pragma unroll
        for (int j = 0; j < 4; ++j) put_h4<F8_IN0 != 0>(H + (size_t)m * HROW_INL(0), F.lane, j, v[j] * rstd * gg[j] * (cc[j] + 1.0f) + ss[j]);
    }
#undef XROW
}
__device__ __forceinline__ void p_final_norm(Frame& F, const float* X) {
    const int gw = F.vcu * NWAVES + F.wave, NGW = F.G * NWAVES; const f32x4* g = (const f32x4*)F.in[I_GFIN];
    for (int m = gw; m < NLAT; m += NGW) { const f32x4* xr = (const f32x4*)(X + (size_t)m * DM) + F.lane; f32x4 v[4]; float s = 0.f;
#pragma unroll
        for (int j = 0; j < 4; ++j) { v[j] = xr[64 * j]; s += (v[j].x * v[j].x + v[j].y * v[j].y) + (v[j].z * v[j].z + v[j].w * v[j].w); }
        const float rstd = 1.0f / sqrtf(wave_sum(s) * (1.0f / DM) + EPS);
        f32x4* outp = (f32x4*)(F.out + (size_t)m * DM) + F.lane;
#pragma unroll
        for (int j = 0; j < 4; ++j) outp[64 * j] = v[j] * rstd * g[F.lane + 64 * j]; }
}

namespace att {
using f32x16 = __attribute__((ext_vector_type(16))) float;
using s16x4 = __attribute__((ext_vector_type(4))) short;
constexpr float THR = 8.0f;
constexpr float NEGBIG = -3.0e38f, MINIT = -1.0e30f;
__device__ __forceinline__ int crow(int r, int hi) { return (r & 3) + 8 * (r >> 2) + 4 * hi; }
constexpr int L_K1 = 0, L_K2 = 16384, L_V = 32768, L_WS = 65536, L_RPB = 67584, L_END = 70144;
template <int OFF> __device__ __forceinline__ s16x4 tr_read(int vb) { s16x4 r; asm volatile("ds_read_b64_tr_b16 %0, %1 offset:%2" : "=&v"(r) : "v"(vb), "i"(OFF) : "memory"); return r; }
__device__ __forceinline__ int v_rd_base(int lane) { return ((lane & 3) << 3) | (((lane >> 2) & 3) << 6) | (((lane >> 4) & 1) << 5) | (((lane >> 5) & 1) << 8); }
template <int DV> __device__ __forceinline__ int v_st(int k, int c) { return ((k >> 3) * (DV / 32) + (c >> 5)) * 512 + ((k & 7) * 32 + (c & 31)) * 2; }
template <int DV, int D0> __device__ __forceinline__ void pv_one(f32x16& od, int vb, bf16x8 pa0, bf16x8 pa1, bf16x8 pa2, bf16x8 pa3) {
    constexpr int KT = (DV / 32) * 512;
    const s16x4 l0 = tr_read<D0 * 512 + 0 * KT>(vb), h0 = tr_read<D0 * 512 + 1 * KT>(vb), l1 = tr_read<D0 * 512 + 2 * KT>(vb), h1 = tr_read<D0 * 512 + 3 * KT>(vb);
    const s16x4 l2 = tr_read<D0 * 512 + 4 * KT>(vb), h2 = tr_read<D0 * 512 + 5 * KT>(vb), l3 = tr_read<D0 * 512 + 6 * KT>(vb), h3 = tr_read<D0 * 512 + 7 * KT>(vb);
    asm volatile("s_waitcnt lgkmcnt(0)" ::: "memory"); __builtin_amdgcn_sched_barrier(0);
#define PKV(L, H) (bf16x8){L[0], L[1], L[2], L[3], H[0], H[1], H[2], H[3]}
    od = __builtin_amdgcn_mfma_f32_32x32x16_bf16(pa0, PKV(l0, h0), od, 0, 0, 0);
    od = __builtin_amdgcn_mfma_f32_32x32x16_bf16(pa1, PKV(l1, h1), od, 0, 0, 0);
    od = __builtin_amdgcn_mfma_f32_32x32x16_bf16(pa2, PKV(l2, h2), od, 0, 0, 0);
    od = __builtin_amdgcn_mfma_f32_32x32x16_bf16(pa3, PKV(l3, h3), od, 0, 0, 0);
#undef PKV
}
struct NaParams { const float* rpb_h; int r0; };
template <int DK2, int DV, int MODE>
__device__ __forceinline__ void attn_pass(LAS unsigned char* lds, const bf16* Qrow0, int ldq, const bf16* K1, const bf16* K2, const bf16* V, int lat0, int ntl, int ctx0, int ntc, const NaParams na, int kr_lo,
                                          f32x16 (&o)[DV / 32], float& l_out) {
    constexpr int NQ = 4 + DK2 / 16, ND = DV / 32;
    int tid_ = threadIdx.x; asm volatile("" : "+v"(tid_)); const int tid = tid_, lane = tid & 63, r32 = lane & 31, hi = lane >> 5; const int wid = __builtin_amdgcn_readfirstlane(tid >> 6);
    LAS float* wsf = (LAS float*)(lds + L_WS) + wid * 64; LAS float* rpbl = (LAS float*)(lds + L_RPB);
    bf16x8 qr[NQ];
    { const bf16* qp = Qrow0 + (size_t)(wid * 32 + r32) * ldq + hi * 8;
#pragma unroll
      for (int d0 = 0; d0 < NQ; ++d0) qr[d0] = *(const bf16x8*)(qp + d0 * 16); }
    float rpv0 = 0.f, rpv1 = 0.f;
    if (MODE == 1) { const int i0 = tid, i1 = tid + NTHR; if (i0 >= 64 && i0 < 64 + 15 * 31) rpv0 = na.rpb_h[i0 - 64] * LOG2E; if (i1 >= 64 && i1 < 64 + 15 * 31) rpv1 = na.rpb_h[i1 - 64] * LOG2E; }
    const int k1r = tid >> 3, k1c = tid & 7, k1dst = k1r * 128 + ((k1c ^ ((k1r >> 1) & 7)) << 4);
    const int k2r = (tid >> 2) & 63, k2c = tid & 3, k2dst = k2r * 64 + ((k2c ^ ((k2r >> 2) & 3)) << 4);
    const int vr = DV == 128 ? (tid >> 4) : (tid >> 3), vc = DV == 128 ? (tid & 15) * 8 : (tid & 7) * 8; const int vdst0 = v_st<DV>(vr, vc), vdst1 = v_st<DV>(vr + 32, vc);
    struct Stg1 { bf16x8 k1, k2, v0, v1; } sgA, sgB;
    const int NT = ntl + ntc;
#define TROW(t) ((t) < ntl ? lat0 + (t) * 64 : ctx0 + ((t) - ntl) * 64)
#define SLOAD(t, S) do { const size_t kr_ = (size_t)TROW(t); S.k1 = *(const bf16x8*)(K1 + (kr_ + k1r) * 512 + k1c * 8); if (DK2 && tid < 256) S.k2 = *(const bf16x8*)(K2 + (kr_ + k2r) * 32 + k2c * 8); \
        S.v0 = *(const bf16x8*)(V + (kr_ + vr) * 512 + vc); if (DV == 128) S.v1 = *(const bf16x8*)(V + (kr_ + vr + 32) * 512 + vc); } while (0)
#define SWRITE(b, S) do { *(LAS bf16x8*)(lds + L_K1 + (b) * 8192 + k1dst) = S.k1; if (DK2 && tid < 256) *(LAS bf16x8*)(lds + L_K2 + (b) * 4096 + k2dst) = S.k2; \
        *(LAS bf16x8*)(lds + L_V + (b) * (DV * 128) + vdst0) = S.v0; if (DV == 128) *(LAS bf16x8*)(lds + L_V + (b) * (DV * 128) + vdst1) = S.v1; } while (0)
    float m_reg = 0.f, l_reg = 0.f; bool first = true; f32x16 negv = f32x16{};
#pragma unroll
    for (int d = 0; d < ND; ++d) o[d] = f32x16{};
    const int rq = na.r0 + (wid >> 1), cq = 32 * (wid & 1) + r32; const int rs_w = min(max(rq - 4, 0), 120), cs = min(max(cq - 8, 0), 48);
    f32x16 pen0 = f32x16{}, pen1 = f32x16{};
    if (MODE == 1) {
#pragma unroll
        for (int r = 0; r < 16; ++r) { const int c0 = crow(r, hi), c1 = 32 + c0; pen0[r] = ((unsigned)(c0 - cs) < 16u) ? 0.f : MINIT; pen1[r] = ((unsigned)(c1 - cs) < 16u) ? 0.f : MINIT; } }
    const int vb0 = (int)(uintptr_t)(lds + L_V) + v_rd_base(lane);
    SLOAD(0, sgA);
    if (MODE == 1) { rpbl[tid] = rpv0; if (tid + NTHR < 15 * 31 + 128) rpbl[tid + NTHR] = rpv1; }
    SWRITE(0, sgA); if (1 < NT) SLOAD(1, sgA); __syncthreads();
    auto tile = [&](const int t, const int cur) __attribute__((always_inline)) {
        bool active = true; int kr = 0;
        if (MODE == 1 && t < ntl) { kr = kr_lo + t; active = (kr >= rs_w) && (kr < rs_w + 8); }
        if (active) {
            f32x16 p0, p1;
            { const LAS unsigned char* kb = lds + L_K1 + cur * 8192;
#pragma unroll
              for (int d0 = 0; d0 < 4; ++d0) { const int ch = 2 * d0 + hi;
                  const bf16x8 b0 = *(const LAS bf16x8*)(kb + r32 * 128 + ((ch ^ ((r32 >> 1) & 7)) << 4));
                  const bf16x8 b1 = *(const LAS bf16x8*)(kb + (32 + r32) * 128 + ((ch ^ (((32 + r32) >> 1) & 7)) << 4));
                  if (d0 == 0) { p0 = __builtin_amdgcn_mfma_f32_32x32x16_bf16(b0, qr[d0], negv, 0, 0, 0); p1 = __builtin_amdgcn_mfma_f32_32x32x16_bf16(b1, qr[d0], negv, 0, 0, 0); }
                  else { p0 = __builtin_amdgcn_mfma_f32_32x32x16_bf16(b0, qr[d0], p0, 0, 0, 0); p1 = __builtin_amdgcn_mfma_f32_32x32x16_bf16(b1, qr[d0], p1, 0, 0, 0); } }
              if (DK2) { const LAS unsigned char* k2b = lds + L_K2 + cur * 4096;
#pragma unroll
                  for (int d0 = 0; d0 < DK2 / 16; ++d0) { const int ch = 2 * d0 + hi;
                      const bf16x8 b0 = *(const LAS bf16x8*)(k2b + r32 * 64 + ((ch ^ ((r32 >> 2) & 3)) << 4));
                      const bf16x8 b1 = *(const LAS bf16x8*)(k2b + (32 + r32) * 64 + ((ch ^ (((32 + r32) >> 2) & 3)) << 4));
                      p0 = __builtin_amdgcn_mfma_f32_32x32x16_bf16(b0, qr[4 + d0], p0, 0, 0, 0); p1 = __builtin_amdgcn_mfma_f32_32x32x16_bf16(b1, qr[4 + d0], p1, 0, 0, 0); } }
            }
            if (MODE == 1 && t < ntl) {
                const LAS float* bl = rpbl + 64 + (kr - rq + 7) * 31 + 15 - cq;
#pragma unroll
                for (int r = 0; r < 16; ++r) { const int c0 = crow(r, hi), c1 = 32 + c0; p0[r] = (p0[r] + bl[c0]) + pen0[r]; p1[r] = (p1[r] + bl[c1]) + pen1[r]; }
            }
#define MX3B(a, b, c) __builtin_fmaxf(__builtin_fmaxf((a), (b)), (c))
            float pa_ = MX3B(p0[0], p0[1], p0[2]), pb_ = MX3B(p1[0], p1[1], p1[2]);
#pragma unroll
            for (int r = 3; r < 15; r += 2) { pa_ = MX3B(pa_, p0[r], p0[r + 1]); pb_ = MX3B(pb_, p1[r], p1[r + 1]); }
            float pmax = MX3B(pa_, pb_, p0[15]); pmax = fmaxf(pmax, p1[15]);
#undef MX3B
            { auto rr = __builtin_amdgcn_permlane32_swap(__float_as_uint(pmax), __float_as_uint(pmax), false, false); pmax = fmaxf(__uint_as_float(rr[0]), __uint_as_float(rr[1])); }
            float alpha = 1.f;
            if (first || !__all(pmax <= THR)) {
                const float dl = first ? pmax : fmaxf(pmax, 0.f); alpha = first ? 1.f : __builtin_amdgcn_exp2f(-dl); m_reg += dl;
#pragma unroll
                for (int r = 0; r < 16; ++r) { p0[r] -= dl; p1[r] -= dl; }
#pragma unroll
                for (int r = 0; r < 16; ++r) negv[r] = -m_reg;
                if (!first) { if (hi == 0) wsf[r32] = alpha;
#pragma unroll
                    for (int d = 0; d < ND; ++d)
#pragma unroll
                        for (int r = 0; r < 16; ++r) o[d][r] *= wsf[crow(r, hi)]; }
                first = false;
            }
            float ps = 0.f;
#pragma unroll
            for (int r = 0; r < 16; ++r) { p0[r] = __builtin_amdgcn_exp2f(p0[r]); p1[r] = __builtin_amdgcn_exp2f(p1[r]); ps += p0[r] + p1[r]; }
            { auto rr = __builtin_amdgcn_permlane32_swap(__float_as_uint(ps), __float_as_uint(ps), false, false); ps = __uint_as_float(rr[0]) + __uint_as_float(rr[1]); }
            l_reg = l_reg * alpha + ps;
            u32x4 w0, w1, w2, w3;
            w0 = (u32x4){cvt_pk_bf16(p0[0], p0[1]), cvt_pk_bf16(p0[2], p0[3]), cvt_pk_bf16(p0[4], p0[5]), cvt_pk_bf16(p0[6], p0[7])};
            w1 = (u32x4){cvt_pk_bf16(p0[8], p0[9]), cvt_pk_bf16(p0[10], p0[11]), cvt_pk_bf16(p0[12], p0[13]), cvt_pk_bf16(p0[14], p0[15])};
            w2 = (u32x4){cvt_pk_bf16(p1[0], p1[1]), cvt_pk_bf16(p1[2], p1[3]), cvt_pk_bf16(p1[4], p1[5]), cvt_pk_bf16(p1[6], p1[7])};
            w3 = (u32x4){cvt_pk_bf16(p1[8], p1[9]), cvt_pk_bf16(p1[10], p1[11]), cvt_pk_bf16(p1[12], p1[13]), cvt_pk_bf16(p1[14], p1[15])};
            const bf16x8 pa0 = __builtin_bit_cast(bf16x8, w0), pa1 = __builtin_bit_cast(bf16x8, w1), pa2 = __builtin_bit_cast(bf16x8, w2), pa3 = __builtin_bit_cast(bf16x8, w3);
            const int vb = vb0 + cur * (DV * 128);
            pv_one<DV, 0>(o[0], vb, pa0, pa1, pa2, pa3); pv_one<DV, 1>(o[1], vb, pa0, pa1, pa2, pa3);
            if constexpr (DV == 128) { pv_one<DV, 2>(o[2], vb, pa0, pa1, pa2, pa3); pv_one<DV, 3>(o[3], vb, pa0, pa1, pa2, pa3); }
        }
    };
    for (int t = 0; t < NT; t += 2) {
        if (t + 2 < NT) SLOAD(t + 2, sgB);
        tile(t, 0);
        if (t + 1 < NT) SWRITE(1, sgA);
        __syncthreads();
        if (t + 1 >= NT) break;
        if (t + 3 < NT) SLOAD(t + 3, sgA);
        tile(t + 1, 1);
        if (t + 2 < NT) SWRITE(0, sgB);
        __syncthreads();
    }
    l_out = l_reg;
#undef TROW
#undef SLOAD
#undef SWRITE
}
__device__ __forceinline__ void row_recip(LAS unsigned char* lds, float l_reg, float (&rli)[16]) {
    const int tid = threadIdx.x; int lane = tid & 63; asm volatile("" : "+v"(lane)); const int r32 = lane & 31, hi = lane >> 5; const int wid = __builtin_amdgcn_readfirstlane(tid >> 6);
    LAS float* wsf = (LAS float*)(lds + L_WS) + wid * 64;
    if (hi == 0) wsf[32 + r32] = l_reg;
#pragma unroll
    for (int r = 0; r < 16; ++r) rli[r] = 1.0f / wsf[32 + crow(r, hi)];
}
template <int DV> __device__ __forceinline__ void store_bf16(LAS unsigned char* lds, const f32x16 (&o)[DV / 32], float l_reg, unsigned char* Y, int ld) {
    const int tid = threadIdx.x; int lane = tid & 63; asm volatile("" : "+v"(lane)); const int r32 = lane & 31, hi = lane >> 5; const int wid = __builtin_amdgcn_readfirstlane(tid >> 6);
    float rli[16]; row_recip(lds, l_reg, rli);
    unsigned char* yw = Y + (size_t)(wid * 32) * ld + r32;
#pragma unroll
    for (int r = 0; r < 16; ++r)
#pragma unroll
        for (int d = 0; d < DV / 32; ++d) yw[(size_t)crow(r, hi) * ld + d * 32] = f8_one(o[d][r] * rli[r] * YS_BC);
}
template <int DV> __device__ __forceinline__ void store_bf16v(const f32x16 (&o)[DV / 32], const f32x16& lv, unsigned char* Y, int ld) {
    const int tid = threadIdx.x; int lane = tid & 63; asm volatile("" : "+v"(lane)); const int r32 = lane & 31, hi = lane >> 5; const int wid = __builtin_amdgcn_readfirstlane(tid >> 6);
    unsigned char* yw = Y + (size_t)(wid * 32) * ld + r32;
#pragma unroll
    for (int r = 0; r < 16; ++r) { const float rl = YS_BC / lv[r];
#pragma unroll
        for (int d = 0; d < DV / 32; ++d) yw[(size_t)crow(r, hi) * ld + d * 32] = f8_one(o[d][r] * rl); }
}
}

namespace att {
template <int DK2, int DV>
__device__ __forceinline__ void attn_pass2(LAS unsigned char* lds, const bf16* Qrow0, int ldq, const bf16* K1, const bf16* K2, const bf16* V, int lat0, int ntl, int ctx0, int ntc, f32x16 (&o)[DV / 32], float& l_out) {
    constexpr int NQ = 4 + DK2 / 16, ND = DV / 32;
    int tid_ = threadIdx.x; asm volatile("" : "+v"(tid_)); const int tid = tid_, lane = tid & 63, r32 = lane & 31, hi = lane >> 5; const int wid = __builtin_amdgcn_readfirstlane(tid >> 6);
    LAS float* wsf = (LAS float*)(lds + L_WS) + wid * 64;
    bf16x8 qr[NQ];
    { const bf16* qp = Qrow0 + (size_t)(wid * 32 + r32) * ldq + hi * 8;
#pragma unroll
      for (int d0 = 0; d0 < NQ; ++d0) qr[d0] = *(const bf16x8*)(qp + d0 * 16); }
    const int k1r = tid >> 3, k1c = tid & 7, k1dst = k1r * 128 + ((k1c ^ ((k1r >> 1) & 7)) << 4);
    const int k2r = (tid >> 2) & 63, k2c = tid & 3, k2dst = k2r * 64 + ((k2c ^ ((k2r >> 2) & 3)) << 4);
    const int vr = DV == 128 ? (tid >> 4) : (tid >> 3), vc = DV == 128 ? (tid & 15) * 8 : (tid & 7) * 8; const int vdst0 = v_st<DV>(vr, vc), vdst1 = v_st<DV>(vr + 32, vc);
    struct Stg { bf16x8 k1, x, v0; } sg[2];
    const int NT = ntl + ntc;
#define TROW(t) ((t) < ntl ? lat0 + (t) * 64 : ctx0 + ((t) - ntl) * 64)
#define SLOAD(i, t) do { const size_t kr_ = (size_t)TROW(t); sg[i].k1 = *(const bf16x8*)(K1 + (kr_ + k1r) * 512 + k1c * 8); sg[i].v0 = *(const bf16x8*)(V + (kr_ + vr) * 512 + vc); \
        if (DV == 128) sg[i].x = *(const bf16x8*)(V + (kr_ + vr + 32) * 512 + vc); else if (DK2) sg[i].x = *(const bf16x8*)(K2 + (kr_ + k2r) * 32 + k2c * 8); } while (0)
#define SWRITE(b, i) do { *(LAS bf16x8*)(lds + L_K1 + (b) * 8192 + k1dst) = sg[i].k1; *(LAS bf16x8*)(lds + L_V + (b) * (DV * 128) + vdst0) = sg[i].v0; \
        if (DV == 128) *(LAS bf16x8*)(lds + L_V + (b) * (DV * 128) + vdst1) = sg[i].x; else if (DK2) *(LAS bf16x8*)(lds + L_K2 + (b) * 4096 + k2dst) = sg[i].x; } while (0)
    float m_reg = MINIT, l_reg = 0.f;
#pragma unroll
    for (int d = 0; d < ND; ++d) o[d] = f32x16{};
    const int vb0 = (int)(uintptr_t)(lds + L_V) + v_rd_base(lane);
    const int ka0 = r32 * 128, ka1 = (32 + r32) * 128, ks0 = (r32 >> 1) & 7, ks1 = ((32 + r32) >> 1) & 7;
    const int k2a0 = r32 * 64, k2a1 = (32 + r32) * 64, k2s0 = (r32 >> 2) & 3, k2s1 = ((32 + r32) >> 2) & 3;
#define QKT(P0, P1, b) do { P0 = f32x16{}; P1 = f32x16{}; const LAS unsigned char* kb_ = lds + L_K1 + (b) * 8192; \
        _Pragma("unroll") for (int d0 = 0; d0 < 4; ++d0) { const int ch = 2 * d0 + hi; \
            const bf16x8 b0 = *(const LAS bf16x8*)(kb_ + ka0 + ((ch ^ ks0) << 4)); const bf16x8 b1 = *(const LAS bf16x8*)(kb_ + ka1 + ((ch ^ ks1) << 4)); \
            P0 = __builtin_amdgcn_mfma_f32_32x32x16_bf16(b0, qr[d0], P0, 0, 0, 0); P1 = __builtin_amdgcn_mfma_f32_32x32x16_bf16(b1, qr[d0], P1, 0, 0, 0); } \
        if (DK2) { const LAS unsigned char* k2b_ = lds + L_K2 + (b) * 4096; \
            _Pragma("unroll") for (int d0 = 0; d0 < DK2 / 16; ++d0) { const int ch = 2 * d0 + hi; \
                const bf16x8 b0 = *(const LAS bf16x8*)(k2b_ + k2a0 + ((ch ^ k2s0) << 4)); const bf16x8 b1 = *(const LAS bf16x8*)(k2b_ + k2a1 + ((ch ^ k2s1) << 4)); \
                P0 = __builtin_amdgcn_mfma_f32_32x32x16_bf16(b0, qr[4 + d0], P0, 0, 0, 0); P1 = __builtin_amdgcn_mfma_f32_32x32x16_bf16(b1, qr[4 + d0], P1, 0, 0, 0); } } } while (0)
#define PARTSM(P0, P1, AL) do { float pmax = P0[0]; \
        _Pragma("unroll") for (int r = 1; r < 16; ++r) pmax = fmaxf(pmax, P0[r]); _Pragma("unroll") for (int r = 0; r < 16; ++r) pmax = fmaxf(pmax, P1[r]); \
        { auto rr = __builtin_amdgcn_permlane32_swap(__float_as_uint(pmax), __float_as_uint(pmax), false, false); pmax = fmaxf(__uint_as_float(rr[0]), __uint_as_float(rr[1])); } \
        if (__builtin_expect(__all(pmax - m_reg <= THR), 1)) { AL = 1.f; } else { const float mn = fmaxf(m_reg, pmax); AL = __builtin_amdgcn_exp2f(m_reg - mn); m_reg = mn; } \
        _Pragma("unroll") for (int r = 0; r < 16; ++r) { P0[r] -= m_reg; P1[r] -= m_reg; } \
        _Pragma("unroll") for (int r = 0; r < 16; ++r) P0[r] = __builtin_amdgcn_exp2f(P0[r]); } while (0)
#define FINSM(P0, P1, AL) do { _Pragma("unroll") for (int r = 0; r < 16; ++r) P1[r] = __builtin_amdgcn_exp2f(P1[r]); float ps = 0.f; \
        _Pragma("unroll") for (int r = 0; r < 16; ++r) ps += P0[r]; _Pragma("unroll") for (int r = 0; r < 16; ++r) ps += P1[r]; \
        { auto rr = __builtin_amdgcn_permlane32_swap(__float_as_uint(ps), __float_as_uint(ps), false, false); ps = __uint_as_float(rr[0]) + __uint_as_float(rr[1]); } \
        l_reg = l_reg * AL + ps; \
        const u32x4 w0 = (u32x4){cvt_pk_bf16(P0[0], P0[1]), cvt_pk_bf16(P0[2], P0[3]), cvt_pk_bf16(P0[4], P0[5]), cvt_pk_bf16(P0[6], P0[7])}; \
        const u32x4 w1 = (u32x4){cvt_pk_bf16(P0[8], P0[9]), cvt_pk_bf16(P0[10], P0[11]), cvt_pk_bf16(P0[12], P0[13]), cvt_pk_bf16(P0[14], P0[15])}; \
        const u32x4 w2 = (u32x4){cvt_pk_bf16(P1[0], P1[1]), cvt_pk_bf16(P1[2], P1[3]), cvt_pk_bf16(P1[4], P1[5]), cvt_pk_bf16(P1[6], P1[7])}; \
        const u32x4 w3 = (u32x4){cvt_pk_bf16(P1[8], P1[9]), cvt_pk_bf16(P1[10], P1[11]), cvt_pk_bf16(P1[12], P1[13]), cvt_pk_bf16(P1[14], P1[15])}; \
        pa0 = __builtin_bit_cast(bf16x8, w0); pa1 = __builtin_bit_cast(bf16x8, w1); pa2 = __builtin_bit_cast(bf16x8, w2); pa3 = __builtin_bit_cast(bf16x8, w3); } while (0)
#define PV(b) do { const int vb_ = vb0 + (b) * (DV * 128); pv_one<DV, 0>(o[0], vb_, pa0, pa1, pa2, pa3); pv_one<DV, 1>(o[1], vb_, pa0, pa1, pa2, pa3); \
        if constexpr (DV == 128) { pv_one<DV, 2>(o[2], vb_, pa0, pa1, pa2, pa3); pv_one<DV, 3>(o[3], vb_, pa0, pa1, pa2, pa3); } } while (0)
#define RESC(AL) do { if (__any((AL) < 1.f)) { if (hi == 0) wsf[r32] = (AL); \
        _Pragma("unroll") for (int d = 0; d < ND; ++d) _Pragma("unroll") for (int r = 0; r < 16; ++r) o[d][r] *= wsf[crow(r, hi)]; } } while (0)
#define SB() __builtin_amdgcn_sched_barrier(0)
    f32x16 pA0, pA1, pB0, pB1; float alA, alB; bf16x8 pa0, pa1, pa2, pa3;
    SLOAD(0, 0); SWRITE(0, 0); __syncthreads();
    QKT(pA0, pA1, 0); PARTSM(pA0, pA1, alA);
    SLOAD(1, 1); if (2 < NT) SLOAD(0, 2);
    SWRITE(1, 1); __syncthreads();
    RESC(alA);
    for (int j = 1; j + 1 < NT; j += 2) {
        SB(); QKT(pB0, pB1, 1);
        FINSM(pA0, pA1, alA); SB();
        SLOAD(1, j + 2); SB();
        PV(0); PARTSM(pB0, pB1, alB);
        __syncthreads(); SWRITE(0, 0);
        RESC(alB); __syncthreads();
        SB(); QKT(pA0, pA1, 0);
        FINSM(pB0, pB1, alB); SB();
        if (j + 3 < NT) SLOAD(0, j + 3); SB();
        PV(1); PARTSM(pA0, pA1, alA);
        __syncthreads(); SWRITE(1, 1);
        RESC(alA); __syncthreads();
    }
    SB(); QKT(pB0, pB1, 1);
    FINSM(pA0, pA1, alA); SB();
    PV(0); PARTSM(pB0, pB1, alB);
    RESC(alB);
    FINSM(pB0, pB1, alB); SB();
    PV(1);
    __syncthreads();
    l_out = l_reg;
#undef TROW
#undef SLOAD
#undef SWRITE
#undef QKT
#undef PARTSM
#undef FINSM
#undef PV
#undef RESC
#undef SB
}
}
namespace att {
__device__ __forceinline__ unsigned pk4_fp8_nc(float a, float b, float c, float d) { int w = 0; w = __builtin_amdgcn_cvt_pk_fp8_f32(a, b, w, false); w = __builtin_amdgcn_cvt_pk_fp8_f32(c, d, w, true); return (unsigned)w; }
}
namespace att {
template <int DK2, int DV>
__device__ __forceinline__ void attn_pass_f8(LAS unsigned char* lds, const bf16* Qrow0, int ldq, const unsigned char* K1, const bf16* K2, const unsigned char* VT, int vt_stride, int lat0, int ntl, int ctx0, int ntc, f32x16 (&o)[DV / 32], f32x16& l_out) {
    constexpr int NQ2 = DK2 / 16, ND = DV / 32;
    typedef int i32x4_ __attribute__((ext_vector_type(4))); typedef int i32x8_ __attribute__((ext_vector_type(8)));
    int tid_ = threadIdx.x; asm volatile("" : "+v"(tid_)); const int tid = tid_, lane = tid & 63, r32 = lane & 31, hi = lane >> 5; const int wid = __builtin_amdgcn_readfirstlane(tid >> 6);
    LAS float* wsf = (LAS float*)(lds + L_WS) + wid * 64;
    bf16x8 qr2[NQ2 ? NQ2 : 1]; i32x8_ q8;
    const int wq = wid & 3, drow = 16 * wq + (lane >> 2), vrow = (DV == 128 ? 16 * wid : 16 * wq) + (lane >> 2);
    const unsigned char* k1src = K1 + (size_t)drow * 512 + (((lane & 3) ^ ((drow >> 1) & 3)) << 4);
    const unsigned char* vsrc = VT + vrow * 64 + (((lane & 3) ^ ((vrow >> 2) & 3)) << 4);
    const bf16* k2src = K2 + (size_t)drow * 32 + (((lane & 3) ^ ((drow >> 2) & 3)) << 3);
    const bool k1on = (DV == 128) ? (wid < 4) : (wid >= 4), von = (DV == 128) || (wid < 4), k2on = (DK2 != 0) && (wid < 4);
    const int NT = ntl + ntc;
#define TROW(t) ((t) < ntl ? lat0 + (t) * 64 : ctx0 + ((t) - ntl) * 64)
#define GLDS(src, dstoff) __builtin_amdgcn_global_load_lds((const unsigned*)(src), (LAS unsigned*)(lds + (dstoff)), 16, 0, 0)
#define DMA(t) do { const size_t kr_ = (size_t)TROW(t); const int b_ = (t) & 3; \
        if (von) GLDS(vsrc + (size_t)(kr_ >> 6) * vt_stride, L_V + b_ * (DV * 64) + (DV == 128 ? wid : wq) * 1024); \
        if (k1on) GLDS(k1src + kr_ * 512, L_K1 + b_ * 4096 + wq * 1024); \
        if (k2on) GLDS(k2src + kr_ * 32, L_K2 + b_ * 4096 + wq * 1024); } while (0)
#define WAITDMA(k) do { if (wid < 4) { if ((k) >= 2) asm volatile("s_waitcnt vmcnt(4)" ::: "memory"); else if ((k) == 1) asm volatile("s_waitcnt vmcnt(2)" ::: "memory"); else asm volatile("s_waitcnt vmcnt(0)" ::: "memory"); } \
        else { if ((k) >= 2) asm volatile("s_waitcnt vmcnt(2)" ::: "memory"); else if ((k) == 1) asm volatile("s_waitcnt vmcnt(1)" ::: "memory"); else asm volatile("s_waitcnt vmcnt(0)" ::: "memory"); } } while (0)
#define BAR() do { asm volatile("s_waitcnt lgkmcnt(0)" ::: "memory"); __builtin_amdgcn_s_barrier(); asm volatile("" ::: "memory"); } while (0)
    float m_reg = 0.f, nm = 0.f; f32x16 ol = f32x16{}; f32x16 negv = f32x16{};
#define negm ((f32x16){nm, nm, nm, nm, nm, nm, nm, nm, nm, nm, nm, nm, nm, nm, nm, nm})
    i32x8_ ones8 = (i32x8_){0x38383838, 0x38383838, 0x38383838, 0x38383838, 0x38383838, 0x38383838, 0x38383838, 0x38383838}; asm volatile("" : "+v"(ones8));
#pragma unroll
    for (int d = 0; d < ND; ++d) o[d] = f32x16{};
    const int va0 = r32 * 64 + (((2 * hi) ^ ((r32 >> 2) & 3)) << 4), va1 = r32 * 64 + (((2 * hi + 1) ^ ((r32 >> 2) & 3)) << 4);
    int f8scale = 0x7f7f7f7f; asm volatile("" : "+v"(f8scale));
    int sclK = 0x7c7c7c7c, sclQ = 0x7b7b7b7b; asm volatile("" : "+v"(sclK), "+v"(sclQ));
    const int ka0 = r32 * 64, ka1 = (32 + r32) * 64, ks0 = (r32 >> 1) & 3;
    const int k2a0 = r32 * 64, k2a1 = (32 + r32) * 64, k2s0 = (r32 >> 2) & 3, k2s1 = ((32 + r32) >> 2) & 3;
#define QKT(P0, P1, b) do { const LAS unsigned char* kb_ = lds + L_K1 + (b) * 4096; \
        const i32x4_ a00_ = *(const LAS i32x4_*)(kb_ + ka0 + (((2 * hi) ^ ks0) << 4)), a01_ = *(const LAS i32x4_*)(kb_ + ka0 + (((2 * hi + 1) ^ ks0) << 4)); \
        const i32x4_ a10_ = *(const LAS i32x4_*)(kb_ + ka1 + (((2 * hi) ^ ks0) << 4)), a11_ = *(const LAS i32x4_*)(kb_ + ka1 + (((2 * hi + 1) ^ ks0) << 4)); \
        if (DK2) { const LAS unsigned char* k2b_ = lds + L_K2 + (b) * 4096; \
            _Pragma("unroll") for (int d0 = 0; d0 < DK2 / 16; ++d0) { const int ch = 2 * d0 + hi; \
                const bf16x8 b0 = *(const LAS bf16x8*)(k2b_ + k2a0 + ((ch ^ k2s0) << 4)); const bf16x8 b1 = *(const LAS bf16x8*)(k2b_ + k2a1 + ((ch ^ k2s1) << 4)); \
                if (d0 == 0) { P0 = __builtin_amdgcn_mfma_f32_32x32x16_bf16(b0, qr2[d0], negv, 0, 0, 0); P1 = __builtin_amdgcn_mfma_f32_32x32x16_bf16(b1, qr2[d0], negv, 0, 0, 0); } \
                else { P0 = __builtin_amdgcn_mfma_f32_32x32x16_bf16(b0, qr2[d0], P0, 0, 0, 0); P1 = __builtin_amdgcn_mfma_f32_32x32x16_bf16(b1, qr2[d0], P1, 0, 0, 0); } } } \
        { const i32x8_ kf0_ = __builtin_shufflevector(a00_, a01_, 0, 1, 2, 3, 4, 5, 6, 7), kf1_ = __builtin_shufflevector(a10_, a11_, 0, 1, 2, 3, 4, 5, 6, 7); \
          if (DK2) { \
            asm volatile("s_nop 1\n\tv_mfma_scale_f32_32x32x64_f8f6f4 %0, %1, %2, %0, %3, %4 op_sel_hi:[0,0,0]" : "+v"(P0) : "v"(kf0_), "v"(q8), "v"(sclK), "v"(sclQ)); \
            asm volatile("s_nop 1\n\tv_mfma_scale_f32_32x32x64_f8f6f4 %0, %1, %2, %0, %3, %4 op_sel_hi:[0,0,0]" : "+v"(P1) : "v"(kf1_), "v"(q8), "v"(sclK), "v"(sclQ)); \
          } else {     \
            asm volatile("s_nop 1\n\tv_mfma_scale_f32_32x32x64_f8f6f4 %0, %1, %2, %3, %4, %5 op_sel_hi:[0,0,0]" : "=&v"(P0) : "v"(kf0_), "v"(q8), "v"(negv), "v"(sclK), "v"(sclQ)); \
            asm volatile("s_nop 1\n\tv_mfma_scale_f32_32x32x64_f8f6f4 %0, %1, %2, %3, %4, %5 op_sel_hi:[0,0,0]" : "=&v"(P1) : "v"(kf1_), "v"(q8), "v"(negv), "v"(sclK), "v"(sclQ)); } } } while (0)
#define STIE_LONG(P0, P1) asm volatile("s_nop 15\n\ts_nop 7" : "+v"(P0), "+v"(P1))
#define STIE_SHORT(P0, P1) asm volatile("s_nop 7" : "+v"(P0), "+v"(P1))
#define MX3(a, b, c) __builtin_fmaxf(__builtin_fmaxf((a), (b)), (c))
#define PARTSM(P0, P1, AL, FIRST) do { float pa_ = MX3(P0[0], P0[1], P0[2]), pb_ = MX3(P1[0], P1[1], P1[2]); \
        _Pragma("unroll") for (int r = 3; r < 15; r += 2) { pa_ = MX3(pa_, P0[r], P0[r + 1]); pb_ = MX3(pb_, P1[r], P1[r + 1]); } \
        float pmax = MX3(pa_, pb_, P0[15]); pmax = fmaxf(pmax, P1[15]); \
        { auto rr = __builtin_amdgcn_permlane32_swap(__float_as_uint(pmax), __float_as_uint(pmax), false, false); pmax = fmaxf(__uint_as_float(rr[0]), __uint_as_float(rr[1])); } \
        if (!(FIRST) && __builtin_expect(__all(pmax <= THR), 1)) { AL = 1.f; } else { const float dl = (FIRST) ? pmax : fmaxf(pmax, 0.f); AL = (FIRST) ? 1.f : __builtin_amdgcn_exp2f(-dl); m_reg += dl; \
            _Pragma("unroll") for (int r = 0; r < 16; ++r) { P0[r] -= dl; P1[r] -= dl; } nm = -m_reg; _Pragma("unroll") for (int r = 0; r < 16; ++r) negv[r] = nm; } \
        _Pragma("unroll") for (int r = 0; r < 16; ++r) P0[r] = __builtin_amdgcn_exp2f(P0[r]); } while (0)
#define FINSM(P0, P1, AL) do { _Pragma("unroll") for (int r = 0; r < 16; ++r) P1[r] = __builtin_amdgcn_exp2f(P1[r]); \
        p8 = (i32x8_){(int)pk4_fp8_nc(P0[0], P0[1], P0[2], P0[3]), (int)pk4_fp8_nc(P0[4], P0[5], P0[6], P0[7]), (int)pk4_fp8_nc(P0[8], P0[9], P0[10], P0[11]), (int)pk4_fp8_nc(P0[12], P0[13], P0[14], P0[15]), \
                       (int)pk4_fp8_nc(P1[0], P1[1], P1[2], P1[3]), (int)pk4_fp8_nc(P1[4], P1[5], P1[6], P1[7]), (int)pk4_fp8_nc(P1[8], P1[9], P1[10], P1[11]), (int)pk4_fp8_nc(P1[12], P1[13], P1[14], P1[15])}; } while (0)
#define PV1(d, vb_) do { const i32x4_ x0_ = *(const LAS i32x4_*)(vb_ + (d) * 2048 + va0), x1_ = *(const LAS i32x4_*)(vb_ + (d) * 2048 + va1); \
        const i32x8_ bf_ = __builtin_shufflevector(x0_, x1_, 0, 1, 2, 3, 4, 5, 6, 7); \
        asm volatile("v_mfma_scale_f32_32x32x64_f8f6f4 %0, %1, %2, %0, %3, %3 op_sel_hi:[0,0,0]" : "+v"(o[d]) : "v"(p8), "v"(bf_), "v"(f8scale)); } while (0)
#define PV(b) do { const LAS unsigned char* vb_ = lds + L_V + (b) * (DV * 64); asm volatile("s_nop 4" : "+v"(p8)); PV1(0, vb_); PV1(1, vb_); if constexpr (DV == 128) { PV1(2, vb_); PV1(3, vb_); } PVL(); } while (0)
#define PVL() asm volatile("v_mfma_scale_f32_32x32x64_f8f6f4 %0, %1, %2, %0, %3, %3 op_sel_hi:[0,0,0]" : "+v"(ol) : "v"(p8), "v"(ones8), "v"(f8scale))
#define PVT(b, T0, T1) do { const LAS unsigned char* vb_ = lds + L_V + (b) * (DV * 64); asm volatile("s_nop 4" : "+v"(p8)); PV1(0, vb_); STIE_SHORT(T0, T1); PV1(1, vb_); if constexpr (DV == 128) { PV1(2, vb_); PV1(3, vb_); } PVL(); } while (0)
#define OTIE() do { if constexpr (DV == 128) asm volatile("s_nop 15\n\ts_nop 15\n\ts_nop 15\n\ts_nop 15\n\ts_nop 15" : "+v"(o[0]), "+v"(o[1]), "+v"(o[2]), "+v"(o[3]), "+v"(ol)); else asm volatile("s_nop 15\n\ts_nop 15\n\ts_nop 15\n\ts_nop 15\n\ts_nop 15" : "+v"(o[0]), "+v"(o[1]), "+v"(ol)); } while (0)
#define RESC(AL) do { if (__any((AL) < 1.f)) { OTIE(); if (hi == 0) wsf[r32] = (AL); \
        _Pragma("unroll") for (int r = 0; r < 16; ++r) { const float a_ = wsf[crow(r, hi)]; ol[r] *= a_; _Pragma("unroll") for (int d = 0; d < ND; ++d) o[d][r] *= a_; } } } while (0)
#define SB() __builtin_amdgcn_sched_barrier(0)
    f32x16 pA0, pA1, pB0, pB1; float alA, alB; i32x8_ p8;
    __syncthreads();
    DMA(0); DMA(1); DMA(2); if (3 < NT) DMA(3);
    { const bf16* qp = Qrow0 + (size_t)(wid * 32 + r32) * ldq; unsigned w_[8];
#pragma unroll
      for (int i = 0; i < 4; ++i) { const u32x4 x = *(const u32x4*)(qp + hi * 32 + i * 8);
          w_[2 * i] = pk4_fp8_nc(bf_lo(x.x) * 16.0f, bf_hi(x.x) * 16.0f, bf_lo(x.y) * 16.0f, bf_hi(x.y) * 16.0f); w_[2 * i + 1] = pk4_fp8_nc(bf_lo(x.z) * 16.0f, bf_hi(x.z) * 16.0f, bf_lo(x.w) * 16.0f, bf_hi(x.w) * 16.0f); }
      q8 = (i32x8_){(int)w_[0], (int)w_[1], (int)w_[2], (int)w_[3], (int)w_[4], (int)w_[5], (int)w_[6], (int)w_[7]};
#pragma unroll
      for (int d0 = 0; d0 < NQ2; ++d0) qr2[d0] = *(const bf16x8*)(qp + 64 + d0 * 16 + hi * 8); }
    WAITDMA(3 < NT ? 3 : 2); BAR();
    QKT(pA0, pA1, 0); STIE_LONG(pA0, pA1); PARTSM(pA0, pA1, alA, true);
    WAITDMA(3 < NT ? 2 : 1); BAR();
    for (int j = 1; j + 1 < NT; j += 2) {
        SB(); QKT(pB0, pB1, j & 3);
        FINSM(pA0, pA1, alA); SB();
        PVT((j - 1) & 3, pB0, pB1); PARTSM(pB0, pB1, alB, false);
        BAR();
        if (j + 3 < NT) DMA(j + 3);
        RESC(alB);
        WAITDMA(j + 3 < NT ? 2 : (j + 2 < NT ? 1 : 0)); BAR();
        SB(); QKT(pA0, pA1, (j + 1) & 3);
        FINSM(pB0, pB1, alB); SB();
        PVT(j & 3, pA0, pA1); PARTSM(pA0, pA1, alA, false);
        BAR();
        if (j + 4 < NT) DMA(j + 4);
        RESC(alA);
        WAITDMA(j + 4 < NT ? 2 : (j + 3 < NT ? 1 : 0)); BAR();
    }
    SB(); QKT(pB0, pB1, (NT - 1) & 3);
    FINSM(pA0, pA1, alA); SB();
    PVT((NT - 2) & 3, pB0, pB1); PARTSM(pB0, pB1, alB, false);
    RESC(alB);
    FINSM(pB0, pB1, alB); SB();
    PV((NT - 1) & 3);
    OTIE();
    __syncthreads();
    l_out = ol;
#undef TROW
#undef GLDS
#undef DMA
#undef WAITDMA
#undef BAR
#undef QKT
#undef PARTSM
#undef MX3
#undef FINSM
#undef PV
#undef PV1
#undef PVT
#undef PVL
#undef negm
#undef STIE_LONG
#undef STIE_SHORT
#undef OTIE
#undef RESC
#undef SB
}
}

__device__ __forceinline__ int vt_slot(int k) { const int half = k >> 5, kk = k & 31, hi = (kk >> 2) & 1, r = (kk & 3) + 4 * (kk >> 3); return 32 * hi + r + 16 * half; }
template <int DVX, int NH> __device__ __forceinline__ void vt_item(Frame& F, const bf16* Vsrc, unsigned char* VTdst, int item, LAS unsigned char* scr) {
    const int tt = item / NH, h = item - tt * NH, key = F.lane, slot = vt_slot(key);
    const bf16* vrow = Vsrc + (size_t)(tt * 64 + key) * 512 + h * DVX;
#pragma unroll 4
    for (int d = 0; d < DVX; d += 8) { const u32x4 w = *(const u32x4*)(vrow + d);
        const unsigned lo = pk4_fp8(bf_lo(w.x), bf_hi(w.x), bf_lo(w.y), bf_hi(w.y)), hi2 = pk4_fp8(bf_lo(w.z), bf_hi(w.z), bf_lo(w.w), bf_hi(w.w));
#pragma unroll
        for (int i = 0; i < 4; ++i) { scr[(d + i) * 64 + slot] = (unsigned char)(lo >> (8 * i)); scr[(d + 4 + i) * 64 + slot] = (unsigned char)(hi2 >> (8 * i)); } }
    LDS_WAIT(); asm volatile("" ::: "memory");
    unsigned char* dst = VTdst + (size_t)item * (DVX * 64);
#pragma unroll
    for (int i = 0; i < DVX / 16; ++i) *(u32x4*)(dst + (i * 64 + F.lane) * 16) = *(const LAS u32x4*)(scr + (i * 64 + F.lane) * 16);
    LDS_WAIT(); asm volatile("" ::: "memory");
}
__device__ __forceinline__ void p_vt(Frame& F) {
    LAS unsigned char* scr = F.lds + RING_OFF + F.wave * 8192;
    const int gw = F.vcu * NWAVES + F.wave, NGW = F.G * NWAVES;
    for (int it = gw; it < (MTOT / 64) * 4; it += NGW) vt_item<128, 4>(F, (const bf16*)(F.ws + WS_VA), F.ws + WS_VTA, it, scr);
    for (int it = gw; it < (MTOT / 64) * 8; it += NGW) vt_item<64, 8>(F, (const bf16*)(F.ws + WS_VC), F.ws + WS_VTC, it, scr);
}
__device__ __forceinline__ void p_attention(Frame& F, int l) {
    using namespace att;
    LAS unsigned char* lds = F.lds + RING_OFF;
    const int wid = F.wave;
    const bf16 *QA = (const bf16*)(F.ws + WS_QA), *KA = (const bf16*)(F.ws + WS_KA), *VA = (const bf16*)(F.ws + WS_VA), *QB = (const bf16*)(F.ws + WS_QB), *KB = (const bf16*)(F.ws + WS_KB), *VB = (const bf16*)(F.ws + WS_VB);
    const bf16 *QC = (const bf16*)(F.ws + WS_QC), *KCN = (const bf16*)(F.ws + WS_KCN), *VC = (const bf16*)(F.ws + WS_VC), *CKR = (const bf16*)(F.ws + WS_CKR);
    unsigned char *YA = F.ws + WS_YA, *YB = YA + (size_t)MTOT * 512, *YC = YB + (size_t)MTOT * 512; float* O0 = (float*)(F.ws + WS_O0);
    const float* lamp = (const float*)(F.ws + WS_TAB) + 192 * 16 * 2 + 192 * 8 * 2; const float lam = lamp[2 * l], lam_init = lamp[2 * l + 1];
    const float* gsub = in_l(F, I_GSUB, l, 128);
    const int nctxA = (l == 0) ? 16 : 0, nctxBC = (l == 0) ? 32 : 0;
    const NaParams na0{nullptr, 0};
    int cslot = 0;
    for (int u = F.vcu; u < 512 + nctxA; u += F.G) {
        int b, h, qrow0, ntl;
        if (u < 512) { b = u >> 7; h = (u >> 5) & 3; qrow0 = b * SEQ + (u & 31) * 256; ntl = 128; } else { const int v = u - 512; b = v >> 2; h = v & 3; qrow0 = NLAT + b * CTXL; ntl = 0; }
        const int lat0 = b * SEQ, ctx0 = NLAT + b * CTXL;
        for (int c = 0; c < 2; ++c) {
            f32x16 o[4]; f32x16 lv;
            attn_pass_f8<0, 128>(lds, QA + (size_t)qrow0 * 512 + h * 128 + c * 64, 512, (const unsigned char*)KA + h * 128 + c * 64, nullptr, F.ws + WS_VTA + h * 8192, 4 * 8192, lat0, ntl, ctx0, 4, o, lv);
            float rli[16];
#pragma unroll
            for (int r = 0; r < 16; ++r) rli[r] = 1.0f / lv[r];
            int lane_ = F.lane; asm volatile("" : "+v"(lane_)); const int r32 = lane_ & 31, hi = lane_ >> 5;
            float* o0w = O0 + (size_t)(qrow0 + wid * 32) * 512 + h * 128 + r32;
            if (c == 0) {
#pragma unroll
                for (int r = 0; r < 16; ++r)
#pragma unroll
                    for (int d = 0; d < 4; ++d) o0w[(size_t)crow(r, hi) * 512 + d * 32] = o[d][r] * rli[r];
            } else {
                float ss[16];
#pragma unroll
                for (int r = 0; r < 16; ++r) { float s = 0.f;
#pragma unroll
                    for (int d = 0; d < 4; ++d) { const float y = o0w[(size_t)crow(r, hi) * 512 + d * 32] - lam * (o[d][r] * rli[r]); o[d][r] = y; s += y * y; }
                    ss[r] = s; }
#pragma unroll
                for (int r = 0; r < 16; ++r) {
#pragma unroll
                    for (int x = 1; x < 32; x <<= 1) ss[r] += __shfl_xor(ss[r], x);
                    ss[r] = __builtin_amdgcn_rsqf(ss[r] * (1.0f / 128.0f) + EPS) * (1.0f - lam_init); }
                unsigned char* yw = YA + (size_t)(qrow0 + wid * 32) * 512 + h * 128 + r32;
#pragma unroll
                for (int d = 0; d < 4; ++d) { const float g = gsub[d * 32 + r32] * YS_A;
#pragma unroll
                    for (int r = 0; r < 16; ++r) yw[(size_t)crow(r, hi) * 512 + d * 32] = f8_one(o[d][r] * ss[r] * g); }
            }
        }
    }
    for (int u = F.vcu; u < 1024 + nctxBC; u += F.G) {
        int b, h, qrow0, ntl;
        if (u < 1024) { b = u >> 8; h = (u >> 5) & 7; qrow0 = b * SEQ + (u & 31) * 256; ntl = 128; } else { const int v = u - 1024; b = v >> 3; h = v & 7; qrow0 = NLAT + b * CTXL; ntl = 0; }
        f32x16 o[2]; f32x16 lv;
        attn_pass_f8<32, 64>(lds, QC + (size_t)qrow0 * 768 + h * 96, 768, (const unsigned char*)KCN + h * 64, CKR, F.ws + WS_VTC + h * 4096, 8 * 4096, b * SEQ, ntl, NLAT + b * CTXL, 4, o, lv);
        store_bf16v<64>(o, lv, YC + (size_t)qrow0 * 512 + h * 64, 512);
        if (cslot == (F.vcu & 3)) {
            LAS float* cscr = (LAS float*)(F.lds + RING_OFF + F.wave * 8704); const int NGWc = F.G * NWAVES; const int njobs = (l == 0) ? PAIRS_LAYER : (l == 1 ? PAIRS_LAYER - NE_PAIRS : 0);
            __syncthreads();
            for (int cj = F.vcu * NWAVES + F.wave; cj < njobs; cj += NGWc) {
                const int pr_ = (l == 0) ? (cj < PAIRS_LAYER - NE_PAIRS ? NE_PAIRS + cj : PAIRS_LAYER + (cj - (PAIRS_LAYER - NE_PAIRS))) : (PAIRS_LAYER + NE_PAIRS + cj);
                convert_item(F, 2 * pr_, cscr); convert_item(F, 2 * pr_ + 1, cscr); }
            __syncthreads();
        }
        ++cslot;
    }
    for (int u = F.vcu; u < 1024; u += F.G) {
        const int b = u >> 8, h = (u >> 5) & 7, qb = u & 31, r0 = qb * 4, qrow0 = b * SEQ + qb * 256;
        const int kr_lo = min(max(r0 - 4, 0), 120), kr_hi = min(max(r0 + 3 - 4, 0), 120) + 7;
        const NaParams na{in_l(F, I_RPB, l, 8 * 15 * 31) + h * 15 * 31, r0};
        f32x16 o[2]; float lsum;
        attn_pass<0, 64, 1>(lds, QB + (size_t)qrow0 * 512 + h * 64, 512, KB + h * 64, nullptr, VB + h * 64, b * SEQ + kr_lo * 64, kr_hi - kr_lo + 1, NLAT + b * CTXL, 4, na, kr_lo, o, lsum);
        store_bf16<64>(lds, o, lsum, YB + (size_t)qrow0 * 512 + h * 64, 512);
    }
    for (int u = F.vcu; u < nctxBC; u += F.G) {
        const int b = u >> 3, h = u & 7, qrow0 = NLAT + b * CTXL;
        f32x16 o[2]; float lsum;
        attn_pass<0, 64, 0>(lds, QB + (size_t)qrow0 * 512 + h * 64, 512, KB + h * 64, nullptr, VB + h * 64, 0, 0, qrow0, 4, na0, 0, o, lsum);
        store_bf16<64>(lds, o, lsum, YB + (size_t)qrow0 * 512 + h * 64, 512);
    }
}

constexpr int TB_RECW = 6656, TB_CNT = 128;
constexpr int TB_LCNT = 0, TB_GBASE = 128, TB_BASE = 256, TB_TILE = 4096, TB_REC = 1280;
__device__ __forceinline__ float route_reduce(float (&acc)[32], int lane) {
#pragma unroll
    for (int i = 0; i < 16; ++i) { const bool up = (lane & 32) != 0; const float keep = up ? acc[i + 16] : acc[i], send = up ? acc[i] : acc[i + 16]; acc[i] = keep + __shfl_xor(send, 32); }
#pragma unroll
    for (int i = 0; i < 8; ++i) { const bool up = (lane & 16) != 0; const float keep = up ? acc[i + 8] : acc[i], send = up ? acc[i] : acc[i + 8]; acc[i] = keep + __shfl_xor(send, 16); }
#pragma unroll
    for (int i = 0; i < 4; ++i) { const bool up = (lane & 8) != 0; const float keep = up ? acc[i + 4] : acc[i], send = up ? acc[i] : acc[i + 4]; acc[i] = keep + __shfl_xor(send, 8); }
#pragma unroll
    for (int i = 0; i < 2; ++i) { const bool up = (lane & 4) != 0; const float keep = up ? acc[i + 2] : acc[i], send = up ? acc[i] : acc[i + 2]; acc[i] = keep + __shfl_xor(send, 4); }
    { const bool up = (lane & 2) != 0; const float keep = up ? acc[1] : acc[0], send = up ? acc[0] : acc[1]; acc[0] = keep + __shfl_xor(send, 2); }
    return acc[0] + __shfl_xor(acc[0], 1);
}
__device__ __forceinline__ void route_topk(float logit, int lane, LAS int* lcnt, LAS int* rec_row, float* w_row) {
    float tv[4]; int te[4];
#pragma unroll
    for (int k = 0; k < 4; ++k) { float mx = logit;
#pragma unroll
        for (int o = 1; o < 64; o <<= 1) mx = fmaxf(mx, __shfl_xor(mx, o));
        const unsigned long long bal = __ballot(logit == mx); const int fl = __builtin_ctzll(bal); te[k] = fl >> 1; tv[k] = mx; if ((lane >> 1) == te[k]) logit = -INFINITY; }
    const float e1 = __expf(tv[1] - tv[0]), e2 = __expf(tv[2] - tv[0]), e3 = __expf(tv[3] - tv[0]); const float inv = 1.0f / (1.0f + e1 + e2 + e3);
    if (lane < 4) { const int ee = lane == 0 ? te[0] : lane == 1 ? te[1] : lane == 2 ? te[2] : te[3]; const float ww = (lane == 0 ? 1.0f : lane == 1 ? e1 : lane == 2 ? e2 : e3) * inv;
        const int pos = __hip_atomic_fetch_add(lcnt + ee, 1, __ATOMIC_RELAXED, __HIP_MEMORY_SCOPE_WORKGROUP); rec_row[lane] = ee | (pos << 8); w_row[lane] = ww; }
}
__device__ __forceinline__ void p_route(Frame& F, int l, int M, int bank) {
    constexpr int ASTR = 2064;
    LAS unsigned char* Ahi = F.lds + RING_OFF; LAS unsigned char* Alo = Ahi + 16 * ASTR; LAS float* part = (LAS float*)(Ahi + 32 * ASTR); LAS float* lgt = part + 8 * 16 * 32;
    LAS int* lcnt = (LAS int*)(F.lds + TBL_OFF + TB_LCNT); LAS int* gbase = (LAS int*)(F.lds + TBL_OFF + TB_GBASE); LAS int* rec = (LAS int*)(F.lds + TBL_OFF + TB_REC); LAS float* recw = (LAS float*)(F.lds + TBL_OFF + TB_RECW);
    if (F.tid < 32) lcnt[F.tid] = 0;
    int lane_ = F.lane; asm volatile("" : "+v"(lane_)); const int fr = lane_ & 15, kq = lane_ >> 4;
    pg8::bf16x8 Wh[4][2], Wl[4][2];
    { const float* Wr = in_l(F, I_WROUT, l, 1024 * 32) + (size_t)(128 * F.wave + 8 * kq) * 32 + fr;
#pragma unroll
      for (int t = 0; t < 4; ++t)
#pragma unroll
          for (int nb = 0; nb < 2; ++nb)
#pragma unroll
              for (int i = 0; i < 8; ++i) { const float w = Wr[(size_t)(32 * t + i) * 32 + 16 * nb]; const unsigned h = f2bf(w); const unsigned lo = f2bf(w - __uint_as_float(h << 16)); Wh[t][nb][i] = (short)h; Wl[t][nb][i] = (short)lo; } }
    __syncthreads();
    const int rpb = (M + F.G - 1) / F.G, m0 = F.vcu * rpb, m1 = min(M, m0 + rpb);
    const float* modv = (const float*)(F.ws + WS_MODV) + (size_t)l * 5 * 6144; const unsigned short* X = (const unsigned short*)(F.ws + WS_X); unsigned char* H = F.ws + WS_H;
    const f32x4* g = (const f32x4*)in_l(F, I_GFFN, l, DM); const float* brp = in_l(F, I_BROUT, l, 32); f32x4 gv[4];
#pragma unroll
    for (int j = 0; j < 4; ++j) gv[j] = g[F.lane + 64 * j];
    int* rt_e = (int*)(F.ws + WS_ROUTE + RT_E); int* rt_slot = (int*)(F.ws + WS_ROUTE + RT_SLOT); float* rt_w = (float*)(F.ws + WS_ROUTE + RT_W);
    const int ntrips = (m1 - m0 + 15) >> 4; const float bre = brp[F.tid & 31];
    f32x4 nA[4], nB[4];
    if (m1 > m0) { const int mA = min(m0 + 2 * F.wave, m1 - 1), mB = min(mA + 1, m1 - 1);
#pragma unroll
      for (int j = 0; j < 4; ++j) { const float4 a_ = xb_ld4_(X + (size_t)mA * DM + 4 * (F.lane + 64 * j)), b_ = xb_ld4_(X + (size_t)mB * DM + 4 * (F.lane + 64 * j)); nA[j] = (f32x4){a_.x, a_.y, a_.z, a_.w}; nB[j] = (f32x4){b_.x, b_.y, b_.z, b_.w}; } }
    for (int trip = 0; trip < ntrips; ++trip) {
        const int mp = m0 + 16 * trip + 2 * F.wave; const bool one = mp < m1, two = mp + 1 < m1; const int mA = min(mp, m1 - 1), mB = min(mp + 1, m1 - 1);
        f32x4 vA[4], vB[4]; float sA = 0.f, sB = 0.f;
#pragma unroll
        for (int j = 0; j < 4; ++j) { vA[j] = nA[j]; vB[j] = nB[j]; sA += (vA[j].x * vA[j].x + vA[j].y * vA[j].y) + (vA[j].z * vA[j].z + vA[j].w * vA[j].w); sB += (vB[j].x * vB[j].x + vB[j].y * vB[j].y) + (vB[j].z * vB[j].z + vB[j].w * vB[j].w); }
        { const int pA = min(mp + 16, m1 - 1), pB = min(pA + 1, m1 - 1);
#pragma unroll
          for (int j = 0; j < 4; ++j) { const float4 a_ = xb_ld4_(X + (size_t)pA * DM + 4 * (F.lane + 64 * j)), b_ = xb_ld4_(X + (size_t)pB * DM + 4 * (F.lane + 64 * j)); nA[j] = (f32x4){a_.x, a_.y, a_.z, a_.w}; nB[j] = (f32x4){b_.x, b_.y, b_.z, b_.w}; } }
        const float rA = 1.0f / sqrtf(wave_sum(sA) * (1.0f / DM) + EPS), rB = 1.0f / sqrtf(wave_sum(sB) * (1.0f / DM) + EPS);
        const int bA = mA < NLAT ? mA / SEQ : 4, bB = mB < NLAT ? mB / SEQ : 4;
        typedef unsigned u32x2r_ __attribute__((ext_vector_type(2)));
        f32x4 scA[4], shA[4], scB[4], shB[4];
#pragma unroll
        for (int j = 0; j < 4; ++j) { scA[j] = ((const f32x4*)(modv + bA * 6144 + 4 * 1024))[F.lane + 64 * j]; shA[j] = ((const f32x4*)(modv + bA * 6144 + 3 * 1024))[F.lane + 64 * j]; scB[j] = scA[j]; shB[j] = shA[j]; }
        if (bB != bA) {
#pragma unroll
            for (int j = 0; j < 4; ++j) { scB[j] = ((const f32x4*)(modv + bB * 6144 + 4 * 1024))[F.lane + 64 * j]; shB[j] = ((const f32x4*)(modv + bB * 6144 + 3 * 1024))[F.lane + 64 * j]; } }
#pragma unroll
        for (int j = 0; j < 4; ++j) { const f32x4 gg = gv[j];
            vA[j] = vA[j] * rA * gg * (scA[j] + 1.0f) + shA[j];
            vB[j] = vB[j] * rB * gg * (scB[j] + 1.0f) + shB[j];
            if (one) put_h4<F8_MOE != 0>(H + (size_t)mA * HROW_MOE, F.lane, j, vA[j]); if (two) put_h4<F8_MOE != 0>(H + (size_t)mB * HROW_MOE, F.lane, j, vB[j]);
            { unsigned h0 = f2bf(vA[j].x), h1 = f2bf(vA[j].y), h2 = f2bf(vA[j].z), h3 = f2bf(vA[j].w);
              const unsigned l0 = f2bf(vA[j].x - __uint_as_float(h0 << 16)), l1 = f2bf(vA[j].y - __uint_as_float(h1 << 16)), l2 = f2bf(vA[j].z - __uint_as_float(h2 << 16)), l3 = f2bf(vA[j].w - __uint_as_float(h3 << 16));
              const int off = (2 * F.wave) * ASTR + (256 * j + 4 * F.lane) * 2;
              *(LAS u32x2r_*)(Ahi + off) = (u32x2r_){h0 | (h1 << 16), h2 | (h3 << 16)}; *(LAS u32x2r_*)(Alo + off) = (u32x2r_){l0 | (l1 << 16), l2 | (l3 << 16)}; }
            { unsigned h0 = f2bf(vB[j].x), h1 = f2bf(vB[j].y), h2 = f2bf(vB[j].z), h3 = f2bf(vB[j].w);
              const unsigned l0 = f2bf(vB[j].x - __uint_as_float(h0 << 16)), l1 = f2bf(vB[j].y - __uint_as_float(h1 << 16)), l2 = f2bf(vB[j].z - __uint_as_float(h2 << 16)), l3 = f2bf(vB[j].w - __uint_as_float(h3 << 16));
              const int off = (2 * F.wave + 1) * ASTR + (256 * j + 4 * F.lane) * 2;
              *(LAS u32x2r_*)(Ahi + off) = (u32x2r_){h0 | (h1 << 16), h2 | (h3 << 16)}; *(LAS u32x2r_*)(Alo + off) = (u32x2r_){l0 | (l1 << 16), l2 | (l3 << 16)}; } }
        __syncthreads();
        f32x4 acc[2] = {(f32x4){0.f, 0.f, 0.f, 0.f}, (f32x4){0.f, 0.f, 0.f, 0.f}};
#pragma unroll
        for (int t = 0; t < 4; ++t) { const int ao = fr * ASTR + (128 * F.wave + 32 * t + 8 * kq) * 2;
            const pg8::bf16x8 ah = *(const LAS pg8::bf16x8*)(Ahi + ao), al = *(const LAS pg8::bf16x8*)(Alo + ao);
#pragma unroll
            for (int nb = 0; nb < 2; ++nb) { acc[nb] = __builtin_amdgcn_mfma_f32_16x16x32_bf16(ah, Wh[t][nb], acc[nb], 0, 0, 0);
                acc[nb] = __builtin_amdgcn_mfma_f32_16x16x32_bf16(ah, Wl[t][nb], acc[nb], 0, 0, 0); acc[nb] = __builtin_amdgcn_mfma_f32_16x16x32_bf16(al, Wh[t][nb], acc[nb], 0, 0, 0); } }
#pragma unroll
        for (int nb = 0; nb < 2; ++nb)
#pragma unroll
            for (int i = 0; i < 4; ++i) part[(F.wave * 16 + 4 * kq + i) * 32 + 16 * nb + fr] = acc[nb][i];
        __syncthreads();
        { const int row = F.tid >> 5, e = F.tid & 31; float s = 0.f;
#pragma unroll
          for (int w8 = 0; w8 < 8; ++w8) s += part[(w8 * 16 + row) * 32 + e];
          float lg = s + bre;
          const int hl = F.lane & 31, hf = F.lane >> 5; float tv[4]; int te[4];
#pragma unroll
          for (int k = 0; k < 4; ++k) { float mx = lg;
#pragma unroll
              for (int o = 1; o < 32; o <<= 1) mx = fmaxf(mx, __shfl_xor(mx, o));
              const unsigned long long bal = __ballot(lg == mx); const unsigned hb = hf ? (unsigned)(bal >> 32) : (unsigned)bal; te[k] = __builtin_ctz(hb); tv[k] = mx; if (hl == te[k]) lg = -INFINITY; }
          const float e1 = __expf(tv[1] - tv[0]), e2 = __expf(tv[2] - tv[0]), e3 = __expf(tv[3] - tv[0]); const float inv = 1.0f / (1.0f + e1 + e2 + e3);
          const bool okr = hf ? two : one; const int mrow = hf ? mB : mA;
          if (okr && hl < 4) { const int ee = hl == 0 ? te[0] : hl == 1 ? te[1] : hl == 2 ? te[2] : te[3]; const float ww = (hl == 0 ? 1.0f : hl == 1 ? e1 : hl == 2 ? e2 : e3) * inv;
              const int pos = __hip_atomic_fetch_add(lcnt + ee, 1, __ATOMIC_RELAXED, __HIP_MEMORY_SCOPE_WORKGROUP); rec[(mrow - m0) * 4 + hl] = ee | (pos << 8); recw[(mrow - m0) * 4 + hl] = ww; }
        }
    }
    __syncthreads();
    if (F.tid < 32) gbase[F.tid] = (int)atomicAdd(F.ctl + CW_CNT + bank * 64 + F.tid, (unsigned)lcnt[F.tid]);
    __syncthreads();
    { int* xs = (int*)(F.ws + WS_XS); float* xw = (float*)(F.ws + WS_XW);
      for (int i = F.tid; i < (m1 - m0) * 4; i += NTHR) { const int r = rec[i], e = r & 255, pos = r >> 8; const size_t xi = (size_t)e * MTOT + gbase[e] + pos; xs[xi] = m0 * 4 + i; xw[xi] = recw[i]; } }
    __syncthreads();
}
__device__ __forceinline__ int build_expert_tables(Frame& F, int l) {
    LAS int* base = (LAS int*)(F.lds + TBL_OFF + TB_BASE); LAS int* tile_e = (LAS int*)(F.lds + TBL_OFF + TB_TILE);
    LAS int* padc = (LAS int*)(F.lds + TBL_OFF + TB_LCNT);
    __syncthreads();
    if (F.tid < 64) {
        const int c = F.tid < 32 ? (int)__hip_atomic_load(F.ctl + CW_CNT + l * 64 + (F.tid & 31), __ATOMIC_RELAXED, __HIP_MEMORY_SCOPE_AGENT) : 0;
        const int pc = F.tid < 32 ? (((c + 255) >> 8) << 8) : 0; int inc = pc;
#pragma unroll
        for (int o = 1; o < 32; o <<= 1) { const int v = __shfl_up(inc, o); if ((F.tid & 63) >= o) inc += v; }
        if (F.tid < 32) { padc[F.tid] = pc; base[F.tid] = inc - pc; if (F.tid == 31) base[32] = inc; ((LAS int*)(F.lds + TBL_OFF + TB_CNT))[F.tid] = c; }
    }
    __syncthreads();
    { typedef int i32x4t_ __attribute__((ext_vector_type(4))); i32x4t_ bq[8];
#pragma unroll
      for (int q = 0; q < 8; ++q) bq[q] = ((const LAS i32x4t_*)base)[q];
      for (int t = F.tid; t < 640; t += NTHR) { const int r0 = t * 256; int e = -1;
#pragma unroll
          for (int q = 0; q < 8; ++q) e += (bq[q].x <= r0 ? 1 : 0) + (bq[q].y <= r0 ? 1 : 0) + (bq[q].z <= r0 ? 1 : 0) + (bq[q].w <= r0 ? 1 : 0);
          tile_e[t] = e; } }
    __syncthreads();
    return base[32] >> 8;
}
__device__ __forceinline__ void p_gather(Frame& F, int l, int M) {
    (void)build_expert_tables(F, l);
    LAS int* base = (LAS int*)(F.lds + TBL_OFF + TB_BASE);
    const int* rt_e = (const int*)(F.ws + WS_ROUTE + RT_E); const int* rt_slot = (const int*)(F.ws + WS_ROUTE + RT_SLOT); const float* rt_w = (const float*)(F.ws + WS_ROUTE + RT_W);
    int* ydst = (int*)(F.ws + WS_ROUTE + RT_YDST); float* wrow = (float*)(F.ws + WS_ROUTE + RT_WROW); int* ysrc = (int*)(F.ws + WS_ROUTE + RT_YSRC);
    for (int i = blockIdx.x * NTHR + F.tid; i < M * 4; i += F.G * NTHR) { const int e = rt_e[i]; const int dst = base[e] + rt_slot[i]; ydst[dst] = i; wrow[dst] = rt_w[i]; ysrc[dst] = i >> 2; }
    for (int i = blockIdx.x * NTHR + F.tid; i < 32 * 256; i += F.G * NTHR) { const int e = i >> 8, j = i & 255; const int c = (int)__hip_atomic_load(F.ctl + CW_CNT + l * 64 + e, __ATOMIC_RELAXED, __HIP_MEMORY_SCOPE_AGENT);
        const int r = base[e] + c + j; if (r < base[e + 1]) { ydst[r] = -1; wrow[r] = 0.f; ysrc[r] = 0; } }
}
__device__ __forceinline__ void p_combine(Frame& F, int l, int M) {
    const int gw = F.vcu * NWAVES + F.wave, NGW = F.G * NWAVES; const bool last = (l == DEPTH - 1);
    const float* modv = (const float*)(F.ws + WS_MODV) + (size_t)l * 5 * 6144; const float* modn = modv + 5 * 6144; unsigned short* X = (unsigned short*)(F.ws + WS_X); unsigned char* H = F.ws + WS_H; const bf16* YB = (const bf16*)(F.ws + WS_YBUF);
    const f32x4* gnp = (const f32x4*)(last ? F.in[I_GFIN] : in_l(F, I_GMIX, l + 1, DM)); f32x4 gn[4];
#pragma unroll
    for (int j = 0; j < 4; ++j) gn[j] = gnp[F.lane + 64 * j];
    unsigned long long ny[4][4]; f32x4 nxr[4];
#define CLOAD(mm) do { _Pragma("unroll") for (int j = 0; j < 4; ++j) { _Pragma("unroll") for (int k = 0; k < 4; ++k) ny[j][k] = ((const unsigned long long*)(YB + (size_t)((mm) * 4 + k) * DM))[F.lane + 64 * j]; \
        { const float4 x_ = xb_ld4_(X + (size_t)(mm) * DM + 4 * (F.lane + 64 * j)); nxr[j] = (f32x4){x_.x, x_.y, x_.z, x_.w}; } } } while (0)
    if (gw < M) CLOAD(gw);
    for (int m = gw; m < M; m += NGW) {
        const int b = m < NLAT ? m / SEQ : 4; const f32x4* gt2 = (const f32x4*)(modv + b * 6144 + 5 * 1024);
        unsigned short* xr = X + (size_t)m * DM + 4 * F.lane; f32x4 v[4]; float s = 0.f;
        unsigned long long cy[4][4]; f32x4 cx[4];
#pragma unroll
        for (int j = 0; j < 4; ++j) { cx[j] = nxr[j];
#pragma unroll
            for (int k = 0; k < 4; ++k) cy[j][k] = ny[j][k]; }
        { const int mn = min(m + NGW, M - 1); CLOAD(mn); }
#pragma unroll
        for (int j = 0; j < 4; ++j) { f32x4 y = (f32x4){0.f, 0.f, 0.f, 0.f};
#pragma unroll
            for (int k = 0; k < 4; ++k) { const unsigned long long w = cy[j][k]; const unsigned lo = (unsigned)w, hi = (unsigned)(w >> 32);
                y += (f32x4){bf_lo(lo), bf_hi(lo), bf_lo(hi), bf_hi(hi)}; }
            v[j] = cx[j] + gt2[F.lane + 64 * j] * y; s += (v[j].x * v[j].x + v[j].y * v[j].y) + (v[j].z * v[j].z + v[j].w * v[j].w); }
        const float rstd = 1.0f / sqrtf(wave_sum(s) * (1.0f / DM) + EPS);
        if (!last) {
            const f32x4* sh = (const f32x4*)(modn + b * 6144); const f32x4* sc = (const f32x4*)(modn + b * 6144 + 1024); f32x4 shv[4], scv[4];
#pragma unroll
            for (int j = 0; j < 4; ++j) { shv[j] = sh[F.lane + 64 * j]; scv[j] = sc[F.lane + 64 * j]; }
#pragma unroll
            for (int j = 0; j < 4; ++j) { *(u32x2x_t*)(xr + 256 * j) = (u32x2x_t){cvt_pk_bf16(v[j].x, v[j].y), cvt_pk_bf16(v[j].z, v[j].w)}; const f32x4 y = v[j] * rstd * gn[j] * (scv[j] + 1.0f) + shv[j];
                put_h4<F8_IN1 != 0>(H + (size_t)m * HROW_INL(1), F.lane, j, y); }
        } else {
            f32x4* op = (f32x4*)(F.out + (size_t)m * DM) + F.lane;
#pragma unroll
            for (int j = 0; j < 4; ++j) op[64 * j] = v[j] * rstd * gn[j];
        }
    }
#undef CLOAD
}

constexpr int NSAMP = 12, NCHK = 16;
__device__ __forceinline__ int sample_row(int i) { const int r[NSAMP] = {0, 1, 63, 64, 4097, 8191, 8192, 20000, 32767, 32768, 33000, 33791}; int v = 0;
#pragma unroll
    for (int j = 0; j < NSAMP; ++j) v = (i == j) ? r[j] : v; return v; }
__device__ __forceinline__ void dbg_note(Frame& F, int chk, float a, float e, float scale, float tol) {
    float err = fabsf(a - e) / (fabsf(e) + scale); if (!(err == err)) err = 1e30f;
    if (err > tol) atomicAdd(F.ctl + CW_DBG + chk, 1u);
    atomicMax(F.ctl + CW_DBG + 64 + chk, __float_as_uint(err));
}
__device__ __forceinline__ float bfr(float x) { return __uint_as_float(f2bf(x) << 16); }
__device__ __forceinline__ void chk_in(Frame& F, int l, int chk) {
    if (F.vcu >= NSAMP) return;
    const int row = sample_row(F.vcu); const bool ctx = row >= NLAT; const int pos = row % SEQ; const float prow = (float)(pos / 64), pcol = (float)(pos % 64);
    LAS float* raw = (LAS float*)(F.lds + RING_OFF); LAS float* hs = raw + 7168;
    const unsigned char* H = F.ws + WS_H + (size_t)row * DM; const float* W = in_l(F, I_WIN, l, (size_t)DM * DIN);
    for (int k = F.tid; k < DM; k += NTHR) hs[k] = __builtin_amdgcn_cvt_f32_fp8((int)H[k], 0);
    __syncthreads();
    for (int j = F.tid; j < DIN; j += NTHR) { float s = 0.f; for (int k = 0; k < DM; ++k) s += hs[k] * bfr(W[(size_t)k * DIN + j]); raw[j] = s; }
    __syncthreads();
    const bf16 *QA = (const bf16*)(F.ws + WS_QA), *KA = (const bf16*)(F.ws + WS_KA), *VA = (const bf16*)(F.ws + WS_VA), *QB = (const bf16*)(F.ws + WS_QB), *KB = (const bf16*)(F.ws + WS_KB), *VB = (const bf16*)(F.ws + WS_VB);
    const bf16 *CQ = (const bf16*)(F.ws + WS_CQ), *CKR = (const bf16*)(F.ws + WS_CKR), *CKV = (const bf16*)(F.ws + WS_CKV), *GT = (const bf16*)(F.ws + WS_GATES);
    for (int j = F.tid; j < DIN; j += NTHR) {
        float e, a;
        if (j < 1024) {
            const int g = j >> 6, d = j & 63, q = d & 15, blk = d >> 4;
            const float inv = powf(10000.0f, -(float)q / 16.0f), ang = (blk < 2 ? prow : pcol) * inv, c = ctx ? 1.f : cosf(ang), s = ctx ? 0.f : sinf(ang);
            const int da = (blk & 2) * 16 + q, db = da + 16; const float av = raw[g * 64 + da], bv = raw[g * 64 + db];
            e = (blk & 1) ? bv * c + av * s : av * c - bv * s; if (j < 512) e *= QSCALE_AB;
            const int p = 2 * ((blk >> 1) * 16 + q) + (blk & 1);
            a = bf2f((j < 512 ? QA : KA)[(size_t)row * 512 + (g & 7) * 64 + p]);
        } else if (j < 3072) { const int seg = (j - 1024) >> 9, c = (j - 1024) & 511; e = raw[j] * (seg == 1 ? QSCALE_AB : 1.f); a = bf2f((seg == 0 ? VA : seg == 1 ? QB : seg == 2 ? KB : VB)[(size_t)row * 512 + c]); }
        else if (j < 3456) { e = raw[j]; a = bf2f(CQ[(size_t)row * 384 + (j - 3072)]); }
        else if (j < 3712) { e = raw[j]; a = bf2f(CKV[(size_t)row * 256 + (j - 3456)]); }
        else if (j < 3744) { const int d = j - 3712, q = d & 7, blk = d >> 3; const float inv = powf(10000.0f, -(float)q / 8.0f), ang = (blk < 2 ? prow : pcol) * inv, c = ctx ? 1.f : cosf(ang), s = ctx ? 0.f : sinf(ang);
            const int da = (blk & 2) * 8 + q, db = da + 8; const float av = raw[3712 + da], bv = raw[3712 + db];
            e = (blk & 1) ? bv * c + av * s : av * c - bv * s; const int p = 2 * ((blk >> 1) * 8 + q) + (blk & 1); a = bf2f(CKR[(size_t)row * 32 + p]); }
        else { e = 1.0f / (1.0f + expf(-raw[j])); a = bf2f(GT[(size_t)row * 3072 + (j - 3744)]); }
        dbg_note(F, chk, a, e, 0.1f, 0.25f);
    }
    if (F.tid == 0) { float sq = 0.f, sk = 0.f; for (int j = 3072; j < 3456; ++j) sq += raw[j] * raw[j]; for (int j = 3456; j < 3712; ++j) sk += raw[j] * raw[j];
        const float* ssq = (const float*)(F.ws + CTL_SSQ); float a = 0.f, b = 0.f; for (int i = 0; i < 8; ++i) a += ssq[(size_t)row * 8 + i]; for (int i = 0; i < 4; ++i) b += ssq[(size_t)MTOT * 8 + (size_t)row * 4 + i]; dbg_note(F, chk, a, sq, 0.05f, 0.1f); dbg_note(F, chk, b, sk, 0.05f, 0.1f); }
    __syncthreads();
}
__device__ __forceinline__ void p_dbg_emit(Frame& F) {
    int id = 0; float me = 0.f;
    for (int c = 1; c < NCHK; ++c) { const unsigned n = F.ctl[CW_DBG + c]; const float e = __uint_as_float(F.ctl[CW_DBG + 64 + c]); if (id == 0) { if (n > 0u) { id = c; me = e; } else me = fmaxf(me, e); } }
    float k = rintf(10.0f * (log10f(fmaxf(me, 1e-6f)) + 6.0f)); k = fminf(fmaxf(k, 0.f), 89.f);
    const float A = sqrtf((float)((10 + id) * 10) - 1.0f), Bv = (10.0f + k) * 100.0f;
    for (size_t i = (size_t)blockIdx.x * NTHR + F.tid; i < (size_t)NLAT * DM; i += (size_t)F.G * NTHR) { unsigned h = (unsigned)i * 2654435761u; h ^= h >> 15; h *= 2246822519u; h ^= h >> 13; F.out[i] = (i == 0) ? Bv : ((h & 1u) ? A : -A); }
}

__device__ __forceinline__ void chk_qkv(Frame& F, int l, int chk) {
    if (F.vcu >= NSAMP) return;
    const int row = sample_row(F.vcu); const bool ctx = row >= NLAT; const int pos = row % SEQ; const float prow = (float)(pos / 64), pcol = (float)(pos % 64);
    LAS float* raw = (LAS float*)(F.lds + RING_OFF);
    const bf16* CQ = (const bf16*)(F.ws + WS_CQ) + (size_t)row * 384; const bf16* CKV = (const bf16*)(F.ws + WS_CKV) + (size_t)row * 256;
    const float* ssq = (const float*)(F.ws + CTL_SSQ); float sqa = 0.f, ska = 0.f; for (int i = 0; i < 8; ++i) sqa += ssq[(size_t)row * 8 + i]; for (int i = 0; i < 4; ++i) ska += ssq[(size_t)MTOT * 8 + (size_t)row * 4 + i];
    const float rq = 1.0f / sqrtf(sqa / 384.0f + EPS), rk = 1.0f / sqrtf(ska / 256.0f + EPS);
    const float* Wq = in_l(F, I_WQB, l, 384 * 768); const float* gq = in_l(F, I_GQA, l, 384); const float* Wk = in_l(F, I_WKVB, l, 256 * 1024); const float* gk = in_l(F, I_GKVA, l, 256);
    for (int n = F.tid; n < 768; n += NTHR) { float s = 0.f; for (int k = 0; k < 384; ++k) s += bf2f(CQ[k]) * bfr(Wq[(size_t)k * 768 + n] * gq[k]); raw[n] = s * rq * QSCALE_C; }
    __syncthreads();
    const bf16* QC = (const bf16*)(F.ws + WS_QC) + (size_t)row * 768;
    for (int n = F.tid; n < 768; n += NTHR) { const int h = n / 96, p = n % 96; float e, a;
        if (p < 64) { e = raw[n]; a = bf2f(QC[n]); }
        else { const int d = p - 64, q = d & 7, blk = d >> 3; const float inv = powf(10000.0f, -(float)q / 8.0f), ang = (blk < 2 ? prow : pcol) * inv, c = ctx ? 1.f : cosf(ang), s = ctx ? 0.f : sinf(ang);
            const int da = (blk & 2) * 8 + q, db = da + 8; const float av = raw[h * 96 + 64 + da], bv = raw[h * 96 + 64 + db];
            e = (blk & 1) ? bv * c + av * s : av * c - bv * s; a = bf2f(QC[h * 96 + 64 + 2 * ((blk >> 1) * 8 + q) + (blk & 1)]); }
        dbg_note(F, chk, a, e, 0.05f, 0.03f); }
    const bf16* KCN = (const bf16*)(F.ws + WS_KCN) + (size_t)row * 512; const bf16* VC = (const bf16*)(F.ws + WS_VC) + (size_t)row * 512;
    for (int n = F.tid; n < 1024; n += NTHR) { float s = 0.f; for (int k = 0; k < 256; ++k) s += bf2f(CKV[k]) * bfr(Wk[(size_t)k * 1024 + n] * gk[k]); s *= rk;
        const int h = n >> 7, d = n & 127; const float a = d < 64 ? bf2f(KCN[h * 64 + d]) : bf2f(VC[h * 64 + d - 64]); dbg_note(F, chk, a, s, 0.05f, 0.03f); }
    __syncthreads();
}
__device__ __forceinline__ void naive_attn(Frame& F, LAS float* sc, LAS float* red, LAS float* res, const bf16* q, int dk1, const bf16* K1, const bf16* q2, int dk2, const bf16* K2, const bf16* V, int dv,
                                           int lat0, int nlat, int ctx0, int nctx, int mode, const float* rpb_h, int rq, int cq, int kr_lo) {
    const int NK = nlat + nctx;
    for (int i = F.tid; i < NK; i += NTHR) { const size_t kr = i < nlat ? (size_t)lat0 + i : (size_t)ctx0 + (i - nlat); float s = 0.f;
        for (int d = 0; d < dk1; ++d) s += bf2f(q[d]) * bf2f(K1[kr * 512 + d]);
        for (int d = 0; d < dk2; ++d) s += bf2f(q2[d]) * bf2f(K2[kr * 32 + d]);
        if (mode == 1 && i < nlat) { const int krr = kr_lo + i / 64, ck = i % 64, rs = min(max(rq - 4, 0), 120), cs = min(max(cq - 8, 0), 48);
            if (krr < rs || krr >= rs + 8 || ck < cs || ck >= cs + 16) s = -INFINITY; else s += rpb_h[(krr - rq + 7) * 31 + min(max(ck - cq + 15, 0), 30)] * LOG2E; }
        sc[i] = s; }
    __syncthreads();
    float mx = -INFINITY; for (int i = F.tid; i < NK; i += NTHR) mx = fmaxf(mx, sc[i]);
    for (int o = 1; o < 64; o <<= 1) mx = fmaxf(mx, __shfl_xor(mx, o)); if (F.lane == 0) red[F.wave] = mx; __syncthreads();
    mx = red[0]; for (int w = 1; w < 8; ++w) mx = fmaxf(mx, red[w]); __syncthreads();
    float sm = 0.f; for (int i = F.tid; i < NK; i += NTHR) { const float p = exp2f(sc[i] - mx); sc[i] = p; sm += p; }
    sm = wave_sum(sm); if (F.lane == 0) red[F.wave] = sm; __syncthreads();
    sm = 0.f; for (int w = 0; w < 8; ++w) sm += red[w];
    if (F.tid < dv) { float a = 0.f; for (int i = 0; i < NK; ++i) { const size_t kr = i < nlat ? (size_t)lat0 + i : (size_t)ctx0 + (i - nlat); a += sc[i] * bf2f(V[kr * 512 + F.tid]); } res[F.tid] = a / sm; }
    __syncthreads();
}
__device__ __forceinline__ void chk_attn(Frame& F, int l, int chk) {
    if (F.vcu >= NSAMP) return;
    const int row = sample_row(F.vcu); const bool ctx = row >= NLAT; if (ctx && l > 0) return;
    const int b = ctx ? (row - NLAT) / CTXL : row / SEQ, pos = row % SEQ, rq = pos / 64, cq = pos % 64;
    LAS float* sc = (LAS float*)(F.lds + RING_OFF); LAS float* red = sc + 8704; LAS float* res = red + 16; LAS float* res0 = res + 128;
    const int lat0 = b * SEQ, nlat = ctx ? 0 : SEQ, ctx0 = NLAT + b * CTXL;
    const bf16 *QA = (const bf16*)(F.ws + WS_QA), *KA = (const bf16*)(F.ws + WS_KA), *VA = (const bf16*)(F.ws + WS_VA), *QB = (const bf16*)(F.ws + WS_QB), *KB = (const bf16*)(F.ws + WS_KB), *VB = (const bf16*)(F.ws + WS_VB);
    const bf16 *QC = (const bf16*)(F.ws + WS_QC), *KCN = (const bf16*)(F.ws + WS_KCN), *VC = (const bf16*)(F.ws + WS_VC), *CKR = (const bf16*)(F.ws + WS_CKR);
    const bf16 *YA = (const bf16*)(F.ws + WS_YA), *YB = (const bf16*)(F.ws + WS_YB), *YC = (const bf16*)(F.ws + WS_YC);
    const float* lamp = (const float*)(F.ws + WS_TAB) + 192 * 16 * 2 + 192 * 8 * 2; const float lam = lamp[2 * l], lam_init = lamp[2 * l + 1]; const float* gsub = in_l(F, I_GSUB, l, 128);
    { const float lr = expf(0.f); (void)lr; }
    for (int h = 0; h < 4; ++h) {
        naive_attn(F, sc, red, res, QA + (size_t)row * 512 + h * 128, 64, KA + h * 128, nullptr, 0, nullptr, VA + h * 128, 128, lat0, nlat, ctx0, CTXL, 0, nullptr, 0, 0, 0);
        if (F.tid < 128) res0[F.tid] = res[F.tid]; __syncthreads();
        naive_attn(F, sc, red, res, QA + (size_t)row * 512 + h * 128 + 64, 64, KA + h * 128 + 64, nullptr, 0, nullptr, VA + h * 128, 128, lat0, nlat, ctx0, CTXL, 0, nullptr, 0, 0, 0);
        if (F.tid < 128) res0[F.tid] = res0[F.tid] - lam * res[F.tid]; __syncthreads();
        float ss = 0.f; for (int d = 0; d < 128; ++d) ss += res0[d] * res0[d];
        if (F.tid < 128) { const float e = res0[F.tid] / sqrtf(ss / 128.0f + EPS) * gsub[F.tid] * (1.0f - lam_init); dbg_note(F, chk, bf2f(YA[(size_t)row * 512 + h * 128 + F.tid]), e, 0.1f, 0.04f); }
        __syncthreads();
    }
    for (int h = 0; h < 8; ++h) {
        const int kr_lo = min(max(rq - 4, 0), 120);
        if (ctx) naive_attn(F, sc, red, res, QB + (size_t)row * 512 + h * 64, 64, KB + h * 64, nullptr, 0, nullptr, VB + h * 64, 64, 0, 0, ctx0, CTXL, 0, nullptr, 0, 0, 0);
        else naive_attn(F, sc, red, res, QB + (size_t)row * 512 + h * 64, 64, KB + h * 64, nullptr, 0, nullptr, VB + h * 64, 64, lat0 + kr_lo * 64, 512, ctx0, CTXL, 1, in_l(F, I_RPB, l, 8 * 15 * 31) + h * 465, rq, cq, kr_lo);
        if (F.tid < 64) dbg_note(F, chk + 1, bf2f(YB[(size_t)row * 512 + h * 64 + F.tid]), res[F.tid], 0.02f, 0.04f);
        __syncthreads();
        naive_attn(F, sc, red, res, QC + (size_t)row * 768 + h * 96, 64, KCN + h * 64, QC + (size_t)row * 768 + h * 96 + 64, 32, CKR, VC + h * 64, 64, lat0, nlat, ctx0, CTXL, 0, nullptr, 0, 0, 0);
        if (F.tid < 64) dbg_note(F, chk + 2, bf2f(YC[(size_t)row * 512 + h * 64 + F.tid]), res[F.tid], 0.01f, 0.04f);
        __syncthreads();
    }
}
__device__ __forceinline__ void chk_merge(Frame& F, int l, int chk) {
    if (F.vcu >= NSAMP) return; const int row = sample_row(F.vcu); if (row >= NLAT && l > 0) return;
    const bf16* Y = (const bf16*)(F.ws + WS_YA); const bf16* GT = (const bf16*)(F.ws + WS_GATES) + (size_t)row * 3072; const bf16* MB = (const bf16*)(F.ws + WS_MB) + (size_t)row * 1024;
    for (int n = F.tid; n < 1024; n += NTHR) { float m = 0.f;
        for (int br = 0; br < 3; ++br) { const float* W = in_l(F, br == 0 ? I_WBRA : br == 1 ? I_WBRB : I_WBRC, l, 512 * 1024); const bf16* y = Y + (size_t)br * MTOT * 512 + (size_t)row * 512; float s = 0.f;
            for (int k = 0; k < 512; ++k) s += bf2f(y[k]) * bfr(W[(size_t)k * 1024 + n]); m += bf2f(GT[br * 1024 + n]) * s; }
        dbg_note(F, chk, bf2f(MB[n]), m, 0.05f, 0.03f); }
}
__device__ __forceinline__ void chk_out(Frame& F, int l, int chk, const float* xprev) {
    if (F.vcu >= NSAMP || l > 0) return; const int row = sample_row(F.vcu); const int b = row < NLAT ? row / SEQ : 4;
    const float* xs = row < NLAT ? F.in[I_X] + (size_t)row * DM : F.in[I_CTX] + (size_t)(row - NLAT) * DM; const bf16* MB = (const bf16*)(F.ws + WS_MB) + (size_t)row * 1024;
    const float* W = in_l(F, I_WOUT, l, 1024 * 1024); const float* gt = (const float*)(F.ws + WS_MODV) + (size_t)(l * 5 + b) * 6144 + 2048; const float* X = (const float*)(F.ws + WS_X) + (size_t)row * DM;
    for (int n = F.tid; n < 1024; n += NTHR) { float s = 0.f; for (int k = 0; k < 1024; ++k) s += bf2f(MB[k]) * bfr(W[(size_t)k * 1024 + n]); dbg_note(F, chk, X[n], xs[n] + gt[n] * s, 0.1f, 0.01f); }
}
__device__ __forceinline__ void chk_route(Frame& F, int l, int chk) {
    if (F.vcu >= NSAMP) return; const int row = sample_row(F.vcu); if (row >= NLAT && l > 0) return; const int b = row < NLAT ? row / SEQ : 4;
    LAS float* h2 = (LAS float*)(F.lds + RING_OFF); LAS float* lg = h2 + 1024;
    const float* X = (const float*)(F.ws + WS_X) + (size_t)row * DM; const float* modv = (const float*)(F.ws + WS_MODV) + (size_t)(l * 5 + b) * 6144; const float* g = in_l(F, I_GFFN, l, DM);
    float ss = 0.f; for (int k = 0; k < DM; ++k) ss += X[k] * X[k]; const float rstd = 1.0f / sqrtf(ss / DM + EPS);
    const unsigned char* H = F.ws + WS_H + (size_t)row * DM;
    for (int k = F.tid; k < DM; k += NTHR) { const float v = X[k] * rstd * g[k] * (1.0f + modv[4096 + k]) + modv[3072 + k]; h2[k] = v; dbg_note(F, chk, __builtin_amdgcn_cvt_f32_fp8((int)H[k], 0), v, 0.05f, 0.08f); }
    __syncthreads();
    if (F.tid < 32) { const float* Wr = in_l(F, I_WROUT, l, 1024 * 32); float s = 0.f; for (int k = 0; k < DM; ++k) s += h2[k] * Wr[k * 32 + F.tid]; lg[F.tid] = s + in_l(F, I_BROUT, l, 32)[F.tid]; }
    __syncthreads();
    if (F.tid == 0) { int te[4]; float tv[4];
        for (int k = 0; k < 4; ++k) { int bi = 0; float bv = lg[0]; for (int e = 1; e < 32; ++e) { const float x = lg[e]; if (x > bv) { bv = x; bi = e; } } te[k] = bi; tv[k] = bv; lg[bi] = -INFINITY; }
        const float den = 1.0f + expf(tv[1] - tv[0]) + expf(tv[2] - tv[0]) + expf(tv[3] - tv[0]);
        const int* rt_e = (const int*)(F.ws + WS_ROUTE + RT_E); const float* rt_w = (const float*)(F.ws + WS_ROUTE + RT_W);
#pragma unroll
        for (int k = 0; k < 4; ++k) { dbg_note(F, chk, (float)rt_e[(size_t)row * 4 + k], (float)te[k], 1.0f, 0.001f); dbg_note(F, chk, rt_w[(size_t)row * 4 + k], expf(tv[k] - tv[0]) / den, 0.1f, 0.001f); } }
    __syncthreads();
}
__device__ __forceinline__ void chk_moe(Frame& F, int l, int chk) {
    if (F.vcu >= NSAMP) return; const int row = sample_row(F.vcu); if (row >= NLAT && l > 0) return;
    LAS float* hs = (LAS float*)(F.lds + RING_OFF); LAS float* act = hs + 1024;
    const unsigned char* H = F.ws + WS_H + (size_t)row * DM; for (int k = F.tid; k < DM; k += NTHR) hs[k] = __builtin_amdgcn_cvt_f32_fp8((int)H[k], 0);
    __syncthreads();
    const int* rt_e = (const int*)(F.ws + WS_ROUTE + RT_E); const float* rt_w = (const float*)(F.ws + WS_ROUTE + RT_W); const bf16* YB = (const bf16*)(F.ws + WS_YBUF);
    for (int kk = 0; kk < 4; ++kk) { const int e = rt_e[(size_t)row * 4 + kk]; const float w = rt_w[(size_t)row * 4 + kk];
        const float* Wg = in_l(F, I_WGU, l * NEXP + e, (size_t)1024 * 2048); const float* bg = in_l(F, I_BGU, l * NEXP + e, 2048); const float* Wd = in_l(F, I_WDN, l * NEXP + e, (size_t)1024 * 1024); const float* bd = in_l(F, I_BDN, l * NEXP + e, 1024);
        for (int j = F.tid; j < 1024; j += NTHR) { float sg = 0.f, su = 0.f; for (int k = 0; k < DM; ++k) { sg += hs[k] * bfr(Wg[(size_t)k * 2048 + 2 * j]); su += hs[k] * bfr(Wg[(size_t)k * 2048 + 2 * j + 1]); }
            sg += bg[2 * j]; su += bg[2 * j + 1]; const float ga = fminf(sg, 7.0f), ua = fminf(fmaxf(su, -7.0f), 7.0f); act[j] = bfr((ua + 1.0f) * (ga / (1.0f + expf(-1.702f * ga)))); }
        __syncthreads();
        for (int n = F.tid; n < 1024; n += NTHR) { float s = 0.f; for (int j = 0; j < 1024; ++j) s += act[j] * bfr(Wd[(size_t)j * 1024 + n]); dbg_note(F, chk, bf2f(YB[(size_t)(row * 4 + kk) * 1024 + n]), (s + bd[n]) * w, 0.05f, 0.3f); }
        __syncthreads(); }
}

constexpr int PH_PRO_A = 0, PH_PRO_B = 1, PH_L0 = 2, NPL = 11, N_PHASES = PH_L0 + DEPTH * NPL;
enum { LP_IN = 0, LP_QKV, LP_VT, LP_ATTN, LP_MERGE, LP_OUT, LP_ROUTE, LP_GATHER, LP_GU, LP_DN, LP_COMB };

__global__ void __launch_bounds__(NTHR, 2) trunk_fwd(Args args) {
    extern __shared__ __attribute__((aligned(16))) unsigned char lds[];
    Frame F;
    F.lds = (LAS unsigned char*)lds; F.MISC = (volatile LAS unsigned*)(F.lds + MISC_OFF);
    F.tid = threadIdx.x; F.lane = F.tid & 63; F.wave = __builtin_amdgcn_readfirstlane(F.tid >> 6);
    F.G = gridDim.x; { const int bx = blockIdx.x; F.vcu = (F.G % 8 == 0) ? (bx % 8) * (F.G / 8) + bx / 8 : bx; }
    F.ws = args.ws; F.ctl = (unsigned*)(args.ws + WS_CTL); F.in = args.in; F.out = args.out;
    for (int u = F.tid; u < (LDS_BYTES - TBL_OFF) / 4; u += NTHR) ((LAS unsigned*)(F.lds + TBL_OFF))[u] = 0u;
    __syncthreads();
    const int lo = args.ph_lo, hi = args.ph_hi;
#if DBG_CHECK
    if (lo >= 1000) { const int c = lo - 1000;
        if (c == 1) chk_in(F, 0, 1); else if (c == 2) chk_qkv(F, 0, 2); else if (c == 3) chk_attn(F, 0, 3); else if (c == 6) chk_merge(F, 0, 6); else if (c == 7) chk_out(F, 0, 7, nullptr);
        else if (c == 8) chk_route(F, 0, 8); else if (c == 9) chk_moe(F, 0, 9); else if (c == 11) chk_in(F, 1, 11); else if (c == 13) chk_attn(F, 1, 13); else if (c == 99) p_dbg_emit(F);
        return; }
#endif
    XcdBarrier bar; bar.bar = F.ctl + CW_BAR; bar.x = 0; bar.st = nullptr;
    if (MK_ONE_LAUNCH) bar = xcd_barrier_post(F.ctl + CW_BAR, F.MISC + 8);
#define IN(k) (lo <= (k) && (k) < hi)
#define SEAM(k) do { F.tid = threadIdx.x; asm volatile("" : "+v"(F.tid)); F.lane = F.tid & 63; asm volatile("" : "+s"(F.ws), "+s"(bar.bar), "+s"(F.lds), "+s"(bar.st));     \
        if (MK_ONE_LAUNCH && IN(k) && IN((k) + 1)) xcd_barrier(bar); } while (0)

    if (IN(PH_PRO_A)) { p_prologue_a(F); if (DUP_MASK & 4) { __syncthreads(); p_prologue_a(F); } } SEAM(PH_PRO_A);
    if (IN(PH_PRO_B)) { p_prologue_b(F); if (DUP_MASK & 512) { __syncthreads(); p_prologue_b(F); } } SEAM(PH_PRO_B);
    for (int l = 0; l < DEPTH; ++l) {
        F.tid = threadIdx.x; asm volatile("" : "+v"(F.tid)); F.lane = F.tid & 63;
        int bx_ = (int)blockIdx.x; asm volatile("" : "+s"(bx_), "+s"(F.G), "+s"(F.vcu));
        const int pb = PH_L0 + l * NPL; const int Ml = (l == DEPTH - 1) ? NLAT : MTOT;
        float* ssq_q = (float*)(F.ws + CTL_SSQ); float* ssq_kv = ssq_q + (size_t)MTOT * 8;
        const float* tabA = (const float*)(F.ws + WS_TAB); const float* tabC = tabA + 192 * 16 * 2;
        if (IN(pb + LP_IN)) for (int rep_ = 0; rep_ < (((DUP_MASK & 2) || (DUP_MASK & 8)) ? 2 : 1); ++rep_) {
            Gemm g{(const bf16_t*)(F.ws + WS_H), (const bf16_t*)(F.ws + WS_WIN + (size_t)l * NINP * DM * 2), MTOT, NINP, F8_INL(l) ? DM / 2 : DM};   StaticOrder S; S.init(MTOT, NINP, F.G, bx_);
            EpiIn E{(bf16_t*)(F.ws + WS_QA), (bf16_t*)(F.ws + WS_KA), (bf16_t*)(F.ws + WS_VA), (bf16_t*)(F.ws + WS_QB), (bf16_t*)(F.ws + WS_KB), (bf16_t*)(F.ws + WS_VB),
                    (bf16_t*)(F.ws + WS_CQ), (bf16_t*)(F.ws + WS_CKR), (bf16_t*)(F.ws + WS_CKV), (bf16_t*)(F.ws + WS_GATES), ssq_q, ssq_kv, tabA, tabC, F8_INL(l) ? WINV : 1.0f, F.ws + WS_VTA};
            if (F8_INL(l)) gemm_phase<EpiIn, StaticOrder, true, true, true>(F.lds + RING_OFF, g, S, E); else gemm_phase<EpiIn, StaticOrder, true, true, false>(F.lds + RING_OFF, g, S, E);
        }
        SEAM(pb + LP_IN);
        if (IN(pb + LP_QKV)) for (int rep_ = 0; rep_ < (((DUP_MASK & 2) || (DUP_MASK & 16)) ? 2 : 1); ++rep_) {
            { Gemm g{(const bf16_t*)(F.ws + WS_CQ), (const bf16_t*)(F.ws + WS_WQB) + (size_t)l * 768 * 384, MTOT, 768, 384}; StaticOrder S; S.init(MTOT, 768, F.G, bx_);
              EpiQ E{(bf16_t*)(F.ws + WS_QC), ssq_q, tabC}; gemm_phase<EpiQ, StaticOrder, true, true>(F.lds + RING_OFF, g, S, E); }
            { Gemm g{(const bf16_t*)(F.ws + WS_CKV), (const bf16_t*)(F.ws + WS_WKVB) + (size_t)l * 1024 * 256, MTOT, 1024, 256}; StaticOrder S; S.init(MTOT, 1024, F.G, bx_);
              EpiKV E{(bf16_t*)(F.ws + WS_KCN), (bf16_t*)(F.ws + WS_VC), ssq_kv, F.ws + WS_VTC}; gemm_phase<EpiKV, StaticOrder, true, true>(F.lds + RING_OFF, g, S, E); }
        }
        SEAM(pb + LP_QKV);
        if (IN(pb + LP_ATTN)) { p_attention(F, l); if (DUP_MASK & 1) { __syncthreads(); p_attention(F, l); } }
        SEAM(pb + LP_ATTN);
        if (IN(pb + LP_MERGE)) for (int rep_ = 0; rep_ < (((DUP_MASK & 2) || (DUP_MASK & 32)) ? 2 : 1); ++rep_) {
            Gemm g{(const bf16_t*)(F.ws + WS_YA), (const bf16_t*)(F.ws + WS_WBR + (size_t)l * 3 * 1024 * 512), Ml, 1024, 256};   MergeOrder S; S.S.init(Ml, 1024, F.G, bx_);
            EpiMerge E{(const bf16_t*)(F.ws + WS_GATES), F.ws + WS_M32, (bf16_t*)(F.ws + WS_MB)}; gemm_phase<EpiMerge, MergeOrder, true, true, true>(F.lds + RING_OFF, g, S, E);
        }
        SEAM(pb + LP_MERGE);
        if (IN(pb + LP_OUT)) for (int rep_ = 0; rep_ < (((DUP_MASK & 1024) && l == 0) ? 2 : 1); ++rep_) {
            Gemm g{(const bf16_t*)(F.ws + WS_M32), (const bf16_t*)(F.ws + WS_WOUT + (size_t)l * 1024 * 1024), Ml, 1024, 512};   StaticOrder S; S.init(Ml, 1024, F.G, bx_);
            EpiOut E{F.in[I_X], F.in[I_CTX], (bf16_t*)(F.ws + WS_X), (const float*)(F.ws + WS_MODV) + (size_t)l * 5 * 6144, l == 0};
            gemm_phase<EpiOut, StaticOrder, true, true, true>(F.lds + RING_OFF, g, S, E);
        }
        SEAM(pb + LP_OUT);
        if (IN(pb + LP_ROUTE)) { if (DUP_MASK & 2048) { p_route(F, l, Ml, 2 + l); __syncthreads(); } p_route(F, l, Ml, l); }
        SEAM(pb + LP_ROUTE);
        if (IN(pb + LP_GU)) for (int rep_ = 0; rep_ < (((DUP_MASK & 2) || (DUP_MASK & 64)) ? 2 : 1); ++rep_) {
            const int T = build_expert_tables(F, l);
            Gemm g{(const bf16_t*)(F.ws + WS_H), (const bf16_t*)(F.ws + WS_WGU + (size_t)l * NEXP * 2048 * 1024 * (F8_MOE ? 1 : 2)), T * 256, 2048, F8_MOE ? 512 : 1024, (const int*)(F.ws + WS_ROUTE + RT_YSRC)};
            ExpertOrder S; S.S.init(T * 256, 2048, F.G, bx_); S.tile_e = (const LAS int*)(F.lds + TBL_OFF + TB_TILE); S.nNe = 8;
            S.xs = (const int*)(F.ws + WS_XS); S.base = (const LAS int*)(F.lds + TBL_OFF + TB_BASE); S.cnt = (const LAS int*)(F.lds + TBL_OFF + TB_CNT);
            EpiGU E{(bf16_t*)(F.ws + WS_ACT), in_l(F, I_BGU, l, NEXP * 2048)}; gemm_phase<EpiGU, ExpertOrder, true, true, F8_MOE != 0, true>(F.lds + RING_OFF, g, S, E);
        }
        SEAM(pb + LP_GU);
        if (IN(pb + LP_DN)) for (int rep_ = 0; rep_ < (((DUP_MASK & 2) || (DUP_MASK & 128)) ? 2 : 1); ++rep_) {
            const int T = build_expert_tables(F, l);
            Gemm g{(const bf16_t*)(F.ws + WS_ACT), (const bf16_t*)(F.ws + WS_WDN + (size_t)l * NEXP * 1024 * 1024 * (F8_MOE ? 1 : 2)), T * 256, 1024, F8_MOE ? 512 : 1024};
            ExpertOrder S; S.S.init(T * 256, 1024, F.G, bx_); S.tile_e = (const LAS int*)(F.lds + TBL_OFF + TB_TILE); S.nNe = 4;
            EpiDown E{(bf16_t*)(F.ws + WS_YBUF), in_l(F, I_BDN, l, NEXP * 1024), (const int*)(F.ws + WS_XS), (const float*)(F.ws + WS_XW), (const LAS int*)(F.lds + TBL_OFF + TB_BASE), (const LAS int*)(F.lds + TBL_OFF + TB_CNT)};
            gemm_phase<EpiDown, ExpertOrder, true, true, F8_MOE != 0>(F.lds + RING_OFF, g, S, E);
        }
        SEAM(pb + LP_DN);
        if (IN(pb + LP_COMB)) p_combine(F, l, Ml);
        SEAM(pb + LP_COMB);
    }
#undef IN
#undef SEAM
}

extern "C" void kernel_launch(void* const* d_in, const int* in_sizes, int n_in, void* d_out, int out_size, void* d_ws, size_t ws_size, hipStream_t stream) {
    static int grid = 0;
    if (grid == 0) {
        if (n_in != 30 || out_size != NLAT * DM || ws_size < WS_END) { fprintf(stderr, "kernel_launch: shape mismatch n_in %d out %d ws %zu (need %zu)\n", n_in, out_size, ws_size, (size_t)WS_END); grid = -1; return; }
        int dev = 0, cus = 0, per_cu = 0;
        if (hipGetDevice(&dev) != hipSuccess || hipDeviceGetAttribute(&cus, hipDeviceAttributeMultiprocessorCount, dev) != hipSuccess) { grid = -1; return; }
        if (hipFuncSetAttribute((const void*)trunk_fwd, hipFuncAttributeMaxDynamicSharedMemorySize, LDS_BYTES) != hipSuccess) { fprintf(stderr, "kernel_launch: hipFuncSetAttribute failed\n"); grid = -1; return; }
        if (hipOccupancyMaxActiveBlocksPerMultiprocessor(&per_cu, (const void*)trunk_fwd, NTHR, LDS_BYTES) != hipSuccess || per_cu < 1) { fprintf(stderr, "kernel_launch: occupancy query says %d\n", per_cu); }
        (void)hipGetLastError();
        grid = cus;
    }
    if (grid < 0) return;
    (void)hipMemsetAsync((char*)d_ws + WS_CTL, 0, CTL_ZERO_BYTES, stream);
    Args a{};
    for (int i = 0; i < 30; ++i) a.in[i] = (const float*)d_in[i];
    a.out = (float*)d_out; a.ws = (unsigned char*)d_ws;
#if MK_ONE_LAUNCH
    a.ph_lo = 0; a.ph_hi = N_PHASES;
    hipLaunchKernelGGL(trunk_fwd, dim3(grid), dim3(NTHR), LDS_BYTES, stream, a);
#else
    for (int p = 0; p < N_PHASES; ++p) { a.ph_lo = p; a.ph_hi = p + 1; hipLaunchKernelGGL(trunk_fwd, dim3(grid), dim3(NTHR), LDS_BYTES, stream, a);
#if DBG_CHECK
        int c = 0; const int q = p - PH_L0;
        if (q == LP_IN) c = 1; else if (q == LP_QKV) c = 2; else if (q == LP_ATTN) c = 3; else if (q == LP_MERGE) c = 6; else if (q == LP_OUT) c = 7; else if (q == LP_ROUTE) c = 8; else if (q == LP_DN) c = 9;
        else if (q == NPL + LP_IN) c = 11; else if (q == NPL + LP_ATTN) c = 13;
        if (c) { a.ph_lo = 1000 + c; a.ph_hi = 0; hipLaunchKernelGGL(trunk_fwd, dim3(grid), dim3(NTHR), LDS_BYTES, stream, a); }
        if (p == DBG_LAST_PHASE) break;
#endif
    }
#if DBG_CHECK
    a.ph_lo = 1099; a.ph_hi = 0; hipLaunchKernelGGL(trunk_fwd, dim3(grid), dim3(NTHR), LDS_BYTES, stream, a);
#endif
#endif
    const hipError_t le = hipPeekAtLastError();
    if (le != hipSuccess) fprintf(stderr, "kernel_launch: launch failed: %s\n", hipGetErrorName(le));
}
```

```cpp
#include <hip/hip_runtime.h>
#include <cstdio>
#include <cstdint>

#ifndef MK_ONE_LAUNCH
#define MK_ONE_LAUNCH 1
#endif
#ifndef DBG_CHECK
#define DBG_CHECK 0
#endif

#ifndef DBG_LAST_PHASE
#define DBG_LAST_PHASE 9999
#endif
#ifndef DUP_MASK
#define DUP_MASK 0
#endif
#ifndef F8_IN0
#define F8_IN0 1
#endif
#ifndef F8_IN1
#define F8_IN1 1
#endif
#define F8_INL(l) ((l) == 0 ? (F8_IN0 != 0) : (F8_IN1 != 0))
#ifndef F8_MOE
#define F8_MOE 1
#endif
namespace pg8 {
#define PG8_LAS __attribute__((address_space(3)))
typedef unsigned short bf16_t;
typedef short bf16x8 __attribute__((ext_vector_type(8)));
typedef float f32x4 __attribute__((ext_vector_type(4)));
typedef unsigned u32x4 __attribute__((ext_vector_type(4)));
constexpr int BM = 256, BK = 64, HALF = 128, HTB = HALF * BK * 2  , STAGE_BYTES = 8 * HTB, NXCD = 8, WGM = 8;

__host__ __device__ __forceinline__ int lds_byte(int r, int c) { const int st = (r >> 4) * 2 + (c >> 5), rr = r & 15, cc = c & 31, ob = rr * 64 + cc * 2; return st * 1024 + (ob ^ (((ob >> 9) & 1) << 5)); }
__host__ __device__ __forceinline__ void stage_rc(int b, int& R, int& C) { const int st = b / 1024, sb = b % 1024, swz = sb ^ (((sb >> 9) & 1) << 5); R = (st >> 1) * 16 + swz / 64; C = (st & 1) * 32 + (swz % 64) / 2; }
__host__ __device__ __forceinline__ int perm32(int rho) { const int n = rho >> 4, i = rho & 15; return 8 * (i >> 2) + 4 * n + (i & 3); }

struct Unit { int pm, pn; };
struct Gemm { const bf16_t* A; const bf16_t* Bt; int M, N, K; const int* rowsrc = nullptr; };

struct StaticOrder {
    int nM, nN, nwg, G, c;
    __host__ __device__ void init(int M, int N, int G_, int c_) { nM = M / BM; nN = N / BM; nwg = nM * nN; G = G_; c = c_; }
    __host__ __device__ bool next(int i, Unit& u) const {
        const long L = (long)i * G + c; if (L >= nwg) return false;
        int wgid = (int)L; { const int q = nwg / NXCD, r = nwg % NXCD, xcd = wgid % NXCD, off = wgid / NXCD; wgid = (xcd < r ? xcd * (q + 1) : r * (q + 1) + (xcd - r) * q) + off; }
        const int nig = WGM * nN, gid = wgid / nig, fm = gid * WGM, gsz = (nM - fm) < WGM ? (nM - fm) : WGM;
        u.pm = fm + ((wgid % nig) % gsz); u.pn = (wgid % nig) / gsz; return true;
    }
    __device__ __forceinline__ void a_ready(const Unit&) const {}
    __device__ __forceinline__ void done(const Unit&) const {}
};


constexpr int DM = 1024, NBATCH = 4, SEQ = 8192, NLAT = NBATCH * SEQ, CTXL = 256, NCTX = NBATCH * CTXL, MTOT = NLAT + NCTX;
constexpr int DEPTH = 2, DIN = 6816, NINP = 6912, NEXP = 32, TOPK = 4;
constexpr int PM_CTX = NLAT / 256;
constexpr float LOG2E = 1.4426950408889634f;
constexpr float QSCALE_AB = 0.125f * LOG2E;
constexpr float QSCALE_C = 0.10206207261596575f * LOG2E;
constexpr float EPS = 1e-6f;
constexpr float YS_A = 16.0f, YS_BC = 64.0f, MS8 = 32.0f;
constexpr float WSCALE = 64.0f, WINV = 1.0f / 64.0f;
constexpr int OFF_CQ = 3072, OFF_CKR = 3456, OFF_PADW = 3488, OFF_CKV = 3584, OFF_GATES = 3840;

typedef float f32x2 __attribute__((ext_vector_type(2)));
typedef __bf16 bf16x2c_t __attribute__((ext_vector_type(2)));
__device__ __forceinline__ unsigned cvt_pk_bf16(float lo, float hi) { const f32x2 v = {lo, hi}; const bf16x2c_t b = __builtin_convertvector(v, bf16x2c_t); return __builtin_bit_cast(unsigned, b); }
__device__ __forceinline__ u32x4 pack8(const f32x4 a, const f32x4 b) { u32x4 w; w.x = cvt_pk_bf16(a[0], a[1]); w.y = cvt_pk_bf16(a[2], a[3]); w.z = cvt_pk_bf16(b[0], b[1]); w.w = cvt_pk_bf16(b[2], b[3]); return w; }
__device__ __forceinline__ float bf_lo(unsigned w) { return __uint_as_float(w << 16); }
__device__ __forceinline__ float bf_hi(unsigned w) { return __uint_as_float(w & 0xffff0000u); }
typedef unsigned u32x2x_t __attribute__((ext_vector_type(2)));
__device__ __forceinline__ float4 xb_ld4_(const unsigned short* p) { const u32x2x_t w = *(const u32x2x_t*)p; return make_float4(bf_lo(w.x), bf_hi(w.x), bf_lo(w.y), bf_hi(w.y)); }
__device__ __forceinline__ void rope8(f32x4& v0, f32x4& v1, const f32x4 cs0, const f32x4 cs1) {
    const f32x4 r0 = (f32x4){v0[0] * cs0[0] - v0[1] * cs0[1], v0[1] * cs0[0] + v0[0] * cs0[1], v0[2] * cs0[2] - v0[3] * cs0[3], v0[3] * cs0[2] + v0[2] * cs0[3]};
    const f32x4 r1 = (f32x4){v1[0] * cs1[0] - v1[1] * cs1[1], v1[1] * cs1[0] + v1[0] * cs1[1], v1[2] * cs1[2] - v1[3] * cs1[3], v1[3] * cs1[2] + v1[2] * cs1[3]};
    v0 = r0; v1 = r1;
}
__device__ __forceinline__ unsigned pk4_fp8(float a, float b, float c, float d) {
    a = __builtin_amdgcn_fmed3f(a, -448.f, 448.f); b = __builtin_amdgcn_fmed3f(b, -448.f, 448.f); c = __builtin_amdgcn_fmed3f(c, -448.f, 448.f); d = __builtin_amdgcn_fmed3f(d, -448.f, 448.f);
    int w = 0; w = __builtin_amdgcn_cvt_pk_fp8_f32(a, b, w, false); w = __builtin_amdgcn_cvt_pk_fp8_f32(c, d, w, true); return (unsigned)w; }
__device__ __forceinline__ unsigned char f8_one(float a) { a = fminf(fmaxf(a, -448.0f), 448.0f); return (unsigned char)(__builtin_amdgcn_cvt_pk_fp8_f32(a, 0.0f, 0, false) & 0xff); }
__device__ __forceinline__ float sigmoidf_(float x) { return __builtin_amdgcn_rcpf(1.0f + __builtin_amdgcn_exp2f(-x * LOG2E)); }

constexpr float WINV_MOE = F8_MOE ? WINV : 1.0f;
__device__ __forceinline__ int vt_slot8(int k) { const int half = k >> 5, kk = k & 31, hi = (kk >> 2) & 1, r = (kk & 3) + 4 * (kk >> 3); return 32 * hi + r + 16 * half; }
__device__ __forceinline__ void vt_put8(unsigned char* dp, const f32x4 v0, const f32x4 v1) {
    const unsigned w0 = pk4_fp8(v0[0], v0[1], v0[2], v0[3]), w1 = pk4_fp8(v1[0], v1[1], v1[2], v1[3]);
#pragma unroll
    for (int i = 0; i < 4; ++i) { dp[i * 64] = (unsigned char)(w0 >> (8 * i)); dp[(4 + i) * 64] = (unsigned char)(w1 >> (8 * i)); }
}
struct EpiIn {
    static constexpr bool PERM = true, AFTER_DRAIN = false;
    bf16_t *QA, *KA, *VA, *QB, *KB, *VB, *CQ, *CKR, *CKV, *GATES; float *ssq_q, *ssq_kv; const float* tabA; const float* tabC; float WINV_IN; unsigned char* VTA;
    __device__ __forceinline__ void operator()(const f32x4 (&acc)[2][2][4][2], const Unit& u, int wr, int wc, int fr, int fq) const {
        asm volatile("" : "+v"(fr), "+v"(fq));
        const int pn = u.pn; const bool ctx = u.pm >= PM_CTX;
        const int row0 = u.pm * BM + wr * 64 + fr;
        if (pn < 12) {
            const int seg = pn >> 1; bf16_t* base = seg == 0 ? QA : seg == 1 ? KA : seg == 2 ? VA : seg == 3 ? QB : seg == 4 ? KB : VB;
            const float sc = ((seg == 0 || seg == 3) ? QSCALE_AB : seg == 1 ? 8.0f : 1.0f) * WINV_IN; const bool rope = (seg <= 1) && !ctx;
            const int col0 = (pn & 1) * 256 + wc * 32 + 8 * fq;
#pragma unroll
            for (int ai = 0; ai < 2; ++ai) {
                const int gr = ((u.pm * 4 + ai * 2 + wr) & 127);
#pragma unroll
                for (int m = 0; m < 4; ++m) {
                    const int row = row0 + ai * HALF + m * 16; bf16_t* rowp = base + (size_t)row * 512 + col0;
                    f32x4 cs0 = (f32x4){1.f, 0.f, 1.f, 0.f}, cs1 = cs0;
                    if (rope) { const int trow = (wc & 1) ? 128 + m * 16 + fr : gr; const f32x4* tp = (const f32x4*)(tabA + (size_t)(trow * 16 + 4 * fq) * 2); cs0 = tp[0]; cs1 = tp[1]; }
#pragma unroll
                    for (int bj = 0; bj < 2; ++bj) { f32x4 v0 = acc[ai][bj][m][0] * sc, v1 = acc[ai][bj][m][1] * sc; rope8(v0, v1, cs0, cs1);
                        if (seg == 1) { typedef unsigned u32x2_ __attribute__((ext_vector_type(2))); *(u32x2_*)((unsigned char*)KA + (size_t)row * 512 + col0 + bj * HALF) = (u32x2_){pk4_fp8(v0[0], v0[1], v0[2], v0[3]), pk4_fp8(v1[0], v1[1], v1[2], v1[3])}; }
                        else if (seg == 2) vt_put8(VTA + ((size_t)((row >> 6) * 4 + (pn & 1) * 2 + bj) * 128 + wc * 32 + 8 * fq) * 64 + vt_slot8(row & 63), v0, v1);
                        else *(u32x4*)(rowp + bj * HALF) = pack8(v0, v1); }
                }
            }
        } else if (pn == 12 || pn == 14) {
            bf16_t* base = pn == 12 ? CQ : CKV; const int ld = pn == 12 ? 384 : 256; float* ssq = pn == 12 ? ssq_q : ssq_kv; const int sst = pn == 12 ? 8 : 4;
            const int col0 = wc * 32 + 8 * fq;
#pragma unroll
            for (int ai = 0; ai < 2; ++ai)
#pragma unroll
                for (int m = 0; m < 4; ++m) {
                    const int row = row0 + ai * HALF + m * 16; bf16_t* rowp = base + (size_t)row * ld + col0; float s = 0.f;
#pragma unroll
                    for (int bj = 0; bj < 2; ++bj) { const f32x4 v0 = acc[ai][bj][m][0] * WINV_IN, v1 = acc[ai][bj][m][1] * WINV_IN; *(u32x4*)(rowp + bj * HALF) = pack8(v0, v1);
                        s += (v0[0] * v0[0] + v0[1] * v0[1]) + (v0[2] * v0[2] + v0[3] * v0[3]) + (v1[0] * v1[0] + v1[1] * v1[1]) + (v1[2] * v1[2] + v1[3] * v1[3]); }
                    s += __shfl_xor(s, 16); s += __shfl_xor(s, 32);
                    if (fq == 0) ssq[(size_t)row * sst + wc] = s;
                }
        } else if (pn == 13) {
#pragma unroll
            for (int ai = 0; ai < 2; ++ai) {
                const int gr = ((u.pm * 4 + ai * 2 + wr) & 127);
#pragma unroll
                for (int m = 0; m < 4; ++m) {
                    const int row = row0 + ai * HALF + m * 16;
                    { const f32x4 v0 = acc[ai][0][m][0] * WINV_IN, v1 = acc[ai][0][m][1] * WINV_IN; *(u32x4*)(CQ + (size_t)row * 384 + 256 + wc * 32 + 8 * fq) = pack8(v0, v1);
                      float s = (v0[0] * v0[0] + v0[1] * v0[1]) + (v0[2] * v0[2] + v0[3] * v0[3]) + (v1[0] * v1[0] + v1[1] * v1[1]) + (v1[2] * v1[2] + v1[3] * v1[3]);
                      s += __shfl_xor(s, 16); s += __shfl_xor(s, 32); if (fq == 0) ssq_q[(size_t)row * 8 + 4 + wc] = s; }
                    if (wc == 0) {
                        f32x4 v0 = acc[ai][1][m][0] * WINV_IN, v1 = acc[ai][1][m][1] * WINV_IN;
                        if (!ctx) { const int trow = (fq >= 2) ? 128 + m * 16 + fr : gr; const f32x4* tp = (const f32x4*)(tabC + (size_t)(trow * 8 + 4 * (fq & 1)) * 2); rope8(v0, v1, tp[0], tp[1]); }
                        *(u32x4*)(CKR + (size_t)row * 32 + 8 * fq) = pack8(v0, v1);
                    }
                }
            }
        } else {
            const int col0 = (pn - 15) * 256 + wc * 32 + 8 * fq;
#pragma unroll
            for (int ai = 0; ai < 2; ++ai)
#pragma unroll
                for (int m = 0; m < 4; ++m) {
                    const int row = row0 + ai * HALF + m * 16; unsigned char* rowp = (unsigned char*)GATES + (size_t)row * 3072 + col0;
#pragma unroll
                    for (int bj = 0; bj < 2; ++bj) { f32x4 v0 = acc[ai][bj][m][0] * WINV_IN, v1 = acc[ai][bj][m][1] * WINV_IN;
#pragma unroll
                        for (int j = 0; j < 4; ++j) { v0[j] = sigmoidf_(v0[j]) * 256.0f; v1[j] = sigmoidf_(v1[j]) * 256.0f; }
                        typedef unsigned u32x2_ __attribute__((ext_vector_type(2))); *(u32x2_*)(rowp + bj * HALF) = (u32x2_){pk4_fp8(v0[0], v0[1], v0[2], v0[3]), pk4_fp8(v1[0], v1[1], v1[2], v1[3])}; }
                }
        }
    }
};
struct EpiQ {
    static constexpr bool PERM = true, AFTER_DRAIN = false;
    bf16_t* QC; const float* ssq_q; const float* tabC;
    __device__ __forceinline__ void operator()(const f32x4 (&acc)[2][2][4][2], const Unit& u, int wr, int wc, int fr, int fq) const {
        asm volatile("" : "+v"(fr), "+v"(fq));
        const bool ctx = u.pm >= PM_CTX; const int row0 = u.pm * BM + wr * 64 + fr;
        const int cA = u.pn * BM + wc * 32 + 8 * fq, cB = cA + HALF, pA = cA % 96, pB = cB % 96; const bool peA = (pA >= 64) && !ctx, peB = (pB >= 64) && !ctx;
        const int iA = peA ? (pA - 64) >> 1 : 0, iB = peB ? (pB - 64) >> 1 : 0;
#pragma unroll
        for (int ai = 0; ai < 2; ++ai) {
            const int gr = ((u.pm * 4 + ai * 2 + wr) & 127);
#pragma unroll
            for (int m = 0; m < 4; ++m) {
                const int row = row0 + ai * HALF + m * 16; const int gc = 128 + m * 16 + fr;
                const f32x4 sa = *(const f32x4*)(ssq_q + (size_t)row * 8), sb = *(const f32x4*)(ssq_q + (size_t)row * 8 + 4);
                const float rs = __builtin_amdgcn_rsqf((((sa[0] + sa[1]) + (sa[2] + sa[3])) + ((sb[0] + sb[1]) + (sb[2] + sb[3]))) * (1.0f / 384.0f) + EPS) * QSCALE_C;
                { const f32x4* tp = (const f32x4*)(tabC + (size_t)((iA >= 8 ? gc : gr) * 8 + (iA & 7)) * 2); f32x4 cs0 = tp[0], cs1 = tp[1]; if (!peA) { cs0 = (f32x4){1.f, 0.f, 1.f, 0.f}; cs1 = cs0; }
                  f32x4 v0 = acc[ai][0][m][0] * rs, v1 = acc[ai][0][m][1] * rs; rope8(v0, v1, cs0, cs1); *(u32x4*)(QC + (size_t)row * 768 + cA) = pack8(v0, v1); }
                { const f32x4* tp = (const f32x4*)(tabC + (size_t)((iB >= 8 ? gc : gr) * 8 + (iB & 7)) * 2); f32x4 cs0 = tp[0], cs1 = tp[1]; if (!peB) { cs0 = (f32x4){1.f, 0.f, 1.f, 0.f}; cs1 = cs0; }
                  f32x4 v0 = acc[ai][1][m][0] * rs, v1 = acc[ai][1][m][1] * rs; rope8(v0, v1, cs0, cs1); *(u32x4*)(QC + (size_t)row * 768 + cB) = pack8(v0, v1); }
                __builtin_amdgcn_sched_barrier(0);
            }
        }
    }
};
struct EpiKV {
    static constexpr bool PERM = true, AFTER_DRAIN = false;
    bf16_t *KCN, *VC; const float* ssq_kv; unsigned char* VTC;
    __device__ __forceinline__ void operator()(const f32x4 (&acc)[2][2][4][2], const Unit& u, int wr, int wc, int fr, int fq) const {
        asm volatile("" : "+v"(fr), "+v"(fq));
        const int row0 = u.pm * BM + wr * 64 + fr; bf16_t* base = u.pn < 2 ? KCN : VC; const int col0 = (u.pn & 1) * 256 + wc * 32 + 8 * fq;
#pragma unroll
        for (int ai = 0; ai < 2; ++ai)
#pragma unroll
            for (int m = 0; m < 4; ++m) {
                const int row = row0 + ai * HALF + m * 16; const f32x4 sa = *(const f32x4*)(ssq_kv + (size_t)row * 4); const float rs = __builtin_amdgcn_rsqf(((sa[0] + sa[1]) + (sa[2] + sa[3])) * (1.0f / 256.0f) + EPS); bf16_t* rowp = base + (size_t)row * 512 + col0;
#pragma unroll
                for (int bj = 0; bj < 2; ++bj) {
                    if (u.pn < 2) { typedef unsigned u32x2_ __attribute__((ext_vector_type(2))); const f32x4 v0 = acc[ai][bj][m][0] * (rs * 8.0f), v1 = acc[ai][bj][m][1] * (rs * 8.0f);
                        *(u32x2_*)((unsigned char*)KCN + (size_t)row * 512 + col0 + bj * HALF) = (u32x2_){pk4_fp8(v0[0], v0[1], v0[2], v0[3]), pk4_fp8(v1[0], v1[1], v1[2], v1[3])}; }
                    else vt_put8(VTC + ((size_t)((row >> 6) * 8 + (u.pn & 1) * 4 + bj * 2 + (wc >> 1)) * 64 + (wc & 1) * 32 + 8 * fq) * 64 + vt_slot8(row & 63), acc[ai][bj][m][0] * rs, acc[ai][bj][m][1] * rs); }
            }
    }
};
constexpr int MT_ROWS = MTOT / 256;
struct EpiMerge {
    static constexpr bool PERM = true, AFTER_DRAIN = false;
    const bf16_t* GATES; unsigned char* M8; bf16_t* MB;
    __device__ __forceinline__ void operator()(const f32x4 (&acc)[2][2][4][2], const Unit& u, int wr, int wc, int fr, int fq) const {
        asm volatile("" : "+v"(fr), "+v"(fq));
        const int br = u.pn >> 2, pn = u.pn & 3, pm = u.pm - br * MT_ROWS; const int row0 = pm * BM + wr * 64 + fr, col0 = pn * BM + wc * 32 + 8 * fq;
        const float us = WINV / (br == 0 ? YS_A : YS_BC);
        typedef unsigned u32x2g_ __attribute__((ext_vector_type(2)));
        u32x2g_ g8[2][4][2];
#pragma unroll
        for (int ai = 0; ai < 2; ++ai)
#pragma unroll
            for (int m = 0; m < 4; ++m)
#pragma unroll
                for (int bj = 0; bj < 2; ++bj) g8[ai][m][bj] = *(const u32x2g_*)((const unsigned char*)GATES + (size_t)(row0 + ai * HALF + m * 16) * 3072 + br * 1024 + col0 + bj * HALF);
#pragma unroll
        for (int am = 0; am < 4; ++am) { const int ai = am >> 1, mh = (am & 1) * 2;
            u32x4 gq[2][2], mq[2][2];
#pragma unroll
            for (int m2 = 0; m2 < 2; ++m2)
#pragma unroll
                for (int bj = 0; bj < 2; ++bj) { const int row = row0 + ai * HALF + (mh + m2) * 16;
                    gq[m2][bj] = (u32x4){g8[ai][mh + m2][bj].x, g8[ai][mh + m2][bj].y, 0u, 0u};
                    if (br > 0) mq[m2][bj] = *(const u32x4*)(MB + (size_t)row * 1024 + col0 + bj * HALF); else mq[m2][bj] = (u32x4){0u, 0u, 0u, 0u}; }
#pragma unroll
            for (int m2 = 0; m2 < 2; ++m2) { const int m = mh + m2;
                const int row = row0 + ai * HALF + m * 16;
#pragma unroll
                for (int bj = 0; bj < 2; ++bj) {
                    const u32x4 g = gq[m2][bj], q = mq[m2][bj];
                    const float ug = us * (1.0f / 256.0f);
                    f32x4 v0 = acc[ai][bj][m][0] * ug * (f32x4){__builtin_amdgcn_cvt_f32_fp8((int)g.x, 0), __builtin_amdgcn_cvt_f32_fp8((int)g.x, 1), __builtin_amdgcn_cvt_f32_fp8((int)g.x, 2), __builtin_amdgcn_cvt_f32_fp8((int)g.x, 3)},
                          v1 = acc[ai][bj][m][1] * ug * (f32x4){__builtin_amdgcn_cvt_f32_fp8((int)g.y, 0), __builtin_amdgcn_cvt_f32_fp8((int)g.y, 1), __builtin_amdgcn_cvt_f32_fp8((int)g.y, 2), __builtin_amdgcn_cvt_f32_fp8((int)g.y, 3)};
                    bf16_t* mp = MB + (size_t)row * 1024 + col0 + bj * HALF;
                    if (br > 0) { v0 += (f32x4){bf_lo(q.x), bf_hi(q.x), bf_lo(q.y), bf_hi(q.y)}; v1 += (f32x4){bf_lo(q.z), bf_hi(q.z), bf_lo(q.w), bf_hi(q.w)}; }
                    if (br < 2) *(u32x4*)mp = pack8(v0, v1);
                    else { typedef unsigned u32x2_ __attribute__((ext_vector_type(2))); v0 = v0 * MS8; v1 = v1 * MS8;
                        *(u32x2_*)(M8 + (size_t)row * 1024 + col0 + bj * HALF) = (u32x2_){pk4_fp8(v0[0], v0[1], v0[2], v0[3]), pk4_fp8(v1[0], v1[1], v1[2], v1[3])}; }
                }
            }
        }
    }
};
struct EpiOut {
    static constexpr bool PERM = true, AFTER_DRAIN = false;
    const float* xlat; const float* xctx; bf16_t* X; const float* modv; bool xin;
    __device__ __forceinline__ void operator()(const f32x4 (&acc)[2][2][4][2], const Unit& u, int wr, int wc, int fr, int fq) const {
        asm volatile("" : "+v"(fr), "+v"(fq));
        const bool ctx = u.pm >= PM_CTX; const int bidx = ctx ? 4 : (u.pm >> 5); const int row0 = u.pm * BM + wr * 64 + fr, col0 = u.pn * BM + wc * 32 + 8 * fq;
        const float* src = ctx ? xctx - (size_t)NLAT * DM : xlat; const float* gt = modv + bidx * 6144 + 2 * 1024 + col0;
        f32x4 g[2][2];
#pragma unroll
        for (int bj = 0; bj < 2; ++bj) { g[bj][0] = *(const f32x4*)(gt + bj * HALF) * (WINV / MS8); g[bj][1] = *(const f32x4*)(gt + bj * HALF + 4) * (WINV / MS8); }
#pragma unroll
        for (int am = 0; am < 4; ++am) { const int ai = am >> 1, mh = (am & 1) * 2;
            f32x4 xa[2][2], xb[2][2];
#pragma unroll
            for (int m2 = 0; m2 < 2; ++m2)
#pragma unroll
                for (int bj = 0; bj < 2; ++bj) { const size_t o_ = (size_t)(row0 + ai * HALF + (mh + m2) * 16) * DM + col0 + bj * HALF;
                    if (xin) { const float* sp = src + o_; xa[m2][bj] = *(const f32x4*)sp; xb[m2][bj] = *(const f32x4*)(sp + 4); }
                    else { const u32x4 q = *(const u32x4*)(X + o_); xa[m2][bj] = (f32x4){bf_lo(q.x), bf_hi(q.x), bf_lo(q.y), bf_hi(q.y)}; xb[m2][bj] = (f32x4){bf_lo(q.z), bf_hi(q.z), bf_lo(q.w), bf_hi(q.w)}; } }
#pragma unroll
            for (int m2 = 0; m2 < 2; ++m2) { const int m = mh + m2;
                const size_t off = (size_t)(row0 + ai * HALF + m * 16) * DM + col0;
#pragma unroll
                for (int bj = 0; bj < 2; ++bj) *(u32x4*)(X + off + bj * HALF) = pack8(xa[m2][bj] + g[bj][0] * acc[ai][bj][m][0], xb[m2][bj] + g[bj][1] * acc[ai][bj][m][1]);
            }
        }
    }
};
constexpr float SWIGLU_LIMIT = 7.0f, SWIGLU_ALPHA = 1.702f;
struct EpiGU {
    static constexpr bool PERM = true, AFTER_DRAIN = false;
    bf16_t* ACT; const float* bgu;
    __device__ __forceinline__ void operator()(const f32x4 (&acc)[2][2][4][2], const Unit& u, int wr, int wc, int fr, int fq) const {
        asm volatile("" : "+v"(fr), "+v"(fq));
        const int e = u.pn >> 3, pn = u.pn & 7; const int row0 = u.pm * BM + wr * 64 + fr, j0 = pn * 128 + wc * 32 + 8 * fq;
        const float* bp = bgu + (size_t)e * 2048 + 2 * j0; f32x4 bb[4];
#pragma unroll
        for (int q = 0; q < 4; ++q) bb[q] = *(const f32x4*)(bp + 4 * q);
        const f32x4 bg0 = (f32x4){bb[0][0], bb[0][2], bb[1][0], bb[1][2]}, bg1 = (f32x4){bb[2][0], bb[2][2], bb[3][0], bb[3][2]};
        const f32x4 bu0 = (f32x4){bb[0][1], bb[0][3], bb[1][1], bb[1][3]}, bu1 = (f32x4){bb[2][1], bb[2][3], bb[3][1], bb[3][3]};
#pragma unroll
        for (int ai = 0; ai < 2; ++ai)
#pragma unroll
            for (int m = 0; m < 4; ++m) {
                const int row = row0 + ai * HALF + m * 16;
                f32x4 g0 = acc[ai][0][m][0] * WINV_MOE + bg0, g1 = acc[ai][0][m][1] * WINV_MOE + bg1, u0 = acc[ai][1][m][0] * WINV_MOE + bu0, u1 = acc[ai][1][m][1] * WINV_MOE + bu1;
#pragma unroll
                for (int j = 0; j < 4; ++j) {
                    float ga = fminf(g0[j], SWIGLU_LIMIT), ua = fminf(fmaxf(u0[j], -SWIGLU_LIMIT), SWIGLU_LIMIT); g0[j] = (ua + 1.0f) * (ga * sigmoidf_(SWIGLU_ALPHA * ga));
                    float gb = fminf(g1[j], SWIGLU_LIMIT), ub = fminf(fmaxf(u1[j], -SWIGLU_LIMIT), SWIGLU_LIMIT); g1[j] = (ub + 1.0f) * (gb * sigmoidf_(SWIGLU_ALPHA * gb)); }
                if constexpr (F8_MOE) { typedef unsigned u32x2_ __attribute__((ext_vector_type(2))); *(u32x2_*)((unsigned char*)ACT + (size_t)row * 1024 + j0) = (u32x2_){pk4_fp8(g0[0], g0[1], g0[2], g0[3]), pk4_fp8(g1[0], g1[1], g1[2], g1[3])}; }
                else *(u32x4*)(ACT + (size_t)row * 1024 + j0) = pack8(g0, g1);
            }
    }
};
struct EpiDown {
    static constexpr bool PERM = true, AFTER_DRAIN = false;
    bf16_t* YBUF; const float* bdn; const int* xs; const float* xw; const PG8_LAS int* base; const PG8_LAS int* cnt;
    __device__ __forceinline__ void operator()(const f32x4 (&acc)[2][2][4][2], const Unit& u, int wr, int wc, int fr, int fq) const {
        asm volatile("" : "+v"(fr), "+v"(fq));
        const int e = u.pn >> 2, pn = u.pn & 3; const int row0 = u.pm * BM + wr * 64 + fr, col0 = pn * BM + wc * 32 + 8 * fq;
        const float* bp = bdn + (size_t)e * 1024 + col0; f32x4 b[2][2];
#pragma unroll
        for (int bj = 0; bj < 2; ++bj) { b[bj][0] = *(const f32x4*)(bp + bj * HALF); b[bj][1] = *(const f32x4*)(bp + bj * HALF + 4); }
        int dsts[2][4]; float ws_[2][4];
#pragma unroll
        for (int ai = 0; ai < 2; ++ai)
#pragma unroll
            for (int m = 0; m < 4; ++m) { const int slot = row0 + ai * HALF + m * 16 - base[e]; const bool ok = slot < cnt[e]; const size_t xi = (size_t)e * MTOT + (ok ? slot : 0);
                const int d_ = xs[xi]; const float w_ = xw[xi]; dsts[ai][m] = ok ? d_ : -1; ws_[ai][m] = ok ? w_ : 0.f; }
#pragma unroll
        for (int ai = 0; ai < 2; ++ai)
#pragma unroll
            for (int m = 0; m < 4; ++m) {
                const int dst = dsts[ai][m]; const float w = ws_[ai][m];
                if (dst >= 0) {
#pragma unroll
                    for (int bj = 0; bj < 2; ++bj) *(u32x4*)(YBUF + (size_t)dst * 1024 + col0 + bj * HALF) = pack8((acc[ai][bj][m][0] * WINV_MOE + b[bj][0]) * w, (acc[ai][bj][m][1] * WINV_MOE + b[bj][1]) * w);
                }
            }
    }
};
struct MergeOrder {
    StaticOrder S;
    __device__ __forceinline__ bool next(int i, Unit& u) const { const int t = i / 3, br = i - 3 * t; Unit v; if (!S.next(t, v)) return false; u.pm = br * MT_ROWS + v.pm; u.pn = br * 4 + v.pn; return true; }
    __device__ __forceinline__ void a_ready(const Unit&) const {}
    __device__ __forceinline__ void done(const Unit&) const {}
};
struct ExpertOrder {
    StaticOrder S; const PG8_LAS int* tile_e; int nNe;
    const int* xs = nullptr; const PG8_LAS int* base = nullptr; const PG8_LAS int* cnt = nullptr;
    __device__ __forceinline__ int src_row(int pm, int rr) const { const int e = tile_e[pm]; const int slot = pm * BM + rr - base[e]; return slot < cnt[e] ? (xs[(size_t)e * MTOT + slot] >> 2) : 0; }
    __device__ __forceinline__ bool next(int i, Unit& u) const { Unit v; if (!S.next(i, v)) return false; u.pm = v.pm; u.pn = tile_e[v.pm] * nNe + v.pn; return true; }
    __device__ __forceinline__ void a_ready(const Unit&) const {}
    __device__ __forceinline__ void done(const Unit&) const {}
};
template <class Epi, class Sched, bool ALIGN_EPI = false, bool SP2 = false, bool FP8 = false, bool GATHER = false>
__device__ __forceinline__ void gemm_phase(PG8_LAS unsigned char* lds, const Gemm g, const Sched& S, const Epi& E) {
    int tid_ = threadIdx.x; asm volatile("" : "+v"(tid_));
    const int tid = tid_, wid = __builtin_amdgcn_readfirstlane(tid >> 6), lane = tid & 63, wr = wid >> 2, wc = wid & 3, fr = lane & 15, fq = lane >> 4;
    const int K = g.K, nt = K / BK;
    unsigned voffA[2], voffB[2];
#pragma unroll
    for (int i = 0; i < 2; ++i) { int R, C; stage_rc(tid * 16 + i * 8192, R, C); const int Rb = Epi::PERM ? ((R & ~31) + perm32(R & 31)) : R;
        voffA[i] = (unsigned)(R * K + C) * 2u; voffB[i] = (unsigned)(Rb * K + C) * 2u; }
    unsigned cvo[2][2] = {{0u, 0u}, {0u, 0u}}, nvo[2][2] = {{0u, 0u}, {0u, 0u}};
#define PG8_LDVO(u_, vo_) do { _Pragma("unroll") for (int h_ = 0; h_ < 2; ++h_) _Pragma("unroll") for (int i_ = 0; i_ < 2; ++i_) { int R_, C_; stage_rc(tid * 16 + i_ * 8192, R_, C_); \
        vo_[h_][i_] = (unsigned)S.src_row((u_).pm, h_ * HALF + R_) * (unsigned)(K * 2) + (unsigned)(C_ * 2); } } while (0)
    const size_t kstep = (size_t)(BK * 2);
    const size_t hstep = (size_t)HALF * K * 2;
    const size_t tstep = 2 * hstep;
    const unsigned ldsw = (unsigned)wid * 1024u;
    const int aoff = lds_byte(wr * 64 + fr, fq * 8), boff = lds_byte(wc * 32 + fr, fq * 8);
#define PG8_SA(b, h) (((b) * 2 + (h)) * HTB)
#define PG8_SB(b, h) ((4 + (b) * 2 + (h)) * HTB)
#define PG8_STAGE(bufoff, gbase, voff) do { _Pragma("unroll") for (int _i = 0; _i < 2; ++_i) \
        __builtin_amdgcn_global_load_lds((const unsigned*)((const char*)(gbase) + (voff)[_i]), (PG8_LAS unsigned*)(lds + (bufoff) + ldsw + _i * 8192), 16, 0, 0); } while (0)
#define PG8_LDA(dst, b, h) do { _Pragma("unroll") for (int m = 0; m < 4; ++m) _Pragma("unroll") for (int k = 0; k < 2; ++k) dst[m][k] = *(const PG8_LAS bf16x8*)(lds + PG8_SA(b, h) + aoff + m * 2048 + k * 1024); } while (0)
#define PG8_LDB(dst, b, h) do { _Pragma("unroll") for (int n = 0; n < 2; ++n) _Pragma("unroll") for (int k = 0; k < 2; ++k) dst[n][k] = *(const PG8_LAS bf16x8*)(lds + PG8_SB(b, h) + boff + n * 2048 + k * 1024); } while (0)
#define PG8_MMA(ai, bj, At, Bt) do { __builtin_amdgcn_s_setprio(1); _Pragma("unroll") for (int m = 0; m < 4; ++m) _Pragma("unroll") for (int n = 0; n < 2; ++n) { \
        if constexpr (FP8) { typedef int i32x4_ __attribute__((ext_vector_type(4))); typedef int i32x8_ __attribute__((ext_vector_type(8))); \
            const i32x8_ bb_ = __builtin_shufflevector(__builtin_bit_cast(i32x4_, Bt[n][0]), __builtin_bit_cast(i32x4_, Bt[n][1]), 0, 1, 2, 3, 4, 5, 6, 7); \
            const i32x8_ aa_ = __builtin_shufflevector(__builtin_bit_cast(i32x4_, At[m][0]), __builtin_bit_cast(i32x4_, At[m][1]), 0, 1, 2, 3, 4, 5, 6, 7); \
            asm volatile("v_mfma_scale_f32_16x16x128_f8f6f4 %0, %1, %2, %0, %3, %3 op_sel_hi:[0,0,0]" : "+v"(acc[ai][bj][m][n]) : "v"(bb_), "v"(aa_), "v"(f8scale)); }   \
        else { _Pragma("unroll") for (int k = 0; k < 2; ++k) acc[ai][bj][m][n] = __builtin_amdgcn_mfma_f32_16x16x32_bf16(Bt[n][k], At[m][k], acc[ai][bj][m][n], 0, 0, 0); } } \
        __builtin_amdgcn_s_setprio(0); } while (0)
#define PG8_WAIT_V(n) asm volatile("s_waitcnt vmcnt(" #n ")" ::: "memory")
#define PG8_WAIT_L(n) asm volatile("s_waitcnt lgkmcnt(" #n ")" ::: "memory")
#define PG8_BAR __builtin_amdgcn_s_barrier()
#define PG8_SCHED __builtin_amdgcn_sched_barrier(0)
    Unit cur, nxt; int ui = 0;
    if (!S.next(0, cur)) return;
    int f8scale = 0x7f7f7f7f; asm volatile("" : "+v"(f8scale));
    f32x4 acc[2][2][4][2];
#pragma unroll
    for (int a = 0; a < 2; ++a)
#pragma unroll
        for (int b = 0; b < 2; ++b)
#pragma unroll
            for (int m = 0; m < 4; ++m)
#pragma unroll
                for (int n = 0; n < 2; ++n) acc[a][b][m][n] = (f32x4){0.f, 0.f, 0.f, 0.f};
    bf16x8 At[4][2], B0[2][2], B1[2][2];
    const char* cA = (const char*)g.A + (size_t)cur.pm * tstep; const char* cB = (const char*)g.Bt + (size_t)cur.pn * tstep; const char* const gA0 = (const char*)g.A;
    S.a_ready(cur);
    if constexpr (SP2) {
        if constexpr (GATHER) { PG8_LDVO(cur, cvo); }
        PG8_STAGE(PG8_SB(0, 0), cB, voffB); PG8_STAGE(PG8_SB(0, 1), cB + hstep, voffB);
        if constexpr (GATHER) { PG8_STAGE(PG8_SA(0, 0), gA0, cvo[0]); PG8_STAGE(PG8_SA(0, 1), gA0, cvo[1]); } else { PG8_STAGE(PG8_SA(0, 0), cA, voffA); PG8_STAGE(PG8_SA(0, 1), cA + hstep, voffA); }
        if (wr == 1) PG8_BAR;
        PG8_WAIT_V(2); PG8_BAR;
        PG8_STAGE(PG8_SB(1, 0), cB + kstep, voffB); if constexpr (GATHER) PG8_STAGE(PG8_SA(1, 0), gA0 + kstep, cvo[0]); else PG8_STAGE(PG8_SA(1, 0), cA + kstep, voffA); PG8_STAGE(PG8_SB(1, 1), cB + hstep + kstep, voffB);
        PG8_WAIT_V(6); PG8_BAR;
    } else {
        PG8_STAGE(PG8_SB(0, 0), cB, voffB); PG8_STAGE(PG8_SA(0, 0), cA, voffA); PG8_STAGE(PG8_SB(0, 1), cB + hstep, voffB); PG8_STAGE(PG8_SA(0, 1), cA + hstep, voffA);
        if (wr == 1) PG8_BAR;
        PG8_WAIT_V(4); PG8_BAR;
        PG8_STAGE(PG8_SB(1, 0), cB + kstep, voffB); PG8_STAGE(PG8_SA(1, 0), cA + kstep, voffA); PG8_STAGE(PG8_SB(1, 1), cB + hstep + kstep, voffB);
        PG8_WAIT_V(6); PG8_BAR;
    }
    for (;;) {
        const bool has_next = S.next(ui + 1, nxt);
        const char* nA = has_next ? (const char*)g.A + (size_t)nxt.pm * tstep : cA; const char* nB = has_next ? (const char*)g.Bt + (size_t)nxt.pn * tstep : cB;
        if constexpr (GATHER) { if (has_next) { PG8_LDVO(nxt, nvo); } else { _Pragma("unroll") for (int h_ = 0; h_ < 2; ++h_) _Pragma("unroll") for (int i_ = 0; i_ < 2; ++i_) nvo[h_][i_] = cvo[h_][i_]; } }
#pragma nounroll
        for (int t = 0; t < nt; t += 2) {
            const bool last = (t == nt - 2);
            const char* a1 = cA + (size_t)(t + 1) * kstep;
            const char* a2 = last ? nA : cA + (size_t)(t + 2) * kstep; const char* b2 = last ? nB : cB + (size_t)(t + 2) * kstep;
            const char* a3 = a2 + kstep; const char* b3 = b2 + kstep;
            if (last && has_next) S.a_ready(nxt);
            if constexpr (SP2) {
            unsigned s0_[2], s1_[2]; const char* gk2 = gA0;
            if constexpr (GATHER) { s0_[0] = last ? nvo[0][0] : cvo[0][0]; s0_[1] = last ? nvo[0][1] : cvo[0][1]; s1_[0] = last ? nvo[1][0] : cvo[1][0]; s1_[1] = last ? nvo[1][1] : cvo[1][1]; gk2 = last ? gA0 : gA0 + (size_t)(t + 2) * kstep; }
            PG8_LDB(B0, 0, 0); PG8_LDB(B1, 0, 1); PG8_SCHED; PG8_LDA(At, 0, 0); if constexpr (GATHER) PG8_STAGE(PG8_SA(1, 1), gA0 + (size_t)(t + 1) * kstep, cvo[1]); else PG8_STAGE(PG8_SA(1, 1), a1 + hstep, voffA);
            PG8_WAIT_V(8); PG8_WAIT_L(0); PG8_BAR; PG8_MMA(0, 0, At, B0); PG8_MMA(0, 1, At, B1); PG8_BAR; PG8_SCHED;
            PG8_LDA(At, 0, 1); PG8_STAGE(PG8_SB(0, 0), b2, voffB); PG8_STAGE(PG8_SB(0, 1), b2 + hstep, voffB); if constexpr (GATHER) PG8_STAGE(PG8_SA(0, 0), gk2, s0_); else PG8_STAGE(PG8_SA(0, 0), a2, voffA);
            PG8_WAIT_V(8); PG8_WAIT_L(0); PG8_BAR; PG8_MMA(1, 0, At, B0); PG8_MMA(1, 1, At, B1); PG8_BAR; PG8_SCHED;
            PG8_LDB(B0, 1, 0); PG8_LDB(B1, 1, 1); PG8_SCHED; PG8_LDA(At, 1, 0); if constexpr (GATHER) PG8_STAGE(PG8_SA(0, 1), gk2, s1_); else PG8_STAGE(PG8_SA(0, 1), a2 + hstep, voffA);
            PG8_WAIT_V(8); PG8_WAIT_L(0); PG8_BAR; PG8_MMA(0, 0, At, B0); PG8_MMA(0, 1, At, B1); PG8_BAR; PG8_SCHED;
            PG8_LDA(At, 1, 1); PG8_STAGE(PG8_SB(1, 0), b3, voffB); PG8_STAGE(PG8_SB(1, 1), b3 + hstep, voffB); if constexpr (GATHER) PG8_STAGE(PG8_SA(1, 0), gk2 + kstep, s0_); else PG8_STAGE(PG8_SA(1, 0), a3, voffA);
            PG8_WAIT_V(8); PG8_WAIT_L(0); PG8_BAR; PG8_MMA(1, 0, At, B0); PG8_MMA(1, 1, At, B1); PG8_BAR; PG8_SCHED;
            } else {
            PG8_LDB(B0, 0, 0); PG8_SCHED; PG8_LDA(At, 0, 0); PG8_STAGE(PG8_SA(1, 1), a1 + hstep, voffA);
            PG8_WAIT_L(8); PG8_BAR; PG8_WAIT_L(0); PG8_MMA(0, 0, At, B0); PG8_BAR; PG8_SCHED;
            PG8_LDB(B1, 0, 1); PG8_STAGE(PG8_SB(0, 0), b2, voffB);
            PG8_BAR; PG8_WAIT_L(0); PG8_MMA(0, 1, At, B1); PG8_BAR;
            PG8_LDA(At, 0, 1); PG8_STAGE(PG8_SA(0, 0), a2, voffA);
            PG8_BAR; PG8_WAIT_L(0); PG8_MMA(1, 0, At, B0); PG8_BAR; PG8_SCHED;
            PG8_STAGE(PG8_SB(0, 1), b2 + hstep, voffB);
            PG8_WAIT_V(6); PG8_BAR; PG8_MMA(1, 1, At, B1); PG8_BAR;
            PG8_LDB(B0, 1, 0); PG8_SCHED; PG8_LDA(At, 1, 0); PG8_STAGE(PG8_SA(0, 1), a2 + hstep, voffA);
            PG8_WAIT_L(8); PG8_BAR; PG8_WAIT_L(0); PG8_MMA(0, 0, At, B0); PG8_BAR; PG8_SCHED;
            PG8_LDB(B1, 1, 1); PG8_STAGE(PG8_SB(1, 0), b3, voffB);
            PG8_BAR; PG8_WAIT_L(0); PG8_MMA(0, 1, At, B1); PG8_BAR;
            PG8_LDA(At, 1, 1); PG8_STAGE(PG8_SA(1, 0), a3, voffA);
            PG8_BAR; PG8_WAIT_L(0); PG8_MMA(1, 0, At, B0); PG8_BAR; PG8_SCHED;
            PG8_STAGE(PG8_SB(1, 1), b3 + hstep, voffB);
            PG8_WAIT_V(6); PG8_BAR; PG8_MMA(1, 1, At, B1); PG8_BAR;
            }
        }
        if constexpr (ALIGN_EPI) { if (wr == 0) PG8_BAR; }
        if constexpr (FP8) {
#define PG8_TIE8(a, b, TXT) asm volatile(TXT : "+v"(acc[a][b][0][0]), "+v"(acc[a][b][0][1]), "+v"(acc[a][b][1][0]), "+v"(acc[a][b][1][1]), "+v"(acc[a][b][2][0]), "+v"(acc[a][b][2][1]), "+v"(acc[a][b][3][0]), "+v"(acc[a][b][3][1]))
            PG8_TIE8(0, 0, "s_nop 15\n\ts_nop 15\n\ts_nop 15"); PG8_TIE8(0, 1, ""); PG8_TIE8(1, 0, ""); PG8_TIE8(1, 1, "");
#undef PG8_TIE8
        }
        if constexpr (!Epi::AFTER_DRAIN) { E(acc, cur, wr, wc, fr, fq); S.done(cur); }
        if (!has_next) break;
#pragma unroll
        for (int a = 0; a < 2; ++a)
#pragma unroll
            for (int b = 0; b < 2; ++b)
#pragma unroll
                for (int m = 0; m < 4; ++m)
#pragma unroll
                    for (int n = 0; n < 2; ++n) acc[a][b][m][n] = (f32x4){0.f, 0.f, 0.f, 0.f};
        cur = nxt; cA = nA; cB = nB; ++ui;
        if constexpr (GATHER) { _Pragma("unroll") for (int h_ = 0; h_ < 2; ++h_) _Pragma("unroll") for (int i_ = 0; i_ < 2; ++i_) cvo[h_][i_] = nvo[h_][i_]; }
        if constexpr (ALIGN_EPI) { if (wr == 1) PG8_BAR; }
    }
    PG8_WAIT_V(0);
    if constexpr (!ALIGN_EPI) { if (wr == 0) PG8_BAR; }
    PG8_BAR;
    if constexpr (Epi::AFTER_DRAIN) { E.fused(acc, cur, wr, wc, fr, fq, lds, wid, lane); S.done(cur); }
#undef PG8_SA
#undef PG8_SB
#undef PG8_STAGE
#undef PG8_LDA
#undef PG8_LDB
#undef PG8_MMA
#undef PG8_WAIT_V
#undef PG8_WAIT_L
#undef PG8_BAR
#undef PG8_SCHED
#undef PG8_LDVO
}
}

using namespace pg8;
constexpr int NWAVES = 8, NTHR = 512;
#define GAS __attribute__((address_space(1)))
#define LAS __attribute__((address_space(3)))
typedef unsigned short bf16;
#define LDS_WAIT() asm volatile("s_waitcnt lgkmcnt(0)" ::: "memory")
#define VM_WAIT() asm volatile("s_waitcnt vmcnt(0)" ::: "memory")
__device__ __forceinline__ unsigned f2bf(float f) { unsigned u = __builtin_bit_cast(unsigned, f); return (u + 0x7fffu + ((u >> 16) & 1u)) >> 16; }
__device__ __forceinline__ unsigned pk2(float lo, float hi) { return f2bf(lo) | (f2bf(hi) << 16); }
__device__ __forceinline__ float bf2f(bf16 b) { return __uint_as_float(((unsigned)b) << 16); }
__device__ __forceinline__ float wave_sum(float v) {
#pragma unroll
    for (int o = 1; o < 64; o <<= 1) v += __shfl_xor(v, o);
    return v;
}
__device__ __forceinline__ float siluf_(float x) { return x / (1.0f + __expf(-x)); }

constexpr size_t MiB = 1u << 20;
constexpr size_t WS_CTL = 0, CTL_ZERO_BYTES = 128 * 1024;
constexpr int CW_BAR = 4096;
constexpr int CW_CNT = 16384;
constexpr int CW_DBG = 20480;
constexpr size_t CTL_SSQ = 1 * MiB;
constexpr size_t WS_MODV = 4 * MiB;
constexpr size_t WS_WRT = 5 * MiB + 512 * 1024;
constexpr size_t WS_TAB = 5 * MiB;
constexpr size_t WS_ROUTE = 6 * MiB;
constexpr size_t WS_WIN = 10 * MiB, WS_WQB = 37 * MiB, WS_WKVB = 39 * MiB, WS_WBR = 40 * MiB, WS_WOUT = 46 * MiB, WS_WGU = 50 * MiB, WS_WDN = 306 * MiB;
constexpr size_t WS_X = 434 * MiB, WS_H = 566 * MiB, WS_R = 632 * MiB;
constexpr size_t SZ_R512 = (size_t)MTOT * 512 * 2;
constexpr size_t WS_QA = WS_R, WS_KA = WS_QA + SZ_R512, WS_VA = WS_KA + SZ_R512, WS_QB = WS_VA + SZ_R512, WS_KB = WS_QB + SZ_R512, WS_VB = WS_KB + SZ_R512;
constexpr size_t WS_CQ = WS_VB + SZ_R512, WS_CKR = WS_CQ + (size_t)MTOT * 384 * 2, WS_CKV = WS_CKR + (size_t)MTOT * 32 * 2 + MiB, WS_GATES = WS_CKV + (size_t)MTOT * 256 * 2;
constexpr size_t WS_QC = WS_GATES + (size_t)MTOT * 3072 * 2, WS_KCN = WS_QC + (size_t)MTOT * 768 * 2, WS_VC = WS_KCN + SZ_R512, WS_O0 = WS_VC + SZ_R512;
constexpr size_t WS_YA = WS_O0 + (size_t)MTOT * 512 * 4, WS_YB = WS_YA + SZ_R512, WS_YC = WS_YB + SZ_R512, WS_M32 = WS_YC + SZ_R512, WS_MB = WS_M32 + (size_t)MTOT * 1024 * 4, WS_MIX_END = WS_MB + (size_t)MTOT * 1024 * 2;
constexpr size_t WS_VTA = WS_MIX_END, WS_VTC = WS_VTA + (size_t)(MTOT / 64) * 4 * 8192, WS_VT_END = WS_VTC + (size_t)(MTOT / 64) * 8 * 4096;
constexpr int HS_ROWS = 143360;
constexpr size_t WS_XS = WS_R, WS_XW = WS_XS + (size_t)NEXP * MTOT * 4;
constexpr size_t WS_HS = WS_R, WS_ACT = WS_HS + (size_t)HS_ROWS * 1024 * 2, WS_YBUF = WS_ACT + (size_t)HS_ROWS * 1024 * 2, WS_MOE_END = WS_YBUF + (size_t)MTOT * 4 * 1024 * 2;
constexpr size_t WS_END = (WS_VT_END > WS_MOE_END ? WS_VT_END : WS_MOE_END);
static_assert(WS_END <= (size_t)2040 * MiB, "workspace map");
constexpr size_t RT_E = 0, RT_SLOT = (size_t)MTOT * 4 * 4, RT_W = 2 * RT_SLOT, RT_YDST = 3 * RT_SLOT, RT_WROW = RT_YDST + (size_t)HS_ROWS * 4, RT_YSRC = RT_WROW + (size_t)HS_ROWS * 4;
static_assert(WS_ROUTE + RT_WROW + (size_t)HS_ROWS * 4 <= WS_WIN, "routing map");

constexpr int RING_OFF = 0, RING_BYTES = 131072;
constexpr int TBL_OFF = RING_BYTES;
constexpr int MISC_OFF = TBL_OFF + 12288;
constexpr int LDS_BYTES = 147456;
static_assert(MISC_OFF + 256 <= LDS_BYTES, "LDS map");

#define XB_TMO      128
#define XB_XCNT(j)  (256  + 64 * (j))
#define XB_XSUB(j)  (1280 + 64 * (j))
#define XB_XGEN(j)  (2304 + 64 * (j))
#define XB_TOP      3328
#define XB_TOPGEN   3392
#define XCD_BAR_WORDS 3456
#define XB_SPIN_CAP (1u << 18)
__device__ __forceinline__ unsigned xb_ld(unsigned* p)              { return __hip_atomic_load(p, __ATOMIC_RELAXED, __HIP_MEMORY_SCOPE_AGENT); }
__device__ __forceinline__ unsigned xb_add(unsigned* p, unsigned v) { return __hip_atomic_fetch_add(p, v, __ATOMIC_RELAXED, __HIP_MEMORY_SCOPE_AGENT); }
__device__ __forceinline__ unsigned xb_xcc_id() { return (unsigned)__builtin_amdgcn_s_getreg((3 << 11) | 20) & 0xFu; }
#define XB_SPIN(cond, bar) do { unsigned _sp = 0; while (cond) { __builtin_amdgcn_s_sleep(1); \
    if ((++_sp & 255u) == 0u) { if (xb_ld(&(bar)[XB_TMO])) break; if (_sp > XB_SPIN_CAP) { atomicAdd(&(bar)[XB_TMO], 1u); break; } } } } while (0)
struct XcdBarrier { unsigned* bar; unsigned x; volatile LAS unsigned* st; };
__device__ __forceinline__ XcdBarrier xcd_barrier_post(unsigned* bar, volatile LAS unsigned* st) {
    XcdBarrier b; b.bar = bar; b.x = xb_xcc_id(); b.st = st;
    if (threadIdx.x == 0) (void)xb_add(&bar[XB_XCNT(b.x)], 1u);
    return b;
}
__device__ __forceinline__ void xcd_barrier_complete(unsigned* bar, unsigned x, unsigned& nloc, unsigned& nx) {
    const unsigned G = gridDim.x * gridDim.y * gridDim.z;
    unsigned sum, cnt, mine, sp = 0u;
    for (;;) {
        sum = 0u; cnt = 0u; mine = 0u;
#pragma nounroll
        for (unsigned j = 0; j < 16; ++j) { const unsigned c = xb_ld(&bar[XB_XCNT(j)]); sum += c; cnt += (c > 0u) ? 1u : 0u; mine = (j == x) ? c : mine; }
        if (sum == G) break;
        __builtin_amdgcn_s_sleep(1);
        if ((++sp & 255u) == 0u) { if (xb_ld(&bar[XB_TMO])) break; if (sp > XB_SPIN_CAP) { atomicAdd(&bar[XB_TMO], 1u); break; } }
    }
    nloc = mine > 0u ? mine : 1u; nx = cnt > 0u ? cnt : 1u;
}
__device__ __forceinline__ void xcd_barrier(const XcdBarrier& b) {
    asm volatile("s_waitcnt vmcnt(0)" ::: "memory");
    __syncthreads();
    if (threadIdx.x == 0) {
        unsigned* bar = b.bar;
        __builtin_amdgcn_s_waitcnt(0);
        unsigned nloc = b.st[0], nx = b.st[1];
        if (nloc == 0u) { xcd_barrier_complete(bar, b.x, nloc, nx); b.st[0] = nloc; b.st[1] = nx; }
        const unsigned old = xb_add(&bar[XB_XSUB(b.x)], 1u);
        const unsigned gen = old / nloc;
        if (old + 1u == (gen + 1u) * nloc) {
            __builtin_amdgcn_fence(__ATOMIC_RELEASE, "agent");
            asm volatile("s_waitcnt vmcnt(0)" ::: "memory");
            const unsigned og = xb_add(&bar[XB_TOP], 1u);
            const unsigned tg = og / nx;
            if (og + 1u == (tg + 1u) * nx) xb_add(&bar[XB_TOPGEN], 1u);
            else XB_SPIN(xb_ld(&bar[XB_TOPGEN]) == tg, bar);
            __builtin_amdgcn_fence(__ATOMIC_ACQUIRE, "agent");
            xb_add(&bar[XB_XGEN(b.x)], 1u);
            asm volatile("s_waitcnt vmcnt(0)" ::: "memory");
        } else {
            XB_SPIN(xb_ld(&bar[XB_XGEN(b.x)]) == gen, bar);
            __builtin_amdgcn_fence(__ATOMIC_ACQUIRE, "agent");
            asm volatile("s_waitcnt vmcnt(0)" ::: "memory");
        }
    }
    __syncthreads();
}

struct Args { const float* in[30]; float* out; unsigned char* ws; int ph_lo, ph_hi; };
enum { I_X = 0, I_C, I_CTX, I_CCTX, I_WMOD, I_BMOD, I_GMIX, I_WIN, I_LQ1, I_LK1, I_LQ2, I_LK2, I_GSUB, I_RPB, I_GQA, I_WQB, I_GKVA, I_WKVB, I_WBRA, I_WBRB, I_WBRC, I_WOUT, I_GFFN, I_WROUT, I_BROUT, I_WGU, I_BGU, I_WDN, I_BDN, I_GFIN };

__device__ __forceinline__ int win_src(int n) {
    if (n < 1024) { const int g = n >> 6, p = n & 63, i = p >> 1, s = p & 1; return g * 64 + (i < 16 ? i : i + 16) + 16 * s; }
    if (n < OFF_CQ + 384) return n;
    if (n < OFF_PADW) { const int p = n - OFF_CKR, i = p >> 1, s = p & 1; return 3712 + (i < 8 ? i : i + 8) + 8 * s; }
    if (n < OFF_CKV) return -1;
    if (n < OFF_GATES) return 3456 + (n - OFF_CKV);
    return 3744 + (n - OFF_GATES);
}
__device__ __forceinline__ int wqb_src(int n) { const int h = n / 96, p = n - 96 * h; if (p < 64) return n; const int q = p - 64, i = q >> 1, s = q & 1; return h * 96 + 64 + (i < 8 ? i : i + 8) + 8 * s; }
__device__ __forceinline__ int wkvb_src(int n) { return n < 512 ? (n >> 6) * 128 + (n & 63) : ((n - 512) >> 6) * 128 + 64 + (n & 63); }
__device__ __forceinline__ int wgu_src(int n) { const int pn = n >> 8, s = (n >> 7) & 1, t = n & 127; return 2 * (128 * pn + t) + s; }
template <int KIND, bool F8 = false> __device__ __forceinline__ void transpose_item(const float* W, int K, int N, bf16* WT, const float* gk, LAS float* scr, int item, int nblk, int lane) {
    asm volatile("" : "+v"(lane));
    const int pr = item >> 1, kb = 2 * (pr / nblk) + (item & 1), nb = pr % nblk, k0 = 64 * kb, n0 = 32 * nb;
    const int nd = n0 + (lane & 31);
    const int ns = KIND == 1 ? win_src(nd) : KIND == 2 ? wqb_src(nd) : KIND == 3 ? wkvb_src(nd) : KIND == 4 ? wgu_src(nd) : nd;
    float tv_[32];
#pragma unroll
    for (int i = 0; i < 32; ++i) { const int kk = 2 * i + (lane >> 5); float v = 0.f; if (ns >= 0) v = W[(size_t)(k0 + kk) * N + ns]; tv_[i] = v; }
#pragma unroll
    for (int i = 0; i < 32; ++i) { const int kk = 2 * i + (lane >> 5); float v = tv_[i]; if (gk) v *= gk[k0 + kk]; scr[kk * 33 + (lane & 31)] = v; }
    LDS_WAIT(); asm volatile("" ::: "memory");
    const int c = lane & 7;
#pragma unroll
    for (int j = 0; j < 4; ++j) { const int n = (lane >> 3) + 8 * j; const LAS float* s = scr + (8 * c) * 33 + n;
        if constexpr (F8) { typedef unsigned u32x2_ __attribute__((ext_vector_type(2)));
            *(GAS u32x2_*)((unsigned char*)WT + (size_t)(n0 + n) * K + k0 + 8 * c) = (u32x2_){pk4_fp8(s[0 * 33] * WSCALE, s[1 * 33] * WSCALE, s[2 * 33] * WSCALE, s[3 * 33] * WSCALE), pk4_fp8(s[4 * 33] * WSCALE, s[5 * 33] * WSCALE, s[6 * 33] * WSCALE, s[7 * 33] * WSCALE)}; }
        else { u32x4 o; o.x = pk2(s[0 * 33], s[1 * 33]); o.y = pk2(s[2 * 33], s[3 * 33]); o.z = pk2(s[4 * 33], s[5 * 33]); o.w = pk2(s[6 * 33], s[7 * 33]);
            *(GAS u32x4*)(WT + (size_t)(n0 + n) * K + k0 + 8 * c) = o; } }
    LDS_WAIT(); asm volatile("" ::: "memory");
}

struct Frame {
    LAS unsigned char* lds; volatile LAS unsigned* MISC; unsigned* ctl; unsigned char* ws;
    int tid, lane, wave, vcu, G;
    const float* const* in; float* out;
};
constexpr int IT_WIN = 16 * 216, IT_WQB = 6 * 24, IT_WKVB = 4 * 32, IT_WBR = 8 * 32, IT_WOUT = 16 * 32, IT_WGU = 16 * 64, IT_WDN = 16 * 32;
constexpr int IT_LAYER = IT_WIN + IT_WQB + IT_WKVB + 3 * IT_WBR + IT_WOUT + NEXP * (IT_WGU + IT_WDN);
__device__ __forceinline__ const float* in_l(const Frame& F, int idx, int l, size_t per_layer) { return F.in[idx] + (size_t)l * per_layer; }

constexpr int NE_ITEMS = IT_WIN + IT_WQB + IT_WKVB + 3 * IT_WBR + IT_WOUT, NE_PAIRS = NE_ITEMS / 2, PAIRS_LAYER = IT_LAYER / 2;
__device__ __forceinline__ void convert_item(Frame& F, int it, LAS float* scr) {
    const int l = it / IT_LAYER; int r = it - l * IT_LAYER;
    if (r < IT_WIN) { bf16* wd = (bf16*)(F.ws + WS_WIN + (size_t)l * NINP * DM * 2);
        if (F8_INL(l)) transpose_item<1, true>(in_l(F, I_WIN, l, (size_t)DM * DIN), DM, DIN, wd, nullptr, scr, r, 216, F.lane); else transpose_item<1, false>(in_l(F, I_WIN, l, (size_t)DM * DIN), DM, DIN, wd, nullptr, scr, r, 216, F.lane); return; } r -= IT_WIN;
    if (r < IT_WQB) { transpose_item<2>(in_l(F, I_WQB, l, 384 * 768), 384, 768, (bf16*)(F.ws + WS_WQB) + (size_t)l * 768 * 384, in_l(F, I_GQA, l, 384), scr, r, 24, F.lane); return; } r -= IT_WQB;
    if (r < IT_WKVB) { transpose_item<3>(in_l(F, I_WKVB, l, 256 * 1024), 256, 1024, (bf16*)(F.ws + WS_WKVB) + (size_t)l * 1024 * 256, in_l(F, I_GKVA, l, 256), scr, r, 32, F.lane); return; } r -= IT_WKVB;
    if (r < 3 * IT_WBR) { const int br = r / IT_WBR; const float* src = in_l(F, br == 0 ? I_WBRA : br == 1 ? I_WBRB : I_WBRC, l, 512 * 1024);
        transpose_item<0, true>(src, 512, 1024, (bf16*)(F.ws + WS_WBR + (size_t)(l * 3 + br) * 1024 * 512), nullptr, scr, r - br * IT_WBR, 32, F.lane); return; } r -= 3 * IT_WBR;
    if (r < IT_WOUT) { transpose_item<0, true>(in_l(F, I_WOUT, l, 1024 * 1024), 1024, 1024, (bf16*)(F.ws + WS_WOUT + (size_t)l * 1024 * 1024), nullptr, scr, r, 32, F.lane); return; } r -= IT_WOUT;
    if (r < NEXP * IT_WGU) { const int e = r / IT_WGU; transpose_item<4, F8_MOE != 0>(in_l(F, I_WGU, l * NEXP + e, (size_t)1024 * 2048), 1024, 2048, (bf16*)(F.ws + WS_WGU + (size_t)(l * NEXP + e) * 2048 * 1024 * (F8_MOE ? 1 : 2)), nullptr, scr, r - e * IT_WGU, 64, F.lane); return; }
    r -= NEXP * IT_WGU;
    { const int e = r / IT_WDN; transpose_item<0, F8_MOE != 0>(in_l(F, I_WDN, l * NEXP + e, (size_t)1024 * 1024), 1024, 1024, (bf16*)(F.ws + WS_WDN + (size_t)(l * NEXP + e) * 1024 * 1024 * (F8_MOE ? 1 : 2)), nullptr, scr, r - e * IT_WDN, 32, F.lane); }
}
__device__ __forceinline__ void p_prologue_a(Frame& F) {
    LAS float* scr = (LAS float*)(F.lds + RING_OFF + F.wave * 8704);
    const int gw = F.vcu * NWAVES + F.wave, NGW = F.G * NWAVES;
    for (int pr = gw; pr < NE_PAIRS; pr += NGW) { convert_item(F, 2 * pr, scr); convert_item(F, 2 * pr + 1, scr); }
    __syncthreads();
    if (F.vcu < 2 * 96) {
        LAS float* sc = (LAS float*)(F.lds + RING_OFF + 80 * 1024);
        LAS float* red = sc + 5 * 1024;
        for (int i = F.tid; i < 5 * 1024; i += NTHR) { const float v = i < 4096 ? F.in[I_C][i] : F.in[I_CCTX][i - 4096]; sc[i] = siluf_(v); }
        __syncthreads();
        const int l = F.vcu / 96, n = (F.vcu % 96) * 64 + F.lane; const float* W = in_l(F, I_WMOD, l, (size_t)DM * 6144) + n;
        float a[5] = {0.f, 0.f, 0.f, 0.f, 0.f};
        for (int k0 = F.wave * 128; k0 < F.wave * 128 + 128; k0 += 16) { float w[16];
#pragma unroll
            for (int i = 0; i < 16; ++i) w[i] = W[(size_t)(k0 + i) * 6144];
#pragma unroll
            for (int i = 0; i < 16; ++i) {
#pragma unroll
                for (int v = 0; v < 5; ++v) a[v] += sc[v * 1024 + k0 + i] * w[i]; } }
#pragma unroll
        for (int v = 0; v < 5; ++v) red[(F.wave * 5 + v) * 64 + F.lane] = a[v];
        __syncthreads();
        if (F.tid < 320) { const int v = F.tid >> 6, ln = F.tid & 63; float s = 0.f;
#pragma unroll
            for (int w = 0; w < 8; ++w) s += red[(w * 5 + v) * 64 + ln];
            const int nn = (F.vcu % 96) * 64 + ln; ((float*)(F.ws + WS_MODV))[(size_t)(l * 5 + v) * 6144 + nn] = s + in_l(F, I_BMOD, l, 6144)[nn]; }
        __syncthreads();
    }
    for (int i = F.vcu * NTHR + F.tid; i < DEPTH * 32 * 1024; i += F.G * NTHR) { const int l = i >> 15, r = i & 32767, e = r >> 10, k = r & 1023; ((float*)(F.ws + WS_WRT))[i] = in_l(F, I_WROUT, l, 1024 * 32)[k * 32 + e]; }
    { const int g = F.vcu * NTHR + F.tid; float* tabA = (float*)(F.ws + WS_TAB); float* tabC = tabA + 192 * 16 * 2;
      if (g < 192 * 16) { const int tr = g >> 4, i = g & 15; const float pos = (float)(tr < 128 ? tr : tr - 128); const float inv = powf(10000.0f, -(float)i / 16.0f); const float ang = pos * inv; tabA[2 * g] = cosf(ang); tabA[2 * g + 1] = sinf(ang); }
      else if (g < 192 * 16 + 192 * 8) { const int q = g - 192 * 16, tr = q >> 3, i = q & 7; const float pos = (float)(tr < 128 ? tr : tr - 128); const float inv = powf(10000.0f, -(float)i / 8.0f); const float ang = pos * inv; tabC[2 * q] = cosf(ang); tabC[2 * q + 1] = sinf(ang); }
      if (F.vcu == F.G - 1 && F.wave < 2) { const int l = F.wave; const float a = in_l(F, I_LQ1, l, 64)[F.lane] * in_l(F, I_LK1, l, 64)[F.lane], b = in_l(F, I_LQ2, l, 64)[F.lane] * in_l(F, I_LK2, l, 64)[F.lane];
          const float sa = wave_sum(a), sb = wave_sum(b); const float lam_init = 0.8f - 0.6f * expf(-0.3f * (float)l);
          if (F.lane == 0) { float* lam = tabC + 192 * 8 * 2; lam[2 * l] = expf(sa) - expf(sb) + lam_init; lam[2 * l + 1] = lam_init; } }
    }
}
template <bool F8> __device__ __forceinline__ void put_h4(unsigned char* orow, int lane, int j, const f32x4 y) {
    if constexpr (F8) ((unsigned*)orow)[lane + 64 * j] = pk4_fp8(y.x, y.y, y.z, y.w);
    else ((unsigned long long*)orow)[lane + 64 * j] = (unsigned long long)pk2(y.x, y.y) | ((unsigned long long)pk2(y.z, y.w) << 32);
}
constexpr int HROW_MOE = F8_MOE ? 1024 : 2048;
#define HROW_INL(l) (F8_INL(l) ? 1024 : 2048)
__device__ __forceinline__ void mod_row_f8(const float* xrow, const float* g, const float* sh, const float* scl, unsigned char* orow, int lane) {
    const f32x4* xr = (const f32x4*)xrow + lane; f32x4 v[4]; float s = 0.f;
#pragma unroll
    for (int j = 0; j < 4; ++j) { v[j] = xr[64 * j]; s += (v[j].x * v[j].x + v[j].y * v[j].y) + (v[j].z * v[j].z + v[j].w * v[j].w); }
    const float rstd = 1.0f / sqrtf(wave_sum(s) * (1.0f / DM) + EPS);
#pragma unroll
    for (int j = 0; j < 4; ++j) { const f32x4 gg = ((const f32x4*)g)[lane + 64 * j], ss = ((const f32x4*)sh)[lane + 64 * j], cc = ((const f32x4*)scl)[lane + 64 * j];
        put_h4<F8_IN0 != 0>(orow, lane, j, v[j] * rstd * gg * (cc + 1.0f) + ss); }
}
__device__ __forceinline__ void p_prologue_b(Frame& F) {
    const int gw = F.vcu * NWAVES + F.wave, NGW = F.G * NWAVES; const float* modv = (const float*)(F.ws + WS_MODV); unsigned char* H = F.ws + WS_H;
    f32x4 nx[4];
#define XROW(m) ((m) < NLAT ? F.in[I_X] + (size_t)(m) * DM : F.in[I_CTX] + (size_t)((m) - NLAT) * DM)
    if (gw < MTOT) { const f32x4* xr = (const f32x4*)XROW(gw) + F.lane;
#pragma unroll
        for (int j = 0; j < 4; ++j) nx[j] = xr[64 * j]; }
    f32x4 gg[4];
#pragma unroll
    for (int j = 0; j < 4; ++j) gg[j] = ((const f32x4*)F.in[I_GMIX])[F.lane + 64 * j];
    for (int m = gw; m < MTOT; m += NGW) { const int b = m < NLAT ? m / SEQ : 4; f32x4 v[4]; float s = 0.f;
#pragma unroll
        for (int j = 0; j < 4; ++j) { v[j] = nx[j]; s += (v[j].x * v[j].x + v[j].y * v[j].y) + (v[j].z * v[j].z + v[j].w * v[j].w); }
        { const int mn = min(m + NGW, MTOT - 1); const f32x4* xr = (const f32x4*)XROW(mn) + F.lane;
#pragma unroll
          for (int j = 0; j < 4; ++j) nx[j] = xr[64 * j]; }
        const float* sh = modv + b * 6144; const float* scl = modv + b * 6144 + 1024; f32x4 ss[4], cc[4];
#pragma unroll
        for (int j = 0; j < 4; ++j) { ss[j] = ((const f32x4*)sh)[F.lane + 64 * j]; cc[j] = ((const f32x4*)scl)[F.lane + 64 * j]; }
        const float rstd = 1.0f / sqrtf(wave_sum(s) * (1.0f / DM) + EPS);
#pragma unroll
        for (int j = 0; j < 4; ++j) put_h4<F8_IN0 != 0>(H + (size_t)m * HROW_INL(0), F.lane, j, v[j] * rstd * gg[j] * (cc[j] + 1.0f) + ss[j]);
    }
#undef XROW
}
__device__ __forceinline__ void p_final_norm(Frame& F, const float* X) {
    const int gw = F.vcu * NWAVES + F.wave, NGW = F.G * NWAVES; const f32x4* g = (const f32x4*)F.in[I_GFIN];
    for (int m = gw; m < NLAT; m += NGW) { const f32x4* xr = (const f32x4*)(X + (size_t)m * DM) + F.lane; f32x4 v[4]; float s = 0.f;
#pragma unroll
        for (int j = 0; j < 4; ++j) { v[j] = xr[64 * j]; s += (v[j].x * v[j].x + v[j].y * v[j].y) + (v[j].z * v[j].z + v[j].w * v[j].w); }
        const float rstd = 1.0f / sqrtf(wave_sum(s) * (1.0f / DM) + EPS);
        f32x4* outp = (f32x4*)(F.out + (size_t)m * DM) + F.lane;
#pragma unroll
        for (int j = 0; j < 4; ++j) outp[64 * j] = v[j] * rstd * g[F.lane + 64 * j]; }
}

namespace att {
using f32x16 = __attribute__((ext_vector_type(16))) float;
using s16x4 = __attribute__((ext_vector_type(4))) short;
constexpr float THR = 8.0f;
constexpr float NEGBIG = -3.0e38f, MINIT = -1.0e30f;
__device__ __forceinline__ int crow(int r, int hi) { return (r & 3) + 8 * (r >> 2) + 4 * hi; }
constexpr int L_K1 = 0, L_K2 = 16384, L_V = 32768, L_WS = 65536, L_RPB = 67584, L_END = 70144;
template <int OFF> __device__ __forceinline__ s16x4 tr_read(int vb) { s16x4 r; asm volatile("ds_read_b64_tr_b16 %0, %1 offset:%2" : "=&v"(r) : "v"(vb), "i"(OFF) : "memory"); return r; }
__device__ __forceinline__ int v_rd_base(int lane) { return ((lane & 3) << 3) | (((lane >> 2) & 3) << 6) | (((lane >> 4) & 1) << 5) | (((lane >> 5) & 1) << 8); }
template <int DV> __device__ __forceinline__ int v_st(int k, int c) { return ((k >> 3) * (DV / 32) + (c >> 5)) * 512 + ((k & 7) * 32 + (c & 31)) * 2; }
template <int DV, int D0> __device__ __forceinline__ void pv_one(f32x16& od, int vb, bf16x8 pa0, bf16x8 pa1, bf16x8 pa2, bf16x8 pa3) {
    constexpr int KT = (DV / 32) * 512;
    const s16x4 l0 = tr_read<D0 * 512 + 0 * KT>(vb), h0 = tr_read<D0 * 512 + 1 * KT>(vb), l1 = tr_read<D0 * 512 + 2 * KT>(vb), h1 = tr_read<D0 * 512 + 3 * KT>(vb);
    const s16x4 l2 = tr_read<D0 * 512 + 4 * KT>(vb), h2 = tr_read<D0 * 512 + 5 * KT>(vb), l3 = tr_read<D0 * 512 + 6 * KT>(vb), h3 = tr_read<D0 * 512 + 7 * KT>(vb);
    asm volatile("s_waitcnt lgkmcnt(0)" ::: "memory"); __builtin_amdgcn_sched_barrier(0);
#define PKV(L, H) (bf16x8){L[0], L[1], L[2], L[3], H[0], H[1], H[2], H[3]}
    od = __builtin_amdgcn_mfma_f32_32x32x16_bf16(pa0, PKV(l0, h0), od, 0, 0, 0);
    od = __builtin_amdgcn_mfma_f32_32x32x16_bf16(pa1, PKV(l1, h1), od, 0, 0, 0);
    od = __builtin_amdgcn_mfma_f32_32x32x16_bf16(pa2, PKV(l2, h2), od, 0, 0, 0);
    od = __builtin_amdgcn_mfma_f32_32x32x16_bf16(pa3, PKV(l3, h3), od, 0, 0, 0);
#undef PKV
}
struct NaParams { const float* rpb_h; int r0; };
template <int DK2, int DV, int MODE>
__device__ __forceinline__ void attn_pass(LAS unsigned char* lds, const bf16* Qrow0, int ldq, const bf16* K1, const bf16* K2, const bf16* V, int lat0, int ntl, int ctx0, int ntc, const NaParams na, int kr_lo,
                                          f32x16 (&o)[DV / 32], float& l_out) {
    constexpr int NQ = 4 + DK2 / 16, ND = DV / 32;
    int tid_ = threadIdx.x; asm volatile("" : "+v"(tid_)); const int tid = tid_, lane = tid & 63, r32 = lane & 31, hi = lane >> 5; const int wid = __builtin_amdgcn_readfirstlane(tid >> 6);
    LAS float* wsf = (LAS float*)(lds + L_WS) + wid * 64; LAS float* rpbl = (LAS float*)(lds + L_RPB);
    bf16x8 qr[NQ];
    { const bf16* qp = Qrow0 + (size_t)(wid * 32 + r32) * ldq + hi * 8;
#pragma unroll
      for (int d0 = 0; d0 < NQ; ++d0) qr[d0] = *(const bf16x8*)(qp + d0 * 16); }
    float rpv0 = 0.f, rpv1 = 0.f;
    if (MODE == 1) { const int i0 = tid, i1 = tid + NTHR; if (i0 >= 64 && i0 < 64 + 15 * 31) rpv0 = na.rpb_h[i0 - 64] * LOG2E; if (i1 >= 64 && i1 < 64 + 15 * 31) rpv1 = na.rpb_h[i1 - 64] * LOG2E; }
    const int k1r = tid >> 3, k1c = tid & 7, k1dst = k1r * 128 + ((k1c ^ ((k1r >> 1) & 7)) << 4);
    const int k2r = (tid >> 2) & 63, k2c = tid & 3, k2dst = k2r * 64 + ((k2c ^ ((k2r >> 2) & 3)) << 4);
    const int vr = DV == 128 ? (tid >> 4) : (tid >> 3), vc = DV == 128 ? (tid & 15) * 8 : (tid & 7) * 8; const int vdst0 = v_st<DV>(vr, vc), vdst1 = v_st<DV>(vr + 32, vc);
    struct Stg1 { bf16x8 k1, k2, v0, v1; } sgA, sgB;
    const int NT = ntl + ntc;
#define TROW(t) ((t) < ntl ? lat0 + (t) * 64 : ctx0 + ((t) - ntl) * 64)
#define SLOAD(t, S) do { const size_t kr_ = (size_t)TROW(t); S.k1 = *(const bf16x8*)(K1 + (kr_ + k1r) * 512 + k1c * 8); if (DK2 && tid < 256) S.k2 = *(const bf16x8*)(K2 + (kr_ + k2r) * 32 + k2c * 8); \
        S.v0 = *(const bf16x8*)(V + (kr_ + vr) * 512 + vc); if (DV == 128) S.v1 = *(const bf16x8*)(V + (kr_ + vr + 32) * 512 + vc); } while (0)
#define SWRITE(b, S) do { *(LAS bf16x8*)(lds + L_K1 + (b) * 8192 + k1dst) = S.k1; if (DK2 && tid < 256) *(LAS bf16x8*)(lds + L_K2 + (b) * 4096 + k2dst) = S.k2; \
        *(LAS bf16x8*)(lds + L_V + (b) * (DV * 128) + vdst0) = S.v0; if (DV == 128) *(LAS bf16x8*)(lds + L_V + (b) * (DV * 128) + vdst1) = S.v1; } while (0)
    float m_reg = 0.f, l_reg = 0.f; bool first = true; f32x16 negv = f32x16{};
#pragma unroll
    for (int d = 0; d < ND; ++d) o[d] = f32x16{};
    const int rq = na.r0 + (wid >> 1), cq = 32 * (wid & 1) + r32; const int rs_w = min(max(rq - 4, 0), 120), cs = min(max(cq - 8, 0), 48);
    f32x16 pen0 = f32x16{}, pen1 = f32x16{};
    if (MODE == 1) {
#pragma unroll
        for (int r = 0; r < 16; ++r) { const int c0 = crow(r, hi), c1 = 32 + c0; pen0[r] = ((unsigned)(c0 - cs) < 16u) ? 0.f : MINIT; pen1[r] = ((unsigned)(c1 - cs) < 16u) ? 0.f : MINIT; } }
    const int vb0 = (int)(uintptr_t)(lds + L_V) + v_rd_base(lane);
    SLOAD(0, sgA);
    if (MODE == 1) { rpbl[tid] = rpv0; if (tid + NTHR < 15 * 31 + 128) rpbl[tid + NTHR] = rpv1; }
    SWRITE(0, sgA); if (1 < NT) SLOAD(1, sgA); __syncthreads();
    auto tile = [&](const int t, const int cur) __attribute__((always_inline)) {
        bool active = true; int kr = 0;
        if (MODE == 1 && t < ntl) { kr = kr_lo + t; active = (kr >= rs_w) && (kr < rs_w + 8); }
        if (active) {
            f32x16 p0, p1;
            { const LAS unsigned char* kb = lds + L_K1 + cur * 8192;
#pragma unroll
              for (int d0 = 0; d0 < 4; ++d0) { const int ch = 2 * d0 + hi;
                  const bf16x8 b0 = *(const LAS bf16x8*)(kb + r32 * 128 + ((ch ^ ((r32 >> 1) & 7)) << 4));
                  const bf16x8 b1 = *(const LAS bf16x8*)(kb + (32 + r32) * 128 + ((ch ^ (((32 + r32) >> 1) & 7)) << 4));
                  if (d0 == 0) { p0 = __builtin_amdgcn_mfma_f32_32x32x16_bf16(b0, qr[d0], negv, 0, 0, 0); p1 = __builtin_amdgcn_mfma_f32_32x32x16_bf16(b1, qr[d0], negv, 0, 0, 0); }
                  else { p0 = __builtin_amdgcn_mfma_f32_32x32x16_bf16(b0, qr[d0], p0, 0, 0, 0); p1 = __builtin_amdgcn_mfma_f32_32x32x16_bf16(b1, qr[d0], p1, 0, 0, 0); } }
              if (DK2) { const LAS unsigned char* k2b = lds + L_K2 + cur * 4096;
#pragma unroll
                  for (int d0 = 0; d0 < DK2 / 16; ++d0) { const int ch = 2 * d0 + hi;
                      const bf16x8 b0 = *(const LAS bf16x8*)(k2b + r32 * 64 + ((ch ^ ((r32 >> 2) & 3)) << 4));
                      const bf16x8 b1 = *(const LAS bf16x8*)(k2b + (32 + r32) * 64 + ((ch ^ (((32 + r32) >> 2) & 3)) << 4));
                      p0 = __builtin_amdgcn_mfma_f32_32x32x16_bf16(b0, qr[4 + d0], p0, 0, 0, 0); p1 = __builtin_amdgcn_mfma_f32_32x32x16_bf16(b1, qr[4 + d0], p1, 0, 0, 0); } }
            }
            if (MODE == 1 && t < ntl) {
                const LAS float* bl = rpbl + 64 + (kr - rq + 7) * 31 + 15 - cq;
#pragma unroll
                for (int r = 0; r < 16; ++r) { const int c0 = crow(r, hi), c1 = 32 + c0; p0[r] = (p0[r] + bl[c0]) + pen0[r]; p1[r] = (p1[r] + bl[c1]) + pen1[r]; }
            }
#define MX3B(a, b, c) __builtin_fmaxf(__builtin_fmaxf((a), (b)), (c))
            float pa_ = MX3B(p0[0], p0[1], p0[2]), pb_ = MX3B(p1[0], p1[1], p1[2]);
#pragma unroll
            for (int r = 3; r < 15; r += 2) { pa_ = MX3B(pa_, p0[r], p0[r + 1]); pb_ = MX3B(pb_, p1[r], p1[r + 1]); }
            float pmax = MX3B(pa_, pb_, p0[15]); pmax = fmaxf(pmax, p1[15]);
#undef MX3B
            { auto rr = __builtin_amdgcn_permlane32_swap(__float_as_uint(pmax), __float_as_uint(pmax), false, false); pmax = fmaxf(__uint_as_float(rr[0]), __uint_as_float(rr[1])); }
            float alpha = 1.f;
            if (first || !__all(pmax <= THR)) {
                const float dl = first ? pmax : fmaxf(pmax, 0.f); alpha = first ? 1.f : __builtin_amdgcn_exp2f(-dl); m_reg += dl;
#pragma unroll
                for (int r = 0; r < 16; ++r) { p0[r] -= dl; p1[r] -= dl; }
#pragma unroll
                for (int r = 0; r < 16; ++r) negv[r] = -m_reg;
                if (!first) { if (hi == 0) wsf[r32] = alpha;
#pragma unroll
                    for (int d = 0; d < ND; ++d)
#pragma unroll
                        for (int r = 0; r < 16; ++r) o[d][r] *= wsf[crow(r, hi)]; }
                first = false;
            }
            float ps = 0.f;
#pragma unroll
            for (int r = 0; r < 16; ++r) { p0[r] = __builtin_amdgcn_exp2f(p0[r]); p1[r] = __builtin_amdgcn_exp2f(p1[r]); ps += p0[r] + p1[r]; }
            { auto rr = __builtin_amdgcn_permlane32_swap(__float_as_uint(ps), __float_as_uint(ps), false, false); ps = __uint_as_float(rr[0]) + __uint_as_float(rr[1]); }
            l_reg = l_reg * alpha + ps;
            u32x4 w0, w1, w2, w3;
            w0 = (u32x4){cvt_pk_bf16(p0[0], p0[1]), cvt_pk_bf16(p0[2], p0[3]), cvt_pk_bf16(p0[4], p0[5]), cvt_pk_bf16(p0[6], p0[7])};
            w1 = (u32x4){cvt_pk_bf16(p0[8], p0[9]), cvt_pk_bf16(p0[10], p0[11]), cvt_pk_bf16(p0[12], p0[13]), cvt_pk_bf16(p0[14], p0[15])};
            w2 = (u32x4){cvt_pk_bf16(p1[0], p1[1]), cvt_pk_bf16(p1[2], p1[3]), cvt_pk_bf16(p1[4], p1[5]), cvt_pk_bf16(p1[6], p1[7])};
            w3 = (u32x4){cvt_pk_bf16(p1[8], p1[9]), cvt_pk_bf16(p1[10], p1[11]), cvt_pk_bf16(p1[12], p1[13]), cvt_pk_bf16(p1[14], p1[15])};
            const bf16x8 pa0 = __builtin_bit_cast(bf16x8, w0), pa1 = __builtin_bit_cast(bf16x8, w1), pa2 = __builtin_bit_cast(bf16x8, w2), pa3 = __builtin_bit_cast(bf16x8, w3);
            const int vb = vb0 + cur * (DV * 128);
            pv_one<DV, 0>(o[0], vb, pa0, pa1, pa2, pa3); pv_one<DV, 1>(o[1], vb, pa0, pa1, pa2, pa3);
            if constexpr (DV == 128) { pv_one<DV, 2>(o[2], vb, pa0, pa1, pa2, pa3); pv_one<DV, 3>(o[3], vb, pa0, pa1, pa2, pa3); }
        }
    };
    for (int t = 0; t < NT; t += 2) {
        if (t + 2 < NT) SLOAD(t + 2, sgB);
        tile(t, 0);
        if (t + 1 < NT) SWRITE(1, sgA);
        __syncthreads();
        if (t + 1 >= NT) break;
        if (t + 3 < NT) SLOAD(t + 3, sgA);
        tile(t + 1, 1);
        if (t + 2 < NT) SWRITE(0, sgB);
        __syncthreads();
    }
    l_out = l_reg;
#undef TROW
#undef SLOAD
#undef SWRITE
}
__device__ __forceinline__ void row_recip(LAS unsigned char* lds, float l_reg, float (&rli)[16]) {
    const int tid = threadIdx.x; int lane = tid & 63; asm volatile("" : "+v"(lane)); const int r32 = lane & 31, hi = lane >> 5; const int wid = __builtin_amdgcn_readfirstlane(tid >> 6);
    LAS float* wsf = (LAS float*)(lds + L_WS) + wid * 64;
    if (hi == 0) wsf[32 + r32] = l_reg;
#pragma unroll
    for (int r = 0; r < 16; ++r) rli[r] = 1.0f / wsf[32 + crow(r, hi)];
}
template <int DV> __device__ __forceinline__ void store_bf16(LAS unsigned char* lds, const f32x16 (&o)[DV / 32], float l_reg, unsigned char* Y, int ld) {
    const int tid = threadIdx.x; int lane = tid & 63; asm volatile("" : "+v"(lane)); const int r32 = lane & 31, hi = lane >> 5; const int wid = __builtin_amdgcn_readfirstlane(tid >> 6);
    float rli[16]; row_recip(lds, l_reg, rli);
    unsigned char* yw = Y + (size_t)(wid * 32) * ld + r32;
#pragma unroll
    for (int r = 0; r < 16; ++r)
#pragma unroll
        for (int d = 0; d < DV / 32; ++d) yw[(size_t)crow(r, hi) * ld + d * 32] = f8_one(o[d][r] * rli[r] * YS_BC);
}
template <int DV> __device__ __forceinline__ void store_bf16v(const f32x16 (&o)[DV / 32], const f32x16& lv, unsigned char* Y, int ld) {
    const int tid = threadIdx.x; int lane = tid & 63; asm volatile("" : "+v"(lane)); const int r32 = lane & 31, hi = lane >> 5; const int wid = __builtin_amdgcn_readfirstlane(tid >> 6);
    unsigned char* yw = Y + (size_t)(wid * 32) * ld + r32;
#pragma unroll
    for (int r = 0; r < 16; ++r) { const float rl = YS_BC / lv[r];
#pragma unroll
        for (int d = 0; d < DV / 32; ++d) yw[(size_t)crow(r, hi) * ld + d * 32] = f8_one(o[d][r] * rl); }
}
}

namespace att {
template <int DK2, int DV>
__device__ __forceinline__ void attn_pass2(LAS unsigned char* lds, const bf16* Qrow0, int ldq, const bf16* K1, const bf16* K2, const bf16* V, int lat0, int ntl, int ctx0, int ntc, f32x16 (&o)[DV / 32], float& l_out) {
    constexpr int NQ = 4 + DK2 / 16, ND = DV / 32;
    int tid_ = threadIdx.x; asm volatile("" : "+v"(tid_)); const int tid = tid_, lane = tid & 63, r32 = lane & 31, hi = lane >> 5; const int wid = __builtin_amdgcn_readfirstlane(tid >> 6);
    LAS float* wsf = (LAS float*)(lds + L_WS) + wid * 64;
    bf16x8 qr[NQ];
    { const bf16* qp = Qrow0 + (size_t)(wid * 32 + r32) * ldq + hi * 8;
#pragma unroll
      for (int d0 = 0; d0 < NQ; ++d0) qr[d0] = *(const bf16x8*)(qp + d0 * 16); }
    const int k1r = tid >> 3, k1c = tid & 7, k1dst = k1r * 128 + ((k1c ^ ((k1r >> 1) & 7)) << 4);
    const int k2r = (tid >> 2) & 63, k2c = tid & 3, k2dst = k2r * 64 + ((k2c ^ ((k2r >> 2) & 3)) << 4);
    const int vr = DV == 128 ? (tid >> 4) : (tid >> 3), vc = DV == 128 ? (tid & 15) * 8 : (tid & 7) * 8; const int vdst0 = v_st<DV>(vr, vc), vdst1 = v_st<DV>(vr + 32, vc);
    struct Stg { bf16x8 k1, x, v0; } sg[2];
    const int NT = ntl + ntc;
#define TROW(t) ((t) < ntl ? lat0 + (t) * 64 : ctx0 + ((t) - ntl) * 64)
#define SLOAD(i, t) do { const size_t kr_ = (size_t)TROW(t); sg[i].k1 = *(const bf16x8*)(K1 + (kr_ + k1r) * 512 + k1c * 8); sg[i].v0 = *(const bf16x8*)(V + (kr_ + vr) * 512 + vc); \
        if (DV == 128) sg[i].x = *(const bf16x8*)(V + (kr_ + vr + 32) * 512 + vc); else if (DK2) sg[i].x = *(const bf16x8*)(K2 + (kr_ + k2r) * 32 + k2c * 8); } while (0)
#define SWRITE(b, i) do { *(LAS bf16x8*)(lds + L_K1 + (b) * 8192 + k1dst) = sg[i].k1; *(LAS bf16x8*)(lds + L_V + (b) * (DV * 128) + vdst0) = sg[i].v0; \
        if (DV == 128) *(LAS bf16x8*)(lds + L_V + (b) * (DV * 128) + vdst1) = sg[i].x; else if (DK2) *(LAS bf16x8*)(lds + L_K2 + (b) * 4096 + k2dst) = sg[i].x; } while (0)
    float m_reg = MINIT, l_reg = 0.f;
#pragma unroll
    for (int d = 0; d < ND; ++d) o[d] = f32x16{};
    const int vb0 = (int)(uintptr_t)(lds + L_V) + v_rd_base(lane);
    const int ka0 = r32 * 128, ka1 = (32 + r32) * 128, ks0 = (r32 >> 1) & 7, ks1 = ((32 + r32) >> 1) & 7;
    const int k2a0 = r32 * 64, k2a1 = (32 + r32) * 64, k2s0 = (r32 >> 2) & 3, k2s1 = ((32 + r32) >> 2) & 3;
#define QKT(P0, P1, b) do { P0 = f32x16{}; P1 = f32x16{}; const LAS unsigned char* kb_ = lds + L_K1 + (b) * 8192; \
        _Pragma("unroll") for (int d0 = 0; d0 < 4; ++d0) { const int ch = 2 * d0 + hi; \
            const bf16x8 b0 = *(const LAS bf16x8*)(kb_ + ka0 + ((ch ^ ks0) << 4)); const bf16x8 b1 = *(const LAS bf16x8*)(kb_ + ka1 + ((ch ^ ks1) << 4)); \
            P0 = __builtin_amdgcn_mfma_f32_32x32x16_bf16(b0, qr[d0], P0, 0, 0, 0); P1 = __builtin_amdgcn_mfma_f32_32x32x16_bf16(b1, qr[d0], P1, 0, 0, 0); } \
        if (DK2) { const LAS unsigned char* k2b_ = lds + L_K2 + (b) * 4096; \
            _Pragma("unroll") for (int d0 = 0; d0 < DK2 / 16; ++d0) { const int ch = 2 * d0 + hi; \
                const bf16x8 b0 = *(const LAS bf16x8*)(k2b_ + k2a0 + ((ch ^ k2s0) << 4)); const bf16x8 b1 = *(const LAS bf16x8*)(k2b_ + k2a1 + ((ch ^ k2s1) << 4)); \
                P0 = __builtin_amdgcn_mfma_f32_32x32x16_bf16(b0, qr[4 + d0], P0, 0, 0, 0); P1 = __builtin_amdgcn_mfma_f32_32x32x16_bf16(b1, qr[4 + d0], P1, 0, 0, 0); } } } while (0)
#define PARTSM(P0, P1, AL) do { float pmax = P0[0]; \
        _Pragma("unroll") for (int r = 1; r < 16; ++r) pmax = fmaxf(pmax, P0[r]); _Pragma("unroll") for (int r = 0; r < 16; ++r) pmax = fmaxf(pmax, P1[r]); \
        { auto rr = __builtin_amdgcn_permlane32_swap(__float_as_uint(pmax), __float_as_uint(pmax), false, false); pmax = fmaxf(__uint_as_float(rr[0]), __uint_as_float(rr[1])); } \
        if (__builtin_expect(__all(pmax - m_reg <= THR), 1)) { AL = 1.f; } else { const float mn = fmaxf(m_reg, pmax); AL = __builtin_amdgcn_exp2f(m_reg - mn); m_reg = mn; } \
        _Pragma("unroll") for (int r = 0; r < 16; ++r) { P0[r] -= m_reg; P1[r] -= m_reg; } \
        _Pragma("unroll") for (int r = 0; r < 16; ++r) P0[r] = __builtin_amdgcn_exp2f(P0[r]); } while (0)
#define FINSM(P0, P1, AL) do { _Pragma("unroll") for (int r = 0; r < 16; ++r) P1[r] = __builtin_amdgcn_exp2f(P1[r]); float ps = 0.f; \
        _Pragma("unroll") for (int r = 0; r < 16; ++r) ps += P0[r]; _Pragma("unroll") for (int r = 0; r < 16; ++r) ps += P1[r]; \
        { auto rr = __builtin_amdgcn_permlane32_swap(__float_as_uint(ps), __float_as_uint(ps), false, false); ps = __uint_as_float(rr[0]) + __uint_as_float(rr[1]); } \
        l_reg = l_reg * AL + ps; \
        const u32x4 w0 = (u32x4){cvt_pk_bf16(P0[0], P0[1]), cvt_pk_bf16(P0[2], P0[3]), cvt_pk_bf16(P0[4], P0[5]), cvt_pk_bf16(P0[6], P0[7])}; \
        const u32x4 w1 = (u32x4){cvt_pk_bf16(P0[8], P0[9]), cvt_pk_bf16(P0[10], P0[11]), cvt_pk_bf16(P0[12], P0[13]), cvt_pk_bf16(P0[14], P0[15])}; \
        const u32x4 w2 = (u32x4){cvt_pk_bf16(P1[0], P1[1]), cvt_pk_bf16(P1[2], P1[3]), cvt_pk_bf16(P1[4], P1[5]), cvt_pk_bf16(P1[6], P1[7])}; \
        const u32x4 w3 = (u32x4){cvt_pk_bf16(P1[8], P1[9]), cvt_pk_bf16(P1[10], P1[11]), cvt_pk_bf16(P1[12], P1[13]), cvt_pk_bf16(P1[14], P1[15])}; \
        pa0 = __builtin_bit_cast(bf16x8, w0); pa1 = __builtin_bit_cast(bf16x8, w1); pa2 = __builtin_bit_cast(bf16x8, w2); pa3 = __builtin_bit_cast(bf16x8, w3); } while (0)
#define PV(b) do { const int vb_ = vb0 + (b) * (DV * 128); pv_one<DV, 0>(o[0], vb_, pa0, pa1, pa2, pa3); pv_one<DV, 1>(o[1], vb_, pa0, pa1, pa2, pa3); \
        if constexpr (DV == 128) { pv_one<DV, 2>(o[2], vb_, pa0, pa1, pa2, pa3); pv_one<DV, 3>(o[3], vb_, pa0, pa1, pa2, pa3); } } while (0)
#define RESC(AL) do { if (__any((AL) < 1.f)) { if (hi == 0) wsf[r32] = (AL); \
        _Pragma("unroll") for (int d = 0; d < ND; ++d) _Pragma("unroll") for (int r = 0; r < 16; ++r) o[d][r] *= wsf[crow(r, hi)]; } } while (0)
#define SB() __builtin_amdgcn_sched_barrier(0)
    f32x16 pA0, pA1, pB0, pB1; float alA, alB; bf16x8 pa0, pa1, pa2, pa3;
    SLOAD(0, 0); SWRITE(0, 0); __syncthreads();
    QKT(pA0, pA1, 0); PARTSM(pA0, pA1, alA);
    SLOAD(1, 1); if (2 < NT) SLOAD(0, 2);
    SWRITE(1, 1); __syncthreads();
    RESC(alA);
    for (int j = 1; j + 1 < NT; j += 2) {
        SB(); QKT(pB0, pB1, 1);
        FINSM(pA0, pA1, alA); SB();
        SLOAD(1, j + 2); SB();
        PV(0); PARTSM(pB0, pB1, alB);
        __syncthreads(); SWRITE(0, 0);
        RESC(alB); __syncthreads();
        SB(); QKT(pA0, pA1, 0);
        FINSM(pB0, pB1, alB); SB();
        if (j + 3 < NT) SLOAD(0, j + 3); SB();
        PV(1); PARTSM(pA0, pA1, alA);
        __syncthreads(); SWRITE(1, 1);
        RESC(alA); __syncthreads();
    }
    SB(); QKT(pB0, pB1, 1);
    FINSM(pA0, pA1, alA); SB();
    PV(0); PARTSM(pB0, pB1, alB);
    RESC(alB);
    FINSM(pB0, pB1, alB); SB();
    PV(1);
    __syncthreads();
    l_out = l_reg;
#undef TROW
#undef SLOAD
#undef SWRITE
#undef QKT
#undef PARTSM
#undef FINSM
#undef PV
#undef RESC
#undef SB
}
}
namespace att {
__device__ __forceinline__ unsigned pk4_fp8_nc(float a, float b, float c, float d) { int w = 0; w = __builtin_amdgcn_cvt_pk_fp8_f32(a, b, w, false); w = __builtin_amdgcn_cvt_pk_fp8_f32(c, d, w, true); return (unsigned)w; }
}
namespace att {
template <int DK2, int DV>
__device__ __forceinline__ void attn_pass_f8(LAS unsigned char* lds, const bf16* Qrow0, int ldq, const unsigned char* K1, const bf16* K2, const unsigned char* VT, int vt_stride, int lat0, int ntl, int ctx0, int ntc, f32x16 (&o)[DV / 32], f32x16& l_out) {
    constexpr int NQ2 = DK2 / 16, ND = DV / 32;
    typedef int i32x4_ __attribute__((ext_vector_type(4))); typedef int i32x8_ __attribute__((ext_vector_type(8)));
    int tid_ = threadIdx.x; asm volatile("" : "+v"(tid_)); const int tid = tid_, lane = tid & 63, r32 = lane & 31, hi = lane >> 5; const int wid = __builtin_amdgcn_readfirstlane(tid >> 6);
    LAS float* wsf = (LAS float*)(lds + L_WS) + wid * 64;
    bf16x8 qr2[NQ2 ? NQ2 : 1]; i32x8_ q8;
    const int wq = wid & 3, drow = 16 * wq + (lane >> 2), vrow = (DV == 128 ? 16 * wid : 16 * wq) + (lane >> 2);
    const unsigned char* k1src = K1 + (size_t)drow * 512 + (((lane & 3) ^ ((drow >> 2) & 3)) << 4);
    const unsigned char* vsrc = VT + vrow * 64 + (((lane & 3) ^ ((vrow >> 2) & 3)) << 4);
    const bf16* k2src = K2 + (size_t)drow * 32 + (((lane & 3) ^ ((drow >> 2) & 3)) << 3);
    const bool k1on = (DV == 128) ? (wid < 4) : (wid >= 4), von = (DV == 128) || (wid < 4), k2on = (DK2 != 0) && (wid < 4);
    const int NT = ntl + ntc;
#define TROW(t) ((t) < ntl ? lat0 + (t) * 64 : ctx0 + ((t) - ntl) * 64)
#define GLDS(src, dstoff) __builtin_amdgcn_global_load_lds((const unsigned*)(src), (LAS unsigned*)(lds + (dstoff)), 16, 0, 0)
#define DMA(t) do { const size_t kr_ = (size_t)TROW(t); const int b_ = (t) & 3; \
        if (von) GLDS(vsrc + (size_t)(kr_ >> 6) * vt_stride, L_V + b_ * (DV * 64) + (DV == 128 ? wid : wq) * 1024); \
        if (k1on) GLDS(k1src + kr_ * 512, L_K1 + b_ * 4096 + wq * 1024); \
        if (k2on) GLDS(k2src + kr_ * 32, L_K2 + b_ * 4096 + wq * 1024); } while (0)
#define WAITDMA(k) do { if (wid < 4) { if ((k) >= 2) asm volatile("s_waitcnt vmcnt(4)" ::: "memory"); else if ((k) == 1) asm volatile("s_waitcnt vmcnt(2)" ::: "memory"); else asm volatile("s_waitcnt vmcnt(0)" ::: "memory"); } \
        else { if ((k) >= 2) asm volatile("s_waitcnt vmcnt(2)" ::: "memory"); else if ((k) == 1) asm volatile("s_waitcnt vmcnt(1)" ::: "memory"); else asm volatile("s_waitcnt vmcnt(0)" ::: "memory"); } } while (0)
#define BAR() do { asm volatile("s_waitcnt lgkmcnt(0)" ::: "memory"); __builtin_amdgcn_s_barrier(); asm volatile("" ::: "memory"); } while (0)
    float m_reg = 0.f, nm = 0.f; f32x16 ol = f32x16{}; f32x16 negv = f32x16{};
#define negm ((f32x16){nm, nm, nm, nm, nm, nm, nm, nm, nm, nm, nm, nm, nm, nm, nm, nm})
    i32x8_ ones8 = (i32x8_){0x38383838, 0x38383838, 0x38383838, 0x38383838, 0x38383838, 0x38383838, 0x38383838, 0x38383838}; asm volatile("" : "+v"(ones8));
#pragma unroll
    for (int d = 0; d < ND; ++d) o[d] = f32x16{};
    const int va0 = r32 * 64 + (((2 * hi) ^ ((r32 >> 2) & 3)) << 4), va1 = r32 * 64 + (((2 * hi + 1) ^ ((r32 >> 2) & 3)) << 4);
    int f8scale = 0x7f7f7f7f; asm volatile("" : "+v"(f8scale));
    int sclK = 0x7c7c7c7c, sclQ = 0x7b7b7b7b; asm volatile("" : "+v"(sclK), "+v"(sclQ));
    const int ka0 = r32 * 64, ka1 = (32 + r32) * 64, ks0 = (r32 >> 2) & 3;
    const int k2a0 = r32 * 64, k2a1 = (32 + r32) * 64, k2s0 = (r32 >> 2) & 3, k2s1 = ((32 + r32) >> 2) & 3;
#define QKT(P0, P1, b) do { const LAS unsigned char* kb_ = lds + L_K1 + (b) * 4096; \
        const i32x4_ a00_ = *(const LAS i32x4_*)(kb_ + ka0 + (((2 * hi) ^ ks0) << 4)), a01_ = *(const LAS i32x4_*)(kb_ + ka0 + (((2 * hi + 1) ^ ks0) << 4)); \
        const i32x4_ a10_ = *(const LAS i32x4_*)(kb_ + ka1 + (((2 * hi) ^ ks0) << 4)), a11_ = *(const LAS i32x4_*)(kb_ + ka1 + (((2 * hi + 1) ^ ks0) << 4)); \
        if (DK2) { const LAS unsigned char* k2b_ = lds + L_K2 + (b) * 4096; \
            _Pragma("unroll") for (int d0 = 0; d0 < DK2 / 16; ++d0) { const int ch = 2 * d0 + hi; \
                const bf16x8 b0 = *(const LAS bf16x8*)(k2b_ + k2a0 + ((ch ^ k2s0) << 4)); const bf16x8 b1 = *(const LAS bf16x8*)(k2b_ + k2a1 + ((ch ^ k2s1) << 4)); \
                if (d0 == 0) { P0 = __builtin_amdgcn_mfma_f32_32x32x16_bf16(b0, qr2[d0], negv, 0, 0, 0); P1 = __builtin_amdgcn_mfma_f32_32x32x16_bf16(b1, qr2[d0], negv, 0, 0, 0); } \
                else { P0 = __builtin_amdgcn_mfma_f32_32x32x16_bf16(b0, qr2[d0], P0, 0, 0, 0); P1 = __builtin_amdgcn_mfma_f32_32x32x16_bf16(b1, qr2[d0], P1, 0, 0, 0); } } } \
        { const i32x8_ kf0_ = __builtin_shufflevector(a00_, a01_, 0, 1, 2, 3, 4, 5, 6, 7), kf1_ = __builtin_shufflevector(a10_, a11_, 0, 1, 2, 3, 4, 5, 6, 7); \
          if (DK2) { \
            asm volatile("s_nop 1\n\tv_mfma_scale_f32_32x32x64_f8f6f4 %0, %1, %2, %0, %3, %4 op_sel_hi:[0,0,0]" : "+v"(P0) : "v"(kf0_), "v"(q8), "v"(sclK), "v"(sclQ)); \
            asm volatile("s_nop 1\n\tv_mfma_scale_f32_32x32x64_f8f6f4 %0, %1, %2, %0, %3, %4 op_sel_hi:[0,0,0]" : "+v"(P1) : "v"(kf1_), "v"(q8), "v"(sclK), "v"(sclQ)); \
          } else {     \
            asm volatile("s_nop 1\n\tv_mfma_scale_f32_32x32x64_f8f6f4 %0, %1, %2, %3, %4, %5 op_sel_hi:[0,0,0]" : "=&v"(P0) : "v"(kf0_), "v"(q8), "v"(negv), "v"(sclK), "v"(sclQ)); \
            asm volatile("s_nop 1\n\tv_mfma_scale_f32_32x32x64_f8f6f4 %0, %1, %2, %3, %4, %5 op_sel_hi:[0,0,0]" : "=&v"(P1) : "v"(kf1_), "v"(q8), "v"(negv), "v"(sclK), "v"(sclQ)); } } } while (0)
#define STIE_LONG(P0, P1) asm volatile("s_nop 15\n\ts_nop 7" : "+v"(P0), "+v"(P1))
#define STIE_SHORT(P0, P1) asm volatile("s_nop 7" : "+v"(P0), "+v"(P1))
#define MX3(a, b, c) __builtin_fmaxf(__builtin_fmaxf((a), (b)), (c))
#define PARTSM(P0, P1, AL, FIRST) do { float pa_ = MX3(P0[0], P0[1], P0[2]), pb_ = MX3(P1[0], P1[1], P1[2]); \
        _Pragma("unroll") for (int r = 3; r < 15; r += 2) { pa_ = MX3(pa_, P0[r], P0[r + 1]); pb_ = MX3(pb_, P1[r], P1[r + 1]); } \
        float pmax = MX3(pa_, pb_, P0[15]); pmax = fmaxf(pmax, P1[15]); \
        { auto rr = __builtin_amdgcn_permlane32_swap(__float_as_uint(pmax), __float_as_uint(pmax), false, false); pmax = fmaxf(__uint_as_float(rr[0]), __uint_as_float(rr[1])); } \
        if (!(FIRST) && __builtin_expect(__all(pmax <= THR), 1)) { AL = 1.f; } else { const float dl = (FIRST) ? pmax : fmaxf(pmax, 0.f); AL = (FIRST) ? 1.f : __builtin_amdgcn_exp2f(-dl); m_reg += dl; \
            _Pragma("unroll") for (int r = 0; r < 16; ++r) { P0[r] -= dl; P1[r] -= dl; } nm = -m_reg; _Pragma("unroll") for (int r = 0; r < 16; ++r) negv[r] = nm; } \
        _Pragma("unroll") for (int r = 0; r < 16; ++r) P0[r] = __builtin_amdgcn_exp2f(P0[r]); } while (0)
#define FINSM(P0, P1, AL) do { _Pragma("unroll") for (int r = 0; r < 16; ++r) P1[r] = __builtin_amdgcn_exp2f(P1[r]); \
        p8 = (i32x8_){(int)pk4_fp8_nc(P0[0], P0[1], P0[2], P0[3]), (int)pk4_fp8_nc(P0[4], P0[5], P0[6], P0[7]), (int)pk4_fp8_nc(P0[8], P0[9], P0[10], P0[11]), (int)pk4_fp8_nc(P0[12], P0[13], P0[14], P0[15]), \
                       (int)pk4_fp8_nc(P1[0], P1[1], P1[2], P1[3]), (int)pk4_fp8_nc(P1[4], P1[5], P1[6], P1[7]), (int)pk4_fp8_nc(P1[8], P1[9], P1[10], P1[11]), (int)pk4_fp8_nc(P1[12], P1[13], P1[14], P1[15])}; } while (0)
#define PV1(d, vb_) do { const i32x4_ x0_ = *(const LAS i32x4_*)(vb_ + (d) * 2048 + va0), x1_ = *(const LAS i32x4_*)(vb_ + (d) * 2048 + va1); \
        const i32x8_ bf_ = __builtin_shufflevector(x0_, x1_, 0, 1, 2, 3, 4, 5, 6, 7); \
        asm volatile("v_mfma_scale_f32_32x32x64_f8f6f4 %0, %1, %2, %0, %3, %3 op_sel_hi:[0,0,0]" : "+v"(o[d]) : "v"(p8), "v"(bf_), "v"(f8scale)); } while (0)
#define PV(b) do { const LAS unsigned char* vb_ = lds + L_V + (b) * (DV * 64); asm volatile("s_nop 4" : "+v"(p8)); PV1(0, vb_); PV1(1, vb_); if constexpr (DV == 128) { PV1(2, vb_); PV1(3, vb_); } PVL(); } while (0)
#define PVL() asm volatile("v_mfma_scale_f32_32x32x64_f8f6f4 %0, %1, %2, %0, %3, %3 op_sel_hi:[0,0,0]" : "+v"(ol) : "v"(p8), "v"(ones8), "v"(f8scale))
#define PVT(b, T0, T1) do { const LAS unsigned char* vb_ = lds + L_V + (b) * (DV * 64); asm volatile("s_nop 4" : "+v"(p8)); PV1(0, vb_); STIE_SHORT(T0, T1); PV1(1, vb_); if constexpr (DV == 128) { PV1(2, vb_); PV1(3, vb_); } PVL(); } while (0)
#define OTIE() do { if constexpr (DV == 128) asm volatile("s_nop 15\n\ts_nop 15\n\ts_nop 15\n\ts_nop 15\n\ts_nop 15" : "+v"(o[0]), "+v"(o[1]), "+v"(o[2]), "+v"(o[3]), "+v"(ol)); else asm volatile("s_nop 15\n\ts_nop 15\n\ts_nop 15\n\ts_nop 15\n\ts_nop 15" : "+v"(o[0]), "+v"(o[1]), "+v"(ol)); } while (0)
#define RESC(AL) do { if (__any((AL) < 1.f)) { OTIE(); if (hi == 0) wsf[r32] = (AL); \
        _Pragma("unroll") for (int r = 0; r < 16; ++r) { const float a_ = wsf[crow(r, hi)]; ol[r] *= a_; _Pragma("unroll") for (int d = 0; d < ND; ++d) o[d][r] *= a_; } } } while (0)
#define SB() __builtin_amdgcn_sched_barrier(0)
    f32x16 pA0, pA1, pB0, pB1; float alA, alB; i32x8_ p8;
    __syncthreads();
    DMA(0); DMA(1); DMA(2); if (3 < NT) DMA(3);
    { const bf16* qp = Qrow0 + (size_t)(wid * 32 + r32) * ldq; unsigned w_[8];
#pragma unroll
      for (int i = 0; i < 4; ++i) { const u32x4 x = *(const u32x4*)(qp + hi * 32 + i * 8);
          w_[2 * i] = pk4_fp8_nc(bf_lo(x.x) * 16.0f, bf_hi(x.x) * 16.0f, bf_lo(x.y) * 16.0f, bf_hi(x.y) * 16.0f); w_[2 * i + 1] = pk4_fp8_nc(bf_lo(x.z) * 16.0f, bf_hi(x.z) * 16.0f, bf_lo(x.w) * 16.0f, bf_hi(x.w) * 16.0f); }
      q8 = (i32x8_){(int)w_[0], (int)w_[1], (int)w_[2], (int)w_[3], (int)w_[4], (int)w_[5], (int)w_[6], (int)w_[7]};
#pragma unroll
      for (int d0 = 0; d0 < NQ2; ++d0) qr2[d0] = *(const bf16x8*)(qp + 64 + d0 * 16 + hi * 8); }
    WAITDMA(3 < NT ? 3 : 2); BAR();
    QKT(pA0, pA1, 0); STIE_LONG(pA0, pA1); PARTSM(pA0, pA1, alA, true);
    WAITDMA(3 < NT ? 2 : 1); BAR();
    for (int j = 1; j + 1 < NT; j += 2) {
        SB(); QKT(pB0, pB1, j & 3);
        FINSM(pA0, pA1, alA); SB();
        PVT((j - 1) & 3, pB0, pB1); PARTSM(pB0, pB1, alB, false);
        BAR();
        if (j + 3 < NT) DMA(j + 3);
        RESC(alB);
        WAITDMA(j + 3 < NT ? 2 : (j + 2 < NT ? 1 : 0)); BAR();
        SB(); QKT(pA0, pA1, (j + 1) & 3);
        FINSM(pB0, pB1, alB); SB();
        PVT(j & 3, pA0, pA1); PARTSM(pA0, pA1, alA, false);
        BAR();
        if (j + 4 < NT) DMA(j + 4);
        RESC(alA);
        WAITDMA(j + 4 < NT ? 2 : (j + 3 < NT ? 1 : 0)); BAR();
    }
    SB(); QKT(pB0, pB1, (NT - 1) & 3);
    FINSM(pA0, pA1, alA); SB();
    PVT((NT - 2) & 3, pB0, pB1); PARTSM(pB0, pB1, alB, false);
    RESC(alB);
    FINSM(pB0, pB1, alB); SB();
    PV((NT - 1) & 3);
    OTIE();
    __syncthreads();
    l_out = ol;
#undef TROW
#undef GLDS
#undef DMA
#undef WAITDMA
#undef BAR
#undef QKT
#undef PARTSM
#undef MX3
#undef FINSM
#undef PV
#undef PV1
#undef PVT
#undef PVL
#undef negm
#undef STIE_LONG
#undef STIE_SHORT
#undef OTIE
#undef RESC
#undef SB
}
}

__device__ __forceinline__ int vt_slot(int k) { const int half = k >> 5, kk = k & 31, hi = (kk >> 2) & 1, r = (kk & 3) + 4 * (kk >> 3); return 32 * hi + r + 16 * half; }
template <int DVX, int NH> __device__ __forceinline__ void vt_item(Frame& F, const bf16* Vsrc, unsigned char* VTdst, int item, LAS unsigned char* scr) {
    const int tt = item / NH, h = item - tt * NH, key = F.lane, slot = vt_slot(key);
    const bf16* vrow = Vsrc + (size_t)(tt * 64 + key) * 512 + h * DVX;
#pragma unroll 4
    for (int d = 0; d < DVX; d += 8) { const u32x4 w = *(const u32x4*)(vrow + d);
        const unsigned lo = pk4_fp8(bf_lo(w.x), bf_hi(w.x), bf_lo(w.y), bf_hi(w.y)), hi2 = pk4_fp8(bf_lo(w.z), bf_hi(w.z), bf_lo(w.w), bf_hi(w.w));
#pragma unroll
        for (int i = 0; i < 4; ++i) { scr[(d + i) * 64 + slot] = (unsigned char)(lo >> (8 * i)); scr[(d + 4 + i) * 64 + slot] = (unsigned char)(hi2 >> (8 * i)); } }
    LDS_WAIT(); asm volatile("" ::: "memory");
    unsigned char* dst = VTdst + (size_t)item * (DVX * 64);
#pragma unroll
    for (int i = 0; i < DVX / 16; ++i) *(u32x4*)(dst + (i * 64 + F.lane) * 16) = *(const LAS u32x4*)(scr + (i * 64 + F.lane) * 16);
    LDS_WAIT(); asm volatile("" ::: "memory");
}
__device__ __forceinline__ void p_vt(Frame& F) {
    LAS unsigned char* scr = F.lds + RING_OFF + F.wave * 8192;
    const int gw = F.vcu * NWAVES + F.wave, NGW = F.G * NWAVES;
    for (int it = gw; it < (MTOT / 64) * 4; it += NGW) vt_item<128, 4>(F, (const bf16*)(F.ws + WS_VA), F.ws + WS_VTA, it, scr);
    for (int it = gw; it < (MTOT / 64) * 8; it += NGW) vt_item<64, 8>(F, (const bf16*)(F.ws + WS_VC), F.ws + WS_VTC, it, scr);
}
__device__ __forceinline__ void p_attention(Frame& F, int l) {
    using namespace att;
    LAS unsigned char* lds = F.lds + RING_OFF;
    const int wid = F.wave;
    const bf16 *QA = (const bf16*)(F.ws + WS_QA), *KA = (const bf16*)(F.ws + WS_KA), *VA = (const bf16*)(F.ws + WS_VA), *QB = (const bf16*)(F.ws + WS_QB), *KB = (const bf16*)(F.ws + WS_KB), *VB = (const bf16*)(F.ws + WS_VB);
    const bf16 *QC = (const bf16*)(F.ws + WS_QC), *KCN = (const bf16*)(F.ws + WS_KCN), *VC = (const bf16*)(F.ws + WS_VC), *CKR = (const bf16*)(F.ws + WS_CKR);
    unsigned char *YA = F.ws + WS_YA, *YB = YA + (size_t)MTOT * 512, *YC = YB + (size_t)MTOT * 512; float* O0 = (float*)(F.ws + WS_O0);
    const float* lamp = (const float*)(F.ws + WS_TAB) + 192 * 16 * 2 + 192 * 8 * 2; const float lam = lamp[2 * l], lam_init = lamp[2 * l + 1];
    const float* gsub = in_l(F, I_GSUB, l, 128);
    const int nctxA = (l == 0) ? 16 : 0, nctxBC = (l == 0) ? 32 : 0;
    const NaParams na0{nullptr, 0};
    int cslot = 0;
    for (int u = F.vcu; u < 512 + nctxA; u += F.G) {
        int b, h, qrow0, ntl;
        if (u < 512) { b = u >> 7; h = (u >> 5) & 3; qrow0 = b * SEQ + (u & 31) * 256; ntl = 128; } else { const int v = u - 512; b = v >> 2; h = v & 3; qrow0 = NLAT + b * CTXL; ntl = 0; }
        const int lat0 = b * SEQ, ctx0 = NLAT + b * CTXL;
        for (int c = 0; c < 2; ++c) {
            f32x16 o[4]; f32x16 lv;
            attn_pass_f8<0, 128>(lds, QA + (size_t)qrow0 * 512 + h * 128 + c * 64, 512, (const unsigned char*)KA + h * 128 + c * 64, nullptr, F.ws + WS_VTA + h * 8192, 4 * 8192, lat0, ntl, ctx0, 4, o, lv);
            float rli[16];
#pragma unroll
            for (int r = 0; r < 16; ++r) rli[r] = 1.0f / lv[r];
            int lane_ = F.lane; asm volatile("" : "+v"(lane_)); const int r32 = lane_ & 31, hi = lane_ >> 5;
            float* o0w = O0 + (size_t)(qrow0 + wid * 32) * 512 + h * 128 + r32;
            if (c == 0) {
#pragma unroll
                for (int r = 0; r < 16; ++r)
#pragma unroll
                    for (int d = 0; d < 4; ++d) o0w[(size_t)crow(r, hi) * 512 + d * 32] = o[d][r] * rli[r];
            } else {
                float ss[16];
#pragma unroll
                for (int r = 0; r < 16; ++r) { float s = 0.f;
#pragma unroll
                    for (int d = 0; d < 4; ++d) { const float y = o0w[(size_t)crow(r, hi) * 512 + d * 32] - lam * (o[d][r] * rli[r]); o[d][r] = y; s += y * y; }
                    ss[r] = s; }
#pragma unroll
                for (int r = 0; r < 16; ++r) {
#pragma unroll
                    for (int x = 1; x < 32; x <<= 1) ss[r] += __shfl_xor(ss[r], x);
                    ss[r] = __builtin_amdgcn_rsqf(ss[r] * (1.0f / 128.0f) + EPS) * (1.0f - lam_init); }
                unsigned char* yw = YA + (size_t)(qrow0 + wid * 32) * 512 + h * 128 + r32;
#pragma unroll
                for (int d = 0; d < 4; ++d) { const float g = gsub[d * 32 + r32] * YS_A;
#pragma unroll
                    for (int r = 0; r < 16; ++r) yw[(size_t)crow(r, hi) * 512 + d * 32] = f8_one(o[d][r] * ss[r] * g); }
            }
        }
    }
    for (int u = F.vcu; u < 1024 + nctxBC; u += F.G) {
        int b, h, qrow0, ntl;
        if (u < 1024) { b = u >> 8; h = (u >> 5) & 7; qrow0 = b * SEQ + (u & 31) * 256; ntl = 128; } else { const int v = u - 1024; b = v >> 3; h = v & 7; qrow0 = NLAT + b * CTXL; ntl = 0; }
        f32x16 o[2]; f32x16 lv;
        attn_pass_f8<32, 64>(lds, QC + (size_t)qrow0 * 768 + h * 96, 768, (const unsigned char*)KCN + h * 64, CKR, F.ws + WS_VTC + h * 4096, 8 * 4096, b * SEQ, ntl, NLAT + b * CTXL, 4, o, lv);
        store_bf16v<64>(o, lv, YC + (size_t)qrow0 * 512 + h * 64, 512);
        if (cslot == (F.vcu & 3)) {
            LAS float* cscr = (LAS float*)(F.lds + RING_OFF + F.wave * 8704); const int NGWc = F.G * NWAVES; const int njobs = (l == 0) ? PAIRS_LAYER : (l == 1 ? PAIRS_LAYER - NE_PAIRS : 0);
            __syncthreads();
            for (int cj = F.vcu * NWAVES + F.wave; cj < njobs; cj += NGWc) {
                const int pr_ = (l == 0) ? (cj < PAIRS_LAYER - NE_PAIRS ? NE_PAIRS + cj : PAIRS_LAYER + (cj - (PAIRS_LAYER - NE_PAIRS))) : (PAIRS_LAYER + NE_PAIRS + cj);
                convert_item(F, 2 * pr_, cscr); convert_item(F, 2 * pr_ + 1, cscr); }
            __syncthreads();
        }
        ++cslot;
    }
    for (int u = F.vcu; u < 1024; u += F.G) {
        const int b = u >> 8, h = (u >> 5) & 7, qb = u & 31, r0 = qb * 4, qrow0 = b * SEQ + qb * 256;
        const int kr_lo = min(max(r0 - 4, 0), 120), kr_hi = min(max(r0 + 3 - 4, 0), 120) + 7;
        const NaParams na{in_l(F, I_RPB, l, 8 * 15 * 31) + h * 15 * 31, r0};
        f32x16 o[2]; float lsum;
        attn_pass<0, 64, 1>(lds, QB + (size_t)qrow0 * 512 + h * 64, 512, KB + h * 64, nullptr, VB + h * 64, b * SEQ + kr_lo * 64, kr_hi - kr_lo + 1, NLAT + b * CTXL, 4, na, kr_lo, o, lsum);
        store_bf16<64>(lds, o, lsum, YB + (size_t)qrow0 * 512 + h * 64, 512);
    }
    for (int u = F.vcu; u < nctxBC; u += F.G) {
        const int b = u >> 3, h = u & 7, qrow0 = NLAT + b * CTXL;
        f32x16 o[2]; float lsum;
        attn_pass<0, 64, 0>(lds, QB + (size_t)qrow0 * 512 + h * 64, 512, KB + h * 64, nullptr, VB + h * 64, 0, 0, qrow0, 4, na0, 0, o, lsum);
        store_bf16<64>(lds, o, lsum, YB + (size_t)qrow0 * 512 + h * 64, 512);
    }
}

constexpr int TB_RECW = 6656, TB_CNT = 128;
constexpr int TB_LCNT = 0, TB_GBASE = 128, TB_BASE = 256, TB_TILE = 4096, TB_REC = 1280;
__device__ __forceinline__ float route_reduce(float (&acc)[32], int lane) {
#pragma unroll
    for (int i = 0; i < 16; ++i) { const bool up = (lane & 32) != 0; const float keep = up ? acc[i + 16] : acc[i], send = up ? acc[i] : acc[i + 16]; acc[i] = keep + __shfl_xor(send, 32); }
#pragma unroll
    for (int i = 0; i < 8; ++i) { const bool up = (lane & 16) != 0; const float keep = up ? acc[i + 8] : acc[i], send = up ? acc[i] : acc[i + 8]; acc[i] = keep + __shfl_xor(send, 16); }
#pragma unroll
    for (int i = 0; i < 4; ++i) { const bool up = (lane & 8) != 0; const float keep = up ? acc[i + 4] : acc[i], send = up ? acc[i] : acc[i + 4]; acc[i] = keep + __shfl_xor(send, 8); }
#pragma unroll
    for (int i = 0; i < 2; ++i) { const bool up = (lane & 4) != 0; const float keep = up ? acc[i + 2] : acc[i], send = up ? acc[i] : acc[i + 2]; acc[i] = keep + __shfl_xor(send, 4); }
    { const bool up = (lane & 2) != 0; const float keep = up ? acc[1] : acc[0], send = up ? acc[0] : acc[1]; acc[0] = keep + __shfl_xor(send, 2); }
    return acc[0] + __shfl_xor(acc[0], 1);
}
__device__ __forceinline__ void route_topk(float logit, int lane, LAS int* lcnt, LAS int* rec_row, float* w_row) {
    float tv[4]; int te[4];
#pragma unroll
    for (int k = 0; k < 4; ++k) { float mx = logit;
#pragma unroll
        for (int o = 1; o < 64; o <<= 1) mx = fmaxf(mx, __shfl_xor(mx, o));
        const unsigned long long bal = __ballot(logit == mx); const int fl = __builtin_ctzll(bal); te[k] = fl >> 1; tv[k] = mx; if ((lane >> 1) == te[k]) logit = -INFINITY; }
    const float e1 = __expf(tv[1] - tv[0]), e2 = __expf(tv[2] - tv[0]), e3 = __expf(tv[3] - tv[0]); const float inv = 1.0f / (1.0f + e1 + e2 + e3);
    if (lane < 4) { const int ee = lane == 0 ? te[0] : lane == 1 ? te[1] : lane == 2 ? te[2] : te[3]; const float ww = (lane == 0 ? 1.0f : lane == 1 ? e1 : lane == 2 ? e2 : e3) * inv;
        const int pos = __hip_atomic_fetch_add(lcnt + ee, 1, __ATOMIC_RELAXED, __HIP_MEMORY_SCOPE_WORKGROUP); rec_row[lane] = ee | (pos << 8); w_row[lane] = ww; }
}
__device__ __forceinline__ void p_route(Frame& F, int l, int M, int bank) {
    constexpr int ASTR = 2064;
    LAS unsigned char* Ahi = F.lds + RING_OFF; LAS unsigned char* Alo = Ahi + 16 * ASTR; LAS float* part = (LAS float*)(Ahi + 32 * ASTR); LAS float* lgt = part + 8 * 16 * 32;
    LAS int* lcnt = (LAS int*)(F.lds + TBL_OFF + TB_LCNT); LAS int* gbase = (LAS int*)(F.lds + TBL_OFF + TB_GBASE); LAS int* rec = (LAS int*)(F.lds + TBL_OFF + TB_REC); LAS float* recw = (LAS float*)(F.lds + TBL_OFF + TB_RECW);
    if (F.tid < 32) lcnt[F.tid] = 0;
    int lane_ = F.lane; asm volatile("" : "+v"(lane_)); const int fr = lane_ & 15, kq = lane_ >> 4;
    pg8::bf16x8 Wh[4][2], Wl[4][2];
    { const float* Wr = in_l(F, I_WROUT, l, 1024 * 32) + (size_t)(128 * F.wave + 8 * kq) * 32 + fr;
#pragma unroll
      for (int t = 0; t < 4; ++t)
#pragma unroll
          for (int nb = 0; nb < 2; ++nb)
#pragma unroll
              for (int i = 0; i < 8; ++i) { const float w = Wr[(size_t)(32 * t + i) * 32 + 16 * nb]; const unsigned h = f2bf(w); const unsigned lo = f2bf(w - __uint_as_float(h << 16)); Wh[t][nb][i] = (short)h; Wl[t][nb][i] = (short)lo; } }
    __syncthreads();
    const int rpb = (M + F.G - 1) / F.G, m0 = F.vcu * rpb, m1 = min(M, m0 + rpb);
    const float* modv = (const float*)(F.ws + WS_MODV) + (size_t)l * 5 * 6144; const unsigned short* X = (const unsigned short*)(F.ws + WS_X); unsigned char* H = F.ws + WS_H;
    const f32x4* g = (const f32x4*)in_l(F, I_GFFN, l, DM); const float* brp = in_l(F, I_BROUT, l, 32); f32x4 gv[4];
#pragma unroll
    for (int j = 0; j < 4; ++j) gv[j] = g[F.lane + 64 * j];
    int* rt_e = (int*)(F.ws + WS_ROUTE + RT_E); int* rt_slot = (int*)(F.ws + WS_ROUTE + RT_SLOT); float* rt_w = (float*)(F.ws + WS_ROUTE + RT_W);
    const int ntrips = (m1 - m0 + 15) >> 4;
    f32x4 nA[4], nB[4];
    if (m1 > m0) { const int mA = min(m0 + 2 * F.wave, m1 - 1), mB = min(mA + 1, m1 - 1);
#pragma unroll
      for (int j = 0; j < 4; ++j) { const float4 a_ = xb_ld4_(X + (size_t)mA * DM + 4 * (F.lane + 64 * j)), b_ = xb_ld4_(X + (size_t)mB * DM + 4 * (F.lane + 64 * j)); nA[j] = (f32x4){a_.x, a_.y, a_.z, a_.w}; nB[j] = (f32x4){b_.x, b_.y, b_.z, b_.w}; } }
    for (int trip = 0; trip < ntrips; ++trip) {
        const int mp = m0 + 16 * trip + 2 * F.wave; const bool one = mp < m1, two = mp + 1 < m1; const int mA = min(mp, m1 - 1), mB = min(mp + 1, m1 - 1);
        f32x4 vA[4], vB[4]; float sA = 0.f, sB = 0.f;
#pragma unroll
        for (int j = 0; j < 4; ++j) { vA[j] = nA[j]; vB[j] = nB[j]; sA += (vA[j].x * vA[j].x + vA[j].y * vA[j].y) + (vA[j].z * vA[j].z + vA[j].w * vA[j].w); sB += (vB[j].x * vB[j].x + vB[j].y * vB[j].y) + (vB[j].z * vB[j].z + vB[j].w * vB[j].w); }
        { const int pA = min(mp + 16, m1 - 1), pB = min(pA + 1, m1 - 1);
#pragma unroll
          for (int j = 0; j < 4; ++j) { const float4 a_ = xb_ld4_(X + (size_t)pA * DM + 4 * (F.lane + 64 * j)), b_ = xb_ld4_(X + (size_t)pB * DM + 4 * (F.lane + 64 * j)); nA[j] = (f32x4){a_.x, a_.y, a_.z, a_.w}; nB[j] = (f32x4){b_.x, b_.y, b_.z, b_.w}; } }
        const float rA = 1.0f / sqrtf(wave_sum(sA) * (1.0f / DM) + EPS), rB = 1.0f / sqrtf(wave_sum(sB) * (1.0f / DM) + EPS);
        const int bA = mA < NLAT ? mA / SEQ : 4, bB = mB < NLAT ? mB / SEQ : 4;
        typedef unsigned u32x2r_ __attribute__((ext_vector_type(2)));
        f32x4 scA[4], shA[4], scB[4], shB[4];
#pragma unroll
        for (int j = 0; j < 4; ++j) { scA[j] = ((const f32x4*)(modv + bA * 6144 + 4 * 1024))[F.lane + 64 * j]; shA[j] = ((const f32x4*)(modv + bA * 6144 + 3 * 1024))[F.lane + 64 * j]; scB[j] = scA[j]; shB[j] = shA[j]; }
        if (bB != bA) {
#pragma unroll
            for (int j = 0; j < 4; ++j) { scB[j] = ((const f32x4*)(modv + bB * 6144 + 4 * 1024))[F.lane + 64 * j]; shB[j] = ((const f32x4*)(modv + bB * 6144 + 3 * 1024))[F.lane + 64 * j]; } }
#pragma unroll
        for (int j = 0; j < 4; ++j) { const f32x4 gg = gv[j];
            vA[j] = vA[j] * rA * gg * (scA[j] + 1.0f) + shA[j];
            vB[j] = vB[j] * rB * gg * (scB[j] + 1.0f) + shB[j];
            if (one) put_h4<F8_MOE != 0>(H + (size_t)mA * HROW_MOE, F.lane, j, vA[j]); if (two) put_h4<F8_MOE != 0>(H + (size_t)mB * HROW_MOE, F.lane, j, vB[j]);
            { unsigned h0 = f2bf(vA[j].x), h1 = f2bf(vA[j].y), h2 = f2bf(vA[j].z), h3 = f2bf(vA[j].w);
              const unsigned l0 = f2bf(vA[j].x - __uint_as_float(h0 << 16)), l1 = f2bf(vA[j].y - __uint_as_float(h1 << 16)), l2 = f2bf(vA[j].z - __uint_as_float(h2 << 16)), l3 = f2bf(vA[j].w - __uint_as_float(h3 << 16));
              const int off = (2 * F.wave) * ASTR + (256 * j + 4 * F.lane) * 2;
              *(LAS u32x2r_*)(Ahi + off) = (u32x2r_){h0 | (h1 << 16), h2 | (h3 << 16)}; *(LAS u32x2r_*)(Alo + off) = (u32x2r_){l0 | (l1 << 16), l2 | (l3 << 16)}; }
            { unsigned h0 = f2bf(vB[j].x), h1 = f2bf(vB[j].y), h2 = f2bf(vB[j].z), h3 = f2bf(vB[j].w);
              const unsigned l0 = f2bf(vB[j].x - __uint_as_float(h0 << 16)), l1 = f2bf(vB[j].y - __uint_as_float(h1 << 16)), l2 = f2bf(vB[j].z - __uint_as_float(h2 << 16)), l3 = f2bf(vB[j].w - __uint_as_float(h3 << 16));
              const int off = (2 * F.wave + 1) * ASTR + (256 * j + 4 * F.lane) * 2;
              *(LAS u32x2r_*)(Ahi + off) = (u32x2r_){h0 | (h1 << 16), h2 | (h3 << 16)}; *(LAS u32x2r_*)(Alo + off) = (u32x2r_){l0 | (l1 << 16), l2 | (l3 << 16)}; } }
        __syncthreads();
        f32x4 acc[2] = {(f32x4){0.f, 0.f, 0.f, 0.f}, (f32x4){0.f, 0.f, 0.f, 0.f}};
#pragma unroll
        for (int t = 0; t < 4; ++t) { const int ao = fr * ASTR + (128 * F.wave + 32 * t + 8 * kq) * 2;
            const pg8::bf16x8 ah = *(const LAS pg8::bf16x8*)(Ahi + ao), al = *(const LAS pg8::bf16x8*)(Alo + ao);
#pragma unroll
            for (int nb = 0; nb < 2; ++nb) { acc[nb] = __builtin_amdgcn_mfma_f32_16x16x32_bf16(ah, Wh[t][nb], acc[nb], 0, 0, 0);
                acc[nb] = __builtin_amdgcn_mfma_f32_16x16x32_bf16(ah, Wl[t][nb], acc[nb], 0, 0, 0); acc[nb] = __builtin_amdgcn_mfma_f32_16x16x32_bf16(al, Wh[t][nb], acc[nb], 0, 0, 0); } }
#pragma unroll
        for (int nb = 0; nb < 2; ++nb)
#pragma unroll
            for (int i = 0; i < 4; ++i) part[(F.wave * 16 + 4 * kq + i) * 32 + 16 * nb + fr] = acc[nb][i];
        __syncthreads();
        { const int row = F.tid >> 5, e = F.tid & 31; float s = 0.f;
#pragma unroll
          for (int w8 = 0; w8 < 8; ++w8) s += part[(w8 * 16 + row) * 32 + e];
          float lg = s + brp[e];
          const int hl = F.lane & 31, hf = F.lane >> 5; float tv[4]; int te[4];
#pragma unroll
          for (int k = 0; k < 4; ++k) { float mx = lg;
#pragma unroll
              for (int o = 1; o < 32; o <<= 1) mx = fmaxf(mx, __shfl_xor(mx, o));
              const unsigned long long bal = __ballot(lg == mx); const unsigned hb = hf ? (unsigned)(bal >> 32) : (unsigned)bal; te[k] = __builtin_ctz(hb); tv[k] = mx; if (hl == te[k]) lg = -INFINITY; }
          const float e1 = __expf(tv[1] - tv[0]), e2 = __expf(tv[2] - tv[0]), e3 = __expf(tv[3] - tv[0]); const float inv = 1.0f / (1.0f + e1 + e2 + e3);
          const bool okr = hf ? two : one; const int mrow = hf ? mB : mA;
          if (okr && hl < 4) { const int ee = hl == 0 ? te[0] : hl == 1 ? te[1] : hl == 2 ? te[2] : te[3]; const float ww = (hl == 0 ? 1.0f : hl == 1 ? e1 : hl == 2 ? e2 : e3) * inv;
              const int pos = __hip_atomic_fetch_add(lcnt + ee, 1, __ATOMIC_RELAXED, __HIP_MEMORY_SCOPE_WORKGROUP); rec[(mrow - m0) * 4 + hl] = ee | (pos << 8); recw[(mrow - m0) * 4 + hl] = ww; }
        }
    }
    __syncthreads();
    if (F.tid < 32) gbase[F.tid] = (int)atomicAdd(F.ctl + CW_CNT + bank * 64 + F.tid, (unsigned)lcnt[F.tid]);
    __syncthreads();
    { int* xs = (int*)(F.ws + WS_XS); float* xw = (float*)(F.ws + WS_XW);
      for (int i = F.tid; i < (m1 - m0) * 4; i += NTHR) { const int r = rec[i], e = r & 255, pos = r >> 8; const size_t xi = (size_t)e * MTOT + gbase[e] + pos; xs[xi] = m0 * 4 + i; xw[xi] = recw[i]; } }
    __syncthreads();
}
__device__ __forceinline__ int build_expert_tables(Frame& F, int l) {
    LAS int* base = (LAS int*)(F.lds + TBL_OFF + TB_BASE); LAS int* tile_e = (LAS int*)(F.lds + TBL_OFF + TB_TILE);
    LAS int* padc = (LAS int*)(F.lds + TBL_OFF + TB_LCNT);
    __syncthreads();
    if (F.tid < 64) {
        const int c = F.tid < 32 ? (int)__hip_atomic_load(F.ctl + CW_CNT + l * 64 + (F.tid & 31), __ATOMIC_RELAXED, __HIP_MEMORY_SCOPE_AGENT) : 0;
        const int pc = F.tid < 32 ? (((c + 255) >> 8) << 8) : 0; int inc = pc;
#pragma unroll
        for (int o = 1; o < 32; o <<= 1) { const int v = __shfl_up(inc, o); if ((F.tid & 63) >= o) inc += v; }
        if (F.tid < 32) { padc[F.tid] = pc; base[F.tid] = inc - pc; if (F.tid == 31) base[32] = inc; ((LAS int*)(F.lds + TBL_OFF + TB_CNT))[F.tid] = c; }
    }
    __syncthreads();
    { typedef int i32x4t_ __attribute__((ext_vector_type(4))); i32x4t_ bq[8];
#pragma unroll
      for (int q = 0; q < 8; ++q) bq[q] = ((const LAS i32x4t_*)base)[q];
      for (int t = F.tid; t < 640; t += NTHR) { const int r0 = t * 256; int e = -1;
#pragma unroll
          for (int q = 0; q < 8; ++q) e += (bq[q].x <= r0 ? 1 : 0) + (bq[q].y <= r0 ? 1 : 0) + (bq[q].z <= r0 ? 1 : 0) + (bq[q].w <= r0 ? 1 : 0);
          tile_e[t] = e; } }
    __syncthreads();
    return base[32] >> 8;
}
__device__ __forceinline__ void p_gather(Frame& F, int l, int M) {
    (void)build_expert_tables(F, l);
    LAS int* base = (LAS int*)(F.lds + TBL_OFF + TB_BASE);
    const int* rt_e = (const int*)(F.ws + WS_ROUTE + RT_E); const int* rt_slot = (const int*)(F.ws + WS_ROUTE + RT_SLOT); const float* rt_w = (const float*)(F.ws + WS_ROUTE + RT_W);
    int* ydst = (int*)(F.ws + WS_ROUTE + RT_YDST); float* wrow = (float*)(F.ws + WS_ROUTE + RT_WROW); int* ysrc = (int*)(F.ws + WS_ROUTE + RT_YSRC);
    for (int i = blockIdx.x * NTHR + F.tid; i < M * 4; i += F.G * NTHR) { const int e = rt_e[i]; const int dst = base[e] + rt_slot[i]; ydst[dst] = i; wrow[dst] = rt_w[i]; ysrc[dst] = i >> 2; }
    for (int i = blockIdx.x * NTHR + F.tid; i < 32 * 256; i += F.G * NTHR) { const int e = i >> 8, j = i & 255; const int c = (int)__hip_atomic_load(F.ctl + CW_CNT + l * 64 + e, __ATOMIC_RELAXED, __HIP_MEMORY_SCOPE_AGENT);
        const int r = base[e] + c + j; if (r < base[e + 1]) { ydst[r] = -1; wrow[r] = 0.f; ysrc[r] = 0; } }
}
__device__ __forceinline__ void p_combine(Frame& F, int l, int M) {
    const int gw = F.vcu * NWAVES + F.wave, NGW = F.G * NWAVES; const bool last = (l == DEPTH - 1);
    const float* modv = (const float*)(F.ws + WS_MODV) + (size_t)l * 5 * 6144; const float* modn = modv + 5 * 6144; unsigned short* X = (unsigned short*)(F.ws + WS_X); unsigned char* H = F.ws + WS_H; const bf16* YB = (const bf16*)(F.ws + WS_YBUF);
    const f32x4* gnp = (const f32x4*)(last ? F.in[I_GFIN] : in_l(F, I_GMIX, l + 1, DM)); f32x4 gn[4];
#pragma unroll
    for (int j = 0; j < 4; ++j) gn[j] = gnp[F.lane + 64 * j];
    unsigned long long ny[4][4]; f32x4 nxr[4];
#define CLOAD(mm) do { _Pragma("unroll") for (int j = 0; j < 4; ++j) { _Pragma("unroll") for (int k = 0; k < 4; ++k) ny[j][k] = ((const unsigned long long*)(YB + (size_t)((mm) * 4 + k) * DM))[F.lane + 64 * j]; \
        { const float4 x_ = xb_ld4_(X + (size_t)(mm) * DM + 4 * (F.lane + 64 * j)); nxr[j] = (f32x4){x_.x, x_.y, x_.z, x_.w}; } } } while (0)
    if (gw < M) CLOAD(gw);
    for (int m = gw; m < M; m += NGW) {
        const int b = m < NLAT ? m / SEQ : 4; const f32x4* gt2 = (const f32x4*)(modv + b * 6144 + 5 * 1024);
        unsigned short* xr = X + (size_t)m * DM + 4 * F.lane; f32x4 v[4]; float s = 0.f;
        unsigned long long cy[4][4]; f32x4 cx[4];
#pragma unroll
        for (int j = 0; j < 4; ++j) { cx[j] = nxr[j];
#pragma unroll
            for (int k = 0; k < 4; ++k) cy[j][k] = ny[j][k]; }
        { const int mn = min(m + NGW, M - 1); CLOAD(mn); }
#pragma unroll
        for (int j = 0; j < 4; ++j) { f32x4 y = (f32x4){0.f, 0.f, 0.f, 0.f};
#pragma unroll
            for (int k = 0; k < 4; ++k) { const unsigned long long w = cy[j][k]; const unsigned lo = (unsigned)w, hi = (unsigned)(w >> 32);
                y += (f32x4){bf_lo(lo), bf_hi(lo), bf_lo(hi), bf_hi(hi)}; }
            v[j] = cx[j] + gt2[F.lane + 64 * j] * y; s += (v[j].x * v[j].x + v[j].y * v[j].y) + (v[j].z * v[j].z + v[j].w * v[j].w); }
        const float rstd = 1.0f / sqrtf(wave_sum(s) * (1.0f / DM) + EPS);
        if (!last) {
            const f32x4* sh = (const f32x4*)(modn + b * 6144); const f32x4* sc = (const f32x4*)(modn + b * 6144 + 1024); f32x4 shv[4], scv[4];
#pragma unroll
            for (int j = 0; j < 4; ++j) { shv[j] = sh[F.lane + 64 * j]; scv[j] = sc[F.lane + 64 * j]; }
#pragma unroll
            for (int j = 0; j < 4; ++j) { *(u32x2x_t*)(xr + 256 * j) = (u32x2x_t){cvt_pk_bf16(v[j].x, v[j].y), cvt_pk_bf16(v[j].z, v[j].w)}; const f32x4 y = v[j] * rstd * gn[j] * (scv[j] + 1.0f) + shv[j];
                put_h4<F8_IN1 != 0>(H + (size_t)m * HROW_INL(1), F.lane, j, y); }
        } else {
            f32x4* op = (f32x4*)(F.out + (size_t)m * DM) + F.lane;
#pragma unroll
            for (int j = 0; j < 4; ++j) op[64 * j] = v[j] * rstd * gn[j];
        }
    }
#undef CLOAD
}

constexpr int NSAMP = 12, NCHK = 16;
__device__ __forceinline__ int sample_row(int i) { const int r[NSAMP] = {0, 1, 63, 64, 4097, 8191, 8192, 20000, 32767, 32768, 33000, 33791}; int v = 0;
#pragma unroll
    for (int j = 0; j < NSAMP; ++j) v = (i == j) ? r[j] : v; return v; }
__device__ __forceinline__ void dbg_note(Frame& F, int chk, float a, float e, float scale, float tol) {
    float err = fabsf(a - e) / (fabsf(e) + scale); if (!(err == err)) err = 1e30f;
    if (err > tol) atomicAdd(F.ctl + CW_DBG + chk, 1u);
    atomicMax(F.ctl + CW_DBG + 64 + chk, __float_as_uint(err));
}
__device__ __forceinline__ float bfr(float x) { return __uint_as_float(f2bf(x) << 16); }
__device__ __forceinline__ void chk_in(Frame& F, int l, int chk) {
    if (F.vcu >= NSAMP) return;
    const int row = sample_row(F.vcu); const bool ctx = row >= NLAT; const int pos = row % SEQ; const float prow = (float)(pos / 64), pcol = (float)(pos % 64);
    LAS float* raw = (LAS float*)(F.lds + RING_OFF); LAS float* hs = raw + 7168;
    const unsigned char* H = F.ws + WS_H + (size_t)row * DM; const float* W = in_l(F, I_WIN, l, (size_t)DM * DIN);
    for (int k = F.tid; k < DM; k += NTHR) hs[k] = __builtin_amdgcn_cvt_f32_fp8((int)H[k], 0);
    __syncthreads();
    for (int j = F.tid; j < DIN; j += NTHR) { float s = 0.f; for (int k = 0; k < DM; ++k) s += hs[k] * bfr(W[(size_t)k * DIN + j]); raw[j] = s; }
    __syncthreads();
    const bf16 *QA = (const bf16*)(F.ws + WS_QA), *KA = (const bf16*)(F.ws + WS_KA), *VA = (const bf16*)(F.ws + WS_VA), *QB = (const bf16*)(F.ws + WS_QB), *KB = (const bf16*)(F.ws + WS_KB), *VB = (const bf16*)(F.ws + WS_VB);
    const bf16 *CQ = (const bf16*)(F.ws + WS_CQ), *CKR = (const bf16*)(F.ws + WS_CKR), *CKV = (const bf16*)(F.ws + WS_CKV), *GT = (const bf16*)(F.ws + WS_GATES);
    for (int j = F.tid; j < DIN; j += NTHR) {
        float e, a;
        if (j < 1024) {
            const int g = j >> 6, d = j & 63, q = d & 15, blk = d >> 4;
            const float inv = powf(10000.0f, -(float)q / 16.0f), ang = (blk < 2 ? prow : pcol) * inv, c = ctx ? 1.f : cosf(ang), s = ctx ? 0.f : sinf(ang);
            const int da = (blk & 2) * 16 + q, db = da + 16; const float av = raw[g * 64 + da], bv = raw[g * 64 + db];
            e = (blk & 1) ? bv * c + av * s : av * c - bv * s; if (j < 512) e *= QSCALE_AB;
            const int p = 2 * ((blk >> 1) * 16 + q) + (blk & 1);
            a = bf2f((j < 512 ? QA : KA)[(size_t)row * 512 + (g & 7) * 64 + p]);
        } else if (j < 3072) { const int seg = (j - 1024) >> 9, c = (j - 1024) & 511; e = raw[j] * (seg == 1 ? QSCALE_AB : 1.f); a = bf2f((seg == 0 ? VA : seg == 1 ? QB : seg == 2 ? KB : VB)[(size_t)row * 512 + c]); }
        else if (j < 3456) { e = raw[j]; a = bf2f(CQ[(size_t)row * 384 + (j - 3072)]); }
        else if (j < 3712) { e = raw[j]; a = bf2f(CKV[(size_t)row * 256 + (j - 3456)]); }
        else if (j < 3744) { const int d = j - 3712, q = d & 7, blk = d >> 3; const float inv = powf(10000.0f, -(float)q / 8.0f), ang = (blk < 2 ? prow : pcol) * inv, c = ctx ? 1.f : cosf(ang), s = ctx ? 0.f : sinf(ang);
            const int da = (blk & 2) * 8 + q, db = da + 8; const float av = raw[3712 + da], bv = raw[3712 + db];
            e = (blk & 1) ? bv * c + av * s : av * c - bv * s; const int p = 2 * ((blk >> 1) * 8 + q) + (blk & 1); a = bf2f(CKR[(size_t)row * 32 + p]); }
        else { e = 1.0f / (1.0f + expf(-raw[j])); a = bf2f(GT[(size_t)row * 3072 + (j - 3744)]); }
        dbg_note(F, chk, a, e, 0.1f, 0.25f);
    }
    if (F.tid == 0) { float sq = 0.f, sk = 0.f; for (int j = 3072; j < 3456; ++j) sq += raw[j] * raw[j]; for (int j = 3456; j < 3712; ++j) sk += raw[j] * raw[j];
        const float* ssq = (const float*)(F.ws + CTL_SSQ); float a = 0.f, b = 0.f; for (int i = 0; i < 8; ++i) a += ssq[(size_t)row * 8 + i]; for (int i = 0; i < 4; ++i) b += ssq[(size_t)MTOT * 8 + (size_t)row * 4 + i]; dbg_note(F, chk, a, sq, 0.05f, 0.1f); dbg_note(F, chk, b, sk, 0.05f, 0.1f); }
    __syncthreads();
}
__device__ __forceinline__ void p_dbg_emit(Frame& F) {
    int id = 0; float me = 0.f;
    for (int c = 1; c < NCHK; ++c) { const unsigned n = F.ctl[CW_DBG + c]; const float e = __uint_as_float(F.ctl[CW_DBG + 64 + c]); if (id == 0) { if (n > 0u) { id = c; me = e; } else me = fmaxf(me, e); } }
    float k = rintf(10.0f * (log10f(fmaxf(me, 1e-6f)) + 6.0f)); k = fminf(fmaxf(k, 0.f), 89.f);
    const float A = sqrtf((float)((10 + id) * 10) - 1.0f), Bv = (10.0f + k) * 100.0f;
    for (size_t i = (size_t)blockIdx.x * NTHR + F.tid; i < (size_t)NLAT * DM; i += (size_t)F.G * NTHR) { unsigned h = (unsigned)i * 2654435761u; h ^= h >> 15; h *= 2246822519u; h ^= h >> 13; F.out[i] = (i == 0) ? Bv : ((h & 1u) ? A : -A); }
}

__device__ __forceinline__ void chk_qkv(Frame& F, int l, int chk) {
    if (F.vcu >= NSAMP) return;
    const int row = sample_row(F.vcu); const bool ctx = row >= NLAT; const int pos = row % SEQ; const float prow = (float)(pos / 64), pcol = (float)(pos % 64);
    LAS float* raw = (LAS float*)(F.lds + RING_OFF);
    const bf16* CQ = (const bf16*)(F.ws + WS_CQ) + (size_t)row * 384; const bf16* CKV = (const bf16*)(F.ws + WS_CKV) + (size_t)row * 256;
    const float* ssq = (const float*)(F.ws + CTL_SSQ); float sqa = 0.f, ska = 0.f; for (int i = 0; i < 8; ++i) sqa += ssq[(size_t)row * 8 + i]; for (int i = 0; i < 4; ++i) ska += ssq[(size_t)MTOT * 8 + (size_t)row * 4 + i];
    const float rq = 1.0f / sqrtf(sqa / 384.0f + EPS), rk = 1.0f / sqrtf(ska / 256.0f + EPS);
    const float* Wq = in_l(F, I_WQB, l, 384 * 768); const float* gq = in_l(F, I_GQA, l, 384); const float* Wk = in_l(F, I_WKVB, l, 256 * 1024); const float* gk = in_l(F, I_GKVA, l, 256);
    for (int n = F.tid; n < 768; n += NTHR) { float s = 0.f; for (int k = 0; k < 384; ++k) s += bf2f(CQ[k]) * bfr(Wq[(size_t)k * 768 + n] * gq[k]); raw[n] = s * rq * QSCALE_C; }
    __syncthreads();
    const bf16* QC = (const bf16*)(F.ws + WS_QC) + (size_t)row * 768;
    for (int n = F.tid; n < 768; n += NTHR) { const int h = n / 96, p = n % 96; float e, a;
        if (p < 64) { e = raw[n]; a = bf2f(QC[n]); }
        else { const int d = p - 64, q = d & 7, blk = d >> 3; const float inv = powf(10000.0f, -(float)q / 8.0f), ang = (blk < 2 ? prow : pcol) * inv, c = ctx ? 1.f : cosf(ang), s = ctx ? 0.f : sinf(ang);
            const int da = (blk & 2) * 8 + q, db = da + 8; const float av = raw[h * 96 + 64 + da], bv = raw[h * 96 + 64 + db];
            e = (blk & 1) ? bv * c + av * s : av * c - bv * s; a = bf2f(QC[h * 96 + 64 + 2 * ((blk >> 1) * 8 + q) + (blk & 1)]); }
        dbg_note(F, chk, a, e, 0.05f, 0.03f); }
    const bf16* KCN = (const bf16*)(F.ws + WS_KCN) + (size_t)row * 512; const bf16* VC = (const bf16*)(F.ws + WS_VC) + (size_t)row * 512;
    for (int n = F.tid; n < 1024; n += NTHR) { float s = 0.f; for (int k = 0; k < 256; ++k) s += bf2f(CKV[k]) * bfr(Wk[(size_t)k * 1024 + n] * gk[k]); s *= rk;
        const int h = n >> 7, d = n & 127; const float a = d < 64 ? bf2f(KCN[h * 64 + d]) : bf2f(VC[h * 64 + d - 64]); dbg_note(F, chk, a, s, 0.05f, 0.03f); }
    __syncthreads();
}
__device__ __forceinline__ void naive_attn(Frame& F, LAS float* sc, LAS float* red, LAS float* res, const bf16* q, int dk1, const bf16* K1, const bf16* q2, int dk2, const bf16* K2, const bf16* V, int dv,
                                           int lat0, int nlat, int ctx0, int nctx, int mode, const float* rpb_h, int rq, int cq, int kr_lo) {
    const int NK = nlat + nctx;
    for (int i = F.tid; i < NK; i += NTHR) { const size_t kr = i < nlat ? (size_t)lat0 + i : (size_t)ctx0 + (i - nlat); float s = 0.f;
        for (int d = 0; d < dk1; ++d) s += bf2f(q[d]) * bf2f(K1[kr * 512 + d]);
        for (int d = 0; d < dk2; ++d) s += bf2f(q2[d]) * bf2f(K2[kr * 32 + d]);
        if (mode == 1 && i < nlat) { const int krr = kr_lo + i / 64, ck = i % 64, rs = min(max(rq - 4, 0), 120), cs = min(max(cq - 8, 0), 48);
            if (krr < rs || krr >= rs + 8 || ck < cs || ck >= cs + 16) s = -INFINITY; else s += rpb_h[(krr - rq + 7) * 31 + min(max(ck - cq + 15, 0), 30)] * LOG2E; }
        sc[i] = s; }
    __syncthreads();
    float mx = -INFINITY; for (int i = F.tid; i < NK; i += NTHR) mx = fmaxf(mx, sc[i]);
    for (int o = 1; o < 64; o <<= 1) mx = fmaxf(mx, __shfl_xor(mx, o)); if (F.lane == 0) red[F.wave] = mx; __syncthreads();
    mx = red[0]; for (int w = 1; w < 8; ++w) mx = fmaxf(mx, red[w]); __syncthreads();
    float sm = 0.f; for (int i = F.tid; i < NK; i += NTHR) { const float p = exp2f(sc[i] - mx); sc[i] = p; sm += p; }
    sm = wave_sum(sm); if (F.lane == 0) red[F.wave] = sm; __syncthreads();
    sm = 0.f; for (int w = 0; w < 8; ++w) sm += red[w];
    if (F.tid < dv) { float a = 0.f; for (int i = 0; i < NK; ++i) { const size_t kr = i < nlat ? (size_t)lat0 + i : (size_t)ctx0 + (i - nlat); a += sc[i] * bf2f(V[kr * 512 + F.tid]); } res[F.tid] = a / sm; }
    __syncthreads();
}
__device__ __forceinline__ void chk_attn(Frame& F, int l, int chk) {
    if (F.vcu >= NSAMP) return;
    const int row = sample_row(F.vcu); const bool ctx = row >= NLAT; if (ctx && l > 0) return;
    const int b = ctx ? (row - NLAT) / CTXL : row / SEQ, pos = row % SEQ, rq = pos / 64, cq = pos % 64;
    LAS float* sc = (LAS float*)(F.lds + RING_OFF); LAS float* red = sc + 8704; LAS float* res = red + 16; LAS float* res0 = res + 128;
    const int lat0 = b * SEQ, nlat = ctx ? 0 : SEQ, ctx0 = NLAT + b * CTXL;
    const bf16 *QA = (const bf16*)(F.ws + WS_QA), *KA = (const bf16*)(F.ws + WS_KA), *VA = (const bf16*)(F.ws + WS_VA), *QB = (const bf16*)(F.ws + WS_QB), *KB = (const bf16*)(F.ws + WS_KB), *VB = (const bf16*)(F.ws + WS_VB);
    const bf16 *QC = (const bf16*)(F.ws + WS_QC), *KCN = (const bf16*)(F.ws + WS_KCN), *VC = (const bf16*)(F.ws + WS_VC), *CKR = (const bf16*)(F.ws + WS_CKR);
    const bf16 *YA = (const bf16*)(F.ws + WS_YA), *YB = (const bf16*)(F.ws + WS_YB), *YC = (const bf16*)(F.ws + WS_YC);
    const float* lamp = (const float*)(F.ws + WS_TAB) + 192 * 16 * 2 + 192 * 8 * 2; const float lam = lamp[2 * l], lam_init = lamp[2 * l + 1]; const float* gsub = in_l(F, I_GSUB, l, 128);
    { const float lr = expf(0.f); (void)lr; }
    for (int h = 0; h < 4; ++h) {
        naive_attn(F, sc, red, res, QA + (size_t)row * 512 + h * 128, 64, KA + h * 128, nullptr, 0, nullptr, VA + h * 128, 128, lat0, nlat, ctx0, CTXL, 0, nullptr, 0, 0, 0);
        if (F.tid < 128) res0[F.tid] = res[F.tid]; __syncthreads();
        naive_attn(F, sc, red, res, QA + (size_t)row * 512 + h * 128 + 64, 64, KA + h * 128 + 64, nullptr, 0, nullptr, VA + h * 128, 128, lat0, nlat, ctx0, CTXL, 0, nullptr, 0, 0, 0);
        if (F.tid < 128) res0[F.tid] = res0[F.tid] - lam * res[F.tid]; __syncthreads();
        float ss = 0.f; for (int d = 0; d < 128; ++d) ss += res0[d] * res0[d];
        if (F.tid < 128) { const float e = res0[F.tid] / sqrtf(ss / 128.0f + EPS) * gsub[F.tid] * (1.0f - lam_init); dbg_note(F, chk, bf2f(YA[(size_t)row * 512 + h * 128 + F.tid]), e, 0.1f, 0.04f); }
        __syncthreads();
    }
    for (int h = 0; h < 8; ++h) {
        const int kr_lo = min(max(rq - 4, 0), 120);
        if (ctx) naive_attn(F, sc, red, res, QB + (size_t)row * 512 + h * 64, 64, KB + h * 64, nullptr, 0, nullptr, VB + h * 64, 64, 0, 0, ctx0, CTXL, 0, nullptr, 0, 0, 0);
        else naive_attn(F, sc, red, res, QB + (size_t)row * 512 + h * 64, 64, KB + h * 64, nullptr, 0, nullptr, VB + h * 64, 64, lat0 + kr_lo * 64, 512, ctx0, CTXL, 1, in_l(F, I_RPB, l, 8 * 15 * 31) + h * 465, rq, cq, kr_lo);
        if (F.tid < 64) dbg_note(F, chk + 1, bf2f(YB[(size_t)row * 512 + h * 64 + F.tid]), res[F.tid], 0.02f, 0.04f);
        __syncthreads();
        naive_attn(F, sc, red, res, QC + (size_t)row * 768 + h * 96, 64, KCN + h * 64, QC + (size_t)row * 768 + h * 96 + 64, 32, CKR, VC + h * 64, 64, lat0, nlat, ctx0, CTXL, 0, nullptr, 0, 0, 0);
        if (F.tid < 64) dbg_note(F, chk + 2, bf2f(YC[(size_t)row * 512 + h * 64 + F.tid]), res[F.tid], 0.01f, 0.04f);
        __syncthreads();
    }
}
__device__ __forceinline__ void chk_merge(Frame& F, int l, int chk) {
    if (F.vcu >= NSAMP) return; const int row = sample_row(F.vcu); if (row >= NLAT && l > 0) return;
    const bf16* Y = (const bf16*)(F.ws + WS_YA); const bf16* GT = (const bf16*)(F.ws + WS_GATES) + (size_t)row * 3072; const bf16* MB = (const bf16*)(F.ws + WS_MB) + (size_t)row * 1024;
    for (int n = F.tid; n < 1024; n += NTHR) { float m = 0.f;
        for (int br = 0; br < 3; ++br) { const float* W = in_l(F, br == 0 ? I_WBRA : br == 1 ? I_WBRB : I_WBRC, l, 512 * 1024); const bf16* y = Y + (size_t)br * MTOT * 512 + (size_t)row * 512; float s = 0.f;
            for (int k = 0; k < 512; ++k) s += bf2f(y[k]) * bfr(W[(size_t)k * 1024 + n]); m += bf2f(GT[br * 1024 + n]) * s; }
        dbg_note(F, chk, bf2f(MB[n]), m, 0.05f, 0.03f); }
}
__device__ __forceinline__ void chk_out(Frame& F, int l, int chk, const float* xprev) {
    if (F.vcu >= NSAMP || l > 0) return; const int row = sample_row(F.vcu); const int b = row < NLAT ? row / SEQ : 4;
    const float* xs = row < NLAT ? F.in[I_X] + (size_t)row * DM : F.in[I_CTX] + (size_t)(row - NLAT) * DM; const bf16* MB = (const bf16*)(F.ws + WS_MB) + (size_t)row * 1024;
    const float* W = in_l(F, I_WOUT, l, 1024 * 1024); const float* gt = (const float*)(F.ws + WS_MODV) + (size_t)(l * 5 + b) * 6144 + 2048; const float* X = (const float*)(F.ws + WS_X) + (size_t)row * DM;
    for (int n = F.tid; n < 1024; n += NTHR) { float s = 0.f; for (int k = 0; k < 1024; ++k) s += bf2f(MB[k]) * bfr(W[(size_t)k * 1024 + n]); dbg_note(F, chk, X[n], xs[n] + gt[n] * s, 0.1f, 0.01f); }
}
__device__ __forceinline__ void chk_route(Frame& F, int l, int chk) {
    if (F.vcu >= NSAMP) return; const int row = sample_row(F.vcu); if (row >= NLAT && l > 0) return; const int b = row < NLAT ? row / SEQ : 4;
    LAS float* h2 = (LAS float*)(F.lds + RING_OFF); LAS float* lg = h2 + 1024;
    const float* X = (const float*)(F.ws + WS_X) + (size_t)row * DM; const float* modv = (const float*)(F.ws + WS_MODV) + (size_t)(l * 5 + b) * 6144; const float* g = in_l(F, I_GFFN, l, DM);
    float ss = 0.f; for (int k = 0; k < DM; ++k) ss += X[k] * X[k]; const float rstd = 1.0f / sqrtf(ss / DM + EPS);
    const unsigned char* H = F.ws + WS_H + (size_t)row * DM;
    for (int k = F.tid; k < DM; k += NTHR) { const float v = X[k] * rstd * g[k] * (1.0f + modv[4096 + k]) + modv[3072 + k]; h2[k] = v; dbg_note(F, chk, __builtin_amdgcn_cvt_f32_fp8((int)H[k], 0), v, 0.05f, 0.08f); }
    __syncthreads();
    if (F.tid < 32) { const float* Wr = in_l(F, I_WROUT, l, 1024 * 32); float s = 0.f; for (int k = 0; k < DM; ++k) s += h2[k] * Wr[k * 32 + F.tid]; lg[F.tid] = s + in_l(F, I_BROUT, l, 32)[F.tid]; }
    __syncthreads();
    if (F.tid == 0) { int te[4]; float tv[4];
        for (int k = 0; k < 4; ++k) { int bi = 0; float bv = lg[0]; for (int e = 1; e < 32; ++e) { const float x = lg[e]; if (x > bv) { bv = x; bi = e; } } te[k] = bi; tv[k] = bv; lg[bi] = -INFINITY; }
        const float den = 1.0f + expf(tv[1] - tv[0]) + expf(tv[2] - tv[0]) + expf(tv[3] - tv[0]);
        const int* rt_e = (const int*)(F.ws + WS_ROUTE + RT_E); const float* rt_w = (const float*)(F.ws + WS_ROUTE + RT_W);
#pragma unroll
        for (int k = 0; k < 4; ++k) { dbg_note(F, chk, (float)rt_e[(size_t)row * 4 + k], (float)te[k], 1.0f, 0.001f); dbg_note(F, chk, rt_w[(size_t)row * 4 + k], expf(tv[k] - tv[0]) / den, 0.1f, 0.001f); } }
    __syncthreads();
}
__device__ __forceinline__ void chk_moe(Frame& F, int l, int chk) {
    if (F.vcu >= NSAMP) return; const int row = sample_row(F.vcu); if (row >= NLAT && l > 0) return;
    LAS float* hs = (LAS float*)(F.lds + RING_OFF); LAS float* act = hs + 1024;
    const unsigned char* H = F.ws + WS_H + (size_t)row * DM; for (int k = F.tid; k < DM; k += NTHR) hs[k] = __builtin_amdgcn_cvt_f32_fp8((int)H[k], 0);
    __syncthreads();
    const int* rt_e = (const int*)(F.ws + WS_ROUTE + RT_E); const float* rt_w = (const float*)(F.ws + WS_ROUTE + RT_W); const bf16* YB = (const bf16*)(F.ws + WS_YBUF);
    for (int kk = 0; kk < 4; ++kk) { const int e = rt_e[(size_t)row * 4 + kk]; const float w = rt_w[(size_t)row * 4 + kk];
        const float* Wg = in_l(F, I_WGU, l * NEXP + e, (size_t)1024 * 2048); const float* bg = in_l(F, I_BGU, l * NEXP + e, 2048); const float* Wd = in_l(F, I_WDN, l * NEXP + e, (size_t)1024 * 1024); const float* bd = in_l(F, I_BDN, l * NEXP + e, 1024);
        for (int j = F.tid; j < 1024; j += NTHR) { float sg = 0.f, su = 0.f; for (int k = 0; k < DM; ++k) { sg += hs[k] * bfr(Wg[(size_t)k * 2048 + 2 * j]); su += hs[k] * bfr(Wg[(size_t)k * 2048 + 2 * j + 1]); }
            sg += bg[2 * j]; su += bg[2 * j + 1]; const float ga = fminf(sg, 7.0f), ua = fminf(fmaxf(su, -7.0f), 7.0f); act[j] = bfr((ua + 1.0f) * (ga / (1.0f + expf(-1.702f * ga)))); }
        __syncthreads();
        for (int n = F.tid; n < 1024; n += NTHR) { float s = 0.f; for (int j = 0; j < 1024; ++j) s += act[j] * bfr(Wd[(size_t)j * 1024 + n]); dbg_note(F, chk, bf2f(YB[(size_t)(row * 4 + kk) * 1024 + n]), (s + bd[n]) * w, 0.05f, 0.3f); }
        __syncthreads(); }
}

constexpr int PH_PRO_A = 0, PH_PRO_B = 1, PH_L0 = 2, NPL = 11, N_PHASES = PH_L0 + DEPTH * NPL;
enum { LP_IN = 0, LP_QKV, LP_VT, LP_ATTN, LP_MERGE, LP_OUT, LP_ROUTE, LP_GATHER, LP_GU, LP_DN, LP_COMB };

__global__ void __launch_bounds__(NTHR, 2) trunk_fwd(Args args) {
    extern __shared__ __attribute__((aligned(16))) unsigned char lds[];
    Frame F;
    F.lds = (LAS unsigned char*)lds; F.MISC = (volatile LAS unsigned*)(F.lds + MISC_OFF);
    F.tid = threadIdx.x; F.lane = F.tid & 63; F.wave = __builtin_amdgcn_readfirstlane(F.tid >> 6);
    F.G = gridDim.x; { const int bx = blockIdx.x; F.vcu = (F.G % 8 == 0) ? (bx % 8) * (F.G / 8) + bx / 8 : bx; }
    F.ws = args.ws; F.ctl = (unsigned*)(args.ws + WS_CTL); F.in = args.in; F.out = args.out;
    for (int u = F.tid; u < (LDS_BYTES - TBL_OFF) / 4; u += NTHR) ((LAS unsigned*)(F.lds + TBL_OFF))[u] = 0u;
    __syncthreads();
    const int lo = args.ph_lo, hi = args.ph_hi;
#if DBG_CHECK
    if (lo >= 1000) { const int c = lo - 1000;
        if (c == 1) chk_in(F, 0, 1); else if (c == 2) chk_qkv(F, 0, 2); else if (c == 3) chk_attn(F, 0, 3); else if (c == 6) chk_merge(F, 0, 6); else if (c == 7) chk_out(F, 0, 7, nullptr);
        else if (c == 8) chk_route(F, 0, 8); else if (c == 9) chk_moe(F, 0, 9); else if (c == 11) chk_in(F, 1, 11); else if (c == 13) chk_attn(F, 1, 13); else if (c == 99) p_dbg_emit(F);
        return; }
#endif
    XcdBarrier bar; bar.bar = F.ctl + CW_BAR; bar.x = 0; bar.st = nullptr;
    if (MK_ONE_LAUNCH) bar = xcd_barrier_post(F.ctl + CW_BAR, F.MISC + 8);
#define IN(k) (lo <= (k) && (k) < hi)
#define SEAM(k) do { F.tid = threadIdx.x; asm volatile("" : "+v"(F.tid)); F.lane = F.tid & 63; asm volatile("" : "+s"(F.ws), "+s"(bar.bar), "+s"(F.lds), "+s"(bar.st));     \
        if (MK_ONE_LAUNCH && IN(k) && IN((k) + 1)) xcd_barrier(bar); } while (0)

    if (IN(PH_PRO_A)) { p_prologue_a(F); if (DUP_MASK & 4) { __syncthreads(); p_prologue_a(F); } } SEAM(PH_PRO_A);
    if (IN(PH_PRO_B)) { p_prologue_b(F); if (DUP_MASK & 512) { __syncthreads(); p_prologue_b(F); } } SEAM(PH_PRO_B);
    for (int l = 0; l < DEPTH; ++l) {
        F.tid = threadIdx.x; asm volatile("" : "+v"(F.tid)); F.lane = F.tid & 63;
        int bx_ = (int)blockIdx.x; asm volatile("" : "+s"(bx_), "+s"(F.G), "+s"(F.vcu));
        const int pb = PH_L0 + l * NPL; const int Ml = (l == DEPTH - 1) ? NLAT : MTOT;
        float* ssq_q = (float*)(F.ws + CTL_SSQ); float* ssq_kv = ssq_q + (size_t)MTOT * 8;
        const float* tabA = (const float*)(F.ws + WS_TAB); const float* tabC = tabA + 192 * 16 * 2;
        if (IN(pb + LP_IN)) for (int rep_ = 0; rep_ < (((DUP_MASK & 2) || (DUP_MASK & 8)) ? 2 : 1); ++rep_) {
            Gemm g{(const bf16_t*)(F.ws + WS_H), (const bf16_t*)(F.ws + WS_WIN + (size_t)l * NINP * DM * 2), MTOT, NINP, F8_INL(l) ? DM / 2 : DM};   StaticOrder S; S.init(MTOT, NINP, F.G, bx_);
            EpiIn E{(bf16_t*)(F.ws + WS_QA), (bf16_t*)(F.ws + WS_KA), (bf16_t*)(F.ws + WS_VA), (bf16_t*)(F.ws + WS_QB), (bf16_t*)(F.ws + WS_KB), (bf16_t*)(F.ws + WS_VB),
                    (bf16_t*)(F.ws + WS_CQ), (bf16_t*)(F.ws + WS_CKR), (bf16_t*)(F.ws + WS_CKV), (bf16_t*)(F.ws + WS_GATES), ssq_q, ssq_kv, tabA, tabC, F8_INL(l) ? WINV : 1.0f, F.ws + WS_VTA};
            if (F8_INL(l)) gemm_phase<EpiIn, StaticOrder, true, true, true>(F.lds + RING_OFF, g, S, E); else gemm_phase<EpiIn, StaticOrder, true, true, false>(F.lds + RING_OFF, g, S, E);
        }
        SEAM(pb + LP_IN);
        if (IN(pb + LP_QKV)) for (int rep_ = 0; rep_ < (((DUP_MASK & 2) || (DUP_MASK & 16)) ? 2 : 1); ++rep_) {
            { Gemm g{(const bf16_t*)(F.ws + WS_CQ), (const bf16_t*)(F.ws + WS_WQB) + (size_t)l * 768 * 384, MTOT, 768, 384}; StaticOrder S; S.init(MTOT, 768, F.G, bx_);
              EpiQ E{(bf16_t*)(F.ws + WS_QC), ssq_q, tabC}; gemm_phase<EpiQ, StaticOrder, true, true>(F.lds + RING_OFF, g, S, E); }
            { Gemm g{(const bf16_t*)(F.ws + WS_CKV), (const bf16_t*)(F.ws + WS_WKVB) + (size_t)l * 1024 * 256, MTOT, 1024, 256}; StaticOrder S; S.init(MTOT, 1024, F.G, bx_);
              EpiKV E{(bf16_t*)(F.ws + WS_KCN), (bf16_t*)(F.ws + WS_VC), ssq_kv, F.ws + WS_VTC}; gemm_phase<EpiKV, StaticOrder, true, true>(F.lds + RING_OFF, g, S, E); }
        }
        SEAM(pb + LP_QKV);
        if (IN(pb + LP_ATTN)) { p_attention(F, l); if (DUP_MASK & 1) { __syncthreads(); p_attention(F, l); } }
        SEAM(pb + LP_ATTN);
        if (IN(pb + LP_MERGE)) for (int rep_ = 0; rep_ < (((DUP_MASK & 2) || (DUP_MASK & 32)) ? 2 : 1); ++rep_) {
            Gemm g{(const bf16_t*)(F.ws + WS_YA), (const bf16_t*)(F.ws + WS_WBR + (size_t)l * 3 * 1024 * 512), Ml, 1024, 256};   MergeOrder S; S.S.init(Ml, 1024, F.G, bx_);
            EpiMerge E{(const bf16_t*)(F.ws + WS_GATES), F.ws + WS_M32, (bf16_t*)(F.ws + WS_MB)}; gemm_phase<EpiMerge, MergeOrder, true, true, true>(F.lds + RING_OFF, g, S, E);
        }
        SEAM(pb + LP_MERGE);
        if (IN(pb + LP_OUT)) for (int rep_ = 0; rep_ < (((DUP_MASK & 1024) && l == 0) ? 2 : 1); ++rep_) {
            Gemm g{(const bf16_t*)(F.ws + WS_M32), (const bf16_t*)(F.ws + WS_WOUT + (size_t)l * 1024 * 1024), Ml, 1024, 512};   StaticOrder S; S.init(Ml, 1024, F.G, bx_);
            EpiOut E{F.in[I_X], F.in[I_CTX], (bf16_t*)(F.ws + WS_X), (const float*)(F.ws + WS_MODV) + (size_t)l * 5 * 6144, l == 0};
            gemm_phase<EpiOut, StaticOrder, true, true, true>(F.lds + RING_OFF, g, S, E);
        }
        SEAM(pb + LP_OUT);
        if (IN(pb + LP_ROUTE)) { if (DUP_MASK & 2048) { p_route(F, l, Ml, 2 + l); __syncthreads(); } p_route(F, l, Ml, l); }
        SEAM(pb + LP_ROUTE);
        if (IN(pb + LP_GU)) for (int rep_ = 0; rep_ < (((DUP_MASK & 2) || (DUP_MASK & 64)) ? 2 : 1); ++rep_) {
            const int T = build_expert_tables(F, l);
            Gemm g{(const bf16_t*)(F.ws + WS_H), (const bf16_t*)(F.ws + WS_WGU + (size_t)l * NEXP * 2048 * 1024 * (F8_MOE ? 1 : 2)), T * 256, 2048, F8_MOE ? 512 : 1024, (const int*)(F.ws + WS_ROUTE + RT_YSRC)};
            ExpertOrder S; S.S.init(T * 256, 2048, F.G, bx_); S.tile_e = (const LAS int*)(F.lds + TBL_OFF + TB_TILE); S.nNe = 8;
            S.xs = (const int*)(F.ws + WS_XS); S.base = (const LAS int*)(F.lds + TBL_OFF + TB_BASE); S.cnt = (const LAS int*)(F.lds + TBL_OFF + TB_CNT);
            EpiGU E{(bf16_t*)(F.ws + WS_ACT), in_l(F, I_BGU, l, NEXP * 2048)}; gemm_phase<EpiGU, ExpertOrder, true, true, F8_MOE != 0, true>(F.lds + RING_OFF, g, S, E);
        }
        SEAM(pb + LP_GU);
        if (IN(pb + LP_DN)) for (int rep_ = 0; rep_ < (((DUP_MASK & 2) || (DUP_MASK & 128)) ? 2 : 1); ++rep_) {
            const int T = build_expert_tables(F, l);
            Gemm g{(const bf16_t*)(F.ws + WS_ACT), (const bf16_t*)(F.ws + WS_WDN + (size_t)l * NEXP * 1024 * 1024 * (F8_MOE ? 1 : 2)), T * 256, 1024, F8_MOE ? 512 : 1024};
            ExpertOrder S; S.S.init(T * 256, 1024, F.G, bx_); S.tile_e = (const LAS int*)(F.lds + TBL_OFF + TB_TILE); S.nNe = 4;
            EpiDown E{(bf16_t*)(F.ws + WS_YBUF), in_l(F, I_BDN, l, NEXP * 1024), (const int*)(F.ws + WS_XS), (const float*)(F.ws + WS_XW), (const LAS int*)(F.lds + TBL_OFF + TB_BASE), (const LAS int*)(F.lds + TBL_OFF + TB_CNT)};
            gemm_phase<EpiDown, ExpertOrder, true, true, F8_MOE != 0>(F.lds + RING_OFF, g, S, E);
        }
        SEAM(pb + LP_DN);
        if (IN(pb + LP_COMB)) p_combine(F, l, Ml);
        SEAM(pb + LP_COMB);
    }
#undef IN
#undef SEAM
}

extern "C" void kernel_launch(void* const* d_in, const int* in_sizes, int n_in, void* d_out, int out_size, void* d_ws, size_t ws_size, hipStream_t stream) {
    static int grid = 0;
    if (grid == 0) {
        if (n_in != 30 || out_size != NLAT * DM || ws_size < WS_END) { fprintf(stderr, "kernel_launch: shape mismatch n_in %d out %d ws %zu (need %zu)\n", n_in, out_size, ws_size, (size_t)WS_END); grid = -1; return; }
        int dev = 0, cus = 0, per_cu = 0;
        if (hipGetDevice(&dev) != hipSuccess || hipDeviceGetAttribute(&cus, hipDeviceAttributeMultiprocessorCount, dev) != hipSuccess) { grid = -1; return; }
        if (hipFuncSetAttribute((const void*)trunk_fwd, hipFuncAttributeMaxDynamicSharedMemorySize, LDS_BYTES) != hipSuccess) { fprintf(stderr, "kernel_launch: hipFuncSetAttribute failed\n"); grid = -1; return; }
        if (hipOccupancyMaxActiveBlocksPerMultiprocessor(&per_cu, (const void*)trunk_fwd, NTHR, LDS_BYTES) != hipSuccess || per_cu < 1) { fprintf(stderr, "kernel_launch: occupancy query says %d\n", per_cu); }
        (void)hipGetLastError();
        grid = cus;
    }
    if (grid < 0) return;
    (void)hipMemsetAsync((char*)d_ws + WS_CTL, 0, CTL_ZERO_BYTES, stream);
    Args a{};
    for (int i = 0; i < 30; ++i) a.in[i] = (const float*)d_in[i];
    a.out = (float*)d_out; a.ws = (unsigned char*)d_ws;
#if MK_ONE_LAUNCH
    a.ph_lo = 0; a.ph_hi = N_PHASES;
    hipLaunchKernelGGL(trunk_fwd, dim3(grid), dim3(NTHR), LDS_BYTES, stream, a);
#else
    for (int p = 0; p < N_PHASES; ++p) { a.ph_lo = p; a.ph_hi = p + 1; hipLaunchKernelGGL(trunk_fwd, dim3(grid), dim3(NTHR), LDS_BYTES, stream, a);
#if DBG_CHECK
        int c = 0; const int q = p - PH_L0;
        if (q == LP_IN) c = 1; else if (q == LP_QKV) c = 2; else if (q == LP_ATTN) c = 3; else if (q == LP_MERGE) c = 6; else if (q == LP_OUT) c = 7; else if (q == LP_ROUTE) c = 8; else if (q == LP_DN) c = 9;
        else if (q == NPL + LP_IN) c = 11; else if (q == NPL + LP_ATTN) c = 13;
        if (c) { a.ph_lo = 1000 + c; a.ph_hi = 0; hipLaunchKernelGGL(trunk_fwd, dim3(grid), dim3(NTHR), LDS_BYTES, stream, a); }
        if (p == DBG_LAST_PHASE) break;
#endif
    }
#if DBG_CHECK
    a.ph_lo = 1099; a.ph_hi = 0; hipLaunchKernelGGL(trunk_fwd, dim3(grid), dim3(NTHR), LDS_BYTES, stream, a);
#endif
#endif
    const hipError_t le = hipPeekAtLastError();
    if (le != hipSuccess) fprintf(stderr, "kernel_launch: launch failed: %s\n", hipGetErrorName(le));
}
```

```cpp
#include <hip/hip_runtime.h>
#include <cstdio>
#include <cstdint>

#ifndef MK_ONE_LAUNCH
#define MK_ONE_LAUNCH 1
#endif
#ifndef DBG_CHECK
#define DBG_CHECK 0
#endif

#ifndef DBG_LAST_PHASE
#define DBG_LAST_PHASE 9999
#endif
#ifndef DUP_MASK
#define DUP_MASK 0
#endif
#ifndef F8_IN0
#define F8_IN0 1
#endif
#ifndef F8_IN1
#define F8_IN1 1
#endif
#define F8_INL(l) ((l) == 0 ? (F8_IN0 != 0) : (F8_IN1 != 0))
#ifndef F8_MOE
#define F8_MOE 1
#endif
namespace pg8 {
#define PG8_LAS __attribute__((address_space(3)))
typedef unsigned short bf16_t;
typedef short bf16x8 __attribute__((ext_vector_type(8)));
typedef float f32x4 __attribute__((ext_vector_type(4)));
typedef unsigned u32x4 __attribute__((ext_vector_type(4)));
constexpr int BM = 256, BK = 64, HALF = 128, HTB = HALF * BK * 2  , STAGE_BYTES = 8 * HTB, NXCD = 8, WGM = 8;

__host__ __device__ __forceinline__ int lds_byte(int r, int c) { const int st = (r >> 4) * 2 + (c >> 5), rr = r & 15, cc = c & 31, ob = rr * 64 + cc * 2; return st * 1024 + (ob ^ (((ob >> 9) & 1) << 5)); }
__host__ __device__ __forceinline__ void stage_rc(int b, int& R, int& C) { const int st = b / 1024, sb = b % 1024, swz = sb ^ (((sb >> 9) & 1) << 5); R = (st >> 1) * 16 + swz / 64; C = (st & 1) * 32 + (swz % 64) / 2; }
__host__ __device__ __forceinline__ int perm32(int rho) { const int n = rho >> 4, i = rho & 15; return 8 * (i >> 2) + 4 * n + (i & 3); }

struct Unit { int pm, pn; };
struct Gemm { const bf16_t* A; const bf16_t* Bt; int M, N, K; const int* rowsrc = nullptr; };

struct StaticOrder {
    int nM, nN, nwg, G, c;
    __host__ __device__ void init(int M, int N, int G_, int c_) { nM = M / BM; nN = N / BM; nwg = nM * nN; G = G_; c = c_; }
    __host__ __device__ bool next(int i, Unit& u) const {
        const long L = (long)i * G + c; if (L >= nwg) return false;
        int wgid = (int)L; { const int q = nwg / NXCD, r = nwg % NXCD, xcd = wgid % NXCD, off = wgid / NXCD; wgid = (xcd < r ? xcd * (q + 1) : r * (q + 1) + (xcd - r) * q) + off; }
        const int nig = WGM * nN, gid = wgid / nig, fm = gid * WGM, gsz = (nM - fm) < WGM ? (nM - fm) : WGM;
        u.pm = fm + ((wgid % nig) % gsz); u.pn = (wgid % nig) / gsz; return true;
    }
    __device__ __forceinline__ void a_ready(const Unit&) const {}
    __device__ __forceinline__ void done(const Unit&) const {}
};


constexpr int DM = 1024, NBATCH = 4, SEQ = 8192, NLAT = NBATCH * SEQ, CTXL = 256, NCTX = NBATCH * CTXL, MTOT = NLAT + NCTX;
constexpr int DEPTH = 2, DIN = 6816, NINP = 6912, NEXP = 32, TOPK = 4;
constexpr int PM_CTX = NLAT / 256;
constexpr float LOG2E = 1.4426950408889634f;
constexpr float QSCALE_AB = 0.125f * LOG2E;
constexpr float QSCALE_C = 0.10206207261596575f * LOG2E;
constexpr float EPS = 1e-6f;
constexpr float YS_A = 16.0f, YS_BC = 64.0f, MS8 = 32.0f;
constexpr float WSCALE = 64.0f, WINV = 1.0f / 64.0f;
constexpr int OFF_CQ = 3072, OFF_CKR = 3456, OFF_PADW = 3488, OFF_CKV = 3584, OFF_GATES = 3840;

typedef float f32x2 __attribute__((ext_vector_type(2)));
typedef __bf16 bf16x2c_t __attribute__((ext_vector_type(2)));
__device__ __forceinline__ unsigned cvt_pk_bf16(float lo, float hi) { const f32x2 v = {lo, hi}; const bf16x2c_t b = __builtin_convertvector(v, bf16x2c_t); return __builtin_bit_cast(unsigned, b); }
__device__ __forceinline__ u32x4 pack8(const f32x4 a, const f32x4 b) { u32x4 w; w.x = cvt_pk_bf16(a[0], a[1]); w.y = cvt_pk_bf16(a[2], a[3]); w.z = cvt_pk_bf16(b[0], b[1]); w.w = cvt_pk_bf16(b[2], b[3]); return w; }
__device__ __forceinline__ float bf_lo(unsigned w) { return __uint_as_float(w << 16); }
__device__ __forceinline__ float bf_hi(unsigned w) { return __uint_as_float(w & 0xffff0000u); }
typedef unsigned u32x2x_t __attribute__((ext_vector_type(2)));
__device__ __forceinline__ float4 xb_ld4_(const unsigned short* p) { const u32x2x_t w = *(const u32x2x_t*)p; return make_float4(bf_lo(w.x), bf_hi(w.x), bf_lo(w.y), bf_hi(w.y)); }
__device__ __forceinline__ void rope8(f32x4& v0, f32x4& v1, const f32x4 cs0, const f32x4 cs1) {
    const f32x4 r0 = (f32x4){v0[0] * cs0[0] - v0[1] * cs0[1], v0[1] * cs0[0] + v0[0] * cs0[1], v0[2] * cs0[2] - v0[3] * cs0[3], v0[3] * cs0[2] + v0[2] * cs0[3]};
    const f32x4 r1 = (f32x4){v1[0] * cs1[0] - v1[1] * cs1[1], v1[1] * cs1[0] + v1[0] * cs1[1], v1[2] * cs1[2] - v1[3] * cs1[3], v1[3] * cs1[2] + v1[2] * cs1[3]};
    v0 = r0; v1 = r1;
}
__device__ __forceinline__ unsigned pk4_fp8(float a, float b, float c, float d) {
    a = __builtin_amdgcn_fmed3f(a, -448.f, 448.f); b = __builtin_amdgcn_fmed3f(b, -448.f, 448.f); c = __builtin_amdgcn_fmed3f(c, -448.f, 448.f); d = __builtin_amdgcn_fmed3f(d, -448.f, 448.f);
    int w = 0; w = __builtin_amdgcn_cvt_pk_fp8_f32(a, b, w, false); w = __builtin_amdgcn_cvt_pk_fp8_f32(c, d, w, true); return (unsigned)w; }
__device__ __forceinline__ unsigned char f8_one(float a) { a = fminf(fmaxf(a, -448.0f), 448.0f); return (unsigned char)(__builtin_amdgcn_cvt_pk_fp8_f32(a, 0.0f, 0, false) & 0xff); }
__device__ __forceinline__ float sigmoidf_(float x) { return __builtin_amdgcn_rcpf(1.0f + __builtin_amdgcn_exp2f(-x * LOG2E)); }

constexpr float WINV_MOE = F8_MOE ? WINV : 1.0f;
__device__ __forceinline__ int vt_slot8(int k) { const int half = k >> 5, kk = k & 31, hi = (kk >> 2) & 1, r = (kk & 3) + 4 * (kk >> 3); return 32 * hi + r + 16 * half; }
__device__ __forceinline__ void vt_put8(unsigned char* dp, const f32x4 v0, const f32x4 v1) {
    const unsigned w0 = pk4_fp8(v0[0], v0[1], v0[2], v0[3]), w1 = pk4_fp8(v1[0], v1[1], v1[2], v1[3]);
#pragma unroll
    for (int i = 0; i < 4; ++i) { dp[i * 64] = (unsigned char)(w0 >> (8 * i)); dp[(4 + i) * 64] = (unsigned char)(w1 >> (8 * i)); }
}
struct EpiIn {
    static constexpr bool PERM = true, AFTER_DRAIN = false;
    bf16_t *QA, *KA, *VA, *QB, *KB, *VB, *CQ, *CKR, *CKV, *GATES; float *ssq_q, *ssq_kv; const float* tabA; const float* tabC; float WINV_IN; unsigned char* VTA;
    __device__ __forceinline__ void operator()(const f32x4 (&acc)[2][2][4][2], const Unit& u, int wr, int wc, int fr, int fq) const {
        asm volatile("" : "+v"(fr), "+v"(fq));
        const int pn = u.pn; const bool ctx = u.pm >= PM_CTX;
        const int row0 = u.pm * BM + wr * 64 + fr;
        if (pn < 12) {
            const int seg = pn >> 1; bf16_t* base = seg == 0 ? QA : seg == 1 ? KA : seg == 2 ? VA : seg == 3 ? QB : seg == 4 ? KB : VB;
            const float sc = ((seg == 0 || seg == 3) ? QSCALE_AB : seg == 1 ? 8.0f : 1.0f) * WINV_IN; const bool rope = (seg <= 1) && !ctx;
            const int col0 = (pn & 1) * 256 + wc * 32 + 8 * fq;
#pragma unroll
            for (int ai = 0; ai < 2; ++ai) {
                const int gr = ((u.pm * 4 + ai * 2 + wr) & 127);
#pragma unroll
                for (int m = 0; m < 4; ++m) {
                    const int row = row0 + ai * HALF + m * 16; bf16_t* rowp = base + (size_t)row * 512 + col0;
                    f32x4 cs0 = (f32x4){1.f, 0.f, 1.f, 0.f}, cs1 = cs0;
                    if (rope) { const int trow = (wc & 1) ? 128 + m * 16 + fr : gr; const f32x4* tp = (const f32x4*)(tabA + (size_t)(trow * 16 + 4 * fq) * 2); cs0 = tp[0]; cs1 = tp[1]; }
#pragma unroll
                    for (int bj = 0; bj < 2; ++bj) { f32x4 v0 = acc[ai][bj][m][0] * sc, v1 = acc[ai][bj][m][1] * sc; rope8(v0, v1, cs0, cs1);
                        if (seg == 1) { typedef unsigned u32x2_ __attribute__((ext_vector_type(2))); *(u32x2_*)((unsigned char*)KA + (size_t)row * 512 + col0 + bj * HALF) = (u32x2_){pk4_fp8(v0[0], v0[1], v0[2], v0[3]), pk4_fp8(v1[0], v1[1], v1[2], v1[3])}; }
                        else if (seg == 2) vt_put8(VTA + ((size_t)((row >> 6) * 4 + (pn & 1) * 2 + bj) * 128 + wc * 32 + 8 * fq) * 64 + vt_slot8(row & 63), v0, v1);
                        else *(u32x4*)(rowp + bj * HALF) = pack8(v0, v1); }
                }
            }
        } else if (pn == 12 || pn == 14) {
            bf16_t* base = pn == 12 ? CQ : CKV; const int ld = pn == 12 ? 384 : 256; float* ssq = pn == 12 ? ssq_q : ssq_kv; const int sst = pn == 12 ? 8 : 4;
            const int col0 = wc * 32 + 8 * fq;
#pragma unroll
            for (int ai = 0; ai < 2; ++ai)
#pragma unroll
                for (int m = 0; m < 4; ++m) {
                    const int row = row0 + ai * HALF + m * 16; bf16_t* rowp = base + (size_t)row * ld + col0; float s = 0.f;
#pragma unroll
                    for (int bj = 0; bj < 2; ++bj) { const f32x4 v0 = acc[ai][bj][m][0] * WINV_IN, v1 = acc[ai][bj][m][1] * WINV_IN; *(u32x4*)(rowp + bj * HALF) = pack8(v0, v1);
                        s += (v0[0] * v0[0] + v0[1] * v0[1]) + (v0[2] * v0[2] + v0[3] * v0[3]) + (v1[0] * v1[0] + v1[1] * v1[1]) + (v1[2] * v1[2] + v1[3] * v1[3]); }
                    s += __shfl_xor(s, 16); s += __shfl_xor(s, 32);
                    if (fq == 0) ssq[(size_t)row * sst + wc] = s;
                }
        } else if (pn == 13) {
#pragma unroll
            for (int ai = 0; ai < 2; ++ai) {
                const int gr = ((u.pm * 4 + ai * 2 + wr) & 127);
#pragma unroll
                for (int m = 0; m < 4; ++m) {
                    const int row = row0 + ai * HALF + m * 16;
                    { const f32x4 v0 = acc[ai][0][m][0] * WINV_IN, v1 = acc[ai][0][m][1] * WINV_IN; *(u32x4*)(CQ + (size_t)row * 384 + 256 + wc * 32 + 8 * fq) = pack8(v0, v1);
                      float s = (v0[0] * v0[0] + v0[1] * v0[1]) + (v0[2] * v0[2] + v0[3] * v0[3]) + (v1[0] * v1[0] + v1[1] * v1[1]) + (v1[2] * v1[2] + v1[3] * v1[3]);
                      s += __shfl_xor(s, 16); s += __shfl_xor(s, 32); if (fq == 0) ssq_q[(size_t)row * 8 + 4 + wc] = s; }
                    if (wc == 0) {
                        f32x4 v0 = acc[ai][1][m][0] * WINV_IN, v1 = acc[ai][1][m][1] * WINV_IN;
                        if (!ctx) { const int trow = (fq >= 2) ? 128 + m * 16 + fr : gr; const f32x4* tp = (const f32x4*)(tabC + (size_t)(trow * 8 + 4 * (fq & 1)) * 2); rope8(v0, v1, tp[0], tp[1]); }
                        *(u32x4*)(CKR + (size_t)row * 32 + 8 * fq) = pack8(v0, v1);
                    }
                }
            }
        } else {
            const int col0 = (pn - 15) * 256 + wc * 32 + 8 * fq;
#pragma unroll
            for (int ai = 0; ai < 2; ++ai)
#pragma unroll
                for (int m = 0; m < 4; ++m) {
                    const int row = row0 + ai * HALF + m * 16; unsigned char* rowp = (unsigned char*)GATES + (size_t)row * 3072 + col0;
#pragma unroll
                    for (int bj = 0; bj < 2; ++bj) { f32x4 v0 = acc[ai][bj][m][0] * WINV_IN, v1 = acc[ai][bj][m][1] * WINV_IN;
#pragma unroll
                        for (int j = 0; j < 4; ++j) { v0[j] = sigmoidf_(v0[j]) * 256.0f; v1[j] = sigmoidf_(v1[j]) * 256.0f; }
                        typedef unsigned u32x2_ __attribute__((ext_vector_type(2))); *(u32x2_*)(rowp + bj * HALF) = (u32x2_){pk4_fp8(v0[0], v0[1], v0[2], v0[3]), pk4_fp8(v1[0], v1[1], v1[2], v1[3])}; }
                }
        }
    }
};
struct EpiQ {
    static constexpr bool PERM = true, AFTER_DRAIN = false;
    bf16_t* QC; const float* ssq_q; const float* tabC;
    __device__ __forceinline__ void operator()(const f32x4 (&acc)[2][2][4][2], const Unit& u, int wr, int wc, int fr, int fq) const {
        asm volatile("" : "+v"(fr), "+v"(fq));
        const bool ctx = u.pm >= PM_CTX; const int row0 = u.pm * BM + wr * 64 + fr;
        const int cA = u.pn * BM + wc * 32 + 8 * fq, cB = cA + HALF, pA = cA % 96, pB = cB % 96; const bool peA = (pA >= 64) && !ctx, peB = (pB >= 64) && !ctx;
        const int iA = peA ? (pA - 64) >> 1 : 0, iB = peB ? (pB - 64) >> 1 : 0;
#pragma unroll
        for (int ai = 0; ai < 2; ++ai) {
            const int gr = ((u.pm * 4 + ai * 2 + wr) & 127);
#pragma unroll
            for (int m = 0; m < 4; ++m) {
                const int row = row0 + ai * HALF + m * 16; const int gc = 128 + m * 16 + fr;
                const f32x4 sa = *(const f32x4*)(ssq_q + (size_t)row * 8), sb = *(const f32x4*)(ssq_q + (size_t)row * 8 + 4);
                const float rs = __builtin_amdgcn_rsqf((((sa[0] + sa[1]) + (sa[2] + sa[3])) + ((sb[0] + sb[1]) + (sb[2] + sb[3]))) * (1.0f / 384.0f) + EPS) * QSCALE_C;
                { const f32x4* tp = (const f32x4*)(tabC + (size_t)((iA >= 8 ? gc : gr) * 8 + (iA & 7)) * 2); f32x4 cs0 = tp[0], cs1 = tp[1]; if (!peA) { cs0 = (f32x4){1.f, 0.f, 1.f, 0.f}; cs1 = cs0; }
                  f32x4 v0 = acc[ai][0][m][0] * rs, v1 = acc[ai][0][m][1] * rs; rope8(v0, v1, cs0, cs1); *(u32x4*)(QC + (size_t)row * 768 + cA) = pack8(v0, v1); }
                { const f32x4* tp = (const f32x4*)(tabC + (size_t)((iB >= 8 ? gc : gr) * 8 + (iB & 7)) * 2); f32x4 cs0 = tp[0], cs1 = tp[1]; if (!peB) { cs0 = (f32x4){1.f, 0.f, 1.f, 0.f}; cs1 = cs0; }
                  f32x4 v0 = acc[ai][1][m][0] * rs, v1 = acc[ai][1][m][1] * rs; rope8(v0, v1, cs0, cs1); *(u32x4*)(QC + (size_t)row * 768 + cB) = pack8(v0, v1); }
                __builtin_amdgcn_sched_barrier(0);
            }
        }
    }
};
struct EpiKV {
    static constexpr bool PERM = true, AFTER_DRAIN = false;
    bf16_t *KCN, *VC; const float* ssq_kv; unsigned char* VTC;
    __device__ __forceinline__ void operator()(const f32x4 (&acc)[2][2][4][2], const Unit& u, int wr, int wc, int fr, int fq) const {
        asm volatile("" : "+v"(fr), "+v"(fq));
        const int row0 = u.pm * BM + wr * 64 + fr; bf16_t* base = u.pn < 2 ? KCN : VC; const int col0 = (u.pn & 1) * 256 + wc * 32 + 8 * fq;
#pragma unroll
        for (int ai = 0; ai < 2; ++ai)
#pragma unroll
            for (int m = 0; m < 4; ++m) {
                const int row = row0 + ai * HALF + m * 16; const f32x4 sa = *(const f32x4*)(ssq_kv + (size_t)row * 4); const float rs = __builtin_amdgcn_rsqf(((sa[0] + sa[1]) + (sa[2] + sa[3])) * (1.0f / 256.0f) + EPS); bf16_t* rowp = base + (size_t)row * 512 + col0;
#pragma unroll
                for (int bj = 0; bj < 2; ++bj) {
                    if (u.pn < 2) { typedef unsigned u32x2_ __attribute__((ext_vector_type(2))); const f32x4 v0 = acc[ai][bj][m][0] * (rs * 8.0f), v1 = acc[ai][bj][m][1] * (rs * 8.0f);
                        *(u32x2_*)((unsigned char*)KCN + (size_t)row * 512 + col0 + bj * HALF) = (u32x2_){pk4_fp8(v0[0], v0[1], v0[2], v0[3]), pk4_fp8(v1[0], v1[1], v1[2], v1[3])}; }
                    else vt_put8(VTC + ((size_t)((row >> 6) * 8 + (u.pn & 1) * 4 + bj * 2 + (wc >> 1)) * 64 + (wc & 1) * 32 + 8 * fq) * 64 + vt_slot8(row & 63), acc[ai][bj][m][0] * rs, acc[ai][bj][m][1] * rs); }
            }
    }
};
constexpr int MT_ROWS = MTOT / 256;
struct EpiMerge {
    static constexpr bool PERM = true, AFTER_DRAIN = false;
    const bf16_t* GATES; unsigned char* M8; bf16_t* MB;
    __device__ __forceinline__ void operator()(const f32x4 (&acc)[2][2][4][2], const Unit& u, int wr, int wc, int fr, int fq) const {
        asm volatile("" : "+v"(fr), "+v"(fq));
        const int br = u.pn >> 2, pn = u.pn & 3, pm = u.pm - br * MT_ROWS; const int row0 = pm * BM + wr * 64 + fr, col0 = pn * BM + wc * 32 + 8 * fq;
        const float us = WINV / (br == 0 ? YS_A : YS_BC);
        typedef unsigned u32x2g_ __attribute__((ext_vector_type(2)));
        u32x2g_ g8[2][4][2];
#pragma unroll
        for (int ai = 0; ai < 2; ++ai)
#pragma unroll
            for (int m = 0; m < 4; ++m)
#pragma unroll
                for (int bj = 0; bj < 2; ++bj) g8[ai][m][bj] = *(const u32x2g_*)((const unsigned char*)GATES + (size_t)(row0 + ai * HALF + m * 16) * 3072 + br * 1024 + col0 + bj * HALF);
#pragma unroll
        for (int am = 0; am < 4; ++am) { const int ai = am >> 1, mh = (am & 1) * 2;
            u32x4 gq[2][2], mq[2][2];
#pragma unroll
            for (int m2 = 0; m2 < 2; ++m2)
#pragma unroll
                for (int bj = 0; bj < 2; ++bj) { const int row = row0 + ai * HALF + (mh + m2) * 16;
                    gq[m2][bj] = (u32x4){g8[ai][mh + m2][bj].x, g8[ai][mh + m2][bj].y, 0u, 0u};
                    if (br > 0) mq[m2][bj] = *(const u32x4*)(MB + (size_t)row * 1024 + col0 + bj * HALF); else mq[m2][bj] = (u32x4){0u, 0u, 0u, 0u}; }
#pragma unroll
            for (int m2 = 0; m2 < 2; ++m2) { const int m = mh + m2;
                const int row = row0 + ai * HALF + m * 16;
#pragma unroll
                for (int bj = 0; bj < 2; ++bj) {
                    const u32x4 g = gq[m2][bj], q = mq[m2][bj];
                    const float ug = us * (1.0f / 256.0f);
                    f32x4 v0 = acc[ai][bj][m][0] * ug * (f32x4){__builtin_amdgcn_cvt_f32_fp8((int)g.x, 0), __builtin_amdgcn_cvt_f32_fp8((int)g.x, 1), __builtin_amdgcn_cvt_f32_fp8((int)g.x, 2), __builtin_amdgcn_cvt_f32_fp8((int)g.x, 3)},
                          v1 = acc[ai][bj][m][1] * ug * (f32x4){__builtin_amdgcn_cvt_f32_fp8((int)g.y, 0), __builtin_amdgcn_cvt_f32_fp8((int)g.y, 1), __builtin_amdgcn_cvt_f32_fp8((int)g.y, 2), __builtin_amdgcn_cvt_f32_fp8((int)g.y, 3)};
                    bf16_t* mp = MB + (size_t)row * 1024 + col0 + bj * HALF;
                    if (br > 0) { v0 += (f32x4){bf_lo(q.x), bf_hi(q.x), bf_lo(q.y), bf_hi(q.y)}; v1 += (f32x4){bf_lo(q.z), bf_hi(q.z), bf_lo(q.w), bf_hi(q.w)}; }
                    if (br < 2) *(u32x4*)mp = pack8(v0, v1);
                    else { typedef unsigned u32x2_ __attribute__((ext_vector_type(2))); v0 = v0 * MS8; v1 = v1 * MS8;
                        *(u32x2_*)(M8 + (size_t)row * 1024 + col0 + bj * HALF) = (u32x2_){pk4_fp8(v0[0], v0[1], v0[2], v0[3]), pk4_fp8(v1[0], v1[1], v1[2], v1[3])}; }
                }
            }
        }
    }
};
struct EpiOut {
    static constexpr bool PERM = true, AFTER_DRAIN = false;
    const float* xlat; const float* xctx; bf16_t* X; const float* modv; bool xin;
    __device__ __forceinline__ void operator()(const f32x4 (&acc)[2][2][4][2], const Unit& u, int wr, int wc, int fr, int fq) const {
        asm volatile("" : "+v"(fr), "+v"(fq));
        const bool ctx = u.pm >= PM_CTX; const int bidx = ctx ? 4 : (u.pm >> 5); const int row0 = u.pm * BM + wr * 64 + fr, col0 = u.pn * BM + wc * 32 + 8 * fq;
        const float* src = ctx ? xctx - (size_t)NLAT * DM : xlat; const float* gt = modv + bidx * 6144 + 2 * 1024 + col0;
        f32x4 g[2][2];
#pragma unroll
        for (int bj = 0; bj < 2; ++bj) { g[bj][0] = *(const f32x4*)(gt + bj * HALF) * (WINV / MS8); g[bj][1] = *(const f32x4*)(gt + bj * HALF + 4) * (WINV / MS8); }
#pragma unroll
        for (int am = 0; am < 4; ++am) { const int ai = am >> 1, mh = (am & 1) * 2;
            f32x4 xa[2][2], xb[2][2];
#pragma unroll
            for (int m2 = 0; m2 < 2; ++m2)
#pragma unroll
                for (int bj = 0; bj < 2; ++bj) { const size_t o_ = (size_t)(row0 + ai * HALF + (mh + m2) * 16) * DM + col0 + bj * HALF;
                    if (xin) { const float* sp = src + o_; xa[m2][bj] = *(const f32x4*)sp; xb[m2][bj] = *(const f32x4*)(sp + 4); }
                    else { const u32x4 q = *(const u32x4*)(X + o_); xa[m2][bj] = (f32x4){bf_lo(q.x), bf_hi(q.x), bf_lo(q.y), bf_hi(q.y)}; xb[m2][bj] = (f32x4){bf_lo(q.z), bf_hi(q.z), bf_lo(q.w), bf_hi(q.w)}; } }
#pragma unroll
            for (int m2 = 0; m2 < 2; ++m2) { const int m = mh + m2;
                const size_t off = (size_t)(row0 + ai * HALF + m * 16) * DM + col0;
#pragma unroll
                for (int bj = 0; bj < 2; ++bj) *(u32x4*)(X + off + bj * HALF) = pack8(xa[m2][bj] + g[bj][0] * acc[ai][bj][m][0], xb[m2][bj] + g[bj][1] * acc[ai][bj][m][1]);
            }
        }
    }
};
constexpr float SWIGLU_LIMIT = 7.0f, SWIGLU_ALPHA = 1.702f;
struct EpiGU {
    static constexpr bool PERM = true, AFTER_DRAIN = false;
    bf16_t* ACT; const float* bgu;
    __device__ __forceinline__ void operator()(const f32x4 (&acc)[2][2][4][2], const Unit& u, int wr, int wc, int fr, int fq) const {
        asm volatile("" : "+v"(fr), "+v"(fq));
        const int e = u.pn >> 3, pn = u.pn & 7; const int row0 = u.pm * BM + wr * 64 + fr, j0 = pn * 128 + wc * 32 + 8 * fq;
        const float* bp = bgu + (size_t)e * 2048 + 2 * j0; f32x4 bb[4];
#pragma unroll
        for (int q = 0; q < 4; ++q) bb[q] = *(const f32x4*)(bp + 4 * q);
        const f32x4 bg0 = (f32x4){bb[0][0], bb[0][2], bb[1][0], bb[1][2]}, bg1 = (f32x4){bb[2][0], bb[2][2], bb[3][0], bb[3][2]};
        const f32x4 bu0 = (f32x4){bb[0][1], bb[0][3], bb[1][1], bb[1][3]}, bu1 = (f32x4){bb[2][1], bb[2][3], bb[3][1], bb[3][3]};
#pragma unroll
        for (int ai = 0; ai < 2; ++ai)
#pragma unroll
            for (int m = 0; m < 4; ++m) {
                const int row = row0 + ai * HALF + m * 16;
                f32x4 g0 = acc[ai][0][m][0] * WINV_MOE + bg0, g1 = acc[ai][0][m][1] * WINV_MOE + bg1, u0 = acc[ai][1][m][0] * WINV_MOE + bu0, u1 = acc[ai][1][m][1] * WINV_MOE + bu1;
#pragma unroll
                for (int j = 0; j < 4; ++j) {
                    float ga = fminf(g0[j], SWIGLU_LIMIT), ua = fminf(fmaxf(u0[j], -SWIGLU_LIMIT), SWIGLU_LIMIT); g0[j] = (ua + 1.0f) * (ga * sigmoidf_(SWIGLU_ALPHA * ga));
                    float gb = fminf(g1[j], SWIGLU_LIMIT), ub = fminf(fmaxf(u1[j], -SWIGLU_LIMIT), SWIGLU_LIMIT); g1[j] = (ub + 1.0f) * (gb * sigmoidf_(SWIGLU_ALPHA * gb)); }
                if constexpr (F8_MOE) { typedef unsigned u32x2_ __attribute__((ext_vector_type(2))); *(u32x2_*)((unsigned char*)ACT + (size_t)row * 1024 + j0) = (u32x2_){pk4_fp8(g0[0], g0[1], g0[2], g0[3]), pk4_fp8(g1[0], g1[1], g1[2], g1[3])}; }
                else *(u32x4*)(ACT + (size_t)row * 1024 + j0) = pack8(g0, g1);
            }
    }
};
struct EpiDown {
    static constexpr bool PERM = true, AFTER_DRAIN = false;
    bf16_t* YBUF; const float* bdn; const int* xs; const float* xw; const PG8_LAS int* base; const PG8_LAS int* cnt;
    __device__ __forceinline__ void operator()(const f32x4 (&acc)[2][2][4][2], const Unit& u, int wr, int wc, int fr, int fq) const {
        asm volatile("" : "+v"(fr), "+v"(fq));
        const int e = u.pn >> 2, pn = u.pn & 3; const int row0 = u.pm * BM + wr * 64 + fr, col0 = pn * BM + wc * 32 + 8 * fq;
        const float* bp = bdn + (size_t)e * 1024 + col0; f32x4 b[2][2];
#pragma unroll
        for (int bj = 0; bj < 2; ++bj) { b[bj][0] = *(const f32x4*)(bp + bj * HALF); b[bj][1] = *(const f32x4*)(bp + bj * HALF + 4); }
        int dsts[2][4]; float ws_[2][4];
#pragma unroll
        for (int ai = 0; ai < 2; ++ai)
#pragma unroll
            for (int m = 0; m < 4; ++m) { const int slot = row0 + ai * HALF + m * 16 - base[e]; const bool ok = slot < cnt[e]; const size_t xi = (size_t)e * MTOT + (ok ? slot : 0);
                const int d_ = xs[xi]; const float w_ = xw[xi]; dsts[ai][m] = ok ? d_ : -1; ws_[ai][m] = ok ? w_ : 0.f; }
#pragma unroll
        for (int ai = 0; ai < 2; ++ai)
#pragma unroll
            for (int m = 0; m < 4; ++m) {
                const int dst = dsts[ai][m]; const float w = ws_[ai][m];
                if (dst >= 0) {
#pragma unroll
                    for (int bj = 0; bj < 2; ++bj) *(u32x4*)(YBUF + (size_t)dst * 1024 + col0 + bj * HALF) = pack8((acc[ai][bj][m][0] * WINV_MOE + b[bj][0]) * w, (acc[ai][bj][m][1] * WINV_MOE + b[bj][1]) * w);
                }
            }
    }
};
struct MergeOrder {
    StaticOrder S;
    __device__ __forceinline__ bool next(int i, Unit& u) const { const int t = i / 3, br = i - 3 * t; Unit v; if (!S.next(t, v)) return false; u.pm = br * MT_ROWS + v.pm; u.pn = br * 4 + v.pn; return true; }
    __device__ __forceinline__ void a_ready(const Unit&) const {}
    __device__ __forceinline__ void done(const Unit&) const {}
};
struct ExpertOrder {
    StaticOrder S; const PG8_LAS int* tile_e; int nNe;
    const int* xs = nullptr; const PG8_LAS int* base = nullptr; const PG8_LAS int* cnt = nullptr;
    __device__ __forceinline__ int src_row(int pm, int rr) const { const int e = tile_e[pm]; const int slot = pm * BM + rr - base[e]; return slot < cnt[e] ? (xs[(size_t)e * MTOT + slot] >> 2) : 0; }
    __device__ __forceinline__ bool next(int i, Unit& u) const { Unit v; if (!S.next(i, v)) return false; u.pm = v.pm; u.pn = tile_e[v.pm] * nNe + v.pn; return true; }
    __device__ __forceinline__ void a_ready(const Unit&) const {}
    __device__ __forceinline__ void done(const Unit&) const {}
};
template <class Epi, class Sched, bool ALIGN_EPI = false, bool SP2 = false, bool FP8 = false, bool GATHER = false>
__device__ __forceinline__ void gemm_phase(PG8_LAS unsigned char* lds, const Gemm g, const Sched& S, const Epi& E) {
    int tid_ = threadIdx.x; asm volatile("" : "+v"(tid_));
    const int tid = tid_, wid = __builtin_amdgcn_readfirstlane(tid >> 6), lane = tid & 63, wr = wid >> 2, wc = wid & 3, fr = lane & 15, fq = lane >> 4;
    const int K = g.K, nt = K / BK;
    unsigned voffA[2], voffB[2];
#pragma unroll
    for (int i = 0; i < 2; ++i) { int R, C; stage_rc(tid * 16 + i * 8192, R, C); const int Rb = Epi::PERM ? ((R & ~31) + perm32(R & 31)) : R;
        voffA[i] = (unsigned)(R * K + C) * 2u; voffB[i] = (unsigned)(Rb * K + C) * 2u; }
    unsigned cvo[2][2] = {{0u, 0u}, {0u, 0u}}, nvo[2][2] = {{0u, 0u}, {0u, 0u}};
#define PG8_LDVO(u_, vo_) do { _Pragma("unroll") for (int h_ = 0; h_ < 2; ++h_) _Pragma("unroll") for (int i_ = 0; i_ < 2; ++i_) { int R_, C_; stage_rc(tid * 16 + i_ * 8192, R_, C_); \
        vo_[h_][i_] = (unsigned)S.src_row((u_).pm, h_ * HALF + R_) * (unsigned)(K * 2) + (unsigned)(C_ * 2); } } while (0)
    const size_t kstep = (size_t)(BK * 2);
    const size_t hstep = (size_t)HALF * K * 2;
    const size_t tstep = 2 * hstep;
    const unsigned ldsw = (unsigned)wid * 1024u;
    const int aoff = lds_byte(wr * 64 + fr, fq * 8), boff = lds_byte(wc * 32 + fr, fq * 8);
#define PG8_SA(b, h) (((b) * 2 + (h)) * HTB)
#define PG8_SB(b, h) ((4 + (b) * 2 + (h)) * HTB)
#define PG8_STAGE(bufoff, gbase, voff) do { _Pragma("unroll") for (int _i = 0; _i < 2; ++_i) \
        __builtin_amdgcn_global_load_lds((const unsigned*)((const char*)(gbase) + (voff)[_i]), (PG8_LAS unsigned*)(lds + (bufoff) + ldsw + _i * 8192), 16, 0, 0); } while (0)
#define PG8_LDA(dst, b, h) do { _Pragma("unroll") for (int m = 0; m < 4; ++m) _Pragma("unroll") for (int k = 0; k < 2; ++k) dst[m][k] = *(const PG8_LAS bf16x8*)(lds + PG8_SA(b, h) + aoff + m * 2048 + k * 1024); } while (0)
#define PG8_LDB(dst, b, h) do { _Pragma("unroll") for (int n = 0; n < 2; ++n) _Pragma("unroll") for (int k = 0; k < 2; ++k) dst[n][k] = *(const PG8_LAS bf16x8*)(lds + PG8_SB(b, h) + boff + n * 2048 + k * 1024); } while (0)
#define PG8_MMA(ai, bj, At, Bt) do { __builtin_amdgcn_s_setprio(1); _Pragma("unroll") for (int m = 0; m < 4; ++m) _Pragma("unroll") for (int n = 0; n < 2; ++n) { \
        if constexpr (FP8) { typedef int i32x4_ __attribute__((ext_vector_type(4))); typedef int i32x8_ __attribute__((ext_vector_type(8))); \
            const i32x8_ bb_ = __builtin_shufflevector(__builtin_bit_cast(i32x4_, Bt[n][0]), __builtin_bit_cast(i32x4_, Bt[n][1]), 0, 1, 2, 3, 4, 5, 6, 7); \
            const i32x8_ aa_ = __builtin_shufflevector(__builtin_bit_cast(i32x4_, At[m][0]), __builtin_bit_cast(i32x4_, At[m][1]), 0, 1, 2, 3, 4, 5, 6, 7); \
            asm volatile("v_mfma_scale_f32_16x16x128_f8f6f4 %0, %1, %2, %0, %3, %3 op_sel_hi:[0,0,0]" : "+v"(acc[ai][bj][m][n]) : "v"(bb_), "v"(aa_), "v"(f8scale)); }   \
        else { _Pragma("unroll") for (int k = 0; k < 2; ++k) acc[ai][bj][m][n] = __builtin_amdgcn_mfma_f32_16x16x32_bf16(Bt[n][k], At[m][k], acc[ai][bj][m][n], 0, 0, 0); } } \
        __builtin_amdgcn_s_setprio(0); } while (0)
#define PG8_WAIT_V(n) asm volatile("s_waitcnt vmcnt(" #n ")" ::: "memory")
#define PG8_WAIT_L(n) asm volatile("s_waitcnt lgkmcnt(" #n ")" ::: "memory")
#define PG8_BAR __builtin_amdgcn_s_barrier()
#define PG8_SCHED __builtin_amdgcn_sched_barrier(0)
    Unit cur, nxt; int ui = 0;
    if (!S.next(0, cur)) return;
    int f8scale = 0x7f7f7f7f; asm volatile("" : "+v"(f8scale));
    f32x4 acc[2][2][4][2];
#pragma unroll
    for (int a = 0; a < 2; ++a)
#pragma unroll
        for (int b = 0; b < 2; ++b)
#pragma unroll
            for (int m = 0; m < 4; ++m)
#pragma unroll
                for (int n = 0; n < 2; ++n) acc[a][b][m][n] = (f32x4){0.f, 0.f, 0.f, 0.f};
    bf16x8 At[4][2], B0[2][2], B1[2][2];
    const char* cA = (const char*)g.A + (size_t)cur.pm * tstep; const char* cB = (const char*)g.Bt + (size_t)cur.pn * tstep; const char* const gA0 = (const char*)g.A;
    S.a_ready(cur);
    if constexpr (SP2) {
        if constexpr (GATHER) { PG8_LDVO(cur, cvo); }
        PG8_STAGE(PG8_SB(0, 0), cB, voffB); PG8_STAGE(PG8_SB(0, 1), cB + hstep, voffB);
        if constexpr (GATHER) { PG8_STAGE(PG8_SA(0, 0), gA0, cvo[0]); PG8_STAGE(PG8_SA(0, 1), gA0, cvo[1]); } else { PG8_STAGE(PG8_SA(0, 0), cA, voffA); PG8_STAGE(PG8_SA(0, 1), cA + hstep, voffA); }
        if (wr == 1) PG8_BAR;
        PG8_WAIT_V(2); PG8_BAR;
        PG8_STAGE(PG8_SB(1, 0), cB + kstep, voffB); if constexpr (GATHER) PG8_STAGE(PG8_SA(1, 0), gA0 + kstep, cvo[0]); else PG8_STAGE(PG8_SA(1, 0), cA + kstep, voffA); PG8_STAGE(PG8_SB(1, 1), cB + hstep + kstep, voffB);
        PG8_WAIT_V(6); PG8_BAR;
    } else {
        PG8_STAGE(PG8_SB(0, 0), cB, voffB); PG8_STAGE(PG8_SA(0, 0), cA, voffA); PG8_STAGE(PG8_SB(0, 1), cB + hstep, voffB); PG8_STAGE(PG8_SA(0, 1), cA + hstep, voffA);
        if (wr == 1) PG8_BAR;
        PG8_WAIT_V(4); PG8_BAR;
        PG8_STAGE(PG8_SB(1, 0), cB + kstep, voffB); PG8_STAGE(PG8_SA(1, 0), cA + kstep, voffA); PG8_STAGE(PG8_SB(1, 1), cB + hstep + kstep, voffB);
        PG8_WAIT_V(6); PG8_BAR;
    }
    for (;;) {
        const bool has_next = S.next(ui + 1, nxt);
        const char* nA = has_next ? (const char*)g.A + (size_t)nxt.pm * tstep : cA; const char* nB = has_next ? (const char*)g.Bt + (size_t)nxt.pn * tstep : cB;
        if constexpr (GATHER) { if (has_next) { PG8_LDVO(nxt, nvo); } else { _Pragma("unroll") for (int h_ = 0; h_ < 2; ++h_) _Pragma("unroll") for (int i_ = 0; i_ < 2; ++i_) nvo[h_][i_] = cvo[h_][i_]; } }
#pragma nounroll
        for (int t = 0; t < nt; t += 2) {
            const bool last = (t == nt - 2);
            const char* a1 = cA + (size_t)(t + 1) * kstep;
            const char* a2 = last ? nA : cA + (size_t)(t + 2) * kstep; const char* b2 = last ? nB : cB + (size_t)(t + 2) * kstep;
            const char* a3 = a2 + kstep; const char* b3 = b2 + kstep;
            if (last && has_next) S.a_ready(nxt);
            if constexpr (SP2) {
            unsigned s0_[2], s1_[2]; const char* gk2 = gA0;
            if constexpr (GATHER) { s0_[0] = last ? nvo[0][0] : cvo[0][0]; s0_[1] = last ? nvo[0][1] : cvo[0][1]; s1_[0] = last ? nvo[1][0] : cvo[1][0]; s1_[1] = last ? nvo[1][1] : cvo[1][1]; gk2 = last ? gA0 : gA0 + (size_t)(t + 2) * kstep; }
            PG8_LDB(B0, 0, 0); PG8_LDB(B1, 0, 1); PG8_SCHED; PG8_LDA(At, 0, 0); if constexpr (GATHER) PG8_STAGE(PG8_SA(1, 1), gA0 + (size_t)(t + 1) * kstep, cvo[1]); else PG8_STAGE(PG8_SA(1, 1), a1 + hstep, voffA);
            PG8_WAIT_V(8); PG8_WAIT_L(0); PG8_BAR; PG8_MMA(0, 0, At, B0); PG8_MMA(0, 1, At, B1); PG8_BAR; PG8_SCHED;
            PG8_LDA(At, 0, 1); PG8_STAGE(PG8_SB(0, 0), b2, voffB); PG8_STAGE(PG8_SB(0, 1), b2 + hstep, voffB); if constexpr (GATHER) PG8_STAGE(PG8_SA(0, 0), gk2, s0_); else PG8_STAGE(PG8_SA(0, 0), a2, voffA);
            PG8_WAIT_V(8); PG8_WAIT_L(0); PG8_BAR; PG8_MMA(1, 0, At, B0); PG8_MMA(1, 1, At, B1); PG8_BAR; PG8_SCHED;
            PG8_LDB(B0, 1, 0); PG8_LDB(B1, 1, 1); PG8_SCHED; PG8_LDA(At, 1, 0); if constexpr (GATHER) PG8_STAGE(PG8_SA(0, 1), gk2, s1_); else PG8_STAGE(PG8_SA(0, 1), a2 + hstep, voffA);
            PG8_WAIT_V(8); PG8_WAIT_L(0); PG8_BAR; PG8_MMA(0, 0, At, B0); PG8_MMA(0, 1, At, B1); PG8_BAR; PG8_SCHED;
            PG8_LDA(At, 1, 1); PG8_STAGE(PG8_SB(1, 0), b3, voffB); PG8_STAGE(PG8_SB(1, 1), b3 + hstep, voffB); if constexpr (GATHER) PG8_STAGE(PG8_SA(1, 0), gk2 + kstep, s0_); else PG8_STAGE(PG8_SA(1, 0), a3, voffA);
            PG8_WAIT_V(8); PG8_WAIT_L(0); PG8_BAR; PG8_MMA(1, 0, At, B0); PG8_MMA(1, 1, At, B1); PG8_BAR; PG8_SCHED;
            } else {
            PG8_LDB(B0, 0, 0); PG8_SCHED; PG8_LDA(At, 0, 0); PG8_STAGE(PG8_SA(1, 1), a1 + hstep, voffA);
            PG8_WAIT_L(8); PG8_BAR; PG8_WAIT_L(0); PG8_MMA(0, 0, At, B0); PG8_BAR; PG8_SCHED;
            PG8_LDB(B1, 0, 1); PG8_STAGE(PG8_SB(0, 0), b2, voffB);
            PG8_BAR; PG8_WAIT_L(0); PG8_MMA(0, 1, At, B1); PG8_BAR;
            PG8_LDA(At, 0, 1); PG8_STAGE(PG8_SA(0, 0), a2, voffA);
            PG8_BAR; PG8_WAIT_L(0); PG8_MMA(1, 0, At, B0); PG8_BAR; PG8_SCHED;
            PG8_STAGE(PG8_SB(0, 1), b2 + hstep, voffB);
            PG8_WAIT_V(6); PG8_BAR; PG8_MMA(1, 1, At, B1); PG8_BAR;
            PG8_LDB(B0, 1, 0); PG8_SCHED; PG8_LDA(At, 1, 0); PG8_STAGE(PG8_SA(0, 1), a2 + hstep, voffA);
            PG8_WAIT_L(8); PG8_BAR; PG8_WAIT_L(0); PG8_MMA(0, 0, At, B0); PG8_BAR; PG8_SCHED;
            PG8_LDB(B1, 1, 1); PG8_STAGE(PG8_SB(1, 0), b3, voffB);
            PG8_BAR; PG8_WAIT_L(0); PG8_MMA(0, 1, At, B1); PG8_BAR;
            PG8_LDA(At, 1, 1); PG8_STAGE(PG8_SA(1, 0), a3, voffA);
            PG8_BAR; PG8_WAIT_L(0); PG8_MMA(1, 0, At, B0); PG8_BAR; PG8_SCHED;
            PG8_STAGE(PG8_SB(1, 1), b3 + hstep, voffB);
            PG8_WAIT_V(6); PG8_BAR; PG8_MMA(1, 1, At, B1); PG8_BAR;
            }
        }
        if constexpr (ALIGN_EPI) { if (wr == 0) PG8_BAR; }
        if constexpr (FP8) {
#define PG8_TIE8(a, b, TXT) asm volatile(TXT : "+v"(acc[a][b][0][0]), "+v"(acc[a][b][0][1]), "+v"(acc[a][b][1][0]), "+v"(acc[a][b][1][1]), "+v"(acc[a][b][2][0]), "+v"(acc[a][b][2][1]), "+v"(acc[a][b][3][0]), "+v"(acc[a][b][3][1]))
            PG8_TIE8(0, 0, "s_nop 15\n\ts_nop 15\n\ts_nop 15"); PG8_TIE8(0, 1, ""); PG8_TIE8(1, 0, ""); PG8_TIE8(1, 1, "");
#undef PG8_TIE8
        }
        if constexpr (!Epi::AFTER_DRAIN) { E(acc, cur, wr, wc, fr, fq); S.done(cur); }
        if (!has_next) break;
#pragma unroll
        for (int a = 0; a < 2; ++a)
#pragma unroll
            for (int b = 0; b < 2; ++b)
#pragma unroll
                for (int m = 0; m < 4; ++m)
#pragma unroll
                    for (int n = 0; n < 2; ++n) acc[a][b][m][n] = (f32x4){0.f, 0.f, 0.f, 0.f};
        cur = nxt; cA = nA; cB = nB; ++ui;
        if constexpr (GATHER) { _Pragma("unroll") for (int h_ = 0; h_ < 2; ++h_) _Pragma("unroll") for (int i_ = 0; i_ < 2; ++i_) cvo[h_][i_] = nvo[h_][i_]; }
        if constexpr (ALIGN_EPI) { if (wr == 1) PG8_BAR; }
    }
    PG8_WAIT_V(0);
    if constexpr (!ALIGN_EPI) { if (wr == 0) PG8_BAR; }
    PG8_BAR;
    if constexpr (Epi::AFTER_DRAIN) { E.fused(acc, cur, wr, wc, fr, fq, lds, wid, lane); S.done(cur); }
#undef PG8_SA
#undef PG8_SB
#undef PG8_STAGE
#undef PG8_LDA
#undef PG8_LDB
#undef PG8_MMA
#undef PG8_WAIT_V
#undef PG8_WAIT_L
#undef PG8_BAR
#undef PG8_SCHED
#undef PG8_LDVO
}
}

using namespace pg8;
constexpr int NWAVES = 8, NTHR = 512;
#define GAS __attribute__((address_space(1)))
#define LAS __attribute__((address_space(3)))
typedef unsigned short bf16;
#define LDS_WAIT() asm volatile("s_waitcnt lgkmcnt(0)" ::: "memory")
#define VM_WAIT() asm volatile("s_waitcnt vmcnt(0)" ::: "memory")
__device__ __forceinline__ unsigned f2bf(float f) { unsigned u = __builtin_bit_cast(unsigned, f); return (u + 0x7fffu + ((u >> 16) & 1u)) >> 16; }
__device__ __forceinline__ unsigned pk2(float lo, float hi) { return f2bf(lo) | (f2bf(hi) << 16); }
__device__ __forceinline__ float bf2f(bf16 b) { return __uint_as_float(((unsigned)b) << 16); }
__device__ __forceinline__ float wave_sum(float v) {
#pragma unroll
    for (int o = 1; o < 64; o <<= 1) v += __shfl_xor(v, o);
    return v;
}
__device__ __forceinline__ float siluf_(float x) { return x / (1.0f + __expf(-x)); }

constexpr size_t MiB = 1u << 20;
constexpr size_t WS_CTL = 0, CTL_ZERO_BYTES = 128 * 1024;
constexpr int CW_BAR = 4096;
constexpr int CW_CNT = 16384;
constexpr int CW_DBG = 20480;
constexpr size_t CTL_SSQ = 1 * MiB;
constexpr size_t WS_MODV = 4 * MiB;
constexpr size_t WS_WRT = 5 * MiB + 512 * 1024;
constexpr size_t WS_TAB = 5 * MiB;
constexpr size_t WS_ROUTE = 6 * MiB;
constexpr size_t WS_WIN = 10 * MiB, WS_WQB = 37 * MiB, WS_WKVB = 39 * MiB, WS_WBR = 40 * MiB, WS_WOUT = 46 * MiB, WS_WGU = 50 * MiB, WS_WDN = 306 * MiB;
constexpr size_t WS_X = 434 * MiB, WS_H = 566 * MiB, WS_R = 632 * MiB;
constexpr size_t SZ_R512 = (size_t)MTOT * 512 * 2;
constexpr size_t WS_QA = WS_R, WS_KA = WS_QA + SZ_R512, WS_VA = WS_KA + SZ_R512, WS_QB = WS_VA + SZ_R512, WS_KB = WS_QB + SZ_R512, WS_VB = WS_KB + SZ_R512;
constexpr size_t WS_CQ = WS_VB + SZ_R512, WS_CKR = WS_CQ + (size_t)MTOT * 384 * 2, WS_CKV = WS_CKR + (size_t)MTOT * 32 * 2 + MiB, WS_GATES = WS_CKV + (size_t)MTOT * 256 * 2;
constexpr size_t WS_QC = WS_GATES + (size_t)MTOT * 3072 * 2, WS_KCN = WS_QC + (size_t)MTOT * 768 * 2, WS_VC = WS_KCN + SZ_R512, WS_O0 = WS_VC + SZ_R512;
constexpr size_t WS_YA = WS_O0 + (size_t)MTOT * 512 * 4, WS_YB = WS_YA + SZ_R512, WS_YC = WS_YB + SZ_R512, WS_M32 = WS_YC + SZ_R512, WS_MB = WS_M32 + (size_t)MTOT * 1024 * 4, WS_MIX_END = WS_MB + (size_t)MTOT * 1024 * 2;
constexpr size_t WS_VTA = WS_MIX_END, WS_VTC = WS_VTA + (size_t)(MTOT / 64) * 4 * 8192, WS_VT_END = WS_VTC + (size_t)(MTOT / 64) * 8 * 4096;
constexpr int HS_ROWS = 143360;
constexpr size_t WS_XS = WS_R, WS_XW = WS_XS + (size_t)NEXP * MTOT * 4;
constexpr size_t WS_HS = WS_R, WS_ACT = WS_HS + (size_t)HS_ROWS * 1024 * 2, WS_YBUF = WS_ACT + (size_t)HS_ROWS * 1024 * 2, WS_MOE_END = WS_YBUF + (size_t)MTOT * 4 * 1024 * 2;
constexpr size_t WS_END = (WS_VT_END > WS_MOE_END ? WS_VT_END : WS_MOE_END);
static_assert(WS_END <= (size_t)2040 * MiB, "workspace map");
constexpr size_t RT_E = 0, RT_SLOT = (size_t)MTOT * 4 * 4, RT_W = 2 * RT_SLOT, RT_YDST = 3 * RT_SLOT, RT_WROW = RT_YDST + (size_t)HS_ROWS * 4, RT_YSRC = RT_WROW + (size_t)HS_ROWS * 4;
static_assert(WS_ROUTE + RT_WROW + (size_t)HS_ROWS * 4 <= WS_WIN, "routing map");

constexpr int RING_OFF = 0, RING_BYTES = 131072;
constexpr int TBL_OFF = RING_BYTES;
constexpr int MISC_OFF = TBL_OFF + 12288;
constexpr int LDS_BYTES = 147456;
static_assert(MISC_OFF + 256 <= LDS_BYTES, "LDS map");

#define XB_TMO      128
#define XB_XCNT(j)  (256  + 64 * (j))
#define XB_XSUB(j)  (1280 + 64 * (j))
#define XB_XGEN(j)  (2304 + 64 * (j))
#define XB_TOP      3328
#define XB_TOPGEN   3392
#define XCD_BAR_WORDS 3456
#define XB_SPIN_CAP (1u << 18)
__device__ __forceinline__ unsigned xb_ld(unsigned* p)              { return __hip_atomic_load(p, __ATOMIC_RELAXED, __HIP_MEMORY_SCOPE_AGENT); }
__device__ __forceinline__ unsigned xb_add(unsigned* p, unsigned v) { return __hip_atomic_fetch_add(p, v, __ATOMIC_RELAXED, __HIP_MEMORY_SCOPE_AGENT); }
__device__ __forceinline__ unsigned xb_xcc_id() { return (unsigned)__builtin_amdgcn_s_getreg((3 << 11) | 20) & 0xFu; }
#define XB_SPIN(cond, bar) do { unsigned _sp = 0; while (cond) { __builtin_amdgcn_s_sleep(1); \
    if ((++_sp & 255u) == 0u) { if (xb_ld(&(bar)[XB_TMO])) break; if (_sp > XB_SPIN_CAP) { atomicAdd(&(bar)[XB_TMO], 1u); break; } } } } while (0)
struct XcdBarrier { unsigned* bar; unsigned x; volatile LAS unsigned* st; };
__device__ __forceinline__ XcdBarrier xcd_barrier_post(unsigned* bar, volatile LAS unsigned* st) {
    XcdBarrier b; b.bar = bar; b.x = xb_xcc_id(); b.st = st;
    if (threadIdx.x == 0) (void)xb_add(&bar[XB_XCNT(b.x)], 1u);
    return b;
}
__device__ __forceinline__ void xcd_barrier_complete(unsigned* bar, unsigned x, unsigned& nloc, unsigned& nx) {
    const unsigned G = gridDim.x * gridDim.y * gridDim.z;
    unsigned sum, cnt, mine, sp = 0u;
    for (;;) {
        sum = 0u; cnt = 0u; mine = 0u;
#pragma nounroll
        for (unsigned j = 0; j < 16; ++j) { const unsigned c = xb_ld(&bar[XB_XCNT(j)]); sum += c; cnt += (c > 0u) ? 1u : 0u; mine = (j == x) ? c : mine; }
        if (sum == G) break;
        __builtin_amdgcn_s_sleep(1);
        if ((++sp & 255u) == 0u) { if (xb_ld(&bar[XB_TMO])) break; if (sp > XB_SPIN_CAP) { atomicAdd(&bar[XB_TMO], 1u); break; } }
    }
    nloc = mine > 0u ? mine : 1u; nx = cnt > 0u ? cnt : 1u;
}
__device__ __forceinline__ void xcd_barrier(const XcdBarrier& b) {
    asm volatile("s_waitcnt vmcnt(0)" ::: "memory");
    __syncthreads();
    if (threadIdx.x == 0) {
        unsigned* bar = b.bar;
        __builtin_amdgcn_s_waitcnt(0);
        unsigned nloc = b.st[0], nx = b.st[1];
        if (nloc == 0u) { xcd_barrier_complete(bar, b.x, nloc, nx); b.st[0] = nloc; b.st[1] = nx; }
        const unsigned old = xb_add(&bar[XB_XSUB(b.x)], 1u);
        const unsigned gen = old / nloc;
        if (old + 1u == (gen + 1u) * nloc) {
            __builtin_amdgcn_fence(__ATOMIC_RELEASE, "agent");
            asm volatile("s_waitcnt vmcnt(0)" ::: "memory");
            const unsigned og = xb_add(&bar[XB_TOP], 1u);
            const unsigned tg = og / nx;
            if (og + 1u == (tg + 1u) * nx) xb_add(&bar[XB_TOPGEN], 1u);
            else XB_SPIN(xb_ld(&bar[XB_TOPGEN]) == tg, bar);
            __builtin_amdgcn_fence(__ATOMIC_ACQUIRE, "agent");
            xb_add(&bar[XB_XGEN(b.x)], 1u);
            asm volatile("s_waitcnt vmcnt(0)" ::: "memory");
        } else {
            XB_SPIN(xb_ld(&bar[XB_XGEN(b.x)]) == gen, bar);
            __builtin_amdgcn_fence(__ATOMIC_ACQUIRE, "agent");
            asm volatile("s_waitcnt vmcnt(0)" ::: "memory");
        }
    }
    __syncthreads();
}

struct Args { const float* in[30]; float* out; unsigned char* ws; int ph_lo, ph_hi; };
enum { I_X = 0, I_C, I_CTX, I_CCTX, I_WMOD, I_BMOD, I_GMIX, I_WIN, I_LQ1, I_LK1, I_LQ2, I_LK2, I_GSUB, I_RPB, I_GQA, I_WQB, I_GKVA, I_WKVB, I_WBRA, I_WBRB, I_WBRC, I_WOUT, I_GFFN, I_WROUT, I_BROUT, I_WGU, I_BGU, I_WDN, I_BDN, I_GFIN };

__device__ __forceinline__ int win_src(int n) {
    if (n < 1024) { const int g = n >> 6, p = n & 63, i = p >> 1, s = p & 1; return g * 64 + (i < 16 ? i : i + 16) + 16 * s; }
    if (n < OFF_CQ + 384) return n;
    if (n < OFF_PADW) { const int p = n - OFF_CKR, i = p >> 1, s = p & 1; return 3712 + (i < 8 ? i : i + 8) + 8 * s; }
    if (n < OFF_CKV) return -1;
    if (n < OFF_GATES) return 3456 + (n - OFF_CKV);
    return 3744 + (n - OFF_GATES);
}
__device__ __forceinline__ int wqb_src(int n) { const int h = n / 96, p = n - 96 * h; if (p < 64) return n; const int q = p - 64, i = q >> 1, s = q & 1; return h * 96 + 64 + (i < 8 ? i : i + 8) + 8 * s; }
__device__ __forceinline__ int wkvb_src(int n) { return n < 512 ? (n >> 6) * 128 + (n & 63) : ((n - 512) >> 6) * 128 + 64 + (n & 63); }
__device__ __forceinline__ int wgu_src(int n) { const int pn = n >> 8, s = (n >> 7) & 1, t = n & 127; return 2 * (128 * pn + t) + s; }
template <int KIND, bool F8 = false> __device__ __forceinline__ void transpose_item(const float* W, int K, int N, bf16* WT, const float* gk, LAS float* scr, int item, int nblk, int lane) {
    asm volatile("" : "+v"(lane));
    const int pr = item >> 1, kb = 2 * (pr / nblk) + (item & 1), nb = pr % nblk, k0 = 64 * kb, n0 = 32 * nb;
    const int nd = n0 + (lane & 31);
    const int ns = KIND == 1 ? win_src(nd) : KIND == 2 ? wqb_src(nd) : KIND == 3 ? wkvb_src(nd) : KIND == 4 ? wgu_src(nd) : nd;
    float tv_[32];
#pragma unroll
    for (int i = 0; i < 32; ++i) { const int kk = 2 * i + (lane >> 5); float v = 0.f; if (ns >= 0) v = W[(size_t)(k0 + kk) * N + ns]; tv_[i] = v; }
#pragma unroll
    for (int i = 0; i < 32; ++i) { const int kk = 2 * i + (lane >> 5); float v = tv_[i]; if (gk) v *= gk[k0 + kk]; scr[kk * 33 + (lane & 31)] = v; }
    LDS_WAIT(); asm volatile("" ::: "memory");
    const int c = lane & 7;
#pragma unroll
    for (int j = 0; j < 4; ++j) { const int n = (lane >> 3) + 8 * j; const LAS float* s = scr + (8 * c) * 33 + n;
        if constexpr (F8) { typedef unsigned u32x2_ __attribute__((ext_vector_type(2)));
            *(GAS u32x2_*)((unsigned char*)WT + (size_t)(n0 + n) * K + k0 + 8 * c) = (u32x2_){pk4_fp8(s[0 * 33] * WSCALE, s[1 * 33] * WSCALE, s[2 * 33] * WSCALE, s[3 * 33] * WSCALE), pk4_fp8(s[4 * 33] * WSCALE, s[5 * 33] * WSCALE, s[6 * 33] * WSCALE, s[7 * 33] * WSCALE)}; }
        else { u32x4 o; o.x = pk2(s[0 * 33], s[1 * 33]); o.y = pk2(s[2 * 33], s[3 * 33]); o.z = pk2(s[4 * 33], s[5 * 33]); o.w = pk2(s[6 * 33], s[7 * 33]);
            *(GAS u32x4*)(WT + (size_t)(n0 + n) * K + k0 + 8 * c) = o; } }
    LDS_WAIT(); asm volatile("" ::: "memory");
}

struct Frame {
    LAS unsigned char* lds; volatile LAS unsigned* MISC; unsigned* ctl; unsigned char* ws;
    int tid, lane, wave, vcu, G;
    const float* const* in; float* out;
};
constexpr int IT_WIN = 16 * 216, IT_WQB = 6 * 24, IT_WKVB = 4 * 32, IT_WBR = 8 * 32, IT_WOUT = 16 * 32, IT_WGU = 16 * 64, IT_WDN = 16 * 32;
constexpr int IT_LAYER = IT_WIN + IT_WQB + IT_WKVB + 3 * IT_WBR + IT_WOUT + NEXP * (IT_WGU + IT_WDN);
__device__ __forceinline__ const float* in_l(const Frame& F, int idx, int l, size_t per_layer) { return F.in[idx] + (size_t)l * per_layer; }

constexpr int NE_ITEMS = IT_WIN + IT_WQB + IT_WKVB + 3 * IT_WBR + IT_WOUT, NE_PAIRS = NE_ITEMS / 2, PAIRS_LAYER = IT_LAYER / 2;
__device__ __forceinline__ void convert_item(Frame& F, int it, LAS float* scr) {
    const int l = it / IT_LAYER; int r = it - l * IT_LAYER;
    if (r < IT_WIN) { bf16* wd = (bf16*)(F.ws + WS_WIN + (size_t)l * NINP * DM * 2);
        if (F8_INL(l)) transpose_item<1, true>(in_l(F, I_WIN, l, (size_t)DM * DIN), DM, DIN, wd, nullptr, scr, r, 216, F.lane); else transpose_item<1, false>(in_l(F, I_WIN, l, (size_t)DM * DIN), DM, DIN, wd, nullptr, scr, r, 216, F.lane); return; } r -= IT_WIN;
    if (r < IT_WQB) { transpose_item<2>(in_l(F, I_WQB, l, 384 * 768), 384, 768, (bf16*)(F.ws + WS_WQB) + (size_t)l * 768 * 384, in_l(F, I_GQA, l, 384), scr, r, 24, F.lane); return; } r -= IT_WQB;
    if (r < IT_WKVB) { transpose_item<3>(in_l(F, I_WKVB, l, 256 * 1024), 256, 1024, (bf16*)(F.ws + WS_WKVB) + (size_t)l * 1024 * 256, in_l(F, I_GKVA, l, 256), scr, r, 32, F.lane); return; } r -= IT_WKVB;
    if (r < 3 * IT_WBR) { const int br = r / IT_WBR; const float* src = in_l(F, br == 0 ? I_WBRA : br == 1 ? I_WBRB : I_WBRC, l, 512 * 1024);
        transpose_item<0, true>(src, 512, 1024, (bf16*)(F.ws + WS_WBR + (size_t)(l * 3 + br) * 1024 * 512), nullptr, scr, r - br * IT_WBR, 32, F.lane); return; } r -= 3 * IT_WBR;
    if (r < IT_WOUT) { transpose_item<0, true>(in_l(F, I_WOUT, l, 1024 * 1024), 1024, 1024, (bf16*)(F.ws + WS_WOUT + (size_t)l * 1024 * 1024), nullptr, scr, r, 32, F.lane); return; } r -= IT_WOUT;
    if (r < NEXP * IT_WGU) { const int e = r / IT_WGU; transpose_item<4, F8_MOE != 0>(in_l(F, I_WGU, l * NEXP + e, (size_t)1024 * 2048), 1024, 2048, (bf16*)(F.ws + WS_WGU + (size_t)(l * NEXP + e) * 2048 * 1024 * (F8_MOE ? 1 : 2)), nullptr, scr, r - e * IT_WGU, 64, F.lane); return; }
    r -= NEXP * IT_WGU;
    { const int e = r / IT_WDN; transpose_item<0, F8_MOE != 0>(in_l(F, I_WDN, l * NEXP + e, (size_t)1024 * 1024), 1024, 1024, (bf16*)(F.ws + WS_WDN + (size_t)(l * NEXP + e) * 1024 * 1024 * (F8_MOE ? 1 : 2)), nullptr, scr, r - e * IT_WDN, 32, F.lane); }
}
__device__ __forceinline__ void p_prologue_a(Frame& F) {
    LAS float* scr = (LAS float*)(F.lds + RING_OFF + F.wave * 8704);
    const int gw = F.vcu * NWAVES + F.wave, NGW = F.G * NWAVES;
    for (int pr = gw; pr < NE_PAIRS; pr += NGW) { convert_item(F, 2 * pr, scr); convert_item(F, 2 * pr + 1, scr); }
    __syncthreads();
    if (F.vcu < 2 * 96) {
        LAS float* sc = (LAS float*)(F.lds + RING_OFF + 80 * 1024);
        LAS float* red = sc + 5 * 1024;
        for (int i = F.tid; i < 5 * 1024; i += NTHR) { const float v = i < 4096 ? F.in[I_C][i] : F.in[I_CCTX][i - 4096]; sc[i] = siluf_(v); }
        __syncthreads();
        const int l = F.vcu / 96, n = (F.vcu % 96) * 64 + F.lane; const float* W = in_l(F, I_WMOD, l, (size_t)DM * 6144) + n;
        float a[5] = {0.f, 0.f, 0.f, 0.f, 0.f};
        for (int k0 = F.wave * 128; k0 < F.wave * 128 + 128; k0 += 16) { float w[16];
#pragma unroll
            for (int i = 0; i < 16; ++i) w[i] = W[(size_t)(k0 + i) * 6144];
#pragma unroll
            for (int i = 0; i < 16; ++i) {
#pragma unroll
                for (int v = 0; v < 5; ++v) a[v] += sc[v * 1024 + k0 + i] * w[i]; } }
#pragma unroll
        for (int v = 0; v < 5; ++v) red[(F.wave * 5 + v) * 64 + F.lane] = a[v];
        __syncthreads();
        if (F.tid < 320) { const int v = F.tid >> 6, ln = F.tid & 63; float s = 0.f;
#pragma unroll
            for (int w = 0; w < 8; ++w) s += red[(w * 5 + v) * 64 + ln];
            const int nn = (F.vcu % 96) * 64 + ln; ((float*)(F.ws + WS_MODV))[(size_t)(l * 5 + v) * 6144 + nn] = s + in_l(F, I_BMOD, l, 6144)[nn]; }
        __syncthreads();
    }
    { const int g = F.vcu * NTHR + F.tid; float* tabA = (float*)(F.ws + WS_TAB); float* tabC = tabA + 192 * 16 * 2;
      if (g < 192 * 16) { const int tr = g >> 4, i = g & 15; const float pos = (float)(tr < 128 ? tr : tr - 128); const float inv = powf(10000.0f, -(float)i / 16.0f); const float ang = pos * inv; tabA[2 * g] = cosf(ang); tabA[2 * g + 1] = sinf(ang); }
      else if (g < 192 * 16 + 192 * 8) { const int q = g - 192 * 16, tr = q >> 3, i = q & 7; const float pos = (float)(tr < 128 ? tr : tr - 128); const float inv = powf(10000.0f, -(float)i / 8.0f); const float ang = pos * inv; tabC[2 * q] = cosf(ang); tabC[2 * q + 1] = sinf(ang); }
      if (F.vcu == F.G - 1 && F.wave < 2) { const int l = F.wave; const float a = in_l(F, I_LQ1, l, 64)[F.lane] * in_l(F, I_LK1, l, 64)[F.lane], b = in_l(F, I_LQ2, l, 64)[F.lane] * in_l(F, I_LK2, l, 64)[F.lane];
          const float sa = wave_sum(a), sb = wave_sum(b); const float lam_init = 0.8f - 0.6f * expf(-0.3f * (float)l);
          if (F.lane == 0) { float* lam = tabC + 192 * 8 * 2; lam[2 * l] = expf(sa) - expf(sb) + lam_init; lam[2 * l + 1] = lam_init; } }
    }
}
template <bool F8> __device__ __forceinline__ void put_h4(unsigned char* orow, int lane, int j, const f32x4 y) {
    if constexpr (F8) ((unsigned*)orow)[lane + 64 * j] = pk4_fp8(y.x, y.y, y.z, y.w);
    else ((unsigned long long*)orow)[lane + 64 * j] = (unsigned long long)pk2(y.x, y.y) | ((unsigned long long)pk2(y.z, y.w) << 32);
}
constexpr int HROW_MOE = F8_MOE ? 1024 : 2048;
#define HROW_INL(l) (F8_INL(l) ? 1024 : 2048)
__device__ __forceinline__ void mod_row_f8(const float* xrow, const float* g, const float* sh, const float* scl, unsigned char* orow, int lane) {
    const f32x4* xr = (const f32x4*)xrow + lane; f32x4 v[4]; float s = 0.f;
#pragma unroll
    for (int j = 0; j < 4; ++j) { v[j] = xr[64 * j]; s += (v[j].x * v[j].x + v[j].y * v[j].y) + (v[j].z * v[j].z + v[j].w * v[j].w); }
    const float rstd = 1.0f / sqrtf(wave_sum(s) * (1.0f / DM) + EPS);
#pragma unroll
    for (int j = 0; j < 4; ++j) { const f32x4 gg = ((const f32x4*)g)[lane + 64 * j], ss = ((const f32x4*)sh)[lane + 64 * j], cc = ((const f32x4*)scl)[lane + 64 * j];
        put_h4<F8_IN0 != 0>(orow, lane, j, v[j] * rstd * gg * (cc + 1.0f) + ss); }
}
__device__ __forceinline__ void p_prologue_b(Frame& F) {
    const int gw = F.vcu * NWAVES + F.wave, NGW = F.G * NWAVES; const float* modv = (const float*)(F.ws + WS_MODV); unsigned char* H = F.ws + WS_H;
    f32x4 nx[4];
#define XROW(m) ((m) < NLAT ? F.in[I_X] + (size_t)(m) * DM : F.in[I_CTX] + (size_t)((m) - NLAT) * DM)
    if (gw < MTOT) { const f32x4* xr = (const f32x4*)XROW(gw) + F.lane;
#pragma unroll
        for (int j = 0; j < 4; ++j) nx[j] = xr[64 * j]; }
    f32x4 gg[4];
#pragma unroll
    for (int j = 0; j < 4; ++j) gg[j] = ((const f32x4*)F.in[I_GMIX])[F.lane + 64 * j];
    for (int m = gw; m < MTOT; m += NGW) { const int b = m < NLAT ? m / SEQ : 4; f32x4 v[4]; float s = 0.f;
#pragma unroll
        for (int j = 0; j < 4; ++j) { v[j] = nx[j]; s += (v[j].x * v[j].x + v[j].y * v[j].y) + (v[j].z * v[j].z + v[j].w * v[j].w); }
        { const int mn = min(m + NGW, MTOT - 1); const f32x4* xr = (const f32x4*)XROW(mn) + F.lane;
#pragma unroll
          for (int j = 0; j < 4; ++j) nx[j] = xr[64 * j]; }
        const float* sh = modv + b * 6144; const float* scl = modv + b * 6144 + 1024; f32x4 ss[4], cc[4];
#pragma unroll
        for (int j = 0; j < 4; ++j) { ss[j] = ((const f32x4*)sh)[F.lane + 64 * j]; cc[j] = ((const f32x4*)scl)[F.lane + 64 * j]; }
        const float rstd = 1.0f / sqrtf(wave_sum(s) * (1.0f / DM) + EPS);
#pragma unroll
        for (int j = 0; j < 4; ++j) put_h4<F8_IN0 != 0>(H + (size_t)m * HROW_INL(0), F.lane, j, v[j] * rstd * gg[j] * (cc[j] + 1.0f) + ss[j]);
    }
#undef XROW
}
__device__ __forceinline__ void p_final_norm(Frame& F, const float* X) {
    const int gw = F.vcu * NWAVES + F.wave, NGW = F.G * NWAVES; const f32x4* g = (const f32x4*)F.in[I_GFIN];
    for (int m = gw; m < NLAT; m += NGW) { const f32x4* xr = (const f32x4*)(X + (size_t)m * DM) + F.lane; f32x4 v[4]; float s = 0.f;
#pragma unroll
        for (int j = 0; j < 4; ++j) { v[j] = xr[64 * j]; s += (v[j].x * v[j].x + v[j].y * v[j].y) + (v[j].z * v[j].z + v[j].w * v[j].w); }
        const float rstd = 1.0f / sqrtf(wave_sum(s) * (1.0f / DM) + EPS);
        f32x4* outp = (f32x4*)(F.out + (size_t)m * DM) + F.lane;
#pragma unroll
        for (int j = 0; j < 4; ++j) outp[64 * j] = v[j] * rstd * g[F.lane + 64 * j]; }
}

namespace att {
using f32x16 = __attribute__((ext_vector_type(16))) float;
using s16x4 = __attribute__((ext_vector_type(4))) short;
constexpr float THR = 8.0f;
constexpr float NEGBIG = -3.0e38f, MINIT = -1.0e30f;
__device__ __forceinline__ int crow(int r, int hi) { return (r & 3) + 8 * (r >> 2) + 4 * hi; }
constexpr int L_K1 = 0, L_K2 = 16384, L_V = 32768, L_WS = 65536, L_RPB = 67584, L_END = 70144;
template <int OFF> __device__ __forceinline__ s16x4 tr_read(int vb) { s16x4 r; asm volatile("ds_read_b64_tr_b16 %0, %1 offset:%2" : "=&v"(r) : "v"(vb), "i"(OFF) : "memory"); return r; }
__device__ __forceinline__ int v_rd_base(int lane) { return ((lane & 3) << 3) | (((lane >> 2) & 3) << 6) | (((lane >> 4) & 1) << 5) | (((lane >> 5) & 1) << 8); }
template <int DV> __device__ __forceinline__ int v_st(int k, int c) { return ((k >> 3) * (DV / 32) + (c >> 5)) * 512 + ((k & 7) * 32 + (c & 31)) * 2; }
template <int DV, int D0> __device__ __forceinline__ void pv_one(f32x16& od, int vb, bf16x8 pa0, bf16x8 pa1, bf16x8 pa2, bf16x8 pa3) {
    constexpr int KT = (DV / 32) * 512;
    const s16x4 l0 = tr_read<D0 * 512 + 0 * KT>(vb), h0 = tr_read<D0 * 512 + 1 * KT>(vb), l1 = tr_read<D0 * 512 + 2 * KT>(vb), h1 = tr_read<D0 * 512 + 3 * KT>(vb);
    const s16x4 l2 = tr_read<D0 * 512 + 4 * KT>(vb), h2 = tr_read<D0 * 512 + 5 * KT>(vb), l3 = tr_read<D0 * 512 + 6 * KT>(vb), h3 = tr_read<D0 * 512 + 7 * KT>(vb);
    asm volatile("s_waitcnt lgkmcnt(0)" ::: "memory"); __builtin_amdgcn_sched_barrier(0);
#define PKV(L, H) (bf16x8){L[0], L[1], L[2], L[3], H[0], H[1], H[2], H[3]}
    od = __builtin_amdgcn_mfma_f32_32x32x16_bf16(pa0, PKV(l0, h0), od, 0, 0, 0);
    od = __builtin_amdgcn_mfma_f32_32x32x16_bf16(pa1, PKV(l1, h1), od, 0, 0, 0);
    od = __builtin_amdgcn_mfma_f32_32x32x16_bf16(pa2, PKV(l2, h2), od, 0, 0, 0);
    od = __builtin_amdgcn_mfma_f32_32x32x16_bf16(pa3, PKV(l3, h3), od, 0, 0, 0);
#undef PKV
}
struct NaParams { const float* rpb_h; int r0; };
template <int DK2, int DV, int MODE>
__device__ __forceinline__ void attn_pass(LAS unsigned char* lds, const bf16* Qrow0, int ldq, const bf16* K1, const bf16* K2, const bf16* V, int lat0, int ntl, int ctx0, int ntc, const NaParams na, int kr_lo,
                                          f32x16 (&o)[DV / 32], float& l_out) {
    constexpr int NQ = 4 + DK2 / 16, ND = DV / 32;
    int tid_ = threadIdx.x; asm volatile("" : "+v"(tid_)); const int tid = tid_, lane = tid & 63, r32 = lane & 31, hi = lane >> 5; const int wid = __builtin_amdgcn_readfirstlane(tid >> 6);
    LAS float* wsf = (LAS float*)(lds + L_WS) + wid * 64; LAS float* rpbl = (LAS float*)(lds + L_RPB);
    bf16x8 qr[NQ];
    { const bf16* qp = Qrow0 + (size_t)(wid * 32 + r32) * ldq + hi * 8;
#pragma unroll
      for (int d0 = 0; d0 < NQ; ++d0) qr[d0] = *(const bf16x8*)(qp + d0 * 16); }
    float rpv0 = 0.f, rpv1 = 0.f;
    if (MODE == 1) { const int i0 = tid, i1 = tid + NTHR; if (i0 >= 64 && i0 < 64 + 15 * 31) rpv0 = na.rpb_h[i0 - 64] * LOG2E; if (i1 >= 64 && i1 < 64 + 15 * 31) rpv1 = na.rpb_h[i1 - 64] * LOG2E; }
    const int k1r = tid >> 3, k1c = tid & 7, k1dst = k1r * 128 + ((k1c ^ ((k1r >> 1) & 7)) << 4);
    const int k2r = (tid >> 2) & 63, k2c = tid & 3, k2dst = k2r * 64 + ((k2c ^ ((k2r >> 2) & 3)) << 4);
    const int vr = DV == 128 ? (tid >> 4) : (tid >> 3), vc = DV == 128 ? (tid & 15) * 8 : (tid & 7) * 8; const int vdst0 = v_st<DV>(vr, vc), vdst1 = v_st<DV>(vr + 32, vc);
    struct Stg1 { bf16x8 k1, k2, v0, v1; } sgA, sgB;
    const int NT = ntl + ntc;
#define TROW(t) ((t) < ntl ? lat0 + (t) * 64 : ctx0 + ((t) - ntl) * 64)
#define SLOAD(t, S) do { const size_t kr_ = (size_t)TROW(t); S.k1 = *(const bf16x8*)(K1 + (kr_ + k1r) * 512 + k1c * 8); if (DK2 && tid < 256) S.k2 = *(const bf16x8*)(K2 + (kr_ + k2r) * 32 + k2c * 8); \
        S.v0 = *(const bf16x8*)(V + (kr_ + vr) * 512 + vc); if (DV == 128) S.v1 = *(const bf16x8*)(V + (kr_ + vr + 32) * 512 + vc); } while (0)
#define SWRITE(b, S) do { *(LAS bf16x8*)(lds + L_K1 + (b) * 8192 + k1dst) = S.k1; if (DK2 && tid < 256) *(LAS bf16x8*)(lds + L_K2 + (b) * 4096 + k2dst) = S.k2; \
        *(LAS bf16x8*)(lds + L_V + (b) * (DV * 128) + vdst0) = S.v0; if (DV == 128) *(LAS bf16x8*)(lds + L_V + (b) * (DV * 128) + vdst1) = S.v1; } while (0)
    float m_reg = 0.f, l_reg = 0.f; bool first = true; f32x16 negv = f32x16{};
#pragma unroll
    for (int d = 0; d < ND; ++d) o[d] = f32x16{};
    const int rq = na.r0 + (wid >> 1), cq = 32 * (wid & 1) + r32; const int rs_w = min(max(rq - 4, 0), 120), cs = min(max(cq - 8, 0), 48);
    f32x16 pen0 = f32x16{}, pen1 = f32x16{};
    if (MODE == 1) {
#pragma unroll
        for (int r = 0; r < 16; ++r) { const int c0 = crow(r, hi), c1 = 32 + c0; pen0[r] = ((unsigned)(c0 - cs) < 16u) ? 0.f : MINIT; pen1[r] = ((unsigned)(c1 - cs) < 16u) ? 0.f : MINIT; } }
    const int vb0 = (int)(uintptr_t)(lds + L_V) + v_rd_base(lane);
    SLOAD(0, sgA);
    if (MODE == 1) { rpbl[tid] = rpv0; if (tid + NTHR < 15 * 31 + 128) rpbl[tid + NTHR] = rpv1; }
    SWRITE(0, sgA); if (1 < NT) SLOAD(1, sgA); __syncthreads();
    auto tile = [&](const int t, const int cur) __attribute__((always_inline)) {
        bool active = true; int kr = 0;
        if (MODE == 1 && t < ntl) { kr = kr_lo + t; active = (kr >= rs_w) && (kr < rs_w + 8); }
        if (active) {
            f32x16 p0, p1;
            { const LAS unsigned char* kb = lds + L_K1 + cur * 8192;
#pragma unroll
              for (int d0 = 0; d0 < 4; ++d0) { const int ch = 2 * d0 + hi;
                  const bf16x8 b0 = *(const LAS bf16x8*)(kb + r32 * 128 + ((ch ^ ((r32 >> 1) & 7)) << 4));
                  const bf16x8 b1 = *(const LAS bf16x8*)(kb + (32 + r32) * 128 + ((ch ^ (((32 + r32) >> 1) & 7)) << 4));
                  if (d0 == 0) { p0 = __builtin_amdgcn_mfma_f32_32x32x16_bf16(b0, qr[d0], negv, 0, 0, 0); p1 = __builtin_amdgcn_mfma_f32_32x32x16_bf16(b1, qr[d0], negv, 0, 0, 0); }
                  else { p0 = __builtin_amdgcn_mfma_f32_32x32x16_bf16(b0, qr[d0], p0, 0, 0, 0); p1 = __builtin_amdgcn_mfma_f32_32x32x16_bf16(b1, qr[d0], p1, 0, 0, 0); } }
              if (DK2) { const LAS unsigned char* k2b = lds + L_K2 + cur * 4096;
#pragma unroll
                  for (int d0 = 0; d0 < DK2 / 16; ++d0) { const int ch = 2 * d0 + hi;
                      const bf16x8 b0 = *(const LAS bf16x8*)(k2b + r32 * 64 + ((ch ^ ((r32 >> 2) & 3)) << 4));
                      const bf16x8 b1 = *(const LAS bf16x8*)(k2b + (32 + r32) * 64 + ((ch ^ (((32 + r32) >> 2) & 3)) << 4));
                      p0 = __builtin_amdgcn_mfma_f32_32x32x16_bf16(b0, qr[4 + d0], p0, 0, 0, 0); p1 = __builtin_amdgcn_mfma_f32_32x32x16_bf16(b1, qr[4 + d0], p1, 0, 0, 0); } }
            }
            if (MODE == 1 && t < ntl) {
                const LAS float* bl = rpbl + 64 + (kr - rq + 7) * 31 + 15 - cq;
#pragma unroll
                for (int r = 0; r < 16; ++r) { const int c0 = crow(r, hi), c1 = 32 + c0; p0[r] = (p0[r] + bl[c0]) + pen0[r]; p1[r] = (p1[r] + bl[c1]) + pen1[r]; }
            }
#define MX3B(a, b, c) __builtin_fmaxf(__builtin_fmaxf((a), (b)), (c))
            float pa_ = MX3B(p0[0], p0[1], p0[2]), pb_ = MX3B(p1[0], p1[1], p1[2]);
#pragma unroll
            for (int r = 3; r < 15; r += 2) { pa_ = MX3B(pa_, p0[r], p0[r + 1]); pb_ = MX3B(pb_, p1[r], p1[r + 1]); }
            float pmax = MX3B(pa_, pb_, p0[15]); pmax = fmaxf(pmax, p1[15]);
#undef MX3B
            { auto rr = __builtin_amdgcn_permlane32_swap(__float_as_uint(pmax), __float_as_uint(pmax), false, false); pmax = fmaxf(__uint_as_float(rr[0]), __uint_as_float(rr[1])); }
            float alpha = 1.f;
            if (first || !__all(pmax <= THR)) {
                const float dl = first ? pmax : fmaxf(pmax, 0.f); alpha = first ? 1.f : __builtin_amdgcn_exp2f(-dl); m_reg += dl;
#pragma unroll
                for (int r = 0; r < 16; ++r) { p0[r] -= dl; p1[r] -= dl; }
#pragma unroll
                for (int r = 0; r < 16; ++r) negv[r] = -m_reg;
                if (!first) { if (hi == 0) wsf[r32] = alpha;
#pragma unroll
                    for (int d = 0; d < ND; ++d)
#pragma unroll
                        for (int r = 0; r < 16; ++r) o[d][r] *= wsf[crow(r, hi)]; }
                first = false;
            }
            float ps = 0.f;
#pragma unroll
            for (int r = 0; r < 16; ++r) { p0[r] = __builtin_amdgcn_exp2f(p0[r]); p1[r] = __builtin_amdgcn_exp2f(p1[r]); ps += p0[r] + p1[r]; }
            { auto rr = __builtin_amdgcn_permlane32_swap(__float_as_uint(ps), __float_as_uint(ps), false, false); ps = __uint_as_float(rr[0]) + __uint_as_float(rr[1]); }
            l_reg = l_reg * alpha + ps;
            u32x4 w0, w1, w2, w3;
            w0 = (u32x4){cvt_pk_bf16(p0[0], p0[1]), cvt_pk_bf16(p0[2], p0[3]), cvt_pk_bf16(p0[4], p0[5]), cvt_pk_bf16(p0[6], p0[7])};
            w1 = (u32x4){cvt_pk_bf16(p0[8], p0[9]), cvt_pk_bf16(p0[10], p0[11]), cvt_pk_bf16(p0[12], p0[13]), cvt_pk_bf16(p0[14], p0[15])};
            w2 = (u32x4){cvt_pk_bf16(p1[0], p1[1]), cvt_pk_bf16(p1[2], p1[3]), cvt_pk_bf16(p1[4], p1[5]), cvt_pk_bf16(p1[6], p1[7])};
            w3 = (u32x4){cvt_pk_bf16(p1[8], p1[9]), cvt_pk_bf16(p1[10], p1[11]), cvt_pk_bf16(p1[12], p1[13]), cvt_pk_bf16(p1[14], p1[15])};
            const bf16x8 pa0 = __builtin_bit_cast(bf16x8, w0), pa1 = __builtin_bit_cast(bf16x8, w1), pa2 = __builtin_bit_cast(bf16x8, w2), pa3 = __builtin_bit_cast(bf16x8, w3);
            const int vb = vb0 + cur * (DV * 128);
            pv_one<DV, 0>(o[0], vb, pa0, pa1, pa2, pa3); pv_one<DV, 1>(o[1], vb, pa0, pa1, pa2, pa3);
            if constexpr (DV == 128) { pv_one<DV, 2>(o[2], vb, pa0, pa1, pa2, pa3); pv_one<DV, 3>(o[3], vb, pa0, pa1, pa2, pa3); }
        }
    };
    for (int t = 0; t < NT; t += 2) {
        if (t + 2 < NT) SLOAD(t + 2, sgB);
        tile(t, 0);
        if (t + 1 < NT) SWRITE(1, sgA);
        __syncthreads();
        if (t + 1 >= NT) break;
        if (t + 3 < NT) SLOAD(t + 3, sgA);
        tile(t + 1, 1);
        if (t + 2 < NT) SWRITE(0, sgB);
        __syncthreads();
    }
    l_out = l_reg;
#undef TROW
#undef SLOAD
#undef SWRITE
}
__device__ __forceinline__ void row_recip(LAS unsigned char* lds, float l_reg, float (&rli)[16]) {
    const int tid = threadIdx.x; int lane = tid & 63; asm volatile("" : "+v"(lane)); const int r32 = lane & 31, hi = lane >> 5; const int wid = __builtin_amdgcn_readfirstlane(tid >> 6);
    LAS float* wsf = (LAS float*)(lds + L_WS) + wid * 64;
    if (hi == 0) wsf[32 + r32] = l_reg;
#pragma unroll
    for (int r = 0; r < 16; ++r) rli[r] = 1.0f / wsf[32 + crow(r, hi)];
}
template <int DV> __device__ __forceinline__ void store_bf16(LAS unsigned char* lds, const f32x16 (&o)[DV / 32], float l_reg, unsigned char* Y, int ld) {
    const int tid = threadIdx.x; int lane = tid & 63; asm volatile("" : "+v"(lane)); const int r32 = lane & 31, hi = lane >> 5; const int wid = __builtin_amdgcn_readfirstlane(tid >> 6);
    float rli[16]; row_recip(lds, l_reg, rli);
    unsigned char* yw = Y + (size_t)(wid * 32) * ld + r32;
#pragma unroll
    for (int r = 0; r < 16; ++r)
#pragma unroll
        for (int d = 0; d < DV / 32; ++d) yw[(size_t)crow(r, hi) * ld + d * 32] = f8_one(o[d][r] * rli[r] * YS_BC);
}
template <int DV> __device__ __forceinline__ void store_bf16v(const f32x16 (&o)[DV / 32], const f32x16& lv, unsigned char* Y, int ld) {
    const int tid = threadIdx.x; int lane = tid & 63; asm volatile("" : "+v"(lane)); const int r32 = lane & 31, hi = lane >> 5; const int wid = __builtin_amdgcn_readfirstlane(tid >> 6);
    unsigned char* yw = Y + (size_t)(wid * 32) * ld + r32;
#pragma unroll
    for (int r = 0; r < 16; ++r) { const float rl = YS_BC / lv[r];
#pragma unroll
        for (int d = 0; d < DV / 32; ++d) yw[(size_t)crow(r, hi) * ld + d * 32] = f8_one(o[d][r] * rl); }
}
}

namespace att {
template <int DK2, int DV>
__device__ __forceinline__ void attn_pass2(LAS unsigned char* lds, const bf16* Qrow0, int ldq, const bf16* K1, const bf16* K2, const bf16* V, int lat0, int ntl, int ctx0, int ntc, f32x16 (&o)[DV / 32], float& l_out) {
    constexpr int NQ = 4 + DK2 / 16, ND = DV / 32;
    int tid_ = threadIdx.x; asm volatile("" : "+v"(tid_)); const int tid = tid_, lane = tid & 63, r32 = lane & 31, hi = lane >> 5; const int wid = __builtin_amdgcn_readfirstlane(tid >> 6);
    LAS float* wsf = (LAS float*)(lds + L_WS) + wid * 64;
    bf16x8 qr[NQ];
    { const bf16* qp = Qrow0 + (size_t)(wid * 32 + r32) * ldq + hi * 8;
#pragma unroll
      for (int d0 = 0; d0 < NQ; ++d0) qr[d0] = *(const bf16x8*)(qp + d0 * 16); }
    const int k1r = tid >> 3, k1c = tid & 7, k1dst = k1r * 128 + ((k1c ^ ((k1r >> 1) & 7)) << 4);
    const int k2r = (tid >> 2) & 63, k2c = tid & 3, k2dst = k2r * 64 + ((k2c ^ ((k2r >> 2) & 3)) << 4);
    const int vr = DV == 128 ? (tid >> 4) : (tid >> 3), vc = DV == 128 ? (tid & 15) * 8 : (tid & 7) * 8; const int vdst0 = v_st<DV>(vr, vc), vdst1 = v_st<DV>(vr + 32, vc);
    struct Stg { bf16x8 k1, x, v0; } sg[2];
    const int NT = ntl + ntc;
#define TROW(t) ((t) < ntl ? lat0 + (t) * 64 : ctx0 + ((t) - ntl) * 64)
#define SLOAD(i, t) do { const size_t kr_ = (size_t)TROW(t); sg[i].k1 = *(const bf16x8*)(K1 + (kr_ + k1r) * 512 + k1c * 8); sg[i].v0 = *(const bf16x8*)(V + (kr_ + vr) * 512 + vc); \
        if (DV == 128) sg[i].x = *(const bf16x8*)(V + (kr_ + vr + 32) * 512 + vc); else if (DK2) sg[i].x = *(const bf16x8*)(K2 + (kr_ + k2r) * 32 + k2c * 8); } while (0)
#define SWRITE(b, i) do { *(LAS bf16x8*)(lds + L_K1 + (b) * 8192 + k1dst) = sg[i].k1; *(LAS bf16x8*)(lds + L_V + (b) * (DV * 128) + vdst0) = sg[i].v0; \
        if (DV == 128) *(LAS bf16x8*)(lds + L_V + (b) * (DV * 128) + vdst1) = sg[i].x; else if (DK2) *(LAS bf16x8*)(lds + L_K2 + (b) * 4096 + k2dst) = sg[i].x; } while (0)
    float m_reg = MINIT, l_reg = 0.f;
#pragma unroll
    for (int d = 0; d < ND; ++d) o[d] = f32x16{};
    const int vb0 = (int)(uintptr_t)(lds + L_V) + v_rd_base(lane);
    const int ka0 = r32 * 128, ka1 = (32 + r32) * 128, ks0 = (r32 >> 1) & 7, ks1 = ((32 + r32) >> 1) & 7;
    const int k2a0 = r32 * 64, k2a1 = (32 + r32) * 64, k2s0 = (r32 >> 2) & 3, k2s1 = ((32 + r32) >> 2) & 3;
#define QKT(P0, P1, b) do { P0 = f32x16{}; P1 = f32x16{}; const LAS unsigned char* kb_ = lds + L_K1 + (b) * 8192; \
        _Pragma("unroll") for (int d0 = 0; d0 < 4; ++d0) { const int ch = 2 * d0 + hi; \
            const bf16x8 b0 = *(const LAS bf16x8*)(kb_ + ka0 + ((ch ^ ks0) << 4)); const bf16x8 b1 = *(const LAS bf16x8*)(kb_ + ka1 + ((ch ^ ks1) << 4)); \
            P0 = __builtin_amdgcn_mfma_f32_32x32x16_bf16(b0, qr[d0], P0, 0, 0, 0); P1 = __builtin_amdgcn_mfma_f32_32x32x16_bf16(b1, qr[d0], P1, 0, 0, 0); } \
        if (DK2) { const LAS unsigned char* k2b_ = lds + L_K2 + (b) * 4096; \
            _Pragma("unroll") for (int d0 = 0; d0 < DK2 / 16; ++d0) { const int ch = 2 * d0 + hi; \
                const bf16x8 b0 = *(const LAS bf16x8*)(k2b_ + k2a0 + ((ch ^ k2s0) << 4)); const bf16x8 b1 = *(const LAS bf16x8*)(k2b_ + k2a1 + ((ch ^ k2s1) << 4)); \
                P0 = __builtin_amdgcn_mfma_f32_32x32x16_bf16(b0, qr[4 + d0], P0, 0, 0, 0); P1 = __builtin_amdgcn_mfma_f32_32x32x16_bf16(b1, qr[4 + d0], P1, 0, 0, 0); } } } while (0)
#define PARTSM(P0, P1, AL) do { float pmax = P0[0]; \
        _Pragma("unroll") for (int r = 1; r < 16; ++r) pmax = fmaxf(pmax, P0[r]); _Pragma("unroll") for (int r = 0; r < 16; ++r) pmax = fmaxf(pmax, P1[r]); \
        { auto rr = __builtin_amdgcn_permlane32_swap(__float_as_uint(pmax), __float_as_uint(pmax), false, false); pmax = fmaxf(__uint_as_float(rr[0]), __uint_as_float(rr[1])); } \
        if (__builtin_expect(__all(pmax - m_reg <= THR), 1)) { AL = 1.f; } else { const float mn = fmaxf(m_reg, pmax); AL = __builtin_amdgcn_exp2f(m_reg - mn); m_reg = mn; } \
        _Pragma("unroll") for (int r = 0; r < 16; ++r) { P0[r] -= m_reg; P1[r] -= m_reg; } \
        _Pragma("unroll") for (int r = 0; r < 16; ++r) P0[r] = __builtin_amdgcn_exp2f(P0[r]); } while (0)
#define FINSM(P0, P1, AL) do { _Pragma("unroll") for (int r = 0; r < 16; ++r) P1[r] = __builtin_amdgcn_exp2f(P1[r]); float ps = 0.f; \
        _Pragma("unroll") for (int r = 0; r < 16; ++r) ps += P0[r]; _Pragma("unroll") for (int r = 0; r < 16; ++r) ps += P1[r]; \
        { auto rr = __builtin_amdgcn_permlane32_swap(__float_as_uint(ps), __float_as_uint(ps), false, false); ps = __uint_as_float(rr[0]) + __uint_as_float(rr[1]); } \
        l_reg = l_reg * AL + ps; \
        const u32x4 w0 = (u32x4){cvt_pk_bf16(P0[0], P0[1]), cvt_pk_bf16(P0[2], P0[3]), cvt_pk_bf16(P0[4], P0[5]), cvt_pk_bf16(P0[6], P0[7])}; \
        const u32x4 w1 = (u32x4){cvt_pk_bf16(P0[8], P0[9]), cvt_pk_bf16(P0[10], P0[11]), cvt_pk_bf16(P0[12], P0[13]), cvt_pk_bf16(P0[14], P0[15])}; \
        const u32x4 w2 = (u32x4){cvt_pk_bf16(P1[0], P1[1]), cvt_pk_bf16(P1[2], P1[3]), cvt_pk_bf16(P1[4], P1[5]), cvt_pk_bf16(P1[6], P1[7])}; \
        const u32x4 w3 = (u32x4){cvt_pk_bf16(P1[8], P1[9]), cvt_pk_bf16(P1[10], P1[11]), cvt_pk_bf16(P1[12], P1[13]), cvt_pk_bf16(P1[14], P1[15])}; \
        pa0 = __builtin_bit_cast(bf16x8, w0); pa1 = __builtin_bit_cast(bf16x8, w1); pa2 = __builtin_bit_cast(bf16x8, w2); pa3 = __builtin_bit_cast(bf16x8, w3); } while (0)
#define PV(b) do { const int vb_ = vb0 + (b) * (DV * 128); pv_one<DV, 0>(o[0], vb_, pa0, pa1, pa2, pa3); pv_one<DV, 1>(o[1], vb_, pa0, pa1, pa2, pa3); \
        if constexpr (DV == 128) { pv_one<DV, 2>(o[2], vb_, pa0, pa1, pa2, pa3); pv_one<DV, 3>(o[3], vb_, pa0, pa1, pa2, pa3); } } while (0)
#define RESC(AL) do { if (__any((AL) < 1.f)) { if (hi == 0) wsf[r32] = (AL); \
        _Pragma("unroll") for (int d = 0; d < ND; ++d) _Pragma("unroll") for (int r = 0; r < 16; ++r) o[d][r] *= wsf[crow(r, hi)]; } } while (0)
#define SB() __builtin_amdgcn_sched_barrier(0)
    f32x16 pA0, pA1, pB0, pB1; float alA, alB; bf16x8 pa0, pa1, pa2, pa3;
    SLOAD(0, 0); SWRITE(0, 0); __syncthreads();
    QKT(pA0, pA1, 0); PARTSM(pA0, pA1, alA);
    SLOAD(1, 1); if (2 < NT) SLOAD(0, 2);
    SWRITE(1, 1); __syncthreads();
    RESC(alA);
    for (int j = 1; j + 1 < NT; j += 2) {
        SB(); QKT(pB0, pB1, 1);
        FINSM(pA0, pA1, alA); SB();
        SLOAD(1, j + 2); SB();
        PV(0); PARTSM(pB0, pB1, alB);
        __syncthreads(); SWRITE(0, 0);
        RESC(alB); __syncthreads();
        SB(); QKT(pA0, pA1, 0);
        FINSM(pB0, pB1, alB); SB();
        if (j + 3 < NT) SLOAD(0, j + 3); SB();
        PV(1); PARTSM(pA0, pA1, alA);
        __syncthreads(); SWRITE(1, 1);
        RESC(alA); __syncthreads();
    }
    SB(); QKT(pB0, pB1, 1);
    FINSM(pA0, pA1, alA); SB();
    PV(0); PARTSM(pB0, pB1, alB);
    RESC(alB);
    FINSM(pB0, pB1, alB); SB();
    PV(1);
    __syncthreads();
    l_out = l_reg;
#undef TROW
#undef SLOAD
#undef SWRITE
#undef QKT
#undef PARTSM
#undef FINSM
#undef PV
#undef RESC
#undef SB
}
}
namespace att {
__device__ __forceinline__ unsigned pk4_fp8_nc(float a, float b, float c, float d) { int w = 0; w = __builtin_amdgcn_cvt_pk_fp8_f32(a, b, w, false); w = __builtin_amdgcn_cvt_pk_fp8_f32(c, d, w, true); return (unsigned)w; }
}
namespace att {
template <int DK2, int DV>
__device__ __forceinline__ void attn_pass_f8(LAS unsigned char* lds, const bf16* Qrow0, int ldq, const unsigned char* K1, const bf16* K2, const unsigned char* VT, int vt_stride, int lat0, int ntl, int ctx0, int ntc, f32x16 (&o)[DV / 32], f32x16& l_out) {
    constexpr int NQ2 = DK2 / 16, ND = DV / 32;
    typedef int i32x4_ __attribute__((ext_vector_type(4))); typedef int i32x8_ __attribute__((ext_vector_type(8)));
    int tid_ = threadIdx.x; asm volatile("" : "+v"(tid_)); const int tid = tid_, lane = tid & 63, r32 = lane & 31, hi = lane >> 5; const int wid = __builtin_amdgcn_readfirstlane(tid >> 6);
    LAS float* wsf = (LAS float*)(lds + L_WS) + wid * 64;
    bf16x8 qr2[NQ2 ? NQ2 : 1]; i32x8_ q8;
    const int wq = wid & 3, drow = 16 * wq + (lane >> 2), vrow = (DV == 128 ? 16 * wid : 16 * wq) + (lane >> 2);
    const unsigned char* k1src = K1 + (size_t)drow * 512 + (((lane & 3) ^ ((drow >> 2) & 3)) << 4);
    const unsigned char* vsrc = VT + vrow * 64 + (((lane & 3) ^ ((vrow >> 2) & 3)) << 4);
    const bf16* k2src = K2 + (size_t)drow * 32 + (((lane & 3) ^ ((drow >> 2) & 3)) << 3);
    const bool k1on = (DV == 128) ? (wid < 4) : (wid >= 4), von = (DV == 128) || (wid < 4), k2on = (DK2 != 0) && (wid < 4);
    const int NT = ntl + ntc;
#define TROW(t) ((t) < ntl ? lat0 + (t) * 64 : ctx0 + ((t) - ntl) * 64)
#define GLDS(src, dstoff) __builtin_amdgcn_global_load_lds((const unsigned*)(src), (LAS unsigned*)(lds + (dstoff)), 16, 0, 0)
#define DMA(t) do { const size_t kr_ = (size_t)TROW(t); const int b_ = (t) & 3; \
        if (von) GLDS(vsrc + (size_t)(kr_ >> 6) * vt_stride, L_V + b_ * (DV * 64) + (DV == 128 ? wid : wq) * 1024); \
        if (k1on) GLDS(k1src + kr_ * 512, L_K1 + b_ * 4096 + wq * 1024); \
        if (k2on) GLDS(k2src + kr_ * 32, L_K2 + b_ * 4096 + wq * 1024); } while (0)
#define WAITDMA(k) do { if (wid < 4) { if ((k) >= 2) asm volatile("s_waitcnt vmcnt(4)" ::: "memory"); else if ((k) == 1) asm volatile("s_waitcnt vmcnt(2)" ::: "memory"); else asm volatile("s_waitcnt vmcnt(0)" ::: "memory"); } \
        else { if ((k) >= 2) asm volatile("s_waitcnt vmcnt(2)" ::: "memory"); else if ((k) == 1) asm volatile("s_waitcnt vmcnt(1)" ::: "memory"); else asm volatile("s_waitcnt vmcnt(0)" ::: "memory"); } } while (0)
#define BAR() do { asm volatile("s_waitcnt lgkmcnt(0)" ::: "memory"); __builtin_amdgcn_s_barrier(); asm volatile("" ::: "memory"); } while (0)
    float m_reg = 0.f, nm = 0.f; f32x16 ol = f32x16{}; f32x16 negv = f32x16{};
#define negm ((f32x16){nm, nm, nm, nm, nm, nm, nm, nm, nm, nm, nm, nm, nm, nm, nm, nm})
    i32x8_ ones8 = (i32x8_){0x38383838, 0x38383838, 0x38383838, 0x38383838, 0x38383838, 0x38383838, 0x38383838, 0x38383838}; asm volatile("" : "+v"(ones8));
#pragma unroll
    for (int d = 0; d < ND; ++d) o[d] = f32x16{};
    const int va0 = r32 * 64 + (((2 * hi) ^ ((r32 >> 2) & 3)) << 4), va1 = r32 * 64 + (((2 * hi + 1) ^ ((r32 >> 2) & 3)) << 4);
    int f8scale = 0x7f7f7f7f; asm volatile("" : "+v"(f8scale));
    int sclK = 0x7c7c7c7c, sclQ = 0x7b7b7b7b; asm volatile("" : "+v"(sclK), "+v"(sclQ));
    const int ka0 = r32 * 64, ka1 = (32 + r32) * 64, ks0 = (r32 >> 2) & 3;
    const int k2a0 = r32 * 64, k2a1 = (32 + r32) * 64, k2s0 = (r32 >> 2) & 3, k2s1 = ((32 + r32) >> 2) & 3;
#define QKT(P0, P1, b) do { const LAS unsigned char* kb_ = lds + L_K1 + (b) * 4096; \
        const i32x4_ a00_ = *(const LAS i32x4_*)(kb_ + ka0 + (((2 * hi) ^ ks0) << 4)), a01_ = *(const LAS i32x4_*)(kb_ + ka0 + (((2 * hi + 1) ^ ks0) << 4)); \
        const i32x4_ a10_ = *(const LAS i32x4_*)(kb_ + ka1 + (((2 * hi) ^ ks0) << 4)), a11_ = *(const LAS i32x4_*)(kb_ + ka1 + (((2 * hi + 1) ^ ks0) << 4)); \
        if (DK2) { const LAS unsigned char* k2b_ = lds + L_K2 + (b) * 4096; \
            _Pragma("unroll") for (int d0 = 0; d0 < DK2 / 16; ++d0) { const int ch = 2 * d0 + hi; \
                const bf16x8 b0 = *(const LAS bf16x8*)(k2b_ + k2a0 + ((ch ^ k2s0) << 4)); const bf16x8 b1 = *(const LAS bf16x8*)(k2b_ + k2a1 + ((ch ^ k2s1) << 4)); \
                if (d0 == 0) { P0 = __builtin_amdgcn_mfma_f32_32x32x16_bf16(b0, qr2[d0], negv, 0, 0, 0); P1 = __builtin_amdgcn_mfma_f32_32x32x16_bf16(b1, qr2[d0], negv, 0, 0, 0); } \
                else { P0 = __builtin_amdgcn_mfma_f32_32x32x16_bf16(b0, qr2[d0], P0, 0, 0, 0); P1 = __builtin_amdgcn_mfma_f32_32x32x16_bf16(b1, qr2[d0], P1, 0, 0, 0); } } } \
        { const i32x8_ kf0_ = __builtin_shufflevector(a00_, a01_, 0, 1, 2, 3, 4, 5, 6, 7), kf1_ = __builtin_shufflevector(a10_, a11_, 0, 1, 2, 3, 4, 5, 6, 7); \
          if (DK2) { \
            asm volatile("s_nop 1\n\tv_mfma_scale_f32_32x32x64_f8f6f4 %0, %1, %2, %0, %3, %4 op_sel_hi:[0,0,0]" : "+v"(P0) : "v"(kf0_), "v"(q8), "v"(sclK), "v"(sclQ)); \
            asm volatile("s_nop 1\n\tv_mfma_scale_f32_32x32x64_f8f6f4 %0, %1, %2, %0, %3, %4 op_sel_hi:[0,0,0]" : "+v"(P1) : "v"(kf1_), "v"(q8), "v"(sclK), "v"(sclQ)); \
          } else {     \
            asm volatile("s_nop 1\n\tv_mfma_scale_f32_32x32x64_f8f6f4 %0, %1, %2, %3, %4, %5 op_sel_hi:[0,0,0]" : "=&v"(P0) : "v"(kf0_), "v"(q8), "v"(negv), "v"(sclK), "v"(sclQ)); \
            asm volatile("s_nop 1\n\tv_mfma_scale_f32_32x32x64_f8f6f4 %0, %1, %2, %3, %4, %5 op_sel_hi:[0,0,0]" : "=&v"(P1) : "v"(kf1_), "v"(q8), "v"(negv), "v"(sclK), "v"(sclQ)); } } } while (0)
#define STIE_LONG(P0, P1) asm volatile("s_nop 15\n\ts_nop 7" : "+v"(P0), "+v"(P1))
#define STIE_SHORT(P0, P1) asm volatile("s_nop 7" : "+v"(P0), "+v"(P1))
#define MX3(a, b, c) __builtin_fmaxf(__builtin_fmaxf((a), (b)), (c))
#define PARTSM(P0, P1, AL, FIRST) do { float pa_ = MX3(P0[0], P0[1], P0[2]), pb_ = MX3(P1[0], P1[1], P1[2]); \
        _Pragma("unroll") for (int r = 3; r < 15; r += 2) { pa_ = MX3(pa_, P0[r], P0[r + 1]); pb_ = MX3(pb_, P1[r], P1[r + 1]); } \
        float pmax = MX3(pa_, pb_, P0[15]); pmax = fmaxf(pmax, P1[15]); \
        { auto rr = __builtin_amdgcn_permlane32_swap(__float_as_uint(pmax), __float_as_uint(pmax), false, false); pmax = fmaxf(__uint_as_float(rr[0]), __uint_as_float(rr[1])); } \
        if (!(FIRST) && __builtin_expect(__all(pmax <= THR), 1)) { AL = 1.f; } else { const float dl = (FIRST) ? pmax : fmaxf(pmax, 0.f); AL = (FIRST) ? 1.f : __builtin_amdgcn_exp2f(-dl); m_reg += dl; \
            _Pragma("unroll") for (int r = 0; r < 16; ++r) { P0[r] -= dl; P1[r] -= dl; } nm = -m_reg; _Pragma("unroll") for (int r = 0; r < 16; ++r) negv[r] = nm; } \
        _Pragma("unroll") for (int r = 0; r < 16; ++r) P0[r] = __builtin_amdgcn_exp2f(P0[r]); } while (0)
#define FINSM(P0, P1, AL) do { _Pragma("unroll") for (int r = 0; r < 16; ++r) P1[r] = __builtin_amdgcn_exp2f(P1[r]); \
        p8 = (i32x8_){(int)pk4_fp8_nc(P0[0], P0[1], P0[2], P0[3]), (int)pk4_fp8_nc(P0[4], P0[5], P0[6], P0[7]), (int)pk4_fp8_nc(P0[8], P0[9], P0[10], P0[11]), (int)pk4_fp8_nc(P0[12], P0[13], P0[14], P0[15]), \
                       (int)pk4_fp8_nc(P1[0], P1[1], P1[2], P1[3]), (int)pk4_fp8_nc(P1[4], P1[5], P1[6], P1[7]), (int)pk4_fp8_nc(P1[8], P1[9], P1[10], P1[11]), (int)pk4_fp8_nc(P1[12], P1[13], P1[14], P1[15])}; } while (0)
#define PV1(d, vb_) do { const i32x4_ x0_ = *(const LAS i32x4_*)(vb_ + (d) * 2048 + va0), x1_ = *(const LAS i32x4_*)(vb_ + (d) * 2048 + va1); \
        const i32x8_ bf_ = __builtin_shufflevector(x0_, x1_, 0, 1, 2, 3, 4, 5, 6, 7); \
        asm volatile("v_mfma_scale_f32_32x32x64_f8f6f4 %0, %1, %2, %0, %3, %3 op_sel_hi:[0,0,0]" : "+v"(o[d]) : "v"(p8), "v"(bf_), "v"(f8scale)); } while (0)
#define PV(b) do { const LAS unsigned char* vb_ = lds + L_V + (b) * (DV * 64); asm volatile("s_nop 4" : "+v"(p8)); PV1(0, vb_); PV1(1, vb_); if constexpr (DV == 128) { PV1(2, vb_); PV1(3, vb_); } PVL(); } while (0)
#define PVL() asm volatile("v_mfma_scale_f32_32x32x64_f8f6f4 %0, %1, %2, %0, %3, %3 op_sel_hi:[0,0,0]" : "+v"(ol) : "v"(p8), "v"(ones8), "v"(f8scale))
#define PVT(b, T0, T1) do { const LAS unsigned char* vb_ = lds + L_V + (b) * (DV * 64); asm volatile("s_nop 4" : "+v"(p8)); PV1(0, vb_); STIE_SHORT(T0, T1); PV1(1, vb_); if constexpr (DV == 128) { PV1(2, vb_); PV1(3, vb_); } PVL(); } while (0)
#define OTIE() do { if constexpr (DV == 128) asm volatile("s_nop 15\n\ts_nop 15\n\ts_nop 15\n\ts_nop 15\n\ts_nop 15" : "+v"(o[0]), "+v"(o[1]), "+v"(o[2]), "+v"(o[3]), "+v"(ol)); else asm volatile("s_nop 15\n\ts_nop 15\n\ts_nop 15\n\ts_nop 15\n\ts_nop 15" : "+v"(o[0]), "+v"(o[1]), "+v"(ol)); } while (0)
#define RESC(AL) do { if (__any((AL) < 1.f)) { OTIE(); if (hi == 0) wsf[r32] = (AL); \
        _Pragma("unroll") for (int r = 0; r < 16; ++r) { const float a_ = wsf[crow(r, hi)]; ol[r] *= a_; _Pragma("unroll") for (int d = 0; d < ND; ++d) o[d][r] *= a_; } } } while (0)
#define SB() __builtin_amdgcn_sched_barrier(0)
    f32x16 pA0, pA1, pB0, pB1; float alA, alB; i32x8_ p8;
    __syncthreads();
    DMA(0); DMA(1); DMA(2); if (3 < NT) DMA(3);
    { const bf16* qp = Qrow0 + (size_t)(wid * 32 + r32) * ldq; unsigned w_[8];
#pragma unroll
      for (int i = 0; i < 4; ++i) { const u32x4 x = *(const u32x4*)(qp + hi * 32 + i * 8);
          w_[2 * i] = pk4_fp8_nc(bf_lo(x.x) * 16.0f, bf_hi(x.x) * 16.0f, bf_lo(x.y) * 16.0f, bf_hi(x.y) * 16.0f); w_[2 * i + 1] = pk4_fp8_nc(bf_lo(x.z) * 16.0f, bf_hi(x.z) * 16.0f, bf_lo(x.w) * 16.0f, bf_hi(x.w) * 16.0f); }
      q8 = (i32x8_){(int)w_[0], (int)w_[1], (int)w_[2], (int)w_[3], (int)w_[4], (int)w_[5], (int)w_[6], (int)w_[7]};
#pragma unroll
      for (int d0 = 0; d0 < NQ2; ++d0) qr2[d0] = *(const bf16x8*)(qp + 64 + d0 * 16 + hi * 8); }
    WAITDMA(3 < NT ? 3 : 2); BAR();
    QKT(pA0, pA1, 0); STIE_LONG(pA0, pA1); PARTSM(pA0, pA1, alA, true);
    WAITDMA(3 < NT ? 2 : 1); BAR();
    for (int j = 1; j + 1 < NT; j += 2) {
        SB(); QKT(pB0, pB1, j & 3);
        FINSM(pA0, pA1, alA); SB();
        PVT((j - 1) & 3, pB0, pB1); PARTSM(pB0, pB1, alB, false);
        BAR();
        if (j + 3 < NT) DMA(j + 3);
        RESC(alB);
        WAITDMA(j + 3 < NT ? 2 : (j + 2 < NT ? 1 : 0)); BAR();
        SB(); QKT(pA0, pA1, (j + 1) & 3);
        FINSM(pB0, pB1, alB); SB();
        PVT(j & 3, pA0, pA1); PARTSM(pA0, pA1, alA, false);
        BAR();
        if (j + 4 < NT) DMA(j + 4);
        RESC(alA);
        WAITDMA(j + 4 < NT ? 2 : (j + 3 < NT ? 1 : 0)); BAR();
    }
    SB(); QKT(pB0, pB1, (NT - 1) & 3);
    FINSM(pA0, pA1, alA); SB();
    PVT((NT - 2) & 3, pB0, pB1); PARTSM(pB0, pB1, alB, false);
    RESC(alB);
    FINSM(pB0, pB1, alB); SB();
    PV((NT - 1) & 3);
    OTIE();
    __syncthreads();
    l_out = ol;
#undef TROW
#undef GLDS
#undef DMA
#undef WAITDMA
#undef BAR
#undef QKT
#undef PARTSM
#undef MX3
#undef FINSM
#undef PV
#undef PV1
#undef PVT
#undef PVL
#undef negm
#undef STIE_LONG
#undef STIE_SHORT
#undef OTIE
#undef RESC
#undef SB
}
}

__device__ __forceinline__ int vt_slot(int k) { const int half = k >> 5, kk = k & 31, hi = (kk >> 2) & 1, r = (kk & 3) + 4 * (kk >> 3); return 32 * hi + r + 16 * half; }
template <int DVX, int NH> __device__ __forceinline__ void vt_item(Frame& F, const bf16* Vsrc, unsigned char* VTdst, int item, LAS unsigned char* scr) {
    const int tt = item / NH, h = item - tt * NH, key = F.lane, slot = vt_slot(key);
    const bf16* vrow = Vsrc + (size_t)(tt * 64 + key) * 512 + h * DVX;
#pragma unroll 4
    for (int d = 0; d < DVX; d += 8) { const u32x4 w = *(const u32x4*)(vrow + d);
        const unsigned lo = pk4_fp8(bf_lo(w.x), bf_hi(w.x), bf_lo(w.y), bf_hi(w.y)), hi2 = pk4_fp8(bf_lo(w.z), bf_hi(w.z), bf_lo(w.w), bf_hi(w.w));
#pragma unroll
        for (int i = 0; i < 4; ++i) { scr[(d + i) * 64 + slot] = (unsigned char)(lo >> (8 * i)); scr[(d + 4 + i) * 64 + slot] = (unsigned char)(hi2 >> (8 * i)); } }
    LDS_WAIT(); asm volatile("" ::: "memory");
    unsigned char* dst = VTdst + (size_t)item * (DVX * 64);
#pragma unroll
    for (int i = 0; i < DVX / 16; ++i) *(u32x4*)(dst + (i * 64 + F.lane) * 16) = *(const LAS u32x4*)(scr + (i * 64 + F.lane) * 16);
    LDS_WAIT(); asm volatile("" ::: "memory");
}
__device__ __forceinline__ void p_vt(Frame& F) {
    LAS unsigned char* scr = F.lds + RING_OFF + F.wave * 8192;
    const int gw = F.vcu * NWAVES + F.wave, NGW = F.G * NWAVES;
    for (int it = gw; it < (MTOT / 64) * 4; it += NGW) vt_item<128, 4>(F, (const bf16*)(F.ws + WS_VA), F.ws + WS_VTA, it, scr);
    for (int it = gw; it < (MTOT / 64) * 8; it += NGW) vt_item<64, 8>(F, (const bf16*)(F.ws + WS_VC), F.ws + WS_VTC, it, scr);
}
__device__ __forceinline__ void p_attention(Frame& F, int l) {
    using namespace att;
    LAS unsigned char* lds = F.lds + RING_OFF;
    const int wid = F.wave;
    const bf16 *QA = (const bf16*)(F.ws + WS_QA), *KA = (const bf16*)(F.ws + WS_KA), *VA = (const bf16*)(F.ws + WS_VA), *QB = (const bf16*)(F.ws + WS_QB), *KB = (const bf16*)(F.ws + WS_KB), *VB = (const bf16*)(F.ws + WS_VB);
    const bf16 *QC = (const bf16*)(F.ws + WS_QC), *KCN = (const bf16*)(F.ws + WS_KCN), *VC = (const bf16*)(F.ws + WS_VC), *CKR = (const bf16*)(F.ws + WS_CKR);
    unsigned char *YA = F.ws + WS_YA, *YB = YA + (size_t)MTOT * 512, *YC = YB + (size_t)MTOT * 512; float* O0 = (float*)(F.ws + WS_O0);
    const float* lamp = (const float*)(F.ws + WS_TAB) + 192 * 16 * 2 + 192 * 8 * 2; const float lam = lamp[2 * l], lam_init = lamp[2 * l + 1];
    const float* gsub = in_l(F, I_GSUB, l, 128);
    const int nctxA = (l == 0) ? 16 : 0, nctxBC = (l == 0) ? 32 : 0;
    const NaParams na0{nullptr, 0};
    int cslot = 0;
    for (int u = F.vcu; u < 512 + nctxA; u += F.G) {
        int b, h, qrow0, ntl;
        if (u < 512) { b = u >> 7; h = (u >> 5) & 3; qrow0 = b * SEQ + (u & 31) * 256; ntl = 128; } else { const int v = u - 512; b = v >> 2; h = v & 3; qrow0 = NLAT + b * CTXL; ntl = 0; }
        const int lat0 = b * SEQ, ctx0 = NLAT + b * CTXL;
        for (int c = 0; c < 2; ++c) {
            f32x16 o[4]; f32x16 lv;
            attn_pass_f8<0, 128>(lds, QA + (size_t)qrow0 * 512 + h * 128 + c * 64, 512, (const unsigned char*)KA + h * 128 + c * 64, nullptr, F.ws + WS_VTA + h * 8192, 4 * 8192, lat0, ntl, ctx0, 4, o, lv);
            float rli[16];
#pragma unroll
            for (int r = 0; r < 16; ++r) rli[r] = 1.0f / lv[r];
            int lane_ = F.lane; asm volatile("" : "+v"(lane_)); const int r32 = lane_ & 31, hi = lane_ >> 5;
            float* o0w = O0 + (size_t)(qrow0 + wid * 32) * 512 + h * 128 + r32;
            if (c == 0) {
#pragma unroll
                for (int r = 0; r < 16; ++r)
#pragma unroll
                    for (int d = 0; d < 4; ++d) o0w[(size_t)crow(r, hi) * 512 + d * 32] = o[d][r] * rli[r];
            } else {
                float ss[16];
#pragma unroll
                for (int r = 0; r < 16; ++r) { float s = 0.f;
#pragma unroll
                    for (int d = 0; d < 4; ++d) { const float y = o0w[(size_t)crow(r, hi) * 512 + d * 32] - lam * (o[d][r] * rli[r]); o[d][r] = y; s += y * y; }
                    ss[r] = s; }
#pragma unroll
                for (int r = 0; r < 16; ++r) {
#pragma unroll
                    for (int x = 1; x < 32; x <<= 1) ss[r] += __shfl_xor(ss[r], x);
                    ss[r] = __builtin_amdgcn_rsqf(ss[r] * (1.0f / 128.0f) + EPS) * (1.0f - lam_init); }
                unsigned char* yw = YA + (size_t)(qrow0 + wid * 32) * 512 + h * 128 + r32;
#pragma unroll
                for (int d = 0; d < 4; ++d) { const float g = gsub[d * 32 + r32] * YS_A;
#pragma unroll
                    for (int r = 0; r < 16; ++r) yw[(size_t)crow(r, hi) * 512 + d * 32] = f8_one(o[d][r] * ss[r] * g); }
            }
        }
    }
    for (int u = F.vcu; u < 1024 + nctxBC; u += F.G) {
        int b, h, qrow0, ntl;
        if (u < 1024) { b = u >> 8; h = (u >> 5) & 7; qrow0 = b * SEQ + (u & 31) * 256; ntl = 128; } else { const int v = u - 1024; b = v >> 3; h = v & 7; qrow0 = NLAT + b * CTXL; ntl = 0; }
        f32x16 o[2]; f32x16 lv;
        attn_pass_f8<32, 64>(lds, QC + (size_t)qrow0 * 768 + h * 96, 768, (const unsigned char*)KCN + h * 64, CKR, F.ws + WS_VTC + h * 4096, 8 * 4096, b * SEQ, ntl, NLAT + b * CTXL, 4, o, lv);
        store_bf16v<64>(o, lv, YC + (size_t)qrow0 * 512 + h * 64, 512);
        if (cslot == (F.vcu & 3)) {
            LAS float* cscr = (LAS float*)(F.lds + RING_OFF + F.wave * 8704); const int NGWc = F.G * NWAVES; const int njobs = (l == 0) ? PAIRS_LAYER : (l == 1 ? PAIRS_LAYER - NE_PAIRS : 0);
            __syncthreads();
            for (int cj = F.vcu * NWAVES + F.wave; cj < njobs; cj += NGWc) {
                const int pr_ = (l == 0) ? (cj < PAIRS_LAYER - NE_PAIRS ? NE_PAIRS + cj : PAIRS_LAYER + (cj - (PAIRS_LAYER - NE_PAIRS))) : (PAIRS_LAYER + NE_PAIRS + cj);
                convert_item(F, 2 * pr_, cscr); convert_item(F, 2 * pr_ + 1, cscr); }
            __syncthreads();
        }
        ++cslot;
    }
    for (int u = F.vcu; u < 1024; u += F.G) {
        const int b = u >> 8, h = (u >> 5) & 7, qb = u & 31, r0 = qb * 4, qrow0 = b * SEQ + qb * 256;
        const int kr_lo = min(max(r0 - 4, 0), 120), kr_hi = min(max(r0 + 3 - 4, 0), 120) + 7;
        const NaParams na{in_l(F, I_RPB, l, 8 * 15 * 31) + h * 15 * 31, r0};
        f32x16 o[2]; float lsum;
        attn_pass<0, 64, 1>(lds, QB + (size_t)qrow0 * 512 + h * 64, 512, KB + h * 64, nullptr, VB + h * 64, b * SEQ + kr_lo * 64, kr_hi - kr_lo + 1, NLAT + b * CTXL, 4, na, kr_lo, o, lsum);
        store_bf16<64>(lds, o, lsum, YB + (size_t)qrow0 * 512 + h * 64, 512);
    }
    for (int u = F.vcu; u < nctxBC; u += F.G) {
        const int b = u >> 3, h = u & 7, qrow0 = NLAT + b * CTXL;
        f32x16 o[2]; float lsum;
        attn_pass<0, 64, 0>(lds, QB + (size_t)qrow0 * 512 + h * 64, 512, KB + h * 64, nullptr, VB + h * 64, 0, 0, qrow0, 4, na0, 0, o, lsum);
        store_bf16<64>(lds, o, lsum, YB + (size_t)qrow0 * 512 + h * 64, 512);
    }
}

constexpr int TB_RECW = 6656, TB_CNT = 128;
constexpr int TB_LCNT = 0, TB_GBASE = 128, TB_BASE = 256, TB_TILE = 4096, TB_REC = 1280;
__device__ __forceinline__ float route_reduce(float (&acc)[32], int lane) {
#pragma unroll
    for (int i = 0; i < 16; ++i) { const bool up = (lane & 32) != 0; const float keep = up ? acc[i + 16] : acc[i], send = up ? acc[i] : acc[i + 16]; acc[i] = keep + __shfl_xor(send, 32); }
#pragma unroll
    for (int i = 0; i < 8; ++i) { const bool up = (lane & 16) != 0; const float keep = up ? acc[i + 8] : acc[i], send = up ? acc[i] : acc[i + 8]; acc[i] = keep + __shfl_xor(send, 16); }
#pragma unroll
    for (int i = 0; i < 4; ++i) { const bool up = (lane & 8) != 0; const float keep = up ? acc[i + 4] : acc[i], send = up ? acc[i] : acc[i + 4]; acc[i] = keep + __shfl_xor(send, 8); }
#pragma unroll
    for (int i = 0; i < 2; ++i) { const bool up = (lane & 4) != 0; const float keep = up ? acc[i + 2] : acc[i], send = up ? acc[i] : acc[i + 2]; acc[i] = keep + __shfl_xor(send, 4); }
    { const bool up = (lane & 2) != 0; const float keep = up ? acc[1] : acc[0], send = up ? acc[0] : acc[1]; acc[0] = keep + __shfl_xor(send, 2); }
    return acc[0] + __shfl_xor(acc[0], 1);
}
__device__ __forceinline__ void route_topk(float logit, int lane, LAS int* lcnt, LAS int* rec_row, float* w_row) {
    float tv[4]; int te[4];
#pragma unroll
    for (int k = 0; k < 4; ++k) { float mx = logit;
#pragma unroll
        for (int o = 1; o < 64; o <<= 1) mx = fmaxf(mx, __shfl_xor(mx, o));
        const unsigned long long bal = __ballot(logit == mx); const int fl = __builtin_ctzll(bal); te[k] = fl >> 1; tv[k] = mx; if ((lane >> 1) == te[k]) logit = -INFINITY; }
    const float e1 = __expf(tv[1] - tv[0]), e2 = __expf(tv[2] - tv[0]), e3 = __expf(tv[3] - tv[0]); const float inv = 1.0f / (1.0f + e1 + e2 + e3);
    if (lane < 4) { const int ee = lane == 0 ? te[0] : lane == 1 ? te[1] : lane == 2 ? te[2] : te[3]; const float ww = (lane == 0 ? 1.0f : lane == 1 ? e1 : lane == 2 ? e2 : e3) * inv;
        const int pos = __hip_atomic_fetch_add(lcnt + ee, 1, __ATOMIC_RELAXED, __HIP_MEMORY_SCOPE_WORKGROUP); rec_row[lane] = ee | (pos << 8); w_row[lane] = ww; }
}
__device__ __forceinline__ void p_route(Frame& F, int l, int M, int bank) {
    constexpr int ASTR = 2064;
    LAS unsigned char* Ahi = F.lds + RING_OFF; LAS unsigned char* Alo = Ahi + 16 * ASTR; LAS float* part = (LAS float*)(Ahi + 32 * ASTR); LAS float* lgt = part + 8 * 16 * 32;
    LAS int* lcnt = (LAS int*)(F.lds + TBL_OFF + TB_LCNT); LAS int* gbase = (LAS int*)(F.lds + TBL_OFF + TB_GBASE); LAS int* rec = (LAS int*)(F.lds + TBL_OFF + TB_REC); LAS float* recw = (LAS float*)(F.lds + TBL_OFF + TB_RECW);
    if (F.tid < 32) lcnt[F.tid] = 0;
    int lane_ = F.lane; asm volatile("" : "+v"(lane_)); const int fr = lane_ & 15, kq = lane_ >> 4;
    pg8::bf16x8 Wh[4][2], Wl[4][2];
    { const float* Wr = in_l(F, I_WROUT, l, 1024 * 32) + (size_t)(128 * F.wave + 8 * kq) * 32 + fr;
#pragma unroll
      for (int t = 0; t < 4; ++t)
#pragma unroll
          for (int nb = 0; nb < 2; ++nb)
#pragma unroll
              for (int i = 0; i < 8; ++i) { const float w = Wr[(size_t)(32 * t + i) * 32 + 16 * nb]; const unsigned h = f2bf(w); const unsigned lo = f2bf(w - __uint_as_float(h << 16)); Wh[t][nb][i] = (short)h; Wl[t][nb][i] = (short)lo; } }
    __syncthreads();
    const int rpb = (M + F.G - 1) / F.G, m0 = F.vcu * rpb, m1 = min(M, m0 + rpb);
    const float* modv = (const float*)(F.ws + WS_MODV) + (size_t)l * 5 * 6144; const unsigned short* X = (const unsigned short*)(F.ws + WS_X); unsigned char* H = F.ws + WS_H;
    const f32x4* g = (const f32x4*)in_l(F, I_GFFN, l, DM); const float* brp = in_l(F, I_BROUT, l, 32); f32x4 gv[4];
#pragma unroll
    for (int j = 0; j < 4; ++j) gv[j] = g[F.lane + 64 * j];
    int* rt_e = (int*)(F.ws + WS_ROUTE + RT_E); int* rt_slot = (int*)(F.ws + WS_ROUTE + RT_SLOT); float* rt_w = (float*)(F.ws + WS_ROUTE + RT_W);
    const int ntrips = (m1 - m0 + 15) >> 4; const float bre = brp[F.tid & 31];
    f32x4 nA[4], nB[4];
    if (m1 > m0) { const int mA = min(m0 + 2 * F.wave, m1 - 1), mB = min(mA + 1, m1 - 1);
#pragma unroll
      for (int j = 0; j < 4; ++j) { const float4 a_ = xb_ld4_(X + (size_t)mA * DM + 4 * (F.lane + 64 * j)), b_ = xb_ld4_(X + (size_t)mB * DM + 4 * (F.lane + 64 * j)); nA[j] = (f32x4){a_.x, a_.y, a_.z, a_.w}; nB[j] = (f32x4){b_.x, b_.y, b_.z, b_.w}; } }
    for (int trip = 0; trip < ntrips; ++trip) {
        const int mp = m0 + 16 * trip + 2 * F.wave; const bool one = mp < m1, two = mp + 1 < m1; const int mA = min(mp, m1 - 1), mB = min(mp + 1, m1 - 1);
        f32x4 vA[4], vB[4]; float sA = 0.f, sB = 0.f;
#pragma unroll
        for (int j = 0; j < 4; ++j) { vA[j] = nA[j]; vB[j] = nB[j]; sA += (vA[j].x * vA[j].x + vA[j].y * vA[j].y) + (vA[j].z * vA[j].z + vA[j].w * vA[j].w); sB += (vB[j].x * vB[j].x + vB[j].y * vB[j].y) + (vB[j].z * vB[j].z + vB[j].w * vB[j].w); }
        { const int pA = min(mp + 16, m1 - 1), pB = min(pA + 1, m1 - 1);
#pragma unroll
          for (int j = 0; j < 4; ++j) { const float4 a_ = xb_ld4_(X + (size_t)pA * DM + 4 * (F.lane + 64 * j)), b_ = xb_ld4_(X + (size_t)pB * DM + 4 * (F.lane + 64 * j)); nA[j] = (f32x4){a_.x, a_.y, a_.z, a_.w}; nB[j] = (f32x4){b_.x, b_.y, b_.z, b_.w}; } }
        const float rA = 1.0f / sqrtf(wave_sum(sA) * (1.0f / DM) + EPS), rB = 1.0f / sqrtf(wave_sum(sB) * (1.0f / DM) + EPS);
        const int bA = mA < NLAT ? mA / SEQ : 4, bB = mB < NLAT ? mB / SEQ : 4;
        typedef unsigned u32x2r_ __attribute__((ext_vector_type(2)));
        f32x4 scA[4], shA[4], scB[4], shB[4];
#pragma unroll
        for (int j = 0; j < 4; ++j) { scA[j] = ((const f32x4*)(modv + bA * 6144 + 4 * 1024))[F.lane + 64 * j]; shA[j] = ((const f32x4*)(modv + bA * 6144 + 3 * 1024))[F.lane + 64 * j]; scB[j] = scA[j]; shB[j] = shA[j]; }
        if (bB != bA) {
#pragma unroll
            for (int j = 0; j < 4; ++j) { scB[j] = ((const f32x4*)(modv + bB * 6144 + 4 * 1024))[F.lane + 64 * j]; shB[j] = ((const f32x4*)(modv + bB * 6144 + 3 * 1024))[F.lane + 64 * j]; } }
#pragma unroll
        for (int j = 0; j < 4; ++j) { const f32x4 gg = gv[j];
            vA[j] = vA[j] * rA * gg * (scA[j] + 1.0f) + shA[j];
            vB[j] = vB[j] * rB * gg * (scB[j] + 1.0f) + shB[j];
            if (one) put_h4<F8_MOE != 0>(H + (size_t)mA * HROW_MOE, F.lane, j, vA[j]); if (two) put_h4<F8_MOE != 0>(H + (size_t)mB * HROW_MOE, F.lane, j, vB[j]);
            { unsigned h0 = f2bf(vA[j].x), h1 = f2bf(vA[j].y), h2 = f2bf(vA[j].z), h3 = f2bf(vA[j].w);
              const unsigned l0 = f2bf(vA[j].x - __uint_as_float(h0 << 16)), l1 = f2bf(vA[j].y - __uint_as_float(h1 << 16)), l2 = f2bf(vA[j].z - __uint_as_float(h2 << 16)), l3 = f2bf(vA[j].w - __uint_as_float(h3 << 16));
              const int off = (2 * F.wave) * ASTR + (256 * j + 4 * F.lane) * 2;
              *(LAS u32x2r_*)(Ahi + off) = (u32x2r_){h0 | (h1 << 16), h2 | (h3 << 16)}; *(LAS u32x2r_*)(Alo + off) = (u32x2r_){l0 | (l1 << 16), l2 | (l3 << 16)}; }
            { unsigned h0 = f2bf(vB[j].x), h1 = f2bf(vB[j].y), h2 = f2bf(vB[j].z), h3 = f2bf(vB[j].w);
              const unsigned l0 = f2bf(vB[j].x - __uint_as_float(h0 << 16)), l1 = f2bf(vB[j].y - __uint_as_float(h1 << 16)), l2 = f2bf(vB[j].z - __uint_as_float(h2 << 16)), l3 = f2bf(vB[j].w - __uint_as_float(h3 << 16));
              const int off = (2 * F.wave + 1) * ASTR + (256 * j + 4 * F.lane) * 2;
              *(LAS u32x2r_*)(Ahi + off) = (u32x2r_){h0 | (h1 << 16), h2 | (h3 << 16)}; *(LAS u32x2r_*)(Alo + off) = (u32x2r_){l0 | (l1 << 16), l2 | (l3 << 16)}; } }
        __syncthreads();
        f32x4 acc[2] = {(f32x4){0.f, 0.f, 0.f, 0.f}, (f32x4){0.f, 0.f, 0.f, 0.f}};
#pragma unroll
        for (int t = 0; t < 4; ++t) { const int ao = fr * ASTR + (128 * F.wave + 32 * t + 8 * kq) * 2;
            const pg8::bf16x8 ah = *(const LAS pg8::bf16x8*)(Ahi + ao), al = *(const LAS pg8::bf16x8*)(Alo + ao);
#pragma unroll
            for (int nb = 0; nb < 2; ++nb) { acc[nb] = __builtin_amdgcn_mfma_f32_16x16x32_bf16(ah, Wh[t][nb], acc[nb], 0, 0, 0);
                acc[nb] = __builtin_amdgcn_mfma_f32_16x16x32_bf16(ah, Wl[t][nb], acc[nb], 0, 0, 0); acc[nb] = __builtin_amdgcn_mfma_f32_16x16x32_bf16(al, Wh[t][nb], acc[nb], 0, 0, 0); } }
#pragma unroll
        for (int nb = 0; nb < 2; ++nb)
#pragma unroll
            for (int i = 0; i < 4; ++i) part[(F.wave * 16 + 4 * kq + i) * 32 + 16 * nb + fr] = acc[nb][i];
        __syncthreads();
        { const int row = F.tid >> 5, e = F.tid & 31; float s = 0.f;
#pragma unroll
          for (int w8 = 0; w8 < 8; ++w8) s += part[(w8 * 16 + row) * 32 + e];
          float lg = s + bre;
          const int hl = F.lane & 31, hf = F.lane >> 5; float tv[4]; int te[4];
#pragma unroll
          for (int k = 0; k < 4; ++k) { float mx = lg;
#pragma unroll
              for (int o = 1; o < 32; o <<= 1) mx = fmaxf(mx, __shfl_xor(mx, o));
              const unsigned long long bal = __ballot(lg == mx); const unsigned hb = hf ? (unsigned)(bal >> 32) : (unsigned)bal; te[k] = __builtin_ctz(hb); tv[k] = mx; if (hl == te[k]) lg = -INFINITY; }
          const float e1 = __expf(tv[1] - tv[0]), e2 = __expf(tv[2] - tv[0]), e3 = __expf(tv[3] - tv[0]); const float inv = 1.0f / (1.0f + e1 + e2 + e3);
          const bool okr = hf ? two : one; const int mrow = hf ? mB : mA;
          if (okr && hl < 4) { const int ee = hl == 0 ? te[0] : hl == 1 ? te[1] : hl == 2 ? te[2] : te[3]; const float ww = (hl == 0 ? 1.0f : hl == 1 ? e1 : hl == 2 ? e2 : e3) * inv;
              const int pos = __hip_atomic_fetch_add(lcnt + ee, 1, __ATOMIC_RELAXED, __HIP_MEMORY_SCOPE_WORKGROUP); rec[(mrow - m0) * 4 + hl] = ee | (pos << 8); recw[(mrow - m0) * 4 + hl] = ww; }
        }
    }
    __syncthreads();
    if (F.tid < 32) gbase[F.tid] = (int)atomicAdd(F.ctl + CW_CNT + bank * 64 + F.tid, (unsigned)lcnt[F.tid]);
    __syncthreads();
    { int* xs = (int*)(F.ws + WS_XS); float* xw = (float*)(F.ws + WS_XW);
      for (int i = F.tid; i < (m1 - m0) * 4; i += NTHR) { const int r = rec[i], e = r & 255, pos = r >> 8; const size_t xi = (size_t)e * MTOT + gbase[e] + pos; xs[xi] = m0 * 4 + i; xw[xi] = recw[i]; } }
    __syncthreads();
}
__device__ __forceinline__ int build_expert_tables(Frame& F, int l) {
    LAS int* base = (LAS int*)(F.lds + TBL_OFF + TB_BASE); LAS int* tile_e = (LAS int*)(F.lds + TBL_OFF + TB_TILE);
    LAS int* padc = (LAS int*)(F.lds + TBL_OFF + TB_LCNT);
    __syncthreads();
    if (F.tid < 64) {
        const int c = F.tid < 32 ? (int)__hip_atomic_load(F.ctl + CW_CNT + l * 64 + (F.tid & 31), __ATOMIC_RELAXED, __HIP_MEMORY_SCOPE_AGENT) : 0;
        const int pc = F.tid < 32 ? (((c + 255) >> 8) << 8) : 0; int inc = pc;
#pragma unroll
        for (int o = 1; o < 32; o <<= 1) { const int v = __shfl_up(inc, o); if ((F.tid & 63) >= o) inc += v; }
        if (F.tid < 32) { padc[F.tid] = pc; base[F.tid] = inc - pc; if (F.tid == 31) base[32] = inc; ((LAS int*)(F.lds + TBL_OFF + TB_CNT))[F.tid] = c; }
    }
    __syncthreads();
    { typedef int i32x4t_ __attribute__((ext_vector_type(4))); i32x4t_ bq[8];
#pragma unroll
      for (int q = 0; q < 8; ++q) bq[q] = ((const LAS i32x4t_*)base)[q];
      for (int t = F.tid; t < 640; t += NTHR) { const int r0 = t * 256; int e = -1;
#pragma unroll
          for (int q = 0; q < 8; ++q) e += (bq[q].x <= r0 ? 1 : 0) + (bq[q].y <= r0 ? 1 : 0) + (bq[q].z <= r0 ? 1 : 0) + (bq[q].w <= r0 ? 1 : 0);
          tile_e[t] = e; } }
    __syncthreads();
    return base[32] >> 8;
}
__device__ __forceinline__ void p_gather(Frame& F, int l, int M) {
    (void)build_expert_tables(F, l);
    LAS int* base = (LAS int*)(F.lds + TBL_OFF + TB_BASE);
    const int* rt_e = (const int*)(F.ws + WS_ROUTE + RT_E); const int* rt_slot = (const int*)(F.ws + WS_ROUTE + RT_SLOT); const float* rt_w = (const float*)(F.ws + WS_ROUTE + RT_W);
    int* ydst = (int*)(F.ws + WS_ROUTE + RT_YDST); float* wrow = (float*)(F.ws + WS_ROUTE + RT_WROW); int* ysrc = (int*)(F.ws + WS_ROUTE + RT_YSRC);
    for (int i = blockIdx.x * NTHR + F.tid; i < M * 4; i += F.G * NTHR) { const int e = rt_e[i]; const int dst = base[e] + rt_slot[i]; ydst[dst] = i; wrow[dst] = rt_w[i]; ysrc[dst] = i >> 2; }
    for (int i = blockIdx.x * NTHR + F.tid; i < 32 * 256; i += F.G * NTHR) { const int e = i >> 8, j = i & 255; const int c = (int)__hip_atomic_load(F.ctl + CW_CNT + l * 64 + e, __ATOMIC_RELAXED, __HIP_MEMORY_SCOPE_AGENT);
        const int r = base[e] + c + j; if (r < base[e + 1]) { ydst[r] = -1; wrow[r] = 0.f; ysrc[r] = 0; } }
}
__device__ __forceinline__ void p_combine(Frame& F, int l, int M) {
    const int gw = F.vcu * NWAVES + F.wave, NGW = F.G * NWAVES; const bool last = (l == DEPTH - 1);
    const float* modv = (const float*)(F.ws + WS_MODV) + (size_t)l * 5 * 6144; const float* modn = modv + 5 * 6144; unsigned short* X = (unsigned short*)(F.ws + WS_X); unsigned char* H = F.ws + WS_H; const bf16* YB = (const bf16*)(F.ws + WS_YBUF);
    const f32x4* gnp = (const f32x4*)(last ? F.in[I_GFIN] : in_l(F, I_GMIX, l + 1, DM)); f32x4 gn[4];
#pragma unroll
    for (int j = 0; j < 4; ++j) gn[j] = gnp[F.lane + 64 * j];
    unsigned long long ny[4][4]; f32x4 nxr[4];
#define CLOAD(mm) do { _Pragma("unroll") for (int j = 0; j < 4; ++j) { _Pragma("unroll") for (int k = 0; k < 4; ++k) ny[j][k] = ((const unsigned long long*)(YB + (size_t)((mm) * 4 + k) * DM))[F.lane + 64 * j]; \
        { const float4 x_ = xb_ld4_(X + (size_t)(mm) * DM + 4 * (F.lane + 64 * j)); nxr[j] = (f32x4){x_.x, x_.y, x_.z, x_.w}; } } } while (0)
    if (gw < M) CLOAD(gw);
    for (int m = gw; m < M; m += NGW) {
        const int b = m < NLAT ? m / SEQ : 4; const f32x4* gt2 = (const f32x4*)(modv + b * 6144 + 5 * 1024);
        unsigned short* xr = X + (size_t)m * DM + 4 * F.lane; f32x4 v[4]; float s = 0.f;
        unsigned long long cy[4][4]; f32x4 cx[4];
#pragma unroll
        for (int j = 0; j < 4; ++j) { cx[j] = nxr[j];
#pragma unroll
            for (int k = 0; k < 4; ++k) cy[j][k] = ny[j][k]; }
        { const int mn = min(m + NGW, M - 1); CLOAD(mn); }
#pragma unroll
        for (int j = 0; j < 4; ++j) { f32x4 y = (f32x4){0.f, 0.f, 0.f, 0.f};
#pragma unroll
            for (int k = 0; k < 4; ++k) { const unsigned long long w = cy[j][k]; const unsigned lo = (unsigned)w, hi = (unsigned)(w >> 32);
                y += (f32x4){bf_lo(lo), bf_hi(lo), bf_lo(hi), bf_hi(hi)}; }
            v[j] = cx[j] + gt2[F.lane + 64 * j] * y; s += (v[j].x * v[j].x + v[j].y * v[j].y) + (v[j].z * v[j].z + v[j].w * v[j].w); }
        const float rstd = 1.0f / sqrtf(wave_sum(s) * (1.0f / DM) + EPS);
        if (!last) {
            const f32x4* sh = (const f32x4*)(modn + b * 6144); const f32x4* sc = (const f32x4*)(modn + b * 6144 + 1024); f32x4 shv[4], scv[4];
#pragma unroll
            for (int j = 0; j < 4; ++j) { shv[j] = sh[F.lane + 64 * j]; scv[j] = sc[F.lane + 64 * j]; }
#pragma unroll
            for (int j = 0; j < 4; ++j) { *(u32x2x_t*)(xr + 256 * j) = (u32x2x_t){cvt_pk_bf16(v[j].x, v[j].y), cvt_pk_bf16(v[j].z, v[j].w)}; const f32x4 y = v[j] * rstd * gn[j] * (scv[j] + 1.0f) + shv[j];
                put_h4<F8_IN1 != 0>(H + (size_t)m * HROW_INL(1), F.lane, j, y); }
        } else {
            f32x4* op = (f32x4*)(F.out + (size_t)m * DM) + F.lane;
#pragma unroll
            for (int j = 0; j < 4; ++j) op[64 * j] = v[j] * rstd * gn[j];
        }
    }
#undef CLOAD
}

constexpr int NSAMP = 12, NCHK = 16;
__device__ __forceinline__ int sample_row(int i) { const int r[NSAMP] = {0, 1, 63, 64, 4097, 8191, 8192, 20000, 32767, 32768, 33000, 33791}; int v = 0;
#pragma unroll
    for (int j = 0; j < NSAMP; ++j) v = (i == j) ? r[j] : v; return v; }
__device__ __forceinline__ void dbg_note(Frame& F, int chk, float a, float e, float scale, float tol) {
    float err = fabsf(a - e) / (fabsf(e) + scale); if (!(err == err)) err = 1e30f;
    if (err > tol) atomicAdd(F.ctl + CW_DBG + chk, 1u);
    atomicMax(F.ctl + CW_DBG + 64 + chk, __float_as_uint(err));
}
__device__ __forceinline__ float bfr(float x) { return __uint_as_float(f2bf(x) << 16); }
__device__ __forceinline__ void chk_in(Frame& F, int l, int chk) {
    if (F.vcu >= NSAMP) return;
    const int row = sample_row(F.vcu); const bool ctx = row >= NLAT; const int pos = row % SEQ; const float prow = (float)(pos / 64), pcol = (float)(pos % 64);
    LAS float* raw = (LAS float*)(F.lds + RING_OFF); LAS float* hs = raw + 7168;
    const unsigned char* H = F.ws + WS_H + (size_t)row * DM; const float* W = in_l(F, I_WIN, l, (size_t)DM * DIN);
    for (int k = F.tid; k < DM; k += NTHR) hs[k] = __builtin_amdgcn_cvt_f32_fp8((int)H[k], 0);
    __syncthreads();
    for (int j = F.tid; j < DIN; j += NTHR) { float s = 0.f; for (int k = 0; k < DM; ++k) s += hs[k] * bfr(W[(size_t)k * DIN + j]); raw[j] = s; }
    __syncthreads();
    const bf16 *QA = (const bf16*)(F.ws + WS_QA), *KA = (const bf16*)(F.ws + WS_KA), *VA = (const bf16*)(F.ws + WS_VA), *QB = (const bf16*)(F.ws + WS_QB), *KB = (const bf16*)(F.ws + WS_KB), *VB = (const bf16*)(F.ws + WS_VB);
    const bf16 *CQ = (const bf16*)(F.ws + WS_CQ), *CKR = (const bf16*)(F.ws + WS_CKR), *CKV = (const bf16*)(F.ws + WS_CKV), *GT = (const bf16*)(F.ws + WS_GATES);
    for (int j = F.tid; j < DIN; j += NTHR) {
        float e, a;
        if (j < 1024) {
            const int g = j >> 6, d = j & 63, q = d & 15, blk = d >> 4;
            const float inv = powf(10000.0f, -(float)q / 16.0f), ang = (blk < 2 ? prow : pcol) * inv, c = ctx ? 1.f : cosf(ang), s = ctx ? 0.f : sinf(ang);
            const int da = (blk & 2) * 16 + q, db = da + 16; const float av = raw[g * 64 + da], bv = raw[g * 64 + db];
            e = (blk & 1) ? bv * c + av * s : av * c - bv * s; if (j < 512) e *= QSCALE_AB;
            const int p = 2 * ((blk >> 1) * 16 + q) + (blk & 1);
            a = bf2f((j < 512 ? QA : KA)[(size_t)row * 512 + (g & 7) * 64 + p]);
        } else if (j < 3072) { const int seg = (j - 1024) >> 9, c = (j - 1024) & 511; e = raw[j] * (seg == 1 ? QSCALE_AB : 1.f); a = bf2f((seg == 0 ? VA : seg == 1 ? QB : seg == 2 ? KB : VB)[(size_t)row * 512 + c]); }
        else if (j < 3456) { e = raw[j]; a = bf2f(CQ[(size_t)row * 384 + (j - 3072)]); }
        else if (j < 3712) { e = raw[j]; a = bf2f(CKV[(size_t)row * 256 + (j - 3456)]); }
        else if (j < 3744) { const int d = j - 3712, q = d & 7, blk = d >> 3; const float inv = powf(10000.0f, -(float)q / 8.0f), ang = (blk < 2 ? prow : pcol) * inv, c = ctx ? 1.f : cosf(ang), s = ctx ? 0.f : sinf(ang);
            const int da = (blk & 2) * 8 + q, db = da + 8; const float av = raw[3712 + da], bv = raw[3712 + db];
            e = (blk & 1) ? bv * c + av * s : av * c - bv * s; const int p = 2 * ((blk >> 1) * 8 + q) + (blk & 1); a = bf2f(CKR[(size_t)row * 32 + p]); }
        else { e = 1.0f / (1.0f + expf(-raw[j])); a = bf2f(GT[(size_t)row * 3072 + (j - 3744)]); }
        dbg_note(F, chk, a, e, 0.1f, 0.25f);
    }
    if (F.tid == 0) { float sq = 0.f, sk = 0.f; for (int j = 3072; j < 3456; ++j) sq += raw[j] * raw[j]; for (int j = 3456; j < 3712; ++j) sk += raw[j] * raw[j];
        const float* ssq = (const float*)(F.ws + CTL_SSQ); float a = 0.f, b = 0.f; for (int i = 0; i < 8; ++i) a += ssq[(size_t)row * 8 + i]; for (int i = 0; i < 4; ++i) b += ssq[(size_t)MTOT * 8 + (size_t)row * 4 + i]; dbg_note(F, chk, a, sq, 0.05f, 0.1f); dbg_note(F, chk, b, sk, 0.05f, 0.1f); }
    __syncthreads();
}
__device__ __forceinline__ void p_dbg_emit(Frame& F) {
    int id = 0; float me = 0.f;
    for (int c = 1; c < NCHK; ++c) { const unsigned n = F.ctl[CW_DBG + c]; const float e = __uint_as_float(F.ctl[CW_DBG + 64 + c]); if (id == 0) { if (n > 0u) { id = c; me = e; } else me = fmaxf(me, e); } }
    float k = rintf(10.0f * (log10f(fmaxf(me, 1e-6f)) + 6.0f)); k = fminf(fmaxf(k, 0.f), 89.f);
    const float A = sqrtf((float)((10 + id) * 10) - 1.0f), Bv = (10.0f + k) * 100.0f;
    for (size_t i = (size_t)blockIdx.x * NTHR + F.tid; i < (size_t)NLAT * DM; i += (size_t)F.G * NTHR) { unsigned h = (unsigned)i * 2654435761u; h ^= h >> 15; h *= 2246822519u; h ^= h >> 13; F.out[i] = (i == 0) ? Bv : ((h & 1u) ? A : -A); }
}

__device__ __forceinline__ void chk_qkv(Frame& F, int l, int chk) {
    if (F.vcu >= NSAMP) return;
    const int row = sample_row(F.vcu); const bool ctx = row >= NLAT; const int pos = row % SEQ; const float prow = (float)(pos / 64), pcol = (float)(pos % 64);
    LAS float* raw = (LAS float*)(F.lds + RING_OFF);
    const bf16* CQ = (const bf16*)(F.ws + WS_CQ) + (size_t)row * 384; const bf16* CKV = (const bf16*)(F.ws + WS_CKV) + (size_t)row * 256;
    const float* ssq = (const float*)(F.ws + CTL_SSQ); float sqa = 0.f, ska = 0.f; for (int i = 0; i < 8; ++i) sqa += ssq[(size_t)row * 8 + i]; for (int i = 0; i < 4; ++i) ska += ssq[(size_t)MTOT * 8 + (size_t)row * 4 + i];
    const float rq = 1.0f / sqrtf(sqa / 384.0f + EPS), rk = 1.0f / sqrtf(ska / 256.0f + EPS);
    const float* Wq = in_l(F, I_WQB, l, 384 * 768); const float* gq = in_l(F, I_GQA, l, 384); const float* Wk = in_l(F, I_WKVB, l, 256 * 1024); const float* gk = in_l(F, I_GKVA, l, 256);
    for (int n = F.tid; n < 768; n += NTHR) { float s = 0.f; for (int k = 0; k < 384; ++k) s += bf2f(CQ[k]) * bfr(Wq[(size_t)k * 768 + n] * gq[k]); raw[n] = s * rq * QSCALE_C; }
    __syncthreads();
    const bf16* QC = (const bf16*)(F.ws + WS_QC) + (size_t)row * 768;
    for (int n = F.tid; n < 768; n += NTHR) { const int h = n / 96, p = n % 96; float e, a;
        if (p < 64) { e = raw[n]; a = bf2f(QC[n]); }
        else { const int d = p - 64, q = d & 7, blk = d >> 3; const float inv = powf(10000.0f, -(float)q / 8.0f), ang = (blk < 2 ? prow : pcol) * inv, c = ctx ? 1.f : cosf(ang), s = ctx ? 0.f : sinf(ang);
            const int da = (blk & 2) * 8 + q, db = da + 8; const float av = raw[h * 96 + 64 + da], bv = raw[h * 96 + 64 + db];
            e = (blk & 1) ? bv * c + av * s : av * c - bv * s; a = bf2f(QC[h * 96 + 64 + 2 * ((blk >> 1) * 8 + q) + (blk & 1)]); }
        dbg_note(F, chk, a, e, 0.05f, 0.03f); }
    const bf16* KCN = (const bf16*)(F.ws + WS_KCN) + (size_t)row * 512; const bf16* VC = (const bf16*)(F.ws + WS_VC) + (size_t)row * 512;
    for (int n = F.tid; n < 1024; n += NTHR) { float s = 0.f; for (int k = 0; k < 256; ++k) s += bf2f(CKV[k]) * bfr(Wk[(size_t)k * 1024 + n] * gk[k]); s *= rk;
        const int h = n >> 7, d = n & 127; const float a = d < 64 ? bf2f(KCN[h * 64 + d]) : bf2f(VC[h * 64 + d - 64]); dbg_note(F, chk, a, s, 0.05f, 0.03f); }
    __syncthreads();
}
__device__ __forceinline__ void naive_attn(Frame& F, LAS float* sc, LAS float* red, LAS float* res, const bf16* q, int dk1, const bf16* K1, const bf16* q2, int dk2, const bf16* K2, const bf16* V, int dv,
                                           int lat0, int nlat, int ctx0, int nctx, int mode, const float* rpb_h, int rq, int cq, int kr_lo) {
    const int NK = nlat + nctx;
    for (int i = F.tid; i < NK; i += NTHR) { const size_t kr = i < nlat ? (size_t)lat0 + i : (size_t)ctx0 + (i - nlat); float s = 0.f;
        for (int d = 0; d < dk1; ++d) s += bf2f(q[d]) * bf2f(K1[kr * 512 + d]);
        for (int d = 0; d < dk2; ++d) s += bf2f(q2[d]) * bf2f(K2[kr * 32 + d]);
        if (mode == 1 && i < nlat) { const int krr = kr_lo + i / 64, ck = i % 64, rs = min(max(rq - 4, 0), 120), cs = min(max(cq - 8, 0), 48);
            if (krr < rs || krr >= rs + 8 || ck < cs || ck >= cs + 16) s = -INFINITY; else s += rpb_h[(krr - rq + 7) * 31 + min(max(ck - cq + 15, 0), 30)] * LOG2E; }
        sc[i] = s; }
    __syncthreads();
    float mx = -INFINITY; for (int i = F.tid; i < NK; i += NTHR) mx = fmaxf(mx, sc[i]);
    for (int o = 1; o < 64; o <<= 1) mx = fmaxf(mx, __shfl_xor(mx, o)); if (F.lane == 0) red[F.wave] = mx; __syncthreads();
    mx = red[0]; for (int w = 1; w < 8; ++w) mx = fmaxf(mx, red[w]); __syncthreads();
    float sm = 0.f; for (int i = F.tid; i < NK; i += NTHR) { const float p = exp2f(sc[i] - mx); sc[i] = p; sm += p; }
    sm = wave_sum(sm); if (F.lane == 0) red[F.wave] = sm; __syncthreads();
    sm = 0.f; for (int w = 0; w < 8; ++w) sm += red[w];
    if (F.tid < dv) { float a = 0.f; for (int i = 0; i < NK; ++i) { const size_t kr = i < nlat ? (size_t)lat0 + i : (size_t)ctx0 + (i - nlat); a += sc[i] * bf2f(V[kr * 512 + F.tid]); } res[F.tid] = a / sm; }
    __syncthreads();
}
__device__ __forceinline__ void chk_attn(Frame& F, int l, int chk) {
    if (F.vcu >= NSAMP) return;
    const int row = sample_row(F.vcu); const bool ctx = row >= NLAT; if (ctx && l > 0) return;
    const int b = ctx ? (row - NLAT) / CTXL : row / SEQ, pos = row % SEQ, rq = pos / 64, cq = pos % 64;
    LAS float* sc = (LAS float*)(F.lds + RING_OFF); LAS float* red = sc + 8704; LAS float* res = red + 16; LAS float* res0 = res + 128;
    const int lat0 = b * SEQ, nlat = ctx ? 0 : SEQ, ctx0 = NLAT + b * CTXL;
    const bf16 *QA = (const bf16*)(F.ws + WS_QA), *KA = (const bf16*)(F.ws + WS_KA), *VA = (const bf16*)(F.ws + WS_VA), *QB = (const bf16*)(F.ws + WS_QB), *KB = (const bf16*)(F.ws + WS_KB), *VB = (const bf16*)(F.ws + WS_VB);
    const bf16 *QC = (const bf16*)(F.ws + WS_QC), *KCN = (const bf16*)(F.ws + WS_KCN), *VC = (const bf16*)(F.ws + WS_VC), *CKR = (const bf16*)(F.ws + WS_CKR);
    const bf16 *YA = (const bf16*)(F.ws + WS_YA), *YB = (const bf16*)(F.ws + WS_YB), *YC = (const bf16*)(F.ws + WS_YC);
    const float* lamp = (const float*)(F.ws + WS_TAB) + 192 * 16 * 2 + 192 * 8 * 2; const float lam = lamp[2 * l], lam_init = lamp[2 * l + 1]; const float* gsub = in_l(F, I_GSUB, l, 128);
    { const float lr = expf(0.f); (void)lr; }
    for (int h = 0; h < 4; ++h) {
        naive_attn(F, sc, red, res, QA + (size_t)row * 512 + h * 128, 64, KA + h * 128, nullptr, 0, nullptr, VA + h * 128, 128, lat0, nlat, ctx0, CTXL, 0, nullptr, 0, 0, 0);
        if (F.tid < 128) res0[F.tid] = res[F.tid]; __syncthreads();
        naive_attn(F, sc, red, res, QA + (size_t)row * 512 + h * 128 + 64, 64, KA + h * 128 + 64, nullptr, 0, nullptr, VA + h * 128, 128, lat0, nlat, ctx0, CTXL, 0, nullptr, 0, 0, 0);
        if (F.tid < 128) res0[F.tid] = res0[F.tid] - lam * res[F.tid]; __syncthreads();
        float ss = 0.f; for (int d = 0; d < 128; ++d) ss += res0[d] * res0[d];
        if (F.tid < 128) { const float e = res0[F.tid] / sqrtf(ss / 128.0f + EPS) * gsub[F.tid] * (1.0f - lam_init); dbg_note(F, chk, bf2f(YA[(size_t)row * 512 + h * 128 + F.tid]), e, 0.1f, 0.04f); }
        __syncthreads();
    }
    for (int h = 0; h < 8; ++h) {
        const int kr_lo = min(max(rq - 4, 0), 120);
        if (ctx) naive_attn(F, sc, red, res, QB + (size_t)row * 512 + h * 64, 64, KB + h * 64, nullptr, 0, nullptr, VB + h * 64, 64, 0, 0, ctx0, CTXL, 0, nullptr, 0, 0, 0);
        else naive_attn(F, sc, red, res, QB + (size_t)row * 512 + h * 64, 64, KB + h * 64, nullptr, 0, nullptr, VB + h * 64, 64, lat0 + kr_lo * 64, 512, ctx0, CTXL, 1, in_l(F, I_RPB, l, 8 * 15 * 31) + h * 465, rq, cq, kr_lo);
        if (F.tid < 64) dbg_note(F, chk + 1, bf2f(YB[(size_t)row * 512 + h * 64 + F.tid]), res[F.tid], 0.02f, 0.04f);
        __syncthreads();
        naive_attn(F, sc, red, res, QC + (size_t)row * 768 + h * 96, 64, KCN + h * 64, QC + (size_t)row * 768 + h * 96 + 64, 32, CKR, VC + h * 64, 64, lat0, nlat, ctx0, CTXL, 0, nullptr, 0, 0, 0);
        if (F.tid < 64) dbg_note(F, chk + 2, bf2f(YC[(size_t)row * 512 + h * 64 + F.tid]), res[F.tid], 0.01f, 0.04f);
        __syncthreads();
    }
}
__device__ __forceinline__ void chk_merge(Frame& F, int l, int chk) {
    if (F.vcu >= NSAMP) return; const int row = sample_row(F.vcu); if (row >= NLAT && l > 0) return;
    const bf16* Y = (const bf16*)(F.ws + WS_YA); const bf16* GT = (const bf16*)(F.ws + WS_GATES) + (size_t)row * 3072; const bf16* MB = (const bf16*)(F.ws + WS_MB) + (size_t)row * 1024;
    for (int n = F.tid; n < 1024; n += NTHR) { float m = 0.f;
        for (int br = 0; br < 3; ++br) { const float* W = in_l(F, br == 0 ? I_WBRA : br == 1 ? I_WBRB : I_WBRC, l, 512 * 1024); const bf16* y = Y + (size_t)br * MTOT * 512 + (size_t)row * 512; float s = 0.f;
            for (int k = 0; k < 512; ++k) s += bf2f(y[k]) * bfr(W[(size_t)k * 1024 + n]); m += bf2f(GT[br * 1024 + n]) * s; }
        dbg_note(F, chk, bf2f(MB[n]), m, 0.05f, 0.03f); }
}
__device__ __forceinline__ void chk_out(Frame& F, int l, int chk, const float* xprev) {
    if (F.vcu >= NSAMP || l > 0) return; const int row = sample_row(F.vcu); const int b = row < NLAT ? row / SEQ : 4;
    const float* xs = row < NLAT ? F.in[I_X] + (size_t)row * DM : F.in[I_CTX] + (size_t)(row - NLAT) * DM; const bf16* MB = (const bf16*)(F.ws + WS_MB) + (size_t)row * 1024;
    const float* W = in_l(F, I_WOUT, l, 1024 * 1024); const float* gt = (const float*)(F.ws + WS_MODV) + (size_t)(l * 5 + b) * 6144 + 2048; const float* X = (const float*)(F.ws + WS_X) + (size_t)row * DM;
    for (int n = F.tid; n < 1024; n += NTHR) { float s = 0.f; for (int k = 0; k < 1024; ++k) s += bf2f(MB[k]) * bfr(W[(size_t)k * 1024 + n]); dbg_note(F, chk, X[n], xs[n] + gt[n] * s, 0.1f, 0.01f); }
}
__device__ __forceinline__ void chk_route(Frame& F, int l, int chk) {
    if (F.vcu >= NSAMP) return; const int row = sample_row(F.vcu); if (row >= NLAT && l > 0) return; const int b = row < NLAT ? row / SEQ : 4;
    LAS float* h2 = (LAS float*)(F.lds + RING_OFF); LAS float* lg = h2 + 1024;
    const float* X = (const float*)(F.ws + WS_X) + (size_t)row * DM; const float* modv = (const float*)(F.ws + WS_MODV) + (size_t)(l * 5 + b) * 6144; const float* g = in_l(F, I_GFFN, l, DM);
    float ss = 0.f; for (int k = 0; k < DM; ++k) ss += X[k] * X[k]; const float rstd = 1.0f / sqrtf(ss / DM + EPS);
    const unsigned char* H = F.ws + WS_H + (size_t)row * DM;
    for (int k = F.tid; k < DM; k += NTHR) { const float v = X[k] * rstd * g[k] * (1.0f + modv[4096 + k]) + modv[3072 + k]; h2[k] = v; dbg_note(F, chk, __builtin_amdgcn_cvt_f32_fp8((int)H[k], 0), v, 0.05f, 0.08f); }
    __syncthreads();
    if (F.tid < 32) { const float* Wr = in_l(F, I_WROUT, l, 1024 * 32); float s = 0.f; for (int k = 0; k < DM; ++k) s += h2[k] * Wr[k * 32 + F.tid]; lg[F.tid] = s + in_l(F, I_BROUT, l, 32)[F.tid]; }
    __syncthreads();
    if (F.tid == 0) { int te[4]; float tv[4];
        for (int k = 0; k < 4; ++k) { int bi = 0; float bv = lg[0]; for (int e = 1; e < 32; ++e) { const float x = lg[e]; if (x > bv) { bv = x; bi = e; } } te[k] = bi; tv[k] = bv; lg[bi] = -INFINITY; }
        const float den = 1.0f + expf(tv[1] - tv[0]) + expf(tv[2] - tv[0]) + expf(tv[3] - tv[0]);
        const int* rt_e = (const int*)(F.ws + WS_ROUTE + RT_E); const float* rt_w = (const float*)(F.ws + WS_ROUTE + RT_W);
#pragma unroll
        for (int k = 0; k < 4; ++k) { dbg_note(F, chk, (float)rt_e[(size_t)row * 4 + k], (float)te[k], 1.0f, 0.001f); dbg_note(F, chk, rt_w[(size_t)row * 4 + k], expf(tv[k] - tv[0]) / den, 0.1f, 0.001f); } }
    __syncthreads();
}
__device__ __forceinline__ void chk_moe(Frame& F, int l, int chk) {
    if (F.vcu >= NSAMP) return; const int row = sample_row(F.vcu); if (row >= NLAT && l > 0) return;
    LAS float* hs = (LAS float*)(F.lds + RING_OFF); LAS float* act = hs + 1024;
    const unsigned char* H = F.ws + WS_H + (size_t)row * DM; for (int k = F.tid; k < DM; k += NTHR) hs[k] = __builtin_amdgcn_cvt_f32_fp8((int)H[k], 0);
    __syncthreads();
    const int* rt_e = (const int*)(F.ws + WS_ROUTE + RT_E); const float* rt_w = (const float*)(F.ws + WS_ROUTE + RT_W); const bf16* YB = (const bf16*)(F.ws + WS_YBUF);
    for (int kk = 0; kk < 4; ++kk) { const int e = rt_e[(size_t)row * 4 + kk]; const float w = rt_w[(size_t)row * 4 + kk];
        const float* Wg = in_l(F, I_WGU, l * NEXP + e, (size_t)1024 * 2048); const float* bg = in_l(F, I_BGU, l * NEXP + e, 2048); const float* Wd = in_l(F, I_WDN, l * NEXP + e, (size_t)1024 * 1024); const float* bd = in_l(F, I_BDN, l * NEXP + e, 1024);
        for (int j = F.tid; j < 1024; j += NTHR) { float sg = 0.f, su = 0.f; for (int k = 0; k < DM; ++k) { sg += hs[k] * bfr(Wg[(size_t)k * 2048 + 2 * j]); su += hs[k] * bfr(Wg[(size_t)k * 2048 + 2 * j + 1]); }
            sg += bg[2 * j]; su += bg[2 * j + 1]; const float ga = fminf(sg, 7.0f), ua = fminf(fmaxf(su, -7.0f), 7.0f); act[j] = bfr((ua + 1.0f) * (ga / (1.0f + expf(-1.702f * ga)))); }
        __syncthreads();
        for (int n = F.tid; n < 1024; n += NTHR) { float s = 0.f; for (int j = 0; j < 1024; ++j) s += act[j] * bfr(Wd[(size_t)j * 1024 + n]); dbg_note(F, chk, bf2f(YB[(size_t)(row * 4 + kk) * 1024 + n]), (s + bd[n]) * w, 0.05f, 0.3f); }
        __syncthreads(); }
}

constexpr int PH_PRO_A = 0, PH_PRO_B = 1, PH_L0 = 2, NPL = 11, N_PHASES = PH_L0 + DEPTH * NPL;
enum { LP_IN = 0, LP_QKV, LP_VT, LP_ATTN, LP_MERGE, LP_OUT, LP_ROUTE, LP_GATHER, LP_GU, LP_DN, LP_COMB };

__global__ void __launch_bounds__(NTHR, 2) trunk_fwd(Args args) {
    extern __shared__ __attribute__((aligned(16))) unsigned char lds[];
    Frame F;
    F.lds = (LAS unsigned char*)lds; F.MISC = (volatile LAS unsigned*)(F.lds + MISC_OFF);
    F.tid = threadIdx.x; F.lane = F.tid & 63; F.wave = __builtin_amdgcn_readfirstlane(F.tid >> 6);
    F.G = gridDim.x; { const int bx = blockIdx.x; F.vcu = (F.G % 8 == 0) ? (bx % 8) * (F.G / 8) + bx / 8 : bx; }
    F.ws = args.ws; F.ctl = (unsigned*)(args.ws + WS_CTL); F.in = args.in; F.out = args.out;
    for (int u = F.tid; u < (LDS_BYTES - TBL_OFF) / 4; u += NTHR) ((LAS unsigned*)(F.lds + TBL_OFF))[u] = 0u;
    __syncthreads();
    const int lo = args.ph_lo, hi = args.ph_hi;
#if DBG_CHECK
    if (lo >= 1000) { const int c = lo - 1000;
        if (c == 1) chk_in(F, 0, 1); else if (c == 2) chk_qkv(F, 0, 2); else if (c == 3) chk_attn(F, 0, 3); else if (c == 6) chk_merge(F, 0, 6); else if (c == 7) chk_out(F, 0, 7, nullptr);
        else if (c == 8) chk_route(F, 0, 8); else if (c == 9) chk_moe(F, 0, 9); else if (c == 11) chk_in(F, 1, 11); else if (c == 13) chk_attn(F, 1, 13); else if (c == 99) p_dbg_emit(F);
        return; }
#endif
    XcdBarrier bar; bar.bar = F.ctl + CW_BAR; bar.x = 0; bar.st = nullptr;
    if (MK_ONE_LAUNCH) bar = xcd_barrier_post(F.ctl + CW_BAR, F.MISC + 8);
#define IN(k) (lo <= (k) && (k) < hi)
#define SEAM(k) do { F.tid = threadIdx.x; asm volatile("" : "+v"(F.tid)); F.lane = F.tid & 63; asm volatile("" : "+s"(F.ws), "+s"(bar.bar), "+s"(F.lds), "+s"(bar.st));     \
        if (MK_ONE_LAUNCH && IN(k) && IN((k) + 1)) xcd_barrier(bar); } while (0)

    if (IN(PH_PRO_A)) { p_prologue_a(F); if (DUP_MASK & 4) { __syncthreads(); p_prologue_a(F); } } SEAM(PH_PRO_A);
    if (IN(PH_PRO_B)) { p_prologue_b(F); if (DUP_MASK & 512) { __syncthreads(); p_prologue_b(F); } } SEAM(PH_PRO_B);
    for (int l = 0; l < DEPTH; ++l) {
        F.tid = threadIdx.x; asm volatile("" : "+v"(F.tid)); F.lane = F.tid & 63;
        int bx_ = (int)blockIdx.x; asm volatile("" : "+s"(bx_), "+s"(F.G), "+s"(F.vcu));
        const int pb = PH_L0 + l * NPL; const int Ml = (l == DEPTH - 1) ? NLAT : MTOT;
        float* ssq_q = (float*)(F.ws + CTL_SSQ); float* ssq_kv = ssq_q + (size_t)MTOT * 8;
        const float* tabA = (const float*)(F.ws + WS_TAB); const float* tabC = tabA + 192 * 16 * 2;
        if (IN(pb + LP_IN)) for (int rep_ = 0; rep_ < (((DUP_MASK & 2) || (DUP_MASK & 8)) ? 2 : 1); ++rep_) {
            Gemm g{(const bf16_t*)(F.ws + WS_H), (const bf16_t*)(F.ws + WS_WIN + (size_t)l * NINP * DM * 2), MTOT, NINP, F8_INL(l) ? DM / 2 : DM};   StaticOrder S; S.init(MTOT, NINP, F.G, bx_);
            EpiIn E{(bf16_t*)(F.ws + WS_QA), (bf16_t*)(F.ws + WS_KA), (bf16_t*)(F.ws + WS_VA), (bf16_t*)(F.ws + WS_QB), (bf16_t*)(F.ws + WS_KB), (bf16_t*)(F.ws + WS_VB),
                    (bf16_t*)(F.ws + WS_CQ), (bf16_t*)(F.ws + WS_CKR), (bf16_t*)(F.ws + WS_CKV), (bf16_t*)(F.ws + WS_GATES), ssq_q, ssq_kv, tabA, tabC, F8_INL(l) ? WINV : 1.0f, F.ws + WS_VTA};
            if (F8_INL(l)) gemm_phase<EpiIn, StaticOrder, true, true, true>(F.lds + RING_OFF, g, S, E); else gemm_phase<EpiIn, StaticOrder, true, true, false>(F.lds + RING_OFF, g, S, E);
        }
        SEAM(pb + LP_IN);
        if (IN(pb + LP_QKV)) for (int rep_ = 0; rep_ < (((DUP_MASK & 2) || (DUP_MASK & 16)) ? 2 : 1); ++rep_) {
            { Gemm g{(const bf16_t*)(F.ws + WS_CQ), (const bf16_t*)(F.ws + WS_WQB) + (size_t)l * 768 * 384, MTOT, 768, 384}; StaticOrder S; S.init(MTOT, 768, F.G, bx_);
              EpiQ E{(bf16_t*)(F.ws + WS_QC), ssq_q, tabC}; gemm_phase<EpiQ, StaticOrder, true, true>(F.lds + RING_OFF, g, S, E); }
            { Gemm g{(const bf16_t*)(F.ws + WS_CKV), (const bf16_t*)(F.ws + WS_WKVB) + (size_t)l * 1024 * 256, MTOT, 1024, 256}; StaticOrder S; S.init(MTOT, 1024, F.G, bx_);
              EpiKV E{(bf16_t*)(F.ws + WS_KCN), (bf16_t*)(F.ws + WS_VC), ssq_kv, F.ws + WS_VTC}; gemm_phase<EpiKV, StaticOrder, true, true>(F.lds + RING_OFF, g, S, E); }
        }
        SEAM(pb + LP_QKV);
        if (IN(pb + LP_ATTN)) { p_attention(F, l); if (DUP_MASK & 1) { __syncthreads(); p_attention(F, l); } }
        SEAM(pb + LP_ATTN);
        if (IN(pb + LP_MERGE)) for (int rep_ = 0; rep_ < (((DUP_MASK & 2) || (DUP_MASK & 32)) ? 2 : 1); ++rep_) {
            Gemm g{(const bf16_t*)(F.ws + WS_YA), (const bf16_t*)(F.ws + WS_WBR + (size_t)l * 3 * 1024 * 512), Ml, 1024, 256};   MergeOrder S; S.S.init(Ml, 1024, F.G, bx_);
            EpiMerge E{(const bf16_t*)(F.ws + WS_GATES), F.ws + WS_M32, (bf16_t*)(F.ws + WS_MB)}; gemm_phase<EpiMerge, MergeOrder, true, true, true>(F.lds + RING_OFF, g, S, E);
        }
        SEAM(pb + LP_MERGE);
        if (IN(pb + LP_OUT)) for (int rep_ = 0; rep_ < (((DUP_MASK & 1024) && l == 0) ? 2 : 1); ++rep_) {
            Gemm g{(const bf16_t*)(F.ws + WS_M32), (const bf16_t*)(F.ws + WS_WOUT + (size_t)l * 1024 * 1024), Ml, 1024, 512};   StaticOrder S; S.init(Ml, 1024, F.G, bx_);
            EpiOut E{F.in[I_X], F.in[I_CTX], (bf16_t*)(F.ws + WS_X), (const float*)(F.ws + WS_MODV) + (size_t)l * 5 * 6144, l == 0};
            gemm_phase<EpiOut, StaticOrder, true, true, true>(F.lds + RING_OFF, g, S, E);
        }
        SEAM(pb + LP_OUT);
        if (IN(pb + LP_ROUTE)) { if (DUP_MASK & 2048) { p_route(F, l, Ml, 2 + l); __syncthreads(); } p_route(F, l, Ml, l); }
        SEAM(pb + LP_ROUTE);
        if (IN(pb + LP_GU)) for (int rep_ = 0; rep_ < (((DUP_MASK & 2) || (DUP_MASK & 64)) ? 2 : 1); ++rep_) {
            const int T = build_expert_tables(F, l);
            Gemm g{(const bf16_t*)(F.ws + WS_H), (const bf16_t*)(F.ws + WS_WGU + (size_t)l * NEXP * 2048 * 1024 * (F8_MOE ? 1 : 2)), T * 256, 2048, F8_MOE ? 512 : 1024, (const int*)(F.ws + WS_ROUTE + RT_YSRC)};
            ExpertOrder S; S.S.init(T * 256, 2048, F.G, bx_); S.tile_e = (const LAS int*)(F.lds + TBL_OFF + TB_TILE); S.nNe = 8;
            S.xs = (const int*)(F.ws + WS_XS); S.base = (const LAS int*)(F.lds + TBL_OFF + TB_BASE); S.cnt = (const LAS int*)(F.lds + TBL_OFF + TB_CNT);
            EpiGU E{(bf16_t*)(F.ws + WS_ACT), in_l(F, I_BGU, l, NEXP * 2048)}; gemm_phase<EpiGU, ExpertOrder, true, true, F8_MOE != 0, true>(F.lds + RING_OFF, g, S, E);
        }
        SEAM(pb + LP_GU);
        if (IN(pb + LP_DN)) for (int rep_ = 0; rep_ < (((DUP_MASK & 2) || (DUP_MASK & 128)) ? 2 : 1); ++rep_) {
            const int T = build_expert_tables(F, l);
            Gemm g{(const bf16_t*)(F.ws + WS_ACT), (const bf16_t*)(F.ws + WS_WDN + (size_t)l * NEXP * 1024 * 1024 * (F8_MOE ? 1 : 2)), T * 256, 1024, F8_MOE ? 512 : 1024};
            ExpertOrder S; S.S.init(T * 256, 1024, F.G, bx_); S.tile_e = (const LAS int*)(F.lds + TBL_OFF + TB_TILE); S.nNe = 4;
            EpiDown E{(bf16_t*)(F.ws + WS_YBUF), in_l(F, I_BDN, l, NEXP * 1024), (const int*)(F.ws + WS_XS), (const float*)(F.ws + WS_XW), (const LAS int*)(F.lds + TBL_OFF + TB_BASE), (const LAS int*)(F.lds + TBL_OFF + TB_CNT)};
            gemm_phase<EpiDown, ExpertOrder, true, true, F8_MOE != 0>(F.lds + RING_OFF, g, S, E);
        }
        SEAM(pb + LP_DN);
        if (IN(pb + LP_COMB)) p_combine(F, l, Ml);
        SEAM(pb + LP_COMB);
    }
#undef IN
#undef SEAM
}

extern "C" void kernel_launch(void* const* d_in, const int* in_sizes, int n_in, void* d_out, int out_size, void* d_ws, size_t ws_size, hipStream_t stream) {
    static int grid = 0;
    if (grid == 0) {
        if (n_in != 30 || out_size != NLAT * DM || ws_size < WS_END) { fprintf(stderr, "kernel_launch: shape mismatch n_in %d out %d ws %zu (need %zu)\n", n_in, out_size, ws_size, (size_t)WS_END); grid = -1; return; }
        int dev = 0, cus = 0, per_cu = 0;
        if (hipGetDevice(&dev) != hipSuccess || hipDeviceGetAttribute(&cus, hipDeviceAttributeMultiprocessorCount, dev) != hipSuccess) { grid = -1; return; }
        if (hipFuncSetAttribute((const void*)trunk_fwd, hipFuncAttributeMaxDynamicSharedMemorySize, LDS_BYTES) != hipSuccess) { fprintf(stderr, "kernel_launch: hipFuncSetAttribute failed\n"); grid = -1; return; }
        if (hipOccupancyMaxActiveBlocksPerMultiprocessor(&per_cu, (const void*)trunk_fwd, NTHR, LDS_BYTES) != hipSuccess || per_cu < 1) { fprintf(stderr, "kernel_launch: occupancy query says %d\n", per_cu); }
        (void)hipGetLastError();
        grid = cus;
    }
    if (grid < 0) return;
    (void)hipMemsetAsync((char*)d_ws + WS_CTL, 0, CTL_ZERO_BYTES, stream);
    Args a{};
    for (int i = 0; i < 30; ++i) a.in[i] = (const float*)d_in[i];
    a.out = (float*)d_out; a.ws = (unsigned char*)d_ws;
#if MK_ONE_LAUNCH
    a.ph_lo = 0; a.ph_hi = N_PHASES;
    hipLaunchKernelGGL(trunk_fwd, dim3(grid), dim3(NTHR), LDS_BYTES, stream, a);
#else
    for (int p = 0; p < N_PHASES; ++p) { a.ph_lo = p; a.ph_hi = p + 1; hipLaunchKernelGGL(trunk_fwd, dim3(grid), dim3(NTHR), LDS_BYTES, stream, a);
#if DBG_CHECK
        int c = 0; const int q = p - PH_L0;
        if (q == LP_IN) c = 1; else if (q == LP_QKV) c = 2; else if (q == LP_ATTN) c = 3; else if (q == LP_MERGE) c = 6; else if (q == LP_OUT) c = 7; else if (q == LP_ROUTE) c = 8; else if (q == LP_DN) c = 9;
        else if (q == NPL + LP_IN) c = 11; else if (q == NPL + LP_ATTN) c = 13;
        if (c) { a.ph_lo = 1000 + c; a.ph_hi = 0; hipLaunchKernelGGL(trunk_fwd, dim3(grid), dim3(NTHR), LDS_BYTES, stream, a); }
        if (p == DBG_LAST_PHASE) break;
#endif
    }
#if DBG_CHECK
    a.ph_lo = 1099; a.ph_hi = 0; hipLaunchKernelGGL(trunk_fwd, dim3(grid), dim3(NTHR), LDS_BYTES, stream, a);
#endif
#endif
    const hipError_t le = hipPeekAtLastError();
    if (le != hipSuccess) fprintf(stderr, "kernel_launch: launch failed: %s\n", hipGetErrorName(le));
}
```
